# Optimizing an MI355X kernel written in HIP

```python
import math
import jax, jax.numpy as jnp
from jax import lax
import numpy as np

D_MODEL = 1024
BATCH = 4
SEQ = 4096
DEPTH = 2

HEAD_DIM = 64
MOBA_HEADS = 8
DSA_HEADS = 8
MOBA_BLOCK = 256
MOBA_TOPK = 3
MOBA_QCHUNK = 32
DSA_TOPK = 256
DSA_QBLOCK = 128
IDX_HEADS = 4
IDX_DIM = 64
REL_BUCKETS = 32
REL_MAX_DIST = 1024
MLA_HEADS = 16
MLA_Q_RANK = 384
MLA_KV_RANK = 256
MLA_NOPE = 64
MLA_ROPE = 32
MLA_V = 64
MLA_QK = MLA_NOPE + MLA_ROPE
MLA_QBLOCK = 128
ROPE_BASE = 10000.0
D_FF_DENSE = 2816
N_EXPERTS = 8
TOP_K = 2
D_FF_EXPERT = 3584
EPS = 1e-6

EVEN_IN_SIZES = [MOBA_HEADS * HEAD_DIM] * 3 + [DSA_HEADS * HEAD_DIM] * 3 + [IDX_HEADS * IDX_DIM, IDX_DIM, IDX_HEADS]
D_IN_EVEN = sum(EVEN_IN_SIZES)
ODD_IN_SIZES = [MLA_Q_RANK, MLA_KV_RANK, MLA_ROPE]
D_IN_ODD = sum(ODD_IN_SIZES)

kernel_name = "hybrid_moba_dsa_mla_moe"


def _split(a, sizes):
    return jnp.split(a, [int(s) for s in np.cumsum(sizes)[:-1]], axis=-1)


def rmsnorm(x, g):
    xf = x.astype(jnp.float32)
    y = xf * lax.rsqrt(jnp.mean(xf * xf, axis=-1, keepdims=True) + EPS)
    return (y * g.astype(jnp.float32)).astype(x.dtype)


def rel_bucket(dist):
    n = jnp.maximum(dist, 0)
    max_exact = REL_BUCKETS // 2
    nf = jnp.maximum(n, 1).astype(jnp.float32)
    large = max_exact + (jnp.log(nf / max_exact) / math.log(REL_MAX_DIST / max_exact)
                         * (REL_BUCKETS - max_exact)).astype(jnp.int32)
    large = jnp.minimum(large, REL_BUCKETS - 1)
    return jnp.where(n < max_exact, n, large)


def moba_attention(q, k, v, rel_bias_h):
    B, S, H, Dh = q.shape
    nb = -(-S // MOBA_BLOCK)
    S_pad = nb * MOBA_BLOCK
    pad = S_pad - S
    to_bhsd = lambda a: jnp.pad(a, ((0, 0), (0, pad), (0, 0), (0, 0))).transpose(0, 2, 1, 3)
    qh, kh, vh = to_bhsd(q), to_bhsd(k), to_bhsd(v)
    kb = kh.reshape(B, H, nb, MOBA_BLOCK, Dh)
    vb = vh.reshape(B, H, nb, MOBA_BLOCK, Dh)
    kmean = jnp.mean(kb.astype(jnp.float32), axis=3)
    n_sel = min(MOBA_TOPK, nb - 1)
    scale = Dh ** -0.5
    bias_t = rel_bias_h.T.astype(jnp.float32)
    head_ix = jnp.arange(H)[None, :, None, None, None]
    gather_blocks = jax.vmap(jax.vmap(lambda a, i: a[i]))

    def chunk(c):
        t0 = c * MOBA_QCHUNK
        tq = t0 + jnp.arange(MOBA_QCHUNK)
        qc = lax.dynamic_slice_in_dim(qh, t0, MOBA_QCHUNK, axis=2)
        blk = t0 // MOBA_BLOCK
        k_own = lax.dynamic_index_in_dim(kb, blk, axis=2, keepdims=False)
        v_own = lax.dynamic_index_in_dim(vb, blk, axis=2, keepdims=False)
        s_own = blk * MOBA_BLOCK + jnp.arange(MOBA_BLOCK)
        lo = jnp.einsum('bhqd,bhkd->bhqk', qc, k_own, preferred_element_type=jnp.float32) * scale
        lo = lo + rel_bias_h.astype(jnp.float32)[rel_bucket(tq[:, None] - s_own[None, :])].transpose(2, 0, 1)[None]
        lo = jnp.where(s_own[None, :] <= tq[:, None], lo, -jnp.inf)
        if n_sel > 0:
            gate = jnp.einsum('bhqd,bhnd->bhqn', qc.astype(jnp.float32), kmean)
            gate = jnp.where(jnp.arange(nb) < blk, gate, -jnp.inf)
            g_val, sel = lax.top_k(gate, n_sel)
            valid = jnp.isfinite(g_val)
            k_sel = gather_blocks(kb, sel)
            v_sel = gather_blocks(vb, sel)
            s_sel = sel[..., None] * MOBA_BLOCK + jnp.arange(MOBA_BLOCK)
            ls = jnp.einsum('bhqd,bhqnkd->bhqnk', qc, k_sel, preferred_element_type=jnp.float32) * scale
            ls = ls + bias_t[head_ix, rel_bucket(tq[None, None, :, None, None] - s_sel)]
            ls = jnp.where(valid[..., None], ls, -jnp.inf)
            ls = ls.reshape(B, H, MOBA_QCHUNK, n_sel * MOBA_BLOCK)
            p = jax.nn.softmax(jnp.concatenate([lo, ls], axis=-1), axis=-1).astype(v.dtype)
            p_own, p_sel = p[..., :MOBA_BLOCK], p[..., MOBA_BLOCK:].reshape(B, H, MOBA_QCHUNK, n_sel, MOBA_BLOCK)
            return (jnp.einsum('bhqk,bhkd->bhqd', p_own, v_own)
                    + jnp.einsum('bhqnk,bhqnkd->bhqd', p_sel, v_sel))
        p = jax.nn.softmax(lo, axis=-1).astype(v.dtype)
        return jnp.einsum('bhqk,bhkd->bhqd', p, v_own)

    out = lax.map(chunk, jnp.arange(S_pad // MOBA_QCHUNK))
    return out.transpose(1, 0, 3, 2, 4).reshape(B, S_pad, H, Dh)[:, :S]


def dsa_attention(q, k, v, iq, ik, iw, rel_bias_h):
    B, S, H, Dh = q.shape
    n_keep = min(DSA_TOPK, S // 4)
    pos = jnp.arange(S)
    scale = Dh ** -0.5
    idx_scale = (IDX_DIM ** -0.5) * (IDX_HEADS ** -0.5)
    ikf = ik.astype(jnp.float32)
    bias = rel_bias_h.astype(jnp.float32)
    gather_keys = jax.vmap(lambda a, i: a[i])

    def block(c):
        t0 = c * DSA_QBLOCK
        tq = t0 + jnp.arange(DSA_QBLOCK)
        qc = lax.dynamic_slice_in_dim(q, t0, DSA_QBLOCK, axis=1)
        iqc = lax.dynamic_slice_in_dim(iq, t0, DSA_QBLOCK, axis=1).astype(jnp.float32)
        iwc = lax.dynamic_slice_in_dim(iw, t0, DSA_QBLOCK, axis=1).astype(jnp.float32)
        rel = jax.nn.relu(jnp.einsum('bqhd,bsd->bqhs', iqc, ikf))
        score = jnp.einsum('bqh,bqhs->bqs', iwc, rel) * idx_scale
        score = jnp.where(pos[None, None, :] <= tq[None, :, None], score, -jnp.inf)
        s_val, s_idx = lax.top_k(score, n_keep)
        valid = jnp.isfinite(s_val)
        k_sel = gather_keys(k, s_idx)
        v_sel = gather_keys(v, s_idx)
        lg = jnp.einsum('bqhd,bqkhd->bhqk', qc, k_sel, preferred_element_type=jnp.float32) * scale
        lg = lg + bias[rel_bucket(tq[None, :, None] - s_idx)].transpose(0, 3, 1, 2)
        lg = jnp.where(valid[:, None], lg, -jnp.inf)
        p = jax.nn.softmax(lg, axis=-1).astype(v.dtype)
        return jnp.einsum('bhqk,bqkhd->bqhd', p, v_sel)

    out = lax.map(block, jnp.arange(S // DSA_QBLOCK))
    return out.transpose(1, 0, 2, 3, 4).reshape(B, S, H, Dh)


def rope(x, pos):
    half = x.shape[-1] // 2
    freqs = ROPE_BASE ** (-jnp.arange(half, dtype=jnp.float32) / half)
    ang = pos.astype(jnp.float32)[:, None] * freqs
    cos, sin = jnp.cos(ang)[:, None, :], jnp.sin(ang)[:, None, :]
    xf = x.astype(jnp.float32)
    x1, x2 = xf[..., :half], xf[..., half:]
    return jnp.concatenate([x1 * cos - x2 * sin, x1 * sin + x2 * cos], axis=-1).astype(x.dtype)


def causal_attention_blocks(q, k, v):
    B, S, H, D = q.shape
    scale = D ** -0.5
    pos = jnp.arange(S)

    def block(c):
        t0 = c * MLA_QBLOCK
        tq = t0 + jnp.arange(MLA_QBLOCK)
        qc = lax.dynamic_slice_in_dim(q, t0, MLA_QBLOCK, axis=1)
        lg = jnp.einsum('bqhd,bshd->bhqs', qc, k, preferred_element_type=jnp.float32) * scale
        lg = jnp.where(pos[None, :] <= tq[:, None], lg, -jnp.inf)
        p = jax.nn.softmax(lg, axis=-1).astype(v.dtype)
        return jnp.einsum('bhqs,bshd->bqhd', p, v)

    out = lax.map(block, jnp.arange(S // MLA_QBLOCK))
    return out.transpose(1, 0, 2, 3, 4).reshape(B, S, H, v.shape[-1])


def sparse_mixers(h, w_in, moba_q_norm, moba_k_norm, dsa_q_norm, dsa_k_norm, rel_bias, w_out):
    B, S, _ = h.shape
    mq, mk, mv, dq, dk, dv, iq, ik, iw = _split(h @ w_in, EVEN_IN_SIZES)
    heads = lambda a, n: a.reshape(B, S, n, HEAD_DIM)
    mq = rmsnorm(heads(mq, MOBA_HEADS), moba_q_norm)
    mk = rmsnorm(heads(mk, MOBA_HEADS), moba_k_norm)
    dq = rmsnorm(heads(dq, DSA_HEADS), dsa_q_norm)
    dk = rmsnorm(heads(dk, DSA_HEADS), dsa_k_norm)
    a = moba_attention(mq, mk, heads(mv, MOBA_HEADS), rel_bias[:, :MOBA_HEADS])
    b = dsa_attention(dq, dk, heads(dv, DSA_HEADS), iq.reshape(B, S, IDX_HEADS, IDX_DIM), ik, iw,
                      rel_bias[:, MOBA_HEADS:])
    o = jnp.concatenate([a.reshape(B, S, -1), b.reshape(B, S, -1)], axis=-1)
    return o @ w_out


def mla_mixer(h, w_in, q_a_norm, kv_a_norm, w_uq, w_ukv, q_norm, k_norm, w_out):
    B, S, _ = h.shape
    pos = jnp.arange(S)
    cq, ckv, k_pe = _split(h @ w_in, ODD_IN_SIZES)
    q = (rmsnorm(cq, q_a_norm) @ w_uq).reshape(B, S, MLA_HEADS, MLA_QK)
    kv = (rmsnorm(ckv, kv_a_norm) @ w_ukv).reshape(B, S, MLA_HEADS, MLA_NOPE + MLA_V)
    k_nope, v = kv[..., :MLA_NOPE], kv[..., MLA_NOPE:]
    k = jnp.concatenate([k_nope, jnp.broadcast_to(k_pe[:, :, None, :], (B, S, MLA_HEADS, MLA_ROPE))], axis=-1)
    q = rmsnorm(q, q_norm)
    k = rmsnorm(k, k_norm)
    q = jnp.concatenate([q[..., :MLA_NOPE], rope(q[..., MLA_NOPE:], pos)], axis=-1)
    k = jnp.concatenate([k[..., :MLA_NOPE], rope(k[..., MLA_NOPE:], pos)], axis=-1)
    o = causal_attention_blocks(q, k, v)
    return o.reshape(B, S, MLA_HEADS * MLA_V) @ w_out


def swiglu(h, w_gate, w_up, w_down):
    return (jax.nn.silu(h @ w_gate) * (h @ w_up)) @ w_down


def moe_swiglu(h, w_router, b_router, w_gate, w_up, w_down):
    B, S, D = h.shape
    ht = h.reshape(B * S, D)
    logits = (ht @ w_router).astype(jnp.float32) + b_router.astype(jnp.float32)
    top_val, top_idx = lax.top_k(logits, TOP_K)
    gates = jax.nn.softmax(top_val, axis=-1)
    combine = jnp.sum(jax.nn.one_hot(top_idx, N_EXPERTS, dtype=jnp.float32) * gates[..., None], axis=1)
    y = jnp.zeros_like(ht)
    for e in range(N_EXPERTS):
        y = y + combine[:, e:e + 1].astype(h.dtype) * swiglu(ht, w_gate[e], w_up[e], w_down[e])
    return y.reshape(B, S, D)


def setup_inputs(seed: int = 0) -> dict:
    key = jax.random.key(seed)
    ks = iter(jax.random.split(key, 40))
    f32 = jnp.float32
    def w(shape, fan_in):
        return jax.random.normal(next(ks), shape, f32) * (fan_in ** -0.5)
    def gain(shape):
        return 1.0 + 0.1 * jax.random.normal(next(ks), shape, f32)
    NE = (DEPTH + 1) // 2
    NO = DEPTH // 2
    return {
        "x": jax.random.normal(next(ks), (BATCH, SEQ, D_MODEL), f32),
        "rel_bias": 0.5 * jax.random.normal(next(ks), (REL_BUCKETS, MOBA_HEADS + DSA_HEADS), f32),
        "mix_norm_e": gain((NE, D_MODEL)),
        "w_in_e": w((NE, D_MODEL, D_IN_EVEN), D_MODEL),
        "moba_q_norm": gain((NE, HEAD_DIM)),
        "moba_k_norm": gain((NE, HEAD_DIM)),
        "dsa_q_norm": gain((NE, HEAD_DIM)),
        "dsa_k_norm": gain((NE, HEAD_DIM)),
        "w_out_e": w((NE, (MOBA_HEADS + DSA_HEADS) * HEAD_DIM, D_MODEL), (MOBA_HEADS + DSA_HEADS) * HEAD_DIM),
        "ffn_norm_e": gain((NE, D_MODEL)),
        "w_gate_e": w((NE, D_MODEL, D_FF_DENSE), D_MODEL),
        "w_up_e": w((NE, D_MODEL, D_FF_DENSE), D_MODEL),
        "w_down_e": w((NE, D_FF_DENSE, D_MODEL), D_FF_DENSE),
        "mix_norm_o": gain((NO, D_MODEL)),
        "w_in_o": w((NO, D_MODEL, D_IN_ODD), D_MODEL),
        "q_a_norm": gain((NO, MLA_Q_RANK)),
        "kv_a_norm": gain((NO, MLA_KV_RANK)),
        "w_uq": w((NO, MLA_Q_RANK, MLA_HEADS * MLA_QK), MLA_Q_RANK),
        "w_ukv": w((NO, MLA_KV_RANK, MLA_HEADS * (MLA_NOPE + MLA_V)), MLA_KV_RANK),
        "mla_q_norm": gain((NO, MLA_QK)),
        "mla_k_norm": gain((NO, MLA_QK)),
        "w_out_o": w((NO, MLA_HEADS * MLA_V, D_MODEL), MLA_HEADS * MLA_V),
        "ffn_norm_o": gain((NO, D_MODEL)),
        "w_router": w((NO, D_MODEL, N_EXPERTS), D_MODEL),
        "b_router": 0.01 * jax.random.normal(next(ks), (NO, N_EXPERTS), f32),
        "w_gate_o": w((NO, N_EXPERTS, D_MODEL, D_FF_EXPERT), D_MODEL),
        "w_up_o": w((NO, N_EXPERTS, D_MODEL, D_FF_EXPERT), D_MODEL),
        "w_down_o": w((NO, N_EXPERTS, D_FF_EXPERT, D_MODEL), D_FF_EXPERT),
    }


def reference(x, rel_bias, mix_norm_e, w_in_e, moba_q_norm, moba_k_norm, dsa_q_norm, dsa_k_norm,
              w_out_e, ffn_norm_e, w_gate_e, w_up_e, w_down_e, mix_norm_o, w_in_o, q_a_norm, kv_a_norm,
              w_uq, w_ukv, mla_q_norm, mla_k_norm, w_out_o, ffn_norm_o, w_router, b_router,
              w_gate_o, w_up_o, w_down_o):
    for layer in range(DEPTH):
        i = layer // 2
        if layer % 2 == 0:
            h = rmsnorm(x, mix_norm_e[i])
            x = x + sparse_mixers(h, w_in_e[i], moba_q_norm[i], moba_k_norm[i], dsa_q_norm[i],
                                  dsa_k_norm[i], rel_bias, w_out_e[i])
            h = rmsnorm(x, ffn_norm_e[i])
            x = x + swiglu(h, w_gate_e[i], w_up_e[i], w_down_e[i])
        else:
            h = rmsnorm(x, mix_norm_o[i])
            x = x + mla_mixer(h, w_in_o[i], q_a_norm[i], kv_a_norm[i], w_uq[i], w_ukv[i],
                              mla_q_norm[i], mla_k_norm[i], w_out_o[i])
            h = rmsnorm(x, ffn_norm_o[i])
            x = x + moe_swiglu(h, w_router[i], b_router[i], w_gate_o[i], w_up_o[i], w_down_o[i])
    return x
```

```cpp
#define ONE_LAUNCH 1
#define HAVE_ATTN 1
#define HAVE_INDEX 1
#include <hip/hip_runtime.h>
#include <stdint.h>
#include <stdio.h>

typedef unsigned short bf16;
__device__ __forceinline__ float bf2f(bf16 v) { return __uint_as_float(((unsigned)v) << 16); }
__device__ __forceinline__ bf16 f2bf(float f) { unsigned u = __float_as_uint(f); return (bf16)((u + 0x7fffu + ((u >> 16) & 1u)) >> 16); }
typedef float f32x2_t __attribute__((ext_vector_type(2))); typedef __bf16 bf16x2_t __attribute__((ext_vector_type(2)));
__device__ __forceinline__ unsigned pk2(float lo, float hi) { f32x2_t v = {lo, hi}; bf16x2_t b = __builtin_convertvector(v, bf16x2_t); return __builtin_bit_cast(unsigned, b); }

constexpr int NB = 4, SEQ = 4096, M_TOK = NB * SEQ, DM = 1024;
constexpr int QKV_LD = 3584;
constexpr int C_MQ = 0, C_MK = 512, C_MV = 1024, C_DQ = 1536, C_DK = 2048, C_DV = 2560, C_IQ = 3072, C_IK = 3328, C_IW = 3392, N_IN_E = 3396;
constexpr int FF_E = 2816, FF_O = 3584, NEXP = 8;
constexpr int C1_LD = 768, N_IN_O = 672, C1_CQ = 0, C1_CKV = 384, C1_KPE = 640;
constexpr int QR_LD = 1536, KVR_LD = 2048;
constexpr int SLOT_CAP = 34816, TILE_CAP = 136;
constexpr float EPS = 1e-6f;
constexpr float LOG2E = 1.4426950408889634f;
constexpr float QSCALE64 = 0.125f * LOG2E;
constexpr float QSCALE96 = 0.10206207261596575f * LOG2E;

constexpr size_t MiB = 1u << 20;
constexpr size_t WS_CTL = 0;
constexpr size_t WS_KMEAN = 1 * MiB;
constexpr size_t WS_ROUTE_E = 1 * MiB + 128 * 1024;
constexpr size_t WS_ROUTE_G = 1 * MiB + 256 * 1024;
constexpr size_t WS_CNT_WG = 1 * MiB + 384 * 1024;
constexpr size_t WS_SLOT_TOK = 1 * MiB + 400 * 1024;
constexpr size_t WS_SLOT_GATE = 1 * MiB + 544 * 1024;
constexpr size_t WS_TILE_E = 1 * MiB + 688 * 1024;
constexpr size_t WS_TOK_SLOT = 1 * MiB + 704 * 1024;
constexpr size_t WS_REFS = 1 * MiB + 832 * 1024;
constexpr size_t WS_WDN_O = 2 * MiB;
constexpr size_t WS_WGU_O = 58 * MiB;
constexpr size_t WS_Y = 58 * MiB;
constexpr size_t WS_YP = 128 * MiB;
constexpr int MOE_FULL_TILES = 128, MOE_TAIL_SPLIT = 7, MOE_TAIL_ROWS = SLOT_CAP - MOE_FULL_TILES * 256;
constexpr size_t WS_H = 170 * MiB;
constexpr size_t WS_SCR = 202 * MiB;
constexpr size_t WS_QKV0 = WS_SCR;
constexpr size_t WS_O = 314 * MiB;
constexpr size_t WS_ACT0 = WS_SCR;
constexpr size_t WS_C1 = WS_SCR;
constexpr size_t WS_LSP = 226 * MiB;
constexpr size_t WS_CQN = 228 * MiB;
constexpr size_t WS_CKVN = 238 * MiB;
constexpr size_t WS_QR = 246 * MiB;
constexpr size_t WS_KVR = 294 * MiB;
constexpr size_t WS_KM = 358 * MiB;
constexpr size_t WS_O1 = WS_SCR;
constexpr size_t WS_MASKT = 412 * MiB;
constexpr size_t WS_W_IN_E = 420 * MiB;
constexpr size_t WS_W_OUT_E = 427 * MiB;
constexpr size_t WS_W_GU_E = 429 * MiB;
constexpr size_t WS_W_DN_E = 440 * MiB;
constexpr size_t WS_W_IN_O = 446 * MiB;
constexpr size_t WS_W_LAT = 448 * MiB;
constexpr int W_LAT_LD = 640;
constexpr size_t WS_W_UQ = WS_W_LAT, WS_W_UKV = WS_W_LAT;
constexpr size_t WS_W_OUT_O = 452 * MiB + 512 * 1024;
constexpr size_t WS_ACT1 = WS_SCR;
constexpr size_t WS_ROPE = 455 * MiB;
constexpr size_t WS_SSP = 456 * MiB;
constexpr size_t WS_SLOT_RSTD = 457 * MiB;
constexpr size_t WS_RSTD = 457 * MiB + 256 * 1024;
constexpr size_t WS_END = 458 * MiB;
static_assert(WS_W_LAT + (size_t)3584 * 640 * 2 <= WS_W_OUT_O && WS_W_OUT_O + (size_t)1024 * 1024 * 2 <= WS_ROPE, "tail of the ws map");
static_assert(WS_ACT1 + (size_t)SLOT_CAP * FF_O * 2 <= WS_W_IN_O, "ACT1 must not reach the odd-layer weights");
static_assert(WS_Y + (size_t)SLOT_CAP * 1024 * 2 <= WS_YP && WS_YP + (size_t)MOE_TAIL_SPLIT * MOE_TAIL_ROWS * 1024 * 2 <= WS_SCR && WS_TOK_SLOT + (size_t)M_TOK * 8 <= 2 * MiB, "Y / TOK_SLOT map");
static_assert(WS_W_DN_E + (size_t)1024 * 2816 * 2 <= WS_W_IN_O && WS_KM + (size_t)M_TOK * 1536 * 2 <= WS_MASKT, "ws map");

enum { I_X = 0, I_RELB, I_MIXN_E, I_W_IN_E, I_MQN, I_MKN, I_DQN, I_DKN, I_W_OUT_E, I_FFNN_E, I_W_GATE_E, I_W_UP_E, I_W_DOWN_E,
       I_MIXN_O, I_W_IN_O, I_QAN, I_KVAN, I_W_UQ, I_W_UKV, I_MLAQN, I_MLAKN, I_W_OUT_O, I_FFNN_O, I_W_ROUTER, I_B_ROUTER,
       I_W_GATE_O, I_W_UP_O, I_W_DOWN_O, N_INPUTS };

__device__ __forceinline__ float wave_sum(float v) {
#pragma unroll
    for (int o = 1; o < 64; o <<= 1) v += __shfl_xor(v, o);
    return v;
}
__device__ __forceinline__ float wave_max(float v) {
#pragma unroll
    for (int o = 1; o < 64; o <<= 1) v = fmaxf(v, __shfl_xor(v, o));
    return v;
}
__device__ __forceinline__ int rel_bucket(int n) {
    if (n < 16) return n;
    int b = 16;
    b += (n >= 21); b += (n >= 27); b += (n >= 35); b += (n >= 46); b += (n >= 59); b += (n >= 77); b += (n >= 99); b += (n >= 128);
    b += (n >= 166); b += (n >= 216); b += (n >= 280); b += (n >= 363); b += (n >= 470); b += (n >= 609); b += (n >= 790);
    return b;
}
__device__ __forceinline__ unsigned fkey(float f) { unsigned u = __float_as_uint(f); return (u & 0x80000000u) ? ~u : (u | 0x80000000u); }
__device__ __forceinline__ float bflo(unsigned u) { return __uint_as_float(u << 16); }
__device__ __forceinline__ float bfhi(unsigned u) { return __uint_as_float(u & 0xffff0000u); }
__device__ __forceinline__ float silu_f(float x) { return x / (1.f + __expf(-x)); }

namespace pg8 {
#define PG8_LAS __attribute__((address_space(3)))
typedef unsigned short bf16_t;
typedef short bf16x8 __attribute__((ext_vector_type(8)));
typedef float f32x4 __attribute__((ext_vector_type(4)));
typedef unsigned u32x4 __attribute__((ext_vector_type(4)));
constexpr int BM = 256, BK = 64, HALF = 128, HTB = HALF * BK * 2, STAGE_BYTES = 8 * HTB, NXCD = 8, WGM = 8;

__host__ __device__ __forceinline__ int lds_byte(int r, int c) { const int st = (r >> 4) * 2 + (c >> 5), rr = r & 15, cc = c & 31, ob = rr * 64 + cc * 2; return st * 1024 + (ob ^ (((ob >> 9) & 1) << 5)); }
__host__ __device__ __forceinline__ void stage_rc(int b, int& R, int& C) { const int st = b / 1024, sb = b % 1024, swz = sb ^ (((sb >> 9) & 1) << 5); R = (st >> 1) * 16 + swz / 64; C = (st & 1) * 32 + (swz % 64) / 2; }
__host__ __device__ __forceinline__ int perm32(int rho) { const int n = rho >> 4, i = rho & 15; return 8 * (i >> 2) + 4 * n + (i & 3); }

struct Unit { int pm, pn, koff, nt; };
struct Gemm { const bf16_t* A; const bf16_t* Bt; int lda, ldb, K; };

__device__ __forceinline__ bool static_unit(int nM, int nN, int G, int c, int i, int& pm, int& pn) {
    const int nwg = nM * nN; const long L = (long)i * G + c; if (L >= nwg) return false;
    int wgid = (int)L; { const int q = nwg / NXCD, r = nwg % NXCD, xcd = wgid % NXCD, off = wgid / NXCD; wgid = (xcd < r ? xcd * (q + 1) : r * (q + 1) + (xcd - r) * q) + off; }
    const int nig = WGM * nN, gid = wgid / nig, fm = gid * WGM, gsz = (nM - fm) < WGM ? (nM - fm) : WGM;
    pm = fm + ((wgid % nig) % gsz); pn = (wgid % nig) / gsz; return true;
}
struct StaticOrder {
    static constexpr bool USE_LIST = false;
    int nM, nN, G, c;
    __device__ __forceinline__ bool next(int i, Unit& u) const { u.koff = 0; u.nt = 0; return static_unit(nM, nN, G, c, i, u.pm, u.pn); }
};
struct MoeOrder {
    static constexpr bool USE_LIST = true;
    const int* tile_e; int nM, nN, G, c, ksplit, Kpart, pm0;
    __device__ __forceinline__ bool next(int i, Unit& u) const {
        const int nwg = nM * nN; const long L = (long)i * G + c; if (L >= (long)nwg * ksplit) return false;
        const int ks = (int)(L / nwg), w = (int)(L % nwg); int pm, j;
        static_unit(nM, nN, nwg, w, 0, pm, j);
        u.pm = pm0 + pm; u.pn = tile_e[pm0 + pm] * nN + j; u.koff = ks * Kpart; u.nt = 0; return true;
    }
};

struct LatJointOrder {
    static constexpr bool USE_LIST = true;
    int G, c;
    __device__ __forceinline__ void uq(int idx, Unit& u) const { int pm, pn; static_unit(64, 6, 384, idx, 0, pm, pn); u.pm = pm; u.pn = pn; u.koff = 0; u.nt = 6; }
    __device__ __forceinline__ void ukv(int idx, Unit& u) const { int pm, pn; static_unit(64, 8, 512, idx, 0, pm, pn); u.pm = pm; u.pn = 6 + pn; u.koff = 384; u.nt = 4; }
    __device__ __forceinline__ bool next(int i, Unit& u) const {
        if (G == 256) {
            if (c < 128) { if (i == 0) { uq(c, u); return true; } if (i == 1) { uq(128 + c, u); return true; } if (i == 2) { ukv(c, u); return true; } return false; }
            const int d = c - 128; if (i == 0) { uq(256 + d, u); return true; } if (i >= 1 && i <= 3) { ukv(128 + 3 * d + (i - 1), u); return true; } return false; }
        const int L = i * G + c; if (L >= 896) return false; if (L < 384) uq(L, u); else ukv(L - 384, u); return true;
    }
};

__device__ __forceinline__ unsigned cvt_pk_bf16(float lo, float hi) { unsigned r; asm volatile("v_cvt_pk_bf16_f32 %0, %1, %2" : "=v"(r) : "v"(lo), "v"(hi)); return r; }
__device__ __forceinline__ float fast_silu(float x) { return x * __builtin_amdgcn_rcpf(1.f + __builtin_amdgcn_exp2f(-1.4426950408889634f * x)); }

struct EpiBf16 {
    static constexpr bool PERM = true;
    bf16_t* O; int ldc;
    static constexpr bool HAS_SCALE = false;
    __device__ __forceinline__ void preload(PG8_LAS unsigned char*, int, int) const {}
    __device__ __forceinline__ void operator()(const f32x4 (&acc)[2][2][4][2], const Unit& u, int wr, int wc, int fr, int fq, const PG8_LAS unsigned char* sp, int ui) const {
        const int row0 = u.pm * BM + wr * 64 + fr, col0 = u.pn * BM + wc * 32 + 8 * fq;
#pragma unroll
        for (int ai = 0; ai < 2; ++ai)
#pragma unroll
            for (int m = 0; m < 4; ++m) { bf16_t* rowp = O + (size_t)(row0 + ai * HALF + m * 16) * ldc + col0;
#pragma unroll
                for (int bj = 0; bj < 2; ++bj) { const f32x4 v0 = acc[ai][bj][m][0], v1 = acc[ai][bj][m][1];
                    u32x4 w; w.x = cvt_pk_bf16(v0[0], v0[1]); w.y = cvt_pk_bf16(v0[2], v0[3]); w.z = cvt_pk_bf16(v1[0], v1[1]); w.w = cvt_pk_bf16(v1[2], v1[3]);
                    *(u32x4*)(rowp + bj * HALF) = w; } }
    }
};
struct EpiResF32 {
    static constexpr bool PERM = false;
    const float* R; float* O; int ldc;
    static constexpr bool HAS_SCALE = false;
    __device__ __forceinline__ void preload(PG8_LAS unsigned char*, int, int) const {}
    __device__ __forceinline__ void operator()(const f32x4 (&acc)[2][2][4][2], const Unit& u, int wr, int wc, int fr, int fq, const PG8_LAS unsigned char* sp, int ui) const {
        const int row0 = u.pm * BM + wr * 64 + fr, col0 = u.pn * BM + wc * 32 + 4 * fq;
#pragma unroll
        for (int ai = 0; ai < 2; ++ai)
#pragma unroll
            for (int m = 0; m < 4; ++m) { const size_t off = (size_t)(row0 + ai * HALF + m * 16) * ldc + col0;
#pragma unroll
                for (int bj = 0; bj < 2; ++bj)
#pragma unroll
                    for (int n = 0; n < 2; ++n) { const f32x4 r = *(const f32x4*)(R + off + bj * HALF + n * 16); *(f32x4*)(O + off + bj * HALF + n * 16) = r + acc[ai][bj][m][n]; } }
    }
};
struct EpiSwiGLU {
    static constexpr bool PERM = true;
    bf16_t* O; int ldc; int nmod;
    static constexpr bool HAS_SCALE = false;
    __device__ __forceinline__ void preload(PG8_LAS unsigned char*, int, int) const {}
    __device__ __forceinline__ void operator()(const f32x4 (&acc)[2][2][4][2], const Unit& u, int wr, int wc, int fr, int fq, const PG8_LAS unsigned char* sp, int ui) const {
        const int row0 = u.pm * BM + wr * 64 + fr, col0 = (u.pn % nmod) * HALF + wc * 32 + 8 * fq;
#pragma unroll
        for (int ai = 0; ai < 2; ++ai)
#pragma unroll
            for (int m = 0; m < 4; ++m) { const f32x4 g0 = acc[ai][0][m][0], g1 = acc[ai][0][m][1], u0 = acc[ai][1][m][0], u1 = acc[ai][1][m][1];
                u32x4 w; w.x = cvt_pk_bf16(fast_silu(g0[0]) * u0[0], fast_silu(g0[1]) * u0[1]); w.y = cvt_pk_bf16(fast_silu(g0[2]) * u0[2], fast_silu(g0[3]) * u0[3]);
                w.z = cvt_pk_bf16(fast_silu(g1[0]) * u1[0], fast_silu(g1[1]) * u1[1]); w.w = cvt_pk_bf16(fast_silu(g1[2]) * u1[2], fast_silu(g1[3]) * u1[3]);
                *(u32x4*)(O + (size_t)(row0 + ai * HALF + m * 16) * ldc + col0) = w; }
    }
};
struct EpiMoeY {
    static constexpr bool PERM = true;
    bf16_t* Y; size_t kstride; int nmod, kpart, row_off;
    static constexpr bool HAS_SCALE = false;
    __device__ __forceinline__ void preload(PG8_LAS unsigned char*, int, int) const {}
    __device__ __forceinline__ void operator()(const f32x4 (&acc)[2][2][4][2], const Unit& u, int wr, int wc, int fr, int fq, const PG8_LAS unsigned char* sp, int ui) const {
        const int row0 = u.pm * BM - row_off + wr * 64 + fr, col0 = (u.pn % nmod) * BM + wc * 32 + 8 * fq; bf16_t* base = Y + (size_t)(u.koff / kpart) * kstride;
#pragma unroll
        for (int ai = 0; ai < 2; ++ai)
#pragma unroll
            for (int m = 0; m < 4; ++m) { bf16_t* rowp = base + (size_t)(row0 + ai * HALF + m * 16) * 1024 + col0;
#pragma unroll
                for (int bj = 0; bj < 2; ++bj) { const f32x4 v0 = acc[ai][bj][m][0], v1 = acc[ai][bj][m][1];
                    u32x4 w; w.x = cvt_pk_bf16(v0[0], v0[1]); w.y = cvt_pk_bf16(v0[2], v0[3]); w.z = cvt_pk_bf16(v1[0], v1[1]); w.w = cvt_pk_bf16(v1[2], v1[3]);
                    *(u32x4*)(rowp + bj * HALF) = w; } }
    }
};


template <bool RBF> struct EpiResN {
    static constexpr bool PERM = true;
    const float* Rf; bf16_t* XB; float* SSP; int ldc;
    static constexpr bool HAS_SCALE = false;
    __device__ __forceinline__ void preload(PG8_LAS unsigned char*, int, int) const {}
    __device__ __forceinline__ void operator()(const f32x4 (&acc)[2][2][4][2], const Unit& u, int wr, int wc, int fr, int fq, const PG8_LAS unsigned char*, int) const {
        const int row0 = u.pm * BM + wr * 64 + fr, col0 = u.pn * BM + wc * 32 + 8 * fq;
#pragma unroll
        for (int ai = 0; ai < 2; ++ai)
#pragma unroll
            for (int m = 0; m < 4; ++m) { const int row = row0 + ai * HALF + m * 16; const size_t off = (size_t)row * ldc + col0; float ss = 0.f;
#pragma unroll
                for (int bj = 0; bj < 2; ++bj) { f32x4 r0, r1;
                    if (RBF) { const u32x4 rb = *(const u32x4*)(XB + off + bj * HALF);
                        r0 = (f32x4){__uint_as_float(rb.x << 16), __uint_as_float(rb.x & 0xffff0000u), __uint_as_float(rb.y << 16), __uint_as_float(rb.y & 0xffff0000u)};
                        r1 = (f32x4){__uint_as_float(rb.z << 16), __uint_as_float(rb.z & 0xffff0000u), __uint_as_float(rb.w << 16), __uint_as_float(rb.w & 0xffff0000u)}; }
                    else { r0 = *(const f32x4*)(Rf + off + bj * HALF); r1 = *(const f32x4*)(Rf + off + bj * HALF + 4); }
                    const f32x4 v0 = r0 + acc[ai][bj][m][0], v1 = r1 + acc[ai][bj][m][1];
                    ss += ((v0[0] * v0[0] + v0[1] * v0[1]) + (v0[2] * v0[2] + v0[3] * v0[3])) + ((v1[0] * v1[0] + v1[1] * v1[1]) + (v1[2] * v1[2] + v1[3] * v1[3]));
                    u32x4 w; w.x = cvt_pk_bf16(v0[0], v0[1]); w.y = cvt_pk_bf16(v0[2], v0[3]); w.z = cvt_pk_bf16(v1[0], v1[1]); w.w = cvt_pk_bf16(v1[2], v1[3]);
                    *(u32x4*)(XB + off + bj * HALF) = w; }
                ss += __shfl_xor(ss, 16); ss += __shfl_xor(ss, 32);
                if (fq == 0) SSP[(size_t)row * 16 + (u.pn & 3) * 4 + wc] = ss; }
    }
};
constexpr int MAX_UNITS_WG = 15;
constexpr int SP_SCALE = 0, SP_GIDX = MAX_UNITS_WG * 1024, SP_ULIST = 30720 + 256;
struct ScaleSSP {
    const float* SSP; float eps;
    __device__ __forceinline__ float row(const Unit& u, int r) const { const f32x4* p = (const f32x4*)(SSP + (size_t)(u.pm * BM + r) * 16); const f32x4 a = p[0], b = p[1], c = p[2], d = p[3];
        const float s = ((a[0] + a[1]) + (a[2] + a[3])) + ((b[0] + b[1]) + (b[2] + b[3])) + ((c[0] + c[1]) + (c[2] + c[3])) + ((d[0] + d[1]) + (d[2] + d[3]));
        return __builtin_amdgcn_rsqf(s * (1.f / 1024.f) + eps); }
};
struct ScaleSlot {
    const float* srstd;
    __device__ __forceinline__ float row(const Unit& u, int r) const { return srstd[u.pm * BM + r]; }
};
template <class Sched> __device__ __forceinline__ int build_unit_list(PG8_LAS unsigned char* sp, const Sched& sched, int tid) {
    PG8_LAS int* ul = (PG8_LAS int*)(sp + SP_ULIST);
    if (tid < MAX_UNITS_WG + 1) { Unit u; u.pm = -1; u.pn = 0; u.koff = 0; u.nt = 0; const bool ok = (tid < MAX_UNITS_WG) && sched.next(tid, u); ul[4 * tid] = ok ? u.pm : -1; ul[4 * tid + 1] = u.pn; ul[4 * tid + 2] = u.koff; ul[4 * tid + 3] = u.nt; }
    __syncthreads();
    int n = 0; while (n < MAX_UNITS_WG && ul[4 * n] >= 0) ++n;
    return n;
}
template <class Scale> __device__ __forceinline__ void preload_scales(const Scale& S, PG8_LAS unsigned char* sp, int n, int tid) {
    PG8_LAS float* tab = (PG8_LAS float*)(sp + SP_SCALE); const PG8_LAS int* ul = (const PG8_LAS int*)(sp + SP_ULIST);
    const int rows = n * 256;
    for (int j0 = tid; j0 < rows; j0 += 4 * 512) {
        float v[4];
#pragma unroll
        for (int k = 0; k < 4; ++k) { const int j = j0 + k * 512; if (j < rows) { Unit u; u.pm = ul[4 * (j >> 8)]; u.pn = ul[4 * (j >> 8) + 1]; u.koff = 0; u.nt = 0; v[k] = S.row(u, j & 255); } else v[k] = 0.f; }
#pragma unroll
        for (int k = 0; k < 4; ++k) { const int j = j0 + k * 512; if (j < rows) tab[j] = v[k]; }
    }
}
template <class Scale> struct EpiBf16S {
    static constexpr bool PERM = true;
    bf16_t* O; int ldc; Scale S;
    static constexpr bool HAS_SCALE = true;
    __device__ __forceinline__ void preload(PG8_LAS unsigned char* sp, int n, int tid) const { preload_scales(S, sp, n, tid); }
    __device__ __forceinline__ void operator()(const f32x4 (&acc)[2][2][4][2], const Unit& u, int wr, int wc, int fr, int fq, const PG8_LAS unsigned char* sp, int ui) const {
        const int rl = wr * 64 + fr, row0 = u.pm * BM + rl, col0 = u.pn * BM + wc * 32 + 8 * fq;
        float scv[8]; { const unsigned ta = (unsigned)(size_t)sp + (unsigned)SP_SCALE + (unsigned)(ui * 256 + rl) * 4u;
            asm volatile("ds_read_b32 %0, %8\n\tds_read_b32 %1, %8 offset:64\n\tds_read_b32 %2, %8 offset:128\n\tds_read_b32 %3, %8 offset:192\n\tds_read_b32 %4, %8 offset:512\n\tds_read_b32 %5, %8 offset:576\n\tds_read_b32 %6, %8 offset:640\n\tds_read_b32 %7, %8 offset:704\n\ts_waitcnt lgkmcnt(0)"
                : "=&v"(scv[0]), "=&v"(scv[1]), "=&v"(scv[2]), "=&v"(scv[3]), "=&v"(scv[4]), "=&v"(scv[5]), "=&v"(scv[6]), "=&v"(scv[7]) : "v"(ta) : "memory"); }
#pragma unroll
        for (int ai = 0; ai < 2; ++ai)
#pragma unroll
            for (int m = 0; m < 4; ++m) { bf16_t* rowp = O + (size_t)(row0 + ai * HALF + m * 16) * ldc + col0; const float sc = scv[ai * 4 + m];
#pragma unroll
                for (int bj = 0; bj < 2; ++bj) { const f32x4 v0 = acc[ai][bj][m][0] * sc, v1 = acc[ai][bj][m][1] * sc;
                    u32x4 w; w.x = cvt_pk_bf16(v0[0], v0[1]); w.y = cvt_pk_bf16(v0[2], v0[3]); w.z = cvt_pk_bf16(v1[0], v1[1]); w.w = cvt_pk_bf16(v1[2], v1[3]);
                    *(u32x4*)(rowp + bj * HALF) = w; } }
    }
};
template <class Scale> struct EpiBf16SL {
    static constexpr bool PERM = true;
    bf16_t* O; int ldc; float* LSP; Scale S;
    static constexpr bool HAS_SCALE = true;
    __device__ __forceinline__ void preload(PG8_LAS unsigned char* sp, int n, int tid) const { preload_scales(S, sp, n, tid); }
    __device__ __forceinline__ void operator()(const f32x4 (&acc)[2][2][4][2], const Unit& u, int wr, int wc, int fr, int fq, const PG8_LAS unsigned char* sp, int ui) const {
        const int rl = wr * 64 + fr, row0 = u.pm * BM + rl, col0 = u.pn * BM + wc * 32 + 8 * fq;
        float scv[8]; { const unsigned ta = (unsigned)(size_t)sp + (unsigned)SP_SCALE + (unsigned)(ui * 256 + rl) * 4u;
            asm volatile("ds_read_b32 %0, %8\n\tds_read_b32 %1, %8 offset:64\n\tds_read_b32 %2, %8 offset:128\n\tds_read_b32 %3, %8 offset:192\n\tds_read_b32 %4, %8 offset:512\n\tds_read_b32 %5, %8 offset:576\n\tds_read_b32 %6, %8 offset:640\n\tds_read_b32 %7, %8 offset:704\n\ts_waitcnt lgkmcnt(0)"
                : "=&v"(scv[0]), "=&v"(scv[1]), "=&v"(scv[2]), "=&v"(scv[3]), "=&v"(scv[4]), "=&v"(scv[5]), "=&v"(scv[6]), "=&v"(scv[7]) : "v"(ta) : "memory"); }
#pragma unroll
        for (int ai = 0; ai < 2; ++ai)
#pragma unroll
            for (int m = 0; m < 4; ++m) { const int row = row0 + ai * HALF + m * 16; bf16_t* rowp = O + (size_t)row * ldc + col0; const float sc = scv[ai * 4 + m];
#pragma unroll
                for (int bj = 0; bj < 2; ++bj) { const f32x4 v0 = acc[ai][bj][m][0] * sc, v1 = acc[ai][bj][m][1] * sc;
                    u32x4 w; w.x = cvt_pk_bf16(v0[0], v0[1]); w.y = cvt_pk_bf16(v0[2], v0[3]); w.z = cvt_pk_bf16(v1[0], v1[1]); w.w = cvt_pk_bf16(v1[2], v1[3]);
                    *(u32x4*)(rowp + bj * HALF) = w;
                    float ss = ((v0[0] * v0[0] + v0[1] * v0[1]) + (v0[2] * v0[2] + v0[3] * v0[3])) + ((v1[0] * v1[0] + v1[1] * v1[1]) + (v1[2] * v1[2] + v1[3] * v1[3]));
                    ss += __shfl_xor(ss, 16); ss += __shfl_xor(ss, 32);
                    if (fq == 0) LSP[(size_t)row * 24 + u.pn * 8 + bj * 4 + wc] = ss; } }
    }
};
struct ScaleLat {
    const float* LSP; float eps;
    __device__ __forceinline__ float row(const Unit& u, int r) const { const bool isq = u.pn < 6; const float* p = LSP + (size_t)(u.pm * BM + r) * 24 + (isq ? 0 : 12);
        float s = ((p[0] + p[1]) + (p[2] + p[3])) + ((p[4] + p[5]) + (p[6] + p[7])); if (isq) s += (p[8] + p[9]) + (p[10] + p[11]);
        return __builtin_amdgcn_rsqf(s * (isq ? 1.f / 384 : 1.f / 256) + eps); }
};
struct EpiLatJoint {
    static constexpr bool PERM = true;
    bf16_t* QR; bf16_t* KVR; ScaleLat S;
    static constexpr bool HAS_SCALE = true;
    __device__ __forceinline__ void preload(PG8_LAS unsigned char* sp, int n, int tid) const { preload_scales(S, sp, n, tid); }
    __device__ __forceinline__ void operator()(const f32x4 (&acc)[2][2][4][2], const Unit& u, int wr, int wc, int fr, int fq, const PG8_LAS unsigned char* sp, int ui) const {
        const bool isq = u.pn < 6; bf16_t* O = isq ? QR : KVR; const int ldc = isq ? 1536 : 2048;
        const int rl = wr * 64 + fr, row0 = u.pm * BM + rl, col0 = (isq ? u.pn : u.pn - 6) * BM + wc * 32 + 8 * fq;
        float scv[8]; { const unsigned ta = (unsigned)(size_t)sp + (unsigned)SP_SCALE + (unsigned)(ui * 256 + rl) * 4u;
            asm volatile("ds_read_b32 %0, %8\n\tds_read_b32 %1, %8 offset:64\n\tds_read_b32 %2, %8 offset:128\n\tds_read_b32 %3, %8 offset:192\n\tds_read_b32 %4, %8 offset:512\n\tds_read_b32 %5, %8 offset:576\n\tds_read_b32 %6, %8 offset:640\n\tds_read_b32 %7, %8 offset:704\n\ts_waitcnt lgkmcnt(0)"
                : "=&v"(scv[0]), "=&v"(scv[1]), "=&v"(scv[2]), "=&v"(scv[3]), "=&v"(scv[4]), "=&v"(scv[5]), "=&v"(scv[6]), "=&v"(scv[7]) : "v"(ta) : "memory"); }
#pragma unroll
        for (int ai = 0; ai < 2; ++ai)
#pragma unroll
            for (int m = 0; m < 4; ++m) { bf16_t* rowp = O + (size_t)(row0 + ai * HALF + m * 16) * ldc + col0; const float sc = scv[ai * 4 + m];
#pragma unroll
                for (int bj = 0; bj < 2; ++bj) { const f32x4 v0 = acc[ai][bj][m][0] * sc, v1 = acc[ai][bj][m][1] * sc;
                    u32x4 w; w.x = cvt_pk_bf16(v0[0], v0[1]); w.y = cvt_pk_bf16(v0[2], v0[3]); w.z = cvt_pk_bf16(v1[0], v1[1]); w.w = cvt_pk_bf16(v1[2], v1[3]);
                    *(u32x4*)(rowp + bj * HALF) = w; } }
    }
};
template <class Scale> struct EpiSwiGLUS {
    static constexpr bool PERM = true;
    bf16_t* O; int ldc; int nmod; Scale S;
    static constexpr bool HAS_SCALE = true;
    __device__ __forceinline__ void preload(PG8_LAS unsigned char* sp, int n, int tid) const { preload_scales(S, sp, n, tid); }
    __device__ __forceinline__ void operator()(const f32x4 (&acc)[2][2][4][2], const Unit& u, int wr, int wc, int fr, int fq, const PG8_LAS unsigned char* sp, int ui) const {
        const int rl = wr * 64 + fr, row0 = u.pm * BM + rl, col0 = (u.pn % nmod) * HALF + wc * 32 + 8 * fq;
        float scv[8]; { const unsigned ta = (unsigned)(size_t)sp + (unsigned)SP_SCALE + (unsigned)(ui * 256 + rl) * 4u;
            asm volatile("ds_read_b32 %0, %8\n\tds_read_b32 %1, %8 offset:64\n\tds_read_b32 %2, %8 offset:128\n\tds_read_b32 %3, %8 offset:192\n\tds_read_b32 %4, %8 offset:512\n\tds_read_b32 %5, %8 offset:576\n\tds_read_b32 %6, %8 offset:640\n\tds_read_b32 %7, %8 offset:704\n\ts_waitcnt lgkmcnt(0)"
                : "=&v"(scv[0]), "=&v"(scv[1]), "=&v"(scv[2]), "=&v"(scv[3]), "=&v"(scv[4]), "=&v"(scv[5]), "=&v"(scv[6]), "=&v"(scv[7]) : "v"(ta) : "memory"); }
#pragma unroll
        for (int ai = 0; ai < 2; ++ai)
#pragma unroll
            for (int m = 0; m < 4; ++m) { const float sc = scv[ai * 4 + m];
                const f32x4 g0 = acc[ai][0][m][0] * sc, g1 = acc[ai][0][m][1] * sc, u0 = acc[ai][1][m][0] * sc, u1 = acc[ai][1][m][1] * sc;
                u32x4 w; w.x = cvt_pk_bf16(fast_silu(g0[0]) * u0[0], fast_silu(g0[1]) * u0[1]); w.y = cvt_pk_bf16(fast_silu(g0[2]) * u0[2], fast_silu(g0[3]) * u0[3]);
                w.z = cvt_pk_bf16(fast_silu(g1[0]) * u1[0], fast_silu(g1[1]) * u1[1]); w.w = cvt_pk_bf16(fast_silu(g1[2]) * u1[2], fast_silu(g1[3]) * u1[3]);
                *(u32x4*)(O + (size_t)(row0 + ai * HALF + m * 16) * ldc + col0) = w; }
    }
};

template <class Epi, class Sched, bool ALIGN_EPI, bool GATHER>
__device__ __forceinline__ void gemm_phase(PG8_LAS unsigned char* lds, const Gemm g, const Sched& S, const Epi& E, const int* gidx) {
    const int tid = threadIdx.x, wid = __builtin_amdgcn_readfirstlane(tid >> 6), lane = tid & 63, wr = wid >> 2, wc = wid & 3, fr = lane & 15, fq = lane >> 4;
    const int K = g.K, nt = K / BK, lda = g.lda, ldb = g.ldb;
    unsigned vAc[2][2], vAn[2][2], voffB[2]; int Rl[2], Cl[2];
#pragma unroll
    for (int i = 0; i < 2; ++i) { int R, C; stage_rc(tid * 16 + i * 8192, R, C); const int Rb = Epi::PERM ? ((R & ~31) + perm32(R & 31)) : R; Rl[i] = R; Cl[i] = C;
        voffB[i] = (unsigned)(Rb * ldb + C) * 2u;
#pragma unroll
        for (int h = 0; h < 2; ++h) { vAc[h][i] = (unsigned)((R + h * HALF) * lda + C) * 2u; vAn[h][i] = vAc[h][i]; } }
    const size_t kstep = (size_t)(BK * 2);
    const size_t hstepB = (size_t)HALF * ldb * 2, tstepB = 2 * hstepB, tstepA = GATHER ? 0 : (size_t)BM * lda * 2;
    const unsigned ldsw = (unsigned)wid * 1024u;
    const int aoff = lds_byte(wr * 64 + fr, fq * 8), boff = lds_byte(wc * 32 + fr, fq * 8);
#define PG8_SA(b, h) (((b) * 2 + (h)) * HTB)
#define PG8_SB(b, h) ((4 + (b) * 2 + (h)) * HTB)
#define PG8_STAGE(bufoff, gbase, voff) do { _Pragma("unroll") for (int _i = 0; _i < 2; ++_i) \
        __builtin_amdgcn_global_load_lds((const unsigned*)((const char*)(gbase) + (voff)[_i]), (PG8_LAS unsigned*)(lds + (bufoff) + ldsw + _i * 8192), 16, 0, 0); } while (0)
#define PG8_LDA(dst, b, h) do { _Pragma("unroll") for (int m = 0; m < 4; ++m) _Pragma("unroll") for (int k = 0; k < 2; ++k) dst[m][k] = *(const PG8_LAS bf16x8*)(lds + PG8_SA(b, h) + aoff + m * 2048 + k * 1024); } while (0)
#define PG8_LDB(dst, b, h) do { _Pragma("unroll") for (int n = 0; n < 2; ++n) _Pragma("unroll") for (int k = 0; k < 2; ++k) dst[n][k] = *(const PG8_LAS bf16x8*)(lds + PG8_SB(b, h) + boff + n * 2048 + k * 1024); } while (0)
#define PG8_MMA(ai, bj, At, Bt) do { __builtin_amdgcn_s_setprio(1); _Pragma("unroll") for (int m = 0; m < 4; ++m) _Pragma("unroll") for (int n = 0; n < 2; ++n) _Pragma("unroll") for (int k = 0; k < 2; ++k) \
        acc[ai][bj][m][n] = __builtin_amdgcn_mfma_f32_16x16x32_bf16(Bt[n][k], At[m][k], acc[ai][bj][m][n], 0, 0, 0); __builtin_amdgcn_s_setprio(0); } while (0)
#define PG8_WAIT_V(n) asm volatile("s_waitcnt vmcnt(" #n ")" ::: "memory")
#define PG8_WAIT_L(n) asm volatile("s_waitcnt lgkmcnt(" #n ")" ::: "memory")
#define PG8_BAR __builtin_amdgcn_s_barrier()
#define PG8_SCHED __builtin_amdgcn_sched_barrier(0)
    PG8_LAS unsigned char* spare = lds + STAGE_BYTES;
    constexpr bool LIST = Sched::USE_LIST || Epi::HAS_SCALE || GATHER;
    int nunits = 0;
    if constexpr (LIST) { nunits = build_unit_list(spare, S, tid); if (nunits == 0) return;
        E.preload(spare, nunits, tid);
        if (GATHER) { PG8_LAS int* gt = (PG8_LAS int*)(spare + SP_GIDX); const PG8_LAS int* ul = (const PG8_LAS int*)(spare + SP_ULIST);
            for (int j = tid; j < nunits * 256; j += 512) { int t_ = gidx[ul[4 * (j >> 8)] * BM + (j & 255)]; gt[j] = t_ < 0 ? 0 : t_; } }
        __syncthreads(); }
#define PG8_UNIT(i, u, ok) do { if constexpr (LIST) { int a_, b_, c_, d_; const unsigned ad_ = (unsigned)(size_t)(spare + SP_ULIST) + 16u * (unsigned)(i); \
        asm volatile("ds_read_b32 %0, %4\n\tds_read_b32 %1, %4 offset:4\n\tds_read_b32 %2, %4 offset:8\n\tds_read_b32 %3, %4 offset:12\n\ts_waitcnt lgkmcnt(0)" : "=&v"(a_), "=&v"(b_), "=&v"(c_), "=&v"(d_) : "v"(ad_) : "memory"); \
        (u).pm = __builtin_amdgcn_readfirstlane(a_); (u).pn = __builtin_amdgcn_readfirstlane(b_); (u).koff = __builtin_amdgcn_readfirstlane(c_); (u).nt = __builtin_amdgcn_readfirstlane(d_); ok = (u).pm >= 0; } else { ok = S.next(i, u); } } while (0)
#define PG8_GIDX(dst, ord) do { if (GATHER) { int t0_, t1_, t2_, t3_; const unsigned ad_ = (unsigned)(size_t)(spare + SP_GIDX) + 4u * (unsigned)((ord) * 256); \
        asm volatile("ds_read_b32 %0, %4\n\tds_read_b32 %1, %5\n\tds_read_b32 %2, %4 offset:512\n\tds_read_b32 %3, %5 offset:512\n\ts_waitcnt lgkmcnt(0)" : "=&v"(t0_), "=&v"(t1_), "=&v"(t2_), "=&v"(t3_) : "v"(ad_ + 4u * (unsigned)Rl[0]), "v"(ad_ + 4u * (unsigned)Rl[1]) : "memory"); \
        dst[0][0] = (unsigned)(t0_ * lda + Cl[0]) * 2u; dst[0][1] = (unsigned)(t1_ * lda + Cl[1]) * 2u; dst[1][0] = (unsigned)(t2_ * lda + Cl[0]) * 2u; dst[1][1] = (unsigned)(t3_ * lda + Cl[1]) * 2u; } } while (0)
    Unit cur, nxt; int ui = 0;
    { bool ok0; PG8_UNIT(0, cur, ok0); if (!ok0) return; }
    f32x4 acc[2][2][4][2];
#pragma unroll
    for (int a = 0; a < 2; ++a)
#pragma unroll
        for (int b = 0; b < 2; ++b)
#pragma unroll
            for (int m = 0; m < 4; ++m)
#pragma unroll
                for (int n = 0; n < 2; ++n) acc[a][b][m][n] = (f32x4){0.f, 0.f, 0.f, 0.f};
    bf16x8 At[4][2], B0[2][2], B1[2][2];
    PG8_GIDX(vAc, 0);
    const char* cA = (const char*)g.A + (size_t)cur.pm * tstepA + (size_t)cur.koff * 2; const char* cB = (const char*)g.Bt + (size_t)cur.pn * tstepB + (size_t)cur.koff * 2;
    PG8_STAGE(PG8_SB(0, 0), cB, voffB); PG8_STAGE(PG8_SB(0, 1), cB + hstepB, voffB); PG8_STAGE(PG8_SA(0, 0), cA, vAc[0]); PG8_STAGE(PG8_SA(0, 1), cA, vAc[1]);
    if (wr == 1) PG8_BAR;
    PG8_WAIT_V(2); PG8_BAR;
    PG8_STAGE(PG8_SB(1, 0), cB + kstep, voffB); PG8_STAGE(PG8_SA(1, 0), cA + kstep, vAc[0]); PG8_STAGE(PG8_SB(1, 1), cB + hstepB + kstep, voffB);
    PG8_WAIT_V(6); PG8_BAR;
    for (;;) {
        bool has_next; PG8_UNIT(ui + 1, nxt, has_next);
        if (has_next) PG8_GIDX(vAn, ui + 1);
        const char* nA = has_next ? (const char*)g.A + (size_t)nxt.pm * tstepA + (size_t)nxt.koff * 2 : cA; const char* nB = has_next ? (const char*)g.Bt + (size_t)nxt.pn * tstepB + (size_t)nxt.koff * 2 : cB;
        const int ntc = cur.nt > 0 ? cur.nt : nt;
        for (int t = 0; t < ntc; t += 2) {
            const bool last = (t == ntc - 2);
            const char* a1 = cA + (size_t)(t + 1) * kstep;
            const char* a2 = last ? nA : cA + (size_t)(t + 2) * kstep; const char* b2 = last ? nB : cB + (size_t)(t + 2) * kstep;
            const char* a3 = a2 + kstep; const char* b3 = b2 + kstep;
            unsigned vs0[2], vs1[2];
            if (GATHER) { const bool sw = last && has_next; vs0[0] = sw ? vAn[0][0] : vAc[0][0]; vs0[1] = sw ? vAn[0][1] : vAc[0][1]; vs1[0] = sw ? vAn[1][0] : vAc[1][0]; vs1[1] = sw ? vAn[1][1] : vAc[1][1]; }
            else { vs0[0] = vAc[0][0]; vs0[1] = vAc[0][1]; vs1[0] = vAc[1][0]; vs1[1] = vAc[1][1]; }
            PG8_LDB(B0, 0, 0); PG8_LDB(B1, 0, 1); PG8_SCHED; PG8_LDA(At, 0, 0); PG8_STAGE(PG8_SA(1, 1), a1, vAc[1]);
            PG8_WAIT_V(8); PG8_WAIT_L(0); PG8_BAR; PG8_MMA(0, 0, At, B0); PG8_MMA(0, 1, At, B1); PG8_BAR; PG8_SCHED;
            PG8_LDA(At, 0, 1); PG8_STAGE(PG8_SB(0, 0), b2, voffB); PG8_STAGE(PG8_SB(0, 1), b2 + hstepB, voffB); PG8_STAGE(PG8_SA(0, 0), a2, vs0);
            PG8_WAIT_V(8); PG8_WAIT_L(0); PG8_BAR; PG8_MMA(1, 0, At, B0); PG8_MMA(1, 1, At, B1); PG8_BAR; PG8_SCHED;
            PG8_LDB(B0, 1, 0); PG8_LDB(B1, 1, 1); PG8_SCHED; PG8_LDA(At, 1, 0); PG8_STAGE(PG8_SA(0, 1), a2, vs1);
            PG8_WAIT_V(8); PG8_WAIT_L(0); PG8_BAR; PG8_MMA(0, 0, At, B0); PG8_MMA(0, 1, At, B1); PG8_BAR; PG8_SCHED;
            PG8_LDA(At, 1, 1); PG8_STAGE(PG8_SB(1, 0), b3, voffB); PG8_STAGE(PG8_SB(1, 1), b3 + hstepB, voffB); PG8_STAGE(PG8_SA(1, 0), a3, vs0);
            PG8_WAIT_V(8); PG8_WAIT_L(0); PG8_BAR; PG8_MMA(1, 0, At, B0); PG8_MMA(1, 1, At, B1); PG8_BAR; PG8_SCHED;
        }
        if constexpr (ALIGN_EPI) { if (wr == 0) PG8_BAR; }
        E(acc, cur, wr, wc, fr, fq, spare, ui);
        if (!has_next) break;
#pragma unroll
        for (int a = 0; a < 2; ++a)
#pragma unroll
            for (int b = 0; b < 2; ++b)
#pragma unroll
                for (int m = 0; m < 4; ++m)
#pragma unroll
                    for (int n = 0; n < 2; ++n) acc[a][b][m][n] = (f32x4){0.f, 0.f, 0.f, 0.f};
        cur = nxt; cA = nA; cB = nB; ++ui;
        if (GATHER) {
#pragma unroll
            for (int h = 0; h < 2; ++h) { vAc[h][0] = vAn[h][0]; vAc[h][1] = vAn[h][1]; } }
        if constexpr (ALIGN_EPI) { if (wr == 1) PG8_BAR; }
    }
    PG8_WAIT_V(0);
    if constexpr (!ALIGN_EPI) { if (wr == 0) PG8_BAR; }
    PG8_BAR;
#undef PG8_SA
#undef PG8_SB
#undef PG8_STAGE
#undef PG8_LDA
#undef PG8_LDB
#undef PG8_MMA
#undef PG8_WAIT_V
#undef PG8_WAIT_L
#undef PG8_BAR
#undef PG8_SCHED
#undef PG8_GIDX
#undef PG8_UNIT
}
}

#define GAS __attribute__((address_space(1)))
#define LAS __attribute__((address_space(3)))
typedef unsigned v4u __attribute__((ext_vector_type(4)));
typedef unsigned v2u __attribute__((ext_vector_type(2)));
typedef float f32x4 __attribute__((ext_vector_type(4)));
typedef short bf16x8 __attribute__((ext_vector_type(8)));
typedef float f32x16 __attribute__((ext_vector_type(16)));
#define LDS_WAIT() asm volatile("s_waitcnt lgkmcnt(0)" ::: "memory")
#define VM_WAIT() asm volatile("s_waitcnt vmcnt(0)" ::: "memory")
constexpr int NWAVES = 8, NTHR = 512;
constexpr int LDS_BYTES = 163840 - 1024;
constexpr int LDSCTL_OFF = LDS_BYTES - 1024;

struct Args { const float* in[N_INPUTS]; float* out; unsigned char* ws; int ph_lo, ph_hi, sub, pad; };
struct Frame { LAS unsigned char* lds; int tid, lane, wave, G, bid; const float* const* in; float* out; unsigned char* ws;
    template <class T> __device__ __forceinline__ T* w(size_t off) const { return (T*)(ws + off); } };

__device__ __forceinline__ void transpose_item(const float* W, int K, int N, int Npad, bf16* WT, int mode, LAS unsigned char* scr, int item, int nblk, int lane, const float* gk = nullptr, int ldo = 0) {
    const int kb = item / nblk, nb = item % nblk, k0 = 64 * kb, n0 = 64 * nb;
    const int g = lane >> 4, c = lane & 15, nn = n0 + 4 * c; const bool ok = nn < N;
    const float* src = W + (size_t)(k0 + 2 * g) * N + nn;
    f32x4 a[8], b[8];
#pragma unroll
    for (int i = 0; i < 8; ++i) { a[i] = ok ? *(const f32x4*)(src + (size_t)(8 * i) * N) : (f32x4){0.f, 0.f, 0.f, 0.f}; b[i] = ok ? *(const f32x4*)(src + (size_t)(8 * i + 1) * N) : (f32x4){0.f, 0.f, 0.f, 0.f}; }
    if (gk) {
#pragma unroll
        for (int i = 0; i < 8; ++i) { const float2 gg = *(const float2*)(gk + k0 + 8 * i + 2 * g); a[i] = a[i] * gg.x; b[i] = b[i] * gg.y; } }
#pragma unroll
    for (int i = 0; i < 8; ++i)
#pragma unroll
        for (int j = 0; j < 4; ++j) *(LAS unsigned*)(scr + (4 * c + j) * 128 + ((i ^ (c & 7)) * 16) + 4 * g) = pk2(a[i][j], b[i][j]);
    LDS_WAIT(); asm volatile("" ::: "memory");
#pragma unroll
    for (int r = 0; r < 8; ++r) { const int idx = lane + 64 * r, nl = idx >> 3, ch = idx & 7, n = n0 + nl;
        const v4u v = *(const LAS v4u*)(scr + nl * 128 + ((ch ^ ((nl >> 2) & 7)) * 16));
        if (n < Npad) { const int row = (mode == 0) ? n : (256 * (n / 128) + (n % 128) + (mode == 2 ? 128 : 0)); *(v4u*)(WT + (size_t)row * (ldo ? ldo : K) + k0 + 8 * ch) = v; } }
    LDS_WAIT(); asm volatile("" ::: "memory");
}
__device__ __forceinline__ void rms_row(const float* xrow, const float* g, bf16* orow, int lane, f32x4 (&v)[4]) {
    const f32x4* xr = (const f32x4*)xrow + lane; float s = 0.f;
#pragma unroll
    for (int j = 0; j < 4; ++j) { v[j] = xr[64 * j]; s += (v[j].x * v[j].x + v[j].y * v[j].y) + (v[j].z * v[j].z + v[j].w * v[j].w); }
    const float r = rsqrtf(wave_sum(s) * (1.f / DM) + EPS);
    v2u* o8 = (v2u*)orow + lane;
#pragma unroll
    for (int j = 0; j < 4; ++j) { const f32x4 gg = ((const f32x4*)g)[lane + 64 * j]; v[j] = v[j] * r * gg; v2u o; o.x = pk2(v[j].x, v[j].y); o.y = pk2(v[j].z, v[j].w); o8[64 * j] = o; }
}
__device__ __forceinline__ void ph_rmsnorm(Frame& F, const float* X, const float* g, bf16* H) {
    const int gw = F.bid * NWAVES + F.wave, NGW = F.G * NWAVES, lane = F.lane;
    for (int m = gw; m < M_TOK; m += 4 * NGW) {
        f32x4 v[4][4]; float s[4];
#pragma unroll
        for (int r = 0; r < 4; ++r) { const int mm = (m + r * NGW < M_TOK) ? m + r * NGW : m; const f32x4* xr = (const f32x4*)(X + (size_t)mm * DM) + lane;
#pragma unroll
            for (int j = 0; j < 4; ++j) v[r][j] = xr[64 * j]; }
#pragma unroll
        for (int r = 0; r < 4; ++r) { float t = 0.f;
#pragma unroll
            for (int j = 0; j < 4; ++j) t += (v[r][j].x * v[r][j].x + v[r][j].y * v[r][j].y) + (v[r][j].z * v[r][j].z + v[r][j].w * v[r][j].w);
            s[r] = t; }
#pragma unroll
        for (int o = 1; o < 64; o <<= 1) {
#pragma unroll
            for (int r = 0; r < 4; ++r) s[r] += __shfl_xor(s[r], o); }
#pragma unroll
        for (int r = 0; r < 4; ++r) { if (m + r * NGW < M_TOK) { const float rs = rsqrtf(s[r] * (1.f / DM) + EPS); v2u* o8 = (v2u*)(H + (size_t)(m + r * NGW) * DM) + lane;
#pragma unroll
            for (int j = 0; j < 4; ++j) { const f32x4 gg = ((const f32x4*)g)[lane + 64 * j]; const f32x4 y = v[r][j] * rs * gg; v2u o; o.x = pk2(y.x, y.y); o.y = pk2(y.z, y.w); o8[64 * j] = o; } } }
    }
}
__device__ __forceinline__ void ph_rope_table(Frame& F, float2* tab) {
    for (int idx = F.bid * NTHR + F.tid; idx < SEQ * 16; idx += F.G * NTHR) { const int pos = idx >> 4, i = idx & 15;
        const float fr = powf(10000.f, -(float)i / 16.f), ang = (float)pos * fr; tab[idx] = make_float2(cosf(ang), sinf(ang)); }
}
__device__ __forceinline__ void ph_refs(Frame& F) {
    if (F.bid != 0 || F.wave != 0) return;
    const int l = F.lane; float* refs = F.w<float>(WS_REFS);
#pragma unroll
    for (int mode = 0; mode < 3; ++mode) { const int dq = mode == 2 ? 96 : 64;
        const float* gq = F.in[mode == 0 ? I_MQN : mode == 1 ? I_DQN : I_MLAQN]; const float* gk = F.in[mode == 0 ? I_MKN : mode == 1 ? I_DKN : I_MLAKN];
        float aq = fabsf(gq[l]), ak = fabsf(gk[l]); if (mode == 2 && l < 32) { aq = fmaxf(aq, fabsf(gq[64 + l])); ak = fmaxf(ak, fabsf(gk[64 + l])); }
        const float mq = wave_max(aq), mk = wave_max(ak); const float base = (float)dq * mq * mk * (mode == 2 ? QSCALE96 : QSCALE64);
        if (mode == 2) { if (l < 16) refs[32 + l] = base; }
        else {
#pragma unroll
            for (int h = 0; h < 8; ++h) { const float mb = wave_max(l < 32 ? fmaxf(F.in[I_RELB][l * 16 + mode * 8 + h], 0.f) : 0.f); if (l == 0) refs[mode * 16 + h] = base + mb * LOG2E; } }
    }
}
__device__ __forceinline__ void wt_job(Frame& F, LAS unsigned char* scr, int& base, int idx, int K, int N, int Npad, int mode, int nexp, size_t off, const float* gk = nullptr, int ldo = 0) {
    const int gw = F.bid * NWAVES + F.wave, NGW = F.G * NWAVES;
    const int nblk = Npad / 64, per = (K / 64) * nblk, tot = per * nexp;
    const size_t wes = (size_t)K * N, wtes = (size_t)(mode == 0 ? Npad : 2 * Npad) * K;
    int it = base + ((gw - base % NGW) + NGW) % NGW;
    for (; it < base + tot; it += NGW) { const int r = it - base, e = r / per, q = r % per;
        transpose_item(F.in[idx] + (size_t)e * wes, K, N, Npad, F.w<bf16>(off) + (size_t)e * wtes, mode, scr, q, nblk, F.lane, gk, ldo); }
    base += tot;
}
__device__ __forceinline__ void ph_prologue(Frame& F) {
    LAS unsigned char* scr = F.lds + F.wave * 8192;
    int base = 0;
    wt_job(F, scr, base, I_W_IN_E, 1024, N_IN_E, QKV_LD, 0, 1, WS_W_IN_E);
    wt_job(F, scr, base, I_W_OUT_E, 1024, 1024, 1024, 0, 1, WS_W_OUT_E);
    wt_job(F, scr, base, I_W_GATE_E, 1024, FF_E, FF_E, 1, 1, WS_W_GU_E, F.in[I_FFNN_E]);
    wt_job(F, scr, base, I_W_UP_E, 1024, FF_E, FF_E, 2, 1, WS_W_GU_E, F.in[I_FFNN_E]);
    wt_job(F, scr, base, I_W_DOWN_E, FF_E, 1024, 1024, 0, 1, WS_W_DN_E);
    wt_job(F, scr, base, I_W_IN_O, 1024, N_IN_O, C1_LD, 0, 1, WS_W_IN_O, F.in[I_MIXN_O]);
    wt_job(F, scr, base, I_W_UQ, 384, 1536, 1536, 0, 1, WS_W_LAT, F.in[I_QAN], W_LAT_LD);
    wt_job(F, scr, base, I_W_UKV, 256, 2048, 2048, 0, 1, WS_W_LAT + ((size_t)1536 * W_LAT_LD + 384) * 2, F.in[I_KVAN], W_LAT_LD);
    wt_job(F, scr, base, I_W_OUT_O, 1024, 1024, 1024, 0, 1, WS_W_OUT_O);
    ph_rope_table(F, F.w<float2>(WS_ROPE));
    ph_refs(F);
    ph_rmsnorm(F, F.in[I_X], F.in[I_MIXN_E], F.w<bf16>(WS_H));
}
constexpr int MOE_T_GU = (1024 / 64) * (FF_O / 64) * NEXP, MOE_T_DN = (FF_O / 64) * (1024 / 64) * NEXP, MOE_ITEMS = 2 * MOE_T_GU + MOE_T_DN;
constexpr int MOE_TAIL_A = 4096, MOE_TAIL_B = 4096, MOE_TAIL_C = 3072, MOE_TAIL_ALL = MOE_TAIL_A + MOE_TAIL_B + MOE_TAIL_C, NSLOT_MOE = 4;
__device__ __forceinline__ void moe_convert_item(Frame& F, LAS unsigned char* scr, int it) {
    constexpr int PER_GU = (1024 / 64) * (FF_O / 64), PER_DN = (FF_O / 64) * (1024 / 64);
    if (it < 2 * MOE_T_GU) { const int up = it >= MOE_T_GU, r = it - up * MOE_T_GU, e = r / PER_GU, q = r % PER_GU;
        transpose_item(F.in[up ? I_W_UP_O : I_W_GATE_O] + (size_t)e * 1024 * FF_O, 1024, FF_O, FF_O, F.w<bf16>(WS_WGU_O) + (size_t)e * 2 * FF_O * 1024, up ? 2 : 1, scr, q, FF_O / 64, F.lane, F.in[I_FFNN_O]); }
    else { const int r = it - 2 * MOE_T_GU, e = r / PER_DN, q = r % PER_DN;
        transpose_item(F.in[I_W_DOWN_O] + (size_t)e * FF_O * 1024, FF_O, 1024, 1024, F.w<bf16>(WS_WDN_O) + (size_t)e * 1024 * FF_O, 0, scr, q, 1024 / 64, F.lane); }
}
__device__ __forceinline__ void moe_convert_tail(Frame& F, int first, int n, int wg0) {
    if (F.G != 256 || F.bid < wg0) return;
    LAS unsigned char* scr = F.lds + F.wave * 8192; const int nw = (F.G - wg0) * NWAVES, w = (F.bid - wg0) * NWAVES + F.wave;
    for (int it = first + w; it < first + n; it += nw) moe_convert_item(F, scr, it);
}
__device__ __forceinline__ void moe_convert_slice(Frame& F, int slice) {
    LAS unsigned char* scr = F.lds + F.wave * 8192;
    const int gw = F.bid * NWAVES + F.wave, NGW = F.G * NWAVES, first = (F.G == 256) ? MOE_TAIL_ALL : 0;
    for (int it = first + slice * NGW + gw; it < MOE_ITEMS; it += NSLOT_MOE * NGW) moe_convert_item(F, scr, it);
    __syncthreads();
}
__device__ __forceinline__ void ph_rmsnorm_route(Frame& F, const bf16* X, const float* g, float* rstd_out) {
    const float* wr = F.in[I_W_ROUTER]; const float* br = F.in[I_B_ROUTER]; int2* re = F.w<int2>(WS_ROUTE_E); float2* rg = F.w<float2>(WS_ROUTE_G); int* cnt_wg = F.w<int>(WS_CNT_WG);
    LAS int* cnt = (LAS int*)F.lds;
    f32x4 wg[16][2];
#pragma unroll
    for (int j = 0; j < 4; ++j)
#pragma unroll
        for (int q = 0; q < 4; ++q) { const int d = 4 * F.lane + 256 * j + q; const float gd = g[d]; wg[4 * j + q][0] = *(const f32x4*)(wr + d * 8) * gd; wg[4 * j + q][1] = *(const f32x4*)(wr + d * 8 + 4) * gd; }
    float bre[8];
#pragma unroll
    for (int e = 0; e < 8; ++e) bre[e] = br[e];
    for (int ch = F.bid; ch < 256; ch += F.G) {
        if (F.tid < 8) cnt[F.tid] = 0;
        __syncthreads();
        for (int i = F.wave; i < 64; i += 2 * NWAVES) {
            v2u raw[2][4];
#pragma unroll
            for (int r = 0; r < 2; ++r) { const v2u* xr = (const v2u*)(X + (size_t)(ch * 64 + i + r * NWAVES) * DM) + F.lane;
#pragma unroll
                for (int j = 0; j < 4; ++j) raw[r][j] = xr[64 * j]; }
#pragma unroll
            for (int r = 0; r < 2; ++r) { const int m = ch * 64 + i + r * NWAVES; float s = 0.f; float lg[8];
#pragma unroll
                for (int e = 0; e < 8; ++e) lg[e] = 0.f;
#pragma unroll
                for (int j = 0; j < 4; ++j) { const float x4[4] = {bflo(raw[r][j].x), bfhi(raw[r][j].x), bflo(raw[r][j].y), bfhi(raw[r][j].y)};
#pragma unroll
                    for (int q = 0; q < 4; ++q) { const float y = x4[q]; s += y * y; const f32x4 w0 = wg[4 * j + q][0], w1 = wg[4 * j + q][1];
                        lg[0] += y * w0.x; lg[1] += y * w0.y; lg[2] += y * w0.z; lg[3] += y * w0.w; lg[4] += y * w1.x; lg[5] += y * w1.y; lg[6] += y * w1.z; lg[7] += y * w1.w; } }
                const float rs = rsqrtf(wave_sum(s) * (1.f / DM) + EPS);
                if (F.lane == 0) rstd_out[m] = rs;
#pragma unroll
                for (int e = 0; e < 8; ++e) lg[e] = wave_sum(lg[e]) * rs + bre[e];
                int e0 = 0; float v0 = lg[0];
#pragma unroll
                for (int e = 1; e < 8; ++e) if (lg[e] > v0) { v0 = lg[e]; e0 = e; }
                int e1 = -1; float v1 = -INFINITY;
#pragma unroll
                for (int e = 0; e < 8; ++e) if (e != e0 && lg[e] > v1) { v1 = lg[e]; e1 = e; }
                if (F.lane == 0) { const float p1 = 1.f / (1.f + __expf(v0 - v1)); re[m] = make_int2(e0, e1); rg[m] = make_float2(1.f - p1, p1); atomicAdd((int*)&cnt[e0], 1); atomicAdd((int*)&cnt[e1], 1); } } }
        __syncthreads();
        if (F.tid < 8) cnt_wg[ch * 8 + F.tid] = cnt[F.tid];
        __syncthreads();
    }
}
__device__ __forceinline__ void ph_slots(Frame& F) {
    const int2* re = F.w<int2>(WS_ROUTE_E); const float2* rg = F.w<float2>(WS_ROUTE_G); const int* cnt_wg = F.w<int>(WS_CNT_WG);
    int* stok = F.w<int>(WS_SLOT_TOK); float* sgate = F.w<float>(WS_SLOT_GATE); int* tile_e = F.w<int>(WS_TILE_E); int2* tslot = F.w<int2>(WS_TOK_SLOT); const float* rstd = F.w<float>(WS_RSTD); float* srstd = F.w<float>(WS_SLOT_RSTD);
    LAS int* sh = (LAS int*)F.lds;
    { const int e = F.wave, l = F.lane;
      const int c0 = cnt_wg[(4 * l + 0) * 8 + e], c1 = cnt_wg[(4 * l + 1) * 8 + e], c2 = cnt_wg[(4 * l + 2) * 8 + e], c3 = cnt_wg[(4 * l + 3) * 8 + e];
      const int tot = c0 + c1 + c2 + c3; int incl = tot;
#pragma unroll
      for (int off = 1; off < 64; off <<= 1) { const int v = __shfl_up(incl, off); if (l >= off) incl += v; }
      const int excl = incl - tot;
      sh[64 + 8 * (4 * l + 0) + e] = excl; sh[64 + 8 * (4 * l + 1) + e] = excl + c0; sh[64 + 8 * (4 * l + 2) + e] = excl + c0 + c1; sh[64 + 8 * (4 * l + 3) + e] = excl + c0 + c1 + c2;
      if (l == 63) sh[e] = incl; }
    __syncthreads();
    if (F.tid == 0) { int o = 0; for (int e = 0; e < 8; ++e) { sh[8 + e] = o; o += (sh[e] + 255) / 256 * 256; } sh[16] = o; }
    __syncthreads();
    for (int ch = F.bid; ch < 256; ch += F.G) {
        if (F.wave == 0) { const int row = ch * 64 + F.lane; const int2 e = re[row]; const float2 gg = rg[row]; int s0 = 0, s1 = 0;
            const unsigned long long below = (1ull << F.lane) - 1ull;
#pragma unroll
            for (int q = 0; q < 8; ++q) { const unsigned long long m = __ballot(e.x == q) | __ballot(e.y == q); const int pos = sh[8 + q] + sh[64 + 8 * ch + q] + __popcll(m & below);
                if (e.x == q) s0 = pos; if (e.y == q) s1 = pos; }
            const float rr = rstd[row]; stok[s0] = row; sgate[s0] = gg.x; srstd[s0] = rr; stok[s1] = row; sgate[s1] = gg.y; srstd[s1] = rr; tslot[row] = make_int2(s0, s1); }
    }
    if (F.bid == 0) { for (int e = 0; e < 8; ++e) for (int s = sh[8 + e] + sh[e] + F.tid; s < sh[8 + e + 1]; s += NTHR) { stok[s] = -1; sgate[s] = 0.f; srstd[s] = 0.f; }
        for (int tl = F.tid; tl <= TILE_CAP; tl += NTHR) { int e = -1; for (int q = 0; q < 8; ++q) if (tl * 256 >= sh[8 + q] && tl * 256 < sh[8 + q + 1]) e = q; if (tl == TILE_CAP) e = sh[16] / 256; tile_e[tl] = e; } }
    __syncthreads();
}
__device__ __forceinline__ void ph_rmsnorm_lat(Frame& F) {
    const bf16* C1 = F.w<bf16>(WS_C1); bf16* CQN = F.w<bf16>(WS_CQN); bf16* CKVN = F.w<bf16>(WS_CKVN); const float* gq = F.in[I_QAN]; const float* gkv = F.in[I_KVAN];
    const int gw = F.bid * NWAVES + F.wave, NGW = F.G * NWAVES, lane = F.lane;
    const bool isq = lane < 48; const float* g1 = isq ? gq + lane * 8 : gkv + (lane - 48) * 8; const float* g2 = gkv + (16 + lane) * 8;
    float ga[8], gb[8];
#pragma unroll
    for (int j = 0; j < 8; ++j) { ga[j] = g1[j]; gb[j] = (lane < 16) ? g2[j] : 0.f; }
    for (int m = gw; m < M_TOK; m += 4 * NGW) {
        v4u ra[4], rb[4];
#pragma unroll
        for (int r = 0; r < 4; ++r) { const int mm = (m + r * NGW < M_TOK) ? m + r * NGW : m; const v4u* row = (const v4u*)(C1 + (size_t)mm * C1_LD); ra[r] = row[lane]; rb[r] = (lane < 16) ? row[64 + lane] : (v4u){0u, 0u, 0u, 0u}; }
#pragma unroll
        for (int r = 0; r < 4; ++r) { if (m + r * NGW < M_TOK) { const int mm = m + r * NGW;
            float xa[8], xb[8]; float sa = 0.f, sb = 0.f;
#pragma unroll
            for (int e = 0; e < 4; ++e) { xa[2 * e] = bflo(ra[r][e]); xa[2 * e + 1] = bfhi(ra[r][e]); xb[2 * e] = bflo(rb[r][e]); xb[2 * e + 1] = bfhi(rb[r][e]); }
#pragma unroll
            for (int j = 0; j < 8; ++j) { sa += xa[j] * xa[j]; sb += xb[j] * xb[j]; }
            const float sq = wave_sum(isq ? sa : 0.f), skv = wave_sum((isq ? 0.f : sa) + sb);
            const float rq = rsqrtf(sq * (1.f / 384) + EPS), rkv = rsqrtf(skv * (1.f / 256) + EPS), r1 = isq ? rq : rkv;
            v4u o;
#pragma unroll
            for (int e = 0; e < 4; ++e) o[e] = pk2(xa[2 * e] * r1 * ga[2 * e], xa[2 * e + 1] * r1 * ga[2 * e + 1]);
            if (isq) *(v4u*)(CQN + (size_t)mm * 384 + lane * 8) = o; else *(v4u*)(CKVN + (size_t)mm * 256 + (lane - 48) * 8) = o;
            if (lane < 16) { v4u o2;
#pragma unroll
                for (int e = 0; e < 4; ++e) o2[e] = pk2(xb[2 * e] * rkv * gb[2 * e], xb[2 * e + 1] * rkv * gb[2 * e + 1]);
                *(v4u*)(CKVN + (size_t)mm * 256 + (16 + lane) * 8) = o2; } } }
    }
}
__device__ __forceinline__ void ph_qknorm(Frame& F) {
    bf16* QKV = F.w<bf16>(WS_QKV0); float* kmean2 = F.w<float>(WS_KMEAN); LAS float* part = (LAS float*)F.lds;
    const int lane = F.lane;
    for (int u = F.bid; u < 256; u += F.G) { const int grp = u & 1, half = (u >> 1) & 1, blk = (u >> 2) & 15, b = u >> 6;
        const int col = (grp == 0 ? C_MK : C_DK) + lane * 8;
        const float* g = F.in[grp == 0 ? I_MKN : I_DKN] + (lane & 7) * 8;
        float gg[8];
#pragma unroll
        for (int j = 0; j < 8; ++j) gg[j] = g[j];
        float ks[8];
#pragma unroll
        for (int j = 0; j < 8; ++j) ks[j] = 0.f;
        const size_t row0 = (size_t)b * SEQ + blk * 256 + half * 128;
        for (int i0 = F.wave; i0 < 128; i0 += 4 * NWAVES) {
            v4u raw[4];
#pragma unroll
            for (int u4 = 0; u4 < 4; ++u4) raw[u4] = *(const v4u*)(QKV + (row0 + i0 + u4 * NWAVES) * QKV_LD + col);
#pragma unroll
            for (int u4 = 0; u4 < 4; ++u4) { float x[8];
                x[0] = bflo(raw[u4].x); x[1] = bfhi(raw[u4].x); x[2] = bflo(raw[u4].y); x[3] = bfhi(raw[u4].y); x[4] = bflo(raw[u4].z); x[5] = bfhi(raw[u4].z); x[6] = bflo(raw[u4].w); x[7] = bfhi(raw[u4].w);
                float ss = 0.f;
#pragma unroll
                for (int j = 0; j < 8; ++j) ss += x[j] * x[j];
                ss += __shfl_xor(ss, 1); ss += __shfl_xor(ss, 2); ss += __shfl_xor(ss, 4);
                const float r = rsqrtf(ss * (1.f / 64) + EPS);
#pragma unroll
                for (int j = 0; j < 8; ++j) { x[j] = x[j] * r * gg[j]; ks[j] += x[j]; }
                v4u o; o.x = pk2(x[0], x[1]); o.y = pk2(x[2], x[3]); o.z = pk2(x[4], x[5]); o.w = pk2(x[6], x[7]);
                *(v4u*)(QKV + (row0 + i0 + u4 * NWAVES) * QKV_LD + col) = o; } }
        if (grp == 0) {
#pragma unroll
            for (int j = 0; j < 8; ++j) part[F.wave * 512 + lane * 8 + j] = ks[j];
            __syncthreads();
            { const int c = F.tid; float s = 0.f;
#pragma unroll
              for (int w = 0; w < 8; ++w) s += part[w * 512 + c];
              kmean2[((((b * 8 + (c >> 6)) * 16 + blk) * 2) + half) * 64 + (c & 63)] = s; }
            __syncthreads(); }
    }
}
__device__ __forceinline__ void ph_mla_prep(Frame& F, const float2* tab) {
    const bf16* KVR = F.w<bf16>(WS_KVR); const bf16* C1 = F.w<bf16>(WS_C1); bf16* KM = F.w<bf16>(WS_KM); const float* g = F.in[I_MLAKN];
#pragma unroll 1
    for (int idx = F.bid * NTHR + F.tid; idx < M_TOK * 16; idx += F.G * NTHR) { const int row = idx >> 4, h = idx & 15, pos = row & (SEQ - 1);
        asm volatile("" ::: "memory");
        const v4u* src = (const v4u*)(KVR + (size_t)row * KVR_LD + h * 128);
        const v4u* src2 = (const v4u*)(C1 + (size_t)row * C1_LD + C1_KPE);
        v4u raw[12]; float ss = 0.f;
#pragma unroll
        for (int c = 0; c < 12; ++c) raw[c] = (c >= 8) ? src2[c - 8] : src[c];
#pragma unroll
        for (int c = 0; c < 12; ++c) {
#pragma unroll
            for (int e = 0; e < 4; ++e) { const float lo = bflo(raw[c][e]), hh = bfhi(raw[c][e]); ss += lo * lo + hh * hh; } }
        const float r = rsqrtf(ss * (1.f / 96) + EPS);
        v4u* dst = (v4u*)(KM + (size_t)row * QR_LD + h * 96);
#pragma unroll
        for (int c = 0; c < 8; ++c) { v4u o;
#pragma unroll
            for (int e = 0; e < 4; ++e) o[e] = pk2(bflo(raw[c][e]) * r * g[8 * c + 2 * e], bfhi(raw[c][e]) * r * g[8 * c + 2 * e + 1]);
            dst[c] = o; }
#pragma unroll
        for (int cc = 0; cc < 2; ++cc) { v4u o1, o2;
#pragma unroll
            for (int e = 0; e < 4; ++e) { const int i0 = 8 * cc + 2 * e;
                const float a0 = bflo(raw[8 + cc][e]) * r * g[64 + i0], a1 = bfhi(raw[8 + cc][e]) * r * g[64 + i0 + 1], b0 = bflo(raw[10 + cc][e]) * r * g[80 + i0], b1 = bfhi(raw[10 + cc][e]) * r * g[80 + i0 + 1];
                const float2 c0 = tab[pos * 16 + i0], c1 = tab[pos * 16 + i0 + 1];
                o1[e] = pk2(a0 * c0.x - b0 * c0.y, a1 * c1.x - b1 * c1.y); o2[e] = pk2(a0 * c0.y + b0 * c0.x, a1 * c1.y + b1 * c1.x); }
            dst[8 + cc] = o1; dst[10 + cc] = o2; }
    }
}
__device__ __forceinline__ void moe_y_row(const bf16* Y, const bf16* YP, int slot, int lane, float gate, f32x4 (&x)[4]) {
    if (slot < MOE_FULL_TILES * 256) { const v2u* a = (const v2u*)(Y + (size_t)slot * 1024) + lane;
#pragma unroll
        for (int j = 0; j < 4; ++j) { const v2u p = a[64 * j]; x[j].x += gate * bflo(p.x); x[j].y += gate * bfhi(p.x); x[j].z += gate * bflo(p.y); x[j].w += gate * bfhi(p.y); } }
    else { const v2u* a = (const v2u*)(YP + (size_t)(slot - MOE_FULL_TILES * 256) * 1024) + lane;
#pragma unroll
        for (int j = 0; j < 4; ++j) { float s0 = 0.f, s1 = 0.f, s2 = 0.f, s3 = 0.f;
#pragma unroll
            for (int k = 0; k < MOE_TAIL_SPLIT; ++k) { const v2u p = a[(size_t)k * MOE_TAIL_ROWS * 256 + 64 * j]; s0 += bflo(p.x); s1 += bfhi(p.x); s2 += bflo(p.y); s3 += bfhi(p.y); }
            x[j].x += gate * s0; x[j].y += gate * s1; x[j].z += gate * s2; x[j].w += gate * s3; } }
}
__device__ __forceinline__ void ph_moe_combine(Frame& F) {
    const bf16* Y = F.w<bf16>(WS_Y); const bf16* YP = F.w<bf16>(WS_YP); const int2* tslot = F.w<int2>(WS_TOK_SLOT); const float2* rg = F.w<float2>(WS_ROUTE_G); float* X = F.out; const bf16* XB = F.w<bf16>(WS_H);
    const int gw = F.bid * NWAVES + F.wave, NGW = F.G * NWAVES;
#pragma unroll 2
    for (int m = gw; m < M_TOK; m += NGW) { const int2 sl = tslot[m]; const float2 g = rg[m];
        f32x4* xr = (f32x4*)(X + (size_t)m * DM) + F.lane; const v2u* xb = (const v2u*)(XB + (size_t)m * DM) + F.lane; f32x4 x[4];
#pragma unroll
        for (int j = 0; j < 4; ++j) { const v2u p = xb[64 * j]; x[j] = (f32x4){bflo(p.x), bfhi(p.x), bflo(p.y), bfhi(p.y)}; }
        moe_y_row(Y, YP, sl.x, F.lane, g.x, x); moe_y_row(Y, YP, sl.y, F.lane, g.y, x);
#pragma unroll
        for (int j = 0; j < 4; ++j) xr[64 * j] = x[j]; }
}

namespace at {
typedef short s16x4 __attribute__((ext_vector_type(4)));
typedef short v4i16_t __attribute__((ext_vector_type(4)));
typedef __attribute__((address_space(3))) const char* lds_cptr;
__device__ __forceinline__ unsigned cvtpk(float lo, float hi) { return pk2(lo, hi); }
__device__ __forceinline__ int crow(int r, int hi) { return (r & 3) + 8 * (r >> 2) + 4 * hi; }
__device__ __forceinline__ s16x4 vtr(lds_cptr p) { return __builtin_bit_cast(s16x4, __builtin_amdgcn_ds_read_tr16_b64_v4i16((__attribute__((address_space(3))) v4i16_t*)p)); }

__device__ __forceinline__ void glds16(const void* gbase, unsigned voff, unsigned lds_dst) { unsigned keep;
    asm volatile("s_mov_b32 %0, m0\n\ts_mov_b32 m0, %3\n\ts_nop 0\n\tglobal_load_lds_dwordx4 %1, %2\n\ts_mov_b32 m0, %0" : "=&s"(keep) : "v"(voff), "s"(gbase), "s"(lds_dst) : "memory"); }
__device__ __forceinline__ void glds16b(const void* gbase, unsigned voff, unsigned lds_dst) { unsigned keep;
    asm volatile("s_mov_b32 %0, m0\n\ts_mov_b32 m0, %3\n\ts_nop 0\n\tglobal_load_lds_dwordx4 %1, %2 offset:128\n\ts_mov_b32 m0, %0" : "=&s"(keep) : "v"(voff), "s"(gbase), "s"(lds_dst) : "memory"); }
__device__ __forceinline__ void glds4(const void* gbase, unsigned voff, unsigned lds_dst) { unsigned keep;
    asm volatile("s_mov_b32 %0, m0\n\ts_mov_b32 m0, %3\n\ts_nop 0\n\tglobal_load_lds_dword %1, %2\n\ts_mov_b32 m0, %0" : "=&s"(keep) : "v"(voff), "s"(gbase), "s"(lds_dst) : "memory"); }
constexpr int KBUF = 12288, VBUF = 8192, MBUF = 2048;
constexpr int NSTG = 4;
constexpr int L_K = 0, L_V = NSTG * KBUF, L_M = L_V + NSTG * VBUF, L_TAB = L_M + NSTG * MBUF, TAB_GUARD = 64, TAB_N = SEQ + TAB_GUARD, L_WS = L_TAB + TAB_N * 4, L_OST = L_WS + NWAVES * 64 * 4, L_MISC = L_OST + NWAVES * 4096, L_END = L_MISC + 64;
static_assert(L_END <= LDSCTL_OFF, "attention LDS map");

struct AttnP { const bf16* Q; int ldq, qhs; const bf16* K; int ldk, khs; const bf16* V; int ldv, vhs; bf16* O; int ocol0; const float* relb; int bcol0; const float* kmean; const unsigned long long* maskt;
               const float* refs; const float* gq; const float2* rope; };

template <int MODE, int DQK>
__device__ __forceinline__ void attn_unit(Frame& F, const AttnP& P, int b, int h, int qb, bool build_tab) {
    constexpr int ND0 = DQK / 16;
    LAS unsigned char* lds = F.lds; const lds_cptr shm3 = (lds_cptr)F.lds;
    const int tid = F.tid, lane = F.lane, r32 = lane & 31, hi = lane >> 5, wid = F.wave;
    const size_t rowbase = (size_t)b * SEQ; const int q0 = qb * 256, qw = q0 + wid * 32, q = qw + r32;
    LAS float* tab = (LAS float*)(lds + L_TAB) + TAB_GUARD;
    LAS float* wsf = (LAS float*)(lds + L_WS) + wid * 64;
    const float ref = P.refs[MODE * 16 + h];
    if (MODE != 2 && build_tab) {
        for (int n = tid - TAB_GUARD; n < SEQ; n += NTHR) tab[n] = (n < 0) ? 0.f : P.relb[rel_bucket(n) * 16 + P.bcol0 + h] * LOG2E - ref;
    }
    const bf16* Kh = P.K + rowbase * P.ldk + h * P.khs; const bf16* Vh = P.V + rowbase * P.ldv + h * P.vhs;
    const unsigned kvoff = (unsigned)(lane * P.ldk + wid * 8) * 2u;
    const unsigned vvoff = (unsigned)((16 * (wid & 3) + (lane >> 2)) * P.ldv + (wid >> 2) * 32 + (lane & 3) * 8) * 2u;
    const unsigned lds0 = (unsigned)(size_t)lds;
    const unsigned char* mbase = (MODE == 1) ? (const unsigned char*)(P.maskt + ((size_t)b * 64 * SEQ) + qw) : nullptr;
#define AT_DMA(t, bufi) do { const bf16* kt_ = Kh + (size_t)(t) * 64 * P.ldk; \
        at::glds16(kt_, kvoff, (unsigned)__builtin_amdgcn_readfirstlane(lds0 + L_K + (bufi) * KBUF + wid * 1024)); \
        if (DQK == 96 && wid < 4) at::glds16b(kt_, kvoff, (unsigned)__builtin_amdgcn_readfirstlane(lds0 + L_K + (bufi) * KBUF + (8 + wid) * 1024 - 128));   \
        at::glds16(Vh + (size_t)(t) * 64 * P.ldv, vvoff, (unsigned)__builtin_amdgcn_readfirstlane(lds0 + L_V + (bufi) * VBUF + wid * 1024)); \
        if (MODE == 1) at::glds4(mbase + (size_t)(t) * SEQ * 8, (unsigned)lane * 4u, (unsigned)__builtin_amdgcn_readfirstlane(lds0 + L_M + (bufi) * MBUF + wid * 256)); } while (0)
    const int NT = (q0 + 256) / 64;
    const int tdiag = qw >> 6;
    AT_DMA(0, 0); AT_DMA(1, 1); AT_DMA(2, 2);
    bf16x8 qr[ND0];
    { const bf16* Qw = P.Q + (rowbase + q) * P.ldq + h * P.qhs + hi * 8;
#pragma unroll
      for (int d0 = 0; d0 < ND0; ++d0) qr[d0] = *(const bf16x8*)(Qw + d0 * 16); }
    if (MODE != 2) {
        float x[4][8]; float ss = 0.f;
#pragma unroll
        for (int d0 = 0; d0 < 4; ++d0)
#pragma unroll
            for (int j = 0; j < 8; ++j) { x[d0][j] = bf2f((bf16)qr[d0][j]); ss += x[d0][j] * x[d0][j]; }
        ss += __shfl_xor(ss, 32);
        const float rr = rsqrtf(ss * (1.f / 64) + EPS) * QSCALE64; const float* g = P.gq + hi * 8;
#pragma unroll
        for (int d0 = 0; d0 < 4; ++d0) { v4u w;
#pragma unroll
            for (int e = 0; e < 4; ++e) w[e] = pk2(x[d0][2 * e] * rr * g[d0 * 16 + 2 * e], x[d0][2 * e + 1] * rr * g[d0 * 16 + 2 * e + 1]);
            qr[d0] = __builtin_bit_cast(bf16x8, w); }
    }
    if (MODE == 2) {
        float x[6][8]; float ss = 0.f;
#pragma unroll
        for (int d0 = 0; d0 < 6; ++d0)
#pragma unroll
            for (int j = 0; j < 8; ++j) { x[d0][j] = bf2f((bf16)qr[d0][j]); ss += x[d0][j] * x[d0][j]; }
        ss += __shfl_xor(ss, 32);
        const float rr = rsqrtf(ss * (1.f / 96) + EPS) * QSCALE96; const float* g = P.gq + hi * 8;
#pragma unroll
        for (int d0 = 0; d0 < 6; ++d0)
#pragma unroll
            for (int j = 0; j < 8; ++j) x[d0][j] *= rr * g[d0 * 16 + j];
#pragma unroll
        for (int j = 0; j < 8; ++j) { const float2 cs = P.rope[q * 16 + hi * 8 + j]; const float x1 = x[4][j], x2 = x[5][j]; x[4][j] = x1 * cs.x - x2 * cs.y; x[5][j] = x1 * cs.y + x2 * cs.x; }
#pragma unroll
        for (int d0 = 0; d0 < 6; ++d0) { v4u w; w.x = pk2(x[d0][0], x[d0][1]); w.y = pk2(x[d0][2], x[d0][3]); w.z = pk2(x[d0][4], x[d0][5]); w.w = pk2(x[d0][6], x[d0][7]); qr[d0] = __builtin_bit_cast(bf16x8, w); }
    }
    unsigned keep = 0u; const int blk = qb;
    if (MODE == 0) {
        float v1 = -INFINITY, v2 = -INFINITY, v3 = -INFINITY; int i1 = -1, i2 = -1, i3 = -1;
        LAS float* kml = (LAS float*)(lds + L_OST);
        for (int i = tid; i < blk * 64; i += NTHR) { const float* k2 = P.kmean + (size_t)((b * 8 + h) * 16) * 128 + (i >> 6) * 128 + (i & 63); kml[i] = (k2[0] + k2[64]) * (1.f / 256); }
        asm volatile("s_waitcnt lgkmcnt(0)" ::: "memory"); __builtin_amdgcn_s_barrier();
        const LAS float* km0 = kml + hi * 8;
#pragma unroll 1
        for (int j = 0; j < blk; ++j) { const LAS float* km = km0 + j * 64; float g = 0.f;
#pragma unroll
            for (int d0 = 0; d0 < 4; ++d0) { const f32x4 ka = *(const LAS f32x4*)(km + d0 * 16), kb = *(const LAS f32x4*)(km + d0 * 16 + 4); const bf16x8 qq = qr[d0];
                g += bf2f((bf16)qq[0]) * ka.x + bf2f((bf16)qq[1]) * ka.y + bf2f((bf16)qq[2]) * ka.z + bf2f((bf16)qq[3]) * ka.w + bf2f((bf16)qq[4]) * kb.x + bf2f((bf16)qq[5]) * kb.y + bf2f((bf16)qq[6]) * kb.z + bf2f((bf16)qq[7]) * kb.w; }
            g += __shfl_xor(g, 32);
            if (g > v1) { v3 = v2; i3 = i2; v2 = v1; i2 = i1; v1 = g; i1 = j; } else if (g > v2) { v3 = v2; i3 = i2; v2 = g; i2 = j; } else if (g > v3) { v3 = g; i3 = j; } }
        if (i1 >= 0) keep |= 1u << i1; if (i2 >= 0) keep |= 1u << i2; if (i3 >= 0) keep |= 1u << i3;
    }
    float l_reg = 0.f; f32x16 o[2];
#pragma unroll
    for (int r = 0; r < 16; ++r) { o[0][r] = 0.f; o[1][r] = 0.f; }
    f32x16 cfar;
    { const float cf = -ref;
#pragma unroll
      for (int r = 0; r < 16; ++r) cfar[r] = (MODE == 2) ? cf : 0.f; }
#define AT_WAIT() do { if (DQK == 96 && wid < 4) asm volatile("s_waitcnt vmcnt(6) lgkmcnt(0)" ::: "memory"); \
        else if (MODE == 1) asm volatile("s_waitcnt vmcnt(6) lgkmcnt(0)" ::: "memory"); else asm volatile("s_waitcnt vmcnt(4) lgkmcnt(0)" ::: "memory"); } while (0)
#pragma unroll
    for (int d0 = 0; d0 < ND0; ++d0) asm volatile("" : "+v"(qr[d0]));
    asm volatile("" : "+v"(cfar)); asm volatile("" : "+v"(keep));
    asm volatile("s_waitcnt vmcnt(0) lgkmcnt(0)" ::: "memory");
    __builtin_amdgcn_s_barrier();
    for (int t = 0; t < NT; ++t) {
        const int bufi = t & (NSTG - 1);
        if (t + 3 < NT) AT_DMA(t + 3, (t + 3) & (NSTG - 1));
        bool active = t <= tdiag;
        bool lane_keep = true;
        if (MODE == 0) { const int jb = t >> 2; lane_keep = (jb == blk) || ((keep >> jb) & 1u); active = active && (__ballot(lane_keep) != 0ull); }
        if (active) {
            f32x16 p0, p1;
            const lds_cptr kp = shm3 + L_K + bufi * KBUF + hi * 1024 + r32 * 16;
            bf16x8 kf[2 * ND0];
#pragma unroll
            for (int d0 = 0; d0 < ND0; ++d0) { kf[2 * d0] = *(const __attribute__((address_space(3))) bf16x8*)(kp + d0 * 2048); kf[2 * d0 + 1] = *(const __attribute__((address_space(3))) bf16x8*)(kp + d0 * 2048 + 512); }
            v2u mwv = {0u, 0u}; if (MODE == 1) mwv = *(const LAS v2u*)(lds + L_M + bufi * MBUF + wid * 256 + r32 * 8);
            __builtin_amdgcn_sched_barrier(0);
            if (MODE != 2) { const LAS float* tb = tab + (q - 64 * t - 4 * hi);
#pragma unroll
                for (int r = 0; r < 16; ++r) { const int c = (r & 3) + 8 * (r >> 2); p0[r] = tb[-c]; p1[r] = tb[-c - 32]; }
#pragma unroll
                for (int d0 = 0; d0 < ND0; ++d0) { p0 = __builtin_amdgcn_mfma_f32_32x32x16_bf16(kf[2 * d0], qr[d0], p0, 0, 0, 0); p1 = __builtin_amdgcn_mfma_f32_32x32x16_bf16(kf[2 * d0 + 1], qr[d0], p1, 0, 0, 0); } }
            else {
                p0 = __builtin_amdgcn_mfma_f32_32x32x16_bf16(kf[0], qr[0], cfar, 0, 0, 0); p1 = __builtin_amdgcn_mfma_f32_32x32x16_bf16(kf[1], qr[0], cfar, 0, 0, 0);
#pragma unroll
                for (int d0 = 1; d0 < ND0; ++d0) { p0 = __builtin_amdgcn_mfma_f32_32x32x16_bf16(kf[2 * d0], qr[d0], p0, 0, 0, 0); p1 = __builtin_amdgcn_mfma_f32_32x32x16_bf16(kf[2 * d0 + 1], qr[d0], p1, 0, 0, 0); } }
            const lds_cptr vp = shm3 + L_V + bufi * VBUF + ((lane >> 4) & 1) * 32 + (lane & 3) * 8 + (4 * hi + ((lane & 15) >> 2)) * 64;
            bf16x8 vf[4];
#pragma unroll
            for (int i = 0; i < 4; ++i) { const s16x4 lo = vtr(vp + i * 1024), hh = vtr(vp + i * 1024 + 512); vf[i] = (bf16x8){lo[0], lo[1], lo[2], lo[3], hh[0], hh[1], hh[2], hh[3]}; }
            __builtin_amdgcn_sched_barrier(0);
#pragma unroll
            for (int r = 0; r < 16; ++r) { p0[r] = __builtin_amdgcn_exp2f(p0[r]); p1[r] = __builtin_amdgcn_exp2f(p1[r]); }
            if (MODE != 1 && t == tdiag) { const int kb = 64 * t + 4 * hi;
#pragma unroll
                for (int r = 0; r < 16; ++r) { const int kv = kb + (r & 3) + 8 * (r >> 2); if (kv > q) p0[r] = 0.f; if (kv + 32 > q) p1[r] = 0.f; } }
            if (MODE == 1) { const unsigned wl = mwv.x >> (4 * hi), wh = mwv.y >> (4 * hi);
#pragma unroll
                for (int r = 0; r < 16; ++r) { int m0, m1;
                    asm("v_bfe_i32 %0, %1, %2, 1" : "=v"(m0) : "v"(wl), "n"((r & 3) + 8 * (r >> 2))); asm("v_bfe_i32 %0, %1, %2, 1" : "=v"(m1) : "v"(wh), "n"((r & 3) + 8 * (r >> 2)));
                    p0[r] = __uint_as_float(__float_as_uint(p0[r]) & (unsigned)m0); p1[r] = __uint_as_float(__float_as_uint(p1[r]) & (unsigned)m1); } }
            float sacc = 0.f;
#pragma unroll
            for (int r = 0; r < 16; ++r) sacc += p0[r] + p1[r];
            const unsigned kmask = (MODE == 0 && !lane_keep) ? 0u : 0xffffffffu;
            l_reg += (MODE == 0 && !lane_keep) ? 0.f : sacc;
            v4u pw[4];
#pragma unroll
            for (int k = 0; k < 2; ++k) { pw[k].x = cvtpk(p0[8 * k], p0[8 * k + 1]); pw[k].y = cvtpk(p0[8 * k + 2], p0[8 * k + 3]); pw[k].z = cvtpk(p0[8 * k + 4], p0[8 * k + 5]); pw[k].w = cvtpk(p0[8 * k + 6], p0[8 * k + 7]);
                pw[2 + k].x = cvtpk(p1[8 * k], p1[8 * k + 1]); pw[2 + k].y = cvtpk(p1[8 * k + 2], p1[8 * k + 3]); pw[2 + k].z = cvtpk(p1[8 * k + 4], p1[8 * k + 5]); pw[2 + k].w = cvtpk(p1[8 * k + 6], p1[8 * k + 7]); }
            if (MODE == 0) {
#pragma unroll
                for (int k = 0; k < 4; ++k) { pw[k].x &= kmask; pw[k].y &= kmask; pw[k].z &= kmask; pw[k].w &= kmask; } }
            bf16x8 vg[4];
#pragma unroll
            for (int i = 0; i < 4; ++i) { const s16x4 lo = vtr(vp + 4096 + i * 1024), hh = vtr(vp + 4096 + i * 1024 + 512); vg[i] = (bf16x8){lo[0], lo[1], lo[2], lo[3], hh[0], hh[1], hh[2], hh[3]}; }
#pragma unroll
            for (int i = 0; i < 4; ++i) o[0] = __builtin_amdgcn_mfma_f32_32x32x16_bf16(__builtin_bit_cast(bf16x8, pw[i]), vf[i], o[0], 0, 0, 0);
#pragma unroll
            for (int i = 0; i < 4; ++i) o[1] = __builtin_amdgcn_mfma_f32_32x32x16_bf16(__builtin_bit_cast(bf16x8, pw[i]), vg[i], o[1], 0, 0, 0);
        }
        if (t + 3 < NT) AT_WAIT(); else asm volatile("s_waitcnt vmcnt(0) lgkmcnt(0)" ::: "memory");
        __builtin_amdgcn_s_barrier();
    }
#undef AT_WAIT
    l_reg += __shfl_xor(l_reg, 32);
    if (hi == 0) wsf[r32] = l_reg;
    LDS_WAIT();
    float rli[16];
#pragma unroll
    for (int r = 0; r < 16; ++r) rli[r] = __builtin_amdgcn_rcpf(wsf[crow(r, hi)]);
    bf16* Ow = P.O + (rowbase + qw) * 1024 + P.ocol0 + h * 64;
    { LAS bf16* stg = (LAS bf16*)(lds + L_OST) + wid * 2048;
#pragma unroll
      for (int r = 0; r < 16; ++r) { const int orow = crow(r, hi);
#pragma unroll
          for (int d0 = 0; d0 < 2; ++d0) stg[orow * 64 + d0 * 32 + r32] = f2bf(o[d0][r] * rli[r]); }
      LDS_WAIT();
#pragma unroll
      for (int i = 0; i < 4; ++i) { const int row = i * 8 + (lane >> 3), ch = lane & 7; const v4u v = *(const LAS v4u*)(stg + row * 64 + ch * 8); *(v4u*)(Ow + (size_t)row * 1024 + ch * 8) = v; } }
    asm volatile("s_waitcnt lgkmcnt(0)" ::: "memory"); __builtin_amdgcn_s_barrier();
#undef AT_DMA
}
}

__device__ __forceinline__ void ph_attn_l0(Frame& F) {
    const bf16* QKV = F.w<bf16>(WS_QKV0);
    at::AttnP PM{QKV + C_MQ, QKV_LD, 64, QKV + C_MK, QKV_LD, 64, QKV + C_MV, QKV_LD, 64, F.w<bf16>(WS_O), 0, F.in[I_RELB], 0, F.w<float>(WS_KMEAN), nullptr, F.w<float>(WS_REFS), F.in[I_MQN], nullptr};
    at::AttnP PD{QKV + C_DQ, QKV_LD, 64, QKV + C_DK, QKV_LD, 64, QKV + C_DV, QKV_LD, 64, F.w<bf16>(WS_O), 512, F.in[I_RELB], 8, nullptr, F.w<unsigned long long>(WS_MASKT), F.w<float>(WS_REFS), F.in[I_DQN], nullptr};
    const int vcu = (F.G % 8 == 0) ? (F.bid % 8) * (F.G / 8) + F.bid / 8 : F.bid;
    for (int v = vcu; v < 256; v += F.G) { const int bh = v >> 3, s = v & 7, b = bh >> 3, h = bh & 7;
        at::attn_unit<0, 64>(F, PM, b, h, 15 - s, true); moe_convert_slice(F, 0); at::attn_unit<0, 64>(F, PM, b, h, s, false);
        at::attn_unit<1, 64>(F, PD, b, h, 15 - s, true); moe_convert_slice(F, 1); at::attn_unit<1, 64>(F, PD, b, h, s, false); }
}
__device__ __forceinline__ void ph_attn_mla(Frame& F) {
    at::AttnP PA{F.w<bf16>(WS_QR), QR_LD, 96, F.w<bf16>(WS_KM), QR_LD, 96, F.w<bf16>(WS_KVR) + 64, KVR_LD, 128, F.w<bf16>(WS_O1), 0, nullptr, 0, nullptr, nullptr, F.w<float>(WS_REFS), F.in[I_MLAQN], F.w<float2>(WS_ROPE)};
    const int vcu = (F.G % 8 == 0) ? (F.bid % 8) * (F.G / 8) + F.bid / 8 : F.bid;
    for (int v = vcu; v < 256; v += F.G) { const int bh = v >> 2, s = v & 3, b = bh >> 4, h = bh & 15;
        const bool rev = (bh & 1) != 0; const int q0 = rev ? s : 15 - s, q1 = rev ? 11 - s : 4 + s, q2 = rev ? 4 + s : 11 - s, q3 = rev ? 15 - s : s;
        at::attn_unit<2, 96>(F, PA, b, h, q0, false); moe_convert_slice(F, 2); at::attn_unit<2, 96>(F, PA, b, h, q1, false);
        at::attn_unit<2, 96>(F, PA, b, h, q2, false); moe_convert_slice(F, 3); at::attn_unit<2, 96>(F, PA, b, h, q3, false); }
}

namespace ix {
constexpr int HP = 1028;
constexpr int L_HIST = 0, L_ROW = 32 * HP * 4;
constexpr int MP = 129;
constexpr int L_GE = 0, L_EQ = 32 * MP * 4;
static_assert(L_ROW + 3 * 32 * 4 <= LDSCTL_OFF && L_EQ + 32 * MP * 4 <= L_ROW, "index LDS map");

__device__ __forceinline__ float irelu(float x) { const int i = __float_as_int(x); return __int_as_float(i > 0 ? i : 0); }
__device__ __forceinline__ void dsa_index_unit(Frame& F, int b, int qt) {
    const int tid = F.tid, lane = F.lane, r32 = lane & 31, hi = lane >> 5, wid = F.wave;
    const int q0 = qt * 32, q = q0 + r32, KT = qt + 1;
    const bf16* QKV = F.w<bf16>(WS_QKV0); unsigned long long* maskt = F.w<unsigned long long>(WS_MASKT);
    LAS unsigned* hist = (LAS unsigned*)(F.lds + ix::L_HIST); LAS unsigned* rowi = (LAS unsigned*)(F.lds + ix::L_ROW);
    LAS unsigned* pre = rowi; LAS unsigned* krem = rowi + 32; LAS unsigned* cnteq = rowi + 64;
    const bf16* qrow = QKV + (size_t)(b * SEQ + q) * QKV_LD;
    bf16x8 qf[4][4];
#pragma unroll
    for (int h = 0; h < 4; ++h)
#pragma unroll
        for (int d0 = 0; d0 < 4; ++d0) qf[h][d0] = *(const bf16x8*)(qrow + C_IQ + h * 64 + d0 * 16 + hi * 8);
    float wq[4];
    { const v2u wr = *(const v2u*)(qrow + C_IW); wq[0] = __uint_as_float(wr.x << 16); wq[1] = __uint_as_float(wr.x & 0xffff0000u); wq[2] = __uint_as_float(wr.y << 16); wq[3] = __uint_as_float(wr.y & 0xffff0000u); }
    for (int i = tid; i < 32 * ix::HP; i += NTHR) hist[i] = 0u;
    if (tid < 32) { pre[tid] = 0u; const int n = q0 + tid + 1; krem[tid] = (unsigned)(n < 256 ? n : 256); cnteq[tid] = 0u; }
    __syncthreads();
    const bf16* kbase = QKV + (size_t)(b * SEQ) * QKV_LD + C_IK + hi * 8;
    const f32x16 zero16 = {0.f, 0.f, 0.f, 0.f, 0.f, 0.f, 0.f, 0.f, 0.f, 0.f, 0.f, 0.f, 0.f, 0.f, 0.f, 0.f};
#pragma unroll 1
    for (int pass = 0; pass < 3; ++pass) {
        const unsigned mypre = pre[r32];
        if (pass == 2) { __syncthreads(); for (int i = tid; i < 2 * 32 * ix::MP; i += NTHR) hist[i] = 0u; __syncthreads(); }
        bf16x8 kn[4];
        { const bf16* kr = kbase + (size_t)((wid < KT ? wid : 0) * 32 + r32) * QKV_LD;
#pragma unroll
          for (int d0 = 0; d0 < 4; ++d0) kn[d0] = *(const bf16x8*)(kr + d0 * 16); }
#pragma unroll 1
        for (int kt = wid; kt < KT; kt += NWAVES) {
            bf16x8 kf[4];
#pragma unroll
            for (int d0 = 0; d0 < 4; ++d0) kf[d0] = kn[d0];
            { const int ktn = (kt + NWAVES < KT) ? kt + NWAVES : kt; const bf16* kr = kbase + (size_t)(ktn * 32 + r32) * QKV_LD;
#pragma unroll
              for (int d0 = 0; d0 < 4; ++d0) kn[d0] = *(const bf16x8*)(kr + d0 * 16); }
            float sc[16];
            { f32x16 a0, a1;
              a0 = __builtin_amdgcn_mfma_f32_32x32x16_bf16(kf[0], qf[0][0], zero16, 0, 0, 0); a1 = __builtin_amdgcn_mfma_f32_32x32x16_bf16(kf[0], qf[1][0], zero16, 0, 0, 0);
#pragma unroll
              for (int d0 = 1; d0 < 4; ++d0) { a0 = __builtin_amdgcn_mfma_f32_32x32x16_bf16(kf[d0], qf[0][d0], a0, 0, 0, 0); a1 = __builtin_amdgcn_mfma_f32_32x32x16_bf16(kf[d0], qf[1][d0], a1, 0, 0, 0); }
#pragma unroll
              for (int r = 0; r < 16; ++r) sc[r] = wq[0] * irelu(a0[r]) + wq[1] * irelu(a1[r]); }
            { f32x16 a2, a3;
              a2 = __builtin_amdgcn_mfma_f32_32x32x16_bf16(kf[0], qf[2][0], zero16, 0, 0, 0); a3 = __builtin_amdgcn_mfma_f32_32x32x16_bf16(kf[0], qf[3][0], zero16, 0, 0, 0);
#pragma unroll
              for (int d0 = 1; d0 < 4; ++d0) { a2 = __builtin_amdgcn_mfma_f32_32x32x16_bf16(kf[d0], qf[2][d0], a2, 0, 0, 0); a3 = __builtin_amdgcn_mfma_f32_32x32x16_bf16(kf[d0], qf[3][d0], a3, 0, 0, 0); }
#pragma unroll
              for (int r = 0; r < 16; ++r) sc[r] += wq[2] * irelu(a2[r]) + wq[3] * irelu(a3[r]); }
            const bool diag = (kt == KT - 1);
            if (pass < 2) {
                const int sh_bin = pass == 0 ? 21 : 10, sh_pre = 21; const unsigned bmask = 2047u;
                LAS unsigned* hrow = hist + r32 * ix::HP;
#pragma unroll
                for (int r = 0; r < 16; ++r) { const unsigned key = fkey(sc[r]); const int c = (r & 3) + 8 * (r >> 2) + 4 * hi;
                    bool ok = (!diag) || (c <= r32); if (pass > 0) ok = ok && ((key >> sh_pre) == mypre);
                    const unsigned bin = (key >> sh_bin) & bmask;
                    atomicAdd((unsigned*)(hrow + (ok ? (bin >> 1) : 1024u)), (bin & 1u) ? 65536u : 1u); }
            } else {
                unsigned ge = 0u, eq = 0u;
#pragma unroll
                for (int r = 0; r < 16; ++r) { const unsigned key = fkey(sc[r]) >> 10; const int c = (r & 3) + 8 * (r >> 2) + 4 * hi;
                    const bool ok = (!diag) || (c <= r32);
                    if (ok && key >= mypre) ge |= 1u << c; if (ok && key == mypre) eq |= 1u << c; }
                if (ge) atomicOr((unsigned*)(hist + r32 * ix::MP + kt), ge);
                if (eq) atomicOr((unsigned*)(hist + 32 * ix::MP + r32 * ix::MP + kt), eq);
            }
        }
        __syncthreads();
        if (pass < 2) {
#pragma unroll 1
            for (int rr = 0; rr < 4; ++rr) { const int row = wid * 4 + rr; const LAS unsigned* hr = hist + row * ix::HP + lane * 16;
                unsigned wv[16]; unsigned total = 0u;
#pragma unroll
                for (int i = 0; i < 16; ++i) { wv[i] = hr[i]; total += (wv[i] & 0xffffu) + (wv[i] >> 16); }
                unsigned S = total;
#pragma unroll
                for (int off = 1; off < 64; off <<= 1) { const unsigned v = __shfl_down(S, off); if (lane + off < 64) S += v; }
                const unsigned k = krem[row], above = S - total;
                if (S >= k && above < k) { unsigned run = above, bstar = 0u, newk = 0u, cnt = 0u; bool done = false;
#pragma unroll
                    for (int i = 15; i >= 0; --i) { const unsigned ch = wv[i] >> 16, cl = wv[i] & 0xffffu;
                        if (!done) { if (run + ch >= k) { bstar = 32u * lane + 2u * i + 1u; newk = k - run; cnt = ch; done = true; } else run += ch; }
                        if (!done) { if (run + cl >= k) { bstar = 32u * lane + 2u * i; newk = k - run; cnt = cl; done = true; } else run += cl; } }
                    pre[row] = (pre[row] << 11) | bstar; krem[row] = newk; cnteq[row] = cnt; } }
            __syncthreads();
            if (pass < 1) { for (int i = tid; i < 32 * ix::HP; i += NTHR) hist[i] = 0u; __syncthreads(); }
        }
    }
#pragma unroll 1
    for (int rr = 0; rr < 4; ++rr) { const int row = wid * 4 + rr; const unsigned need = krem[row], ce = cnteq[row];
        if (need < ce) { LAS unsigned* g = hist + row * ix::MP; LAS unsigned* e = hist + 32 * ix::MP + row * ix::MP;
            const unsigned e0 = e[2 * lane], e1 = e[2 * lane + 1]; const int c0 = __popc(e0), c1 = __popc(e1), c = c0 + c1; int incl = c;
#pragma unroll
            for (int off = 1; off < 64; off <<= 1) { const int v = __shfl_up(incl, off); if (lane >= off) incl += v; }
            int rem = (int)need - (incl - c); rem = rem < 0 ? 0 : (rem > c ? c : rem);
            const int k0 = rem < c0 ? rem : c0, k1 = rem - k0;
            unsigned y0 = e0; for (int i = 0; i < k0; ++i) y0 &= y0 - 1u;
            unsigned y1 = e1; for (int i = 0; i < k1; ++i) y1 &= y1 - 1u;
            g[2 * lane] &= ~y0; g[2 * lane + 1] &= ~y1; } }
    __syncthreads();
    for (int idx = tid; idx < 32 * 64; idx += NTHR) { const int qq = idx & 31, t = idx >> 5;
        const unsigned lo = hist[qq * ix::MP + 2 * t], hh = hist[qq * ix::MP + 2 * t + 1];
        maskt[((size_t)(b * 64 + t) * SEQ) + q0 + qq] = (unsigned long long)lo | ((unsigned long long)hh << 32); }
    __syncthreads();
}
}
__device__ __forceinline__ void ph_dsa_index(Frame& F) {
    for (int v = F.bid; v < 256; v += F.G) { const int b = v >> 6, i = v & 63; ix::dsa_index_unit(F, b, 127 - i); ix::dsa_index_unit(F, b, i); }
}

#define XB_TMO      128
#define XB_XCNT(j)  (256  + 64 * (j))
#define XB_XSUB(j)  (1280 + 64 * (j))
#define XB_XGEN(j)  (2304 + 64 * (j))
#define XB_TOP      3328
#define XB_TOPGEN   3392
#define XCD_BAR_WORDS 3456
#define XB_SPIN_CAP (1u << 18)

__device__ __forceinline__ unsigned xb_ld(unsigned* p)              { return __hip_atomic_load(p, __ATOMIC_RELAXED, __HIP_MEMORY_SCOPE_AGENT); }
__device__ __forceinline__ unsigned xb_add(unsigned* p, unsigned v) { return __hip_atomic_fetch_add(p, v, __ATOMIC_RELAXED, __HIP_MEMORY_SCOPE_AGENT); }
__device__ __forceinline__ unsigned xb_xcc_id() { return (unsigned)__builtin_amdgcn_s_getreg((3 << 11) | 20) & 0xFu; }
#define XB_SPIN(cond, bar) do { unsigned _sp = 0; while (cond) { __builtin_amdgcn_s_sleep(1); \
    if ((++_sp & 255u) == 0u) { if (xb_ld(&(bar)[XB_TMO])) break; if (_sp > XB_SPIN_CAP) { atomicAdd(&(bar)[XB_TMO], 1u); break; } } } } while (0)

struct XcdBarrier {
    unsigned* bar; unsigned x;
    volatile LAS unsigned* st;
};

__device__ __forceinline__ XcdBarrier xcd_barrier_post(unsigned* bar, volatile LAS unsigned* st) {
    XcdBarrier b; b.bar = bar; b.x = xb_xcc_id(); b.st = st;
    if (threadIdx.x == 0) (void)xb_add(&bar[XB_XCNT(b.x)], 1u);
    return b;
}
__device__ __forceinline__ void xcd_barrier_complete(unsigned* bar, unsigned x, unsigned& nloc, unsigned& nx) {
    const unsigned G = gridDim.x * gridDim.y * gridDim.z;
    unsigned sum, cnt, mine, sp = 0u;
    for (;;) {
        sum = 0u; cnt = 0u; mine = 0u;
#pragma unroll
        for (unsigned j = 0; j < 16; ++j) { const unsigned c = xb_ld(&bar[XB_XCNT(j)]); sum += c; cnt += (c > 0u) ? 1u : 0u; mine = (j == x) ? c : mine; }
        if (sum == G) break;
        __builtin_amdgcn_s_sleep(1);
        if ((++sp & 255u) == 0u) { if (xb_ld(&bar[XB_TMO])) break; if (sp > XB_SPIN_CAP) { atomicAdd(&bar[XB_TMO], 1u); break; } }
    }
    nloc = mine > 0u ? mine : 1u; nx = cnt > 0u ? cnt : 1u;
}

__device__ __forceinline__ void xcd_barrier(const XcdBarrier& b) {
    asm volatile("s_waitcnt vmcnt(0)" ::: "memory");
    __syncthreads();
    if (threadIdx.x == 0) {
        unsigned* bar = b.bar;
        __builtin_amdgcn_s_waitcnt(0);
        unsigned nloc = b.st[0], nx = b.st[1];
        if (nloc == 0u) { xcd_barrier_complete(bar, b.x, nloc, nx); b.st[0] = nloc; b.st[1] = nx; }
        const unsigned old = xb_add(&bar[XB_XSUB(b.x)], 1u);
        const unsigned gen = old / nloc;
        if (old + 1u == (gen + 1u) * nloc) {
            __builtin_amdgcn_fence(__ATOMIC_RELEASE, "agent");
            asm volatile("s_waitcnt vmcnt(0)" ::: "memory");
            const unsigned og = xb_add(&bar[XB_TOP], 1u);
            const unsigned tg = og / nx;
            if (og + 1u == (tg + 1u) * nx) xb_add(&bar[XB_TOPGEN], 1u);
            else XB_SPIN(xb_ld(&bar[XB_TOPGEN]) == tg, bar);
            __builtin_amdgcn_fence(__ATOMIC_ACQUIRE, "agent");
            xb_add(&bar[XB_XGEN(b.x)], 1u);
            asm volatile("s_waitcnt vmcnt(0)" ::: "memory");
        } else {
            XB_SPIN(xb_ld(&bar[XB_XGEN(b.x)]) == gen, bar);
            __builtin_amdgcn_fence(__ATOMIC_ACQUIRE, "agent");
            asm volatile("s_waitcnt vmcnt(0)" ::: "memory");
        }
    }
    __syncthreads();
}

constexpr int NPHASE = 20;
constexpr int CW_BAR = 4096;
#ifndef HAVE_ATTN
#define HAVE_ATTN 0
#endif
#ifndef HAVE_INDEX
#define HAVE_INDEX 0
#endif

__global__ void __launch_bounds__(NTHR, 2) mega(Args args) {
    extern __shared__ __attribute__((aligned(16))) unsigned char lds_raw[];
    Frame F; F.lds = (LAS unsigned char*)lds_raw; F.tid = threadIdx.x; F.lane = F.tid & 63; F.wave = __builtin_amdgcn_readfirstlane(F.tid >> 6);
    F.G = gridDim.x; F.bid = blockIdx.x; F.in = args.in; F.out = args.out; F.ws = args.ws;
    volatile LAS unsigned* MISC = (volatile LAS unsigned*)(F.lds + LDSCTL_OFF);
    for (int u = F.tid; u < 256; u += NTHR) MISC[u] = 0u;
    __syncthreads();
    const int lo = args.ph_lo, hi = args.ph_hi;
    XcdBarrier bar; bar.bar = (unsigned*)(args.ws + WS_CTL) + CW_BAR; bar.x = 0; bar.st = nullptr;
    if (hi - lo > 1) bar = xcd_barrier_post((unsigned*)(args.ws + WS_CTL) + CW_BAR, MISC + 8);
#define IN(k) (lo <= (k) && (k) < hi)
#define SEAM(k) do { if (IN(k) && IN((k) + 1)) xcd_barrier(bar); } while (0)
    PG8_LAS unsigned char* glds = (PG8_LAS unsigned char*)lds_raw;
    const pg8::bf16_t* H = F.w<pg8::bf16_t>(WS_H);

    if (IN(0)) { ph_prologue(F); } SEAM(0);
    if (IN(1)) { pg8::Gemm g{H, F.w<pg8::bf16_t>(WS_W_IN_E), 1024, 1024, 1024}; pg8::StaticOrder S{M_TOK / 256, QKV_LD / 256, F.G, F.bid}; pg8::EpiBf16 E{F.w<pg8::bf16_t>(WS_QKV0), QKV_LD};
        pg8::gemm_phase<pg8::EpiBf16, pg8::StaticOrder, true, false>(glds, g, S, E, nullptr);
        moe_convert_tail(F, 0, MOE_TAIL_A, (M_TOK / 256) * (QKV_LD / 256) % 256); } SEAM(1);
    if (IN(2)) { if (args.sub & 1) ph_qknorm(F);
#if HAVE_INDEX
        if (args.sub & 2) ph_dsa_index(F);
#endif
    } SEAM(2);
    if (IN(3)) {
#if HAVE_ATTN
        ph_attn_l0(F);
#endif
    } SEAM(3);
    if (IN(4)) { pg8::Gemm g{F.w<pg8::bf16_t>(WS_O), F.w<pg8::bf16_t>(WS_W_OUT_E), 1024, 1024, 1024}; pg8::StaticOrder S{M_TOK / 256, 4, F.G, F.bid}; pg8::EpiResN<false> E{F.in[I_X], F.w<pg8::bf16_t>(WS_H), F.w<float>(WS_SSP), 1024};
        pg8::gemm_phase<pg8::EpiResN<false>, pg8::StaticOrder, false, false>(glds, g, S, E, nullptr); } SEAM(4);
    if (IN(6)) { pg8::Gemm g{H, F.w<pg8::bf16_t>(WS_W_GU_E), 1024, 1024, 1024}; pg8::StaticOrder S{M_TOK / 256, 2 * FF_E / 256, F.G, F.bid}; pg8::EpiSwiGLUS<pg8::ScaleSSP> E{F.w<pg8::bf16_t>(WS_ACT0), FF_E, 1 << 20, {F.w<float>(WS_SSP), EPS}};
        pg8::gemm_phase<pg8::EpiSwiGLUS<pg8::ScaleSSP>, pg8::StaticOrder, true, false>(glds, g, S, E, nullptr);
        moe_convert_tail(F, MOE_TAIL_A, MOE_TAIL_B, (M_TOK / 256) * (2 * FF_E / 256) % 256); } SEAM(6);
    if (IN(7)) { pg8::Gemm g{F.w<pg8::bf16_t>(WS_ACT0), F.w<pg8::bf16_t>(WS_W_DN_E), FF_E, FF_E, FF_E}; pg8::StaticOrder S{M_TOK / 256, 4, F.G, F.bid}; pg8::EpiResN<true> E{nullptr, F.w<pg8::bf16_t>(WS_H), F.w<float>(WS_SSP), 1024};
        pg8::gemm_phase<pg8::EpiResN<true>, pg8::StaticOrder, false, false>(glds, g, S, E, nullptr); } SEAM(7);
    if (IN(9)) { pg8::Gemm g{H, F.w<pg8::bf16_t>(WS_W_IN_O), 1024, 1024, 1024}; pg8::StaticOrder S{M_TOK / 256, C1_LD / 256, F.G, F.bid}; pg8::EpiBf16SL<pg8::ScaleSSP> E{F.w<pg8::bf16_t>(WS_C1), C1_LD, F.w<float>(WS_LSP), {F.w<float>(WS_SSP), EPS}};
        pg8::gemm_phase<pg8::EpiBf16SL<pg8::ScaleSSP>, pg8::StaticOrder, true, false>(glds, g, S, E, nullptr);
        moe_convert_tail(F, MOE_TAIL_A + MOE_TAIL_B, MOE_TAIL_C, (M_TOK / 256) * (C1_LD / 256)); } SEAM(9);
    if (IN(11)) { pg8::Gemm g{F.w<pg8::bf16_t>(WS_C1), F.w<pg8::bf16_t>(WS_W_LAT), C1_LD, W_LAT_LD, 384}; pg8::LatJointOrder S{F.G, F.bid};
        pg8::EpiLatJoint E{F.w<pg8::bf16_t>(WS_QR), F.w<pg8::bf16_t>(WS_KVR), {F.w<float>(WS_LSP), EPS}};
        pg8::gemm_phase<pg8::EpiLatJoint, pg8::LatJointOrder, true, false>(glds, g, S, E, nullptr); } SEAM(11);
    if (IN(12)) { ph_mla_prep(F, F.w<float2>(WS_ROPE)); } SEAM(12);
    if (IN(13)) {
#if HAVE_ATTN
        ph_attn_mla(F);
#endif
    } SEAM(13);
    if (IN(14)) { pg8::Gemm g{F.w<pg8::bf16_t>(WS_O1), F.w<pg8::bf16_t>(WS_W_OUT_O), 1024, 1024, 1024}; pg8::StaticOrder S{M_TOK / 256, 4, F.G, F.bid}; pg8::EpiResN<true> E{nullptr, F.w<pg8::bf16_t>(WS_H), F.w<float>(WS_SSP), 1024};
        pg8::gemm_phase<pg8::EpiResN<true>, pg8::StaticOrder, false, false>(glds, g, S, E, nullptr); } SEAM(14);
    if (IN(15)) { ph_rmsnorm_route(F, F.w<bf16>(WS_H), F.in[I_FFNN_O], F.w<float>(WS_RSTD)); } SEAM(15);
    if (IN(16)) { ph_slots(F); } SEAM(16);
    if (IN(17)) { const int* tile_e = F.w<int>(WS_TILE_E); const int ntile = tile_e[TILE_CAP];
        pg8::Gemm g{H, F.w<pg8::bf16_t>(WS_WGU_O), 1024, 1024, 1024}; pg8::MoeOrder S{tile_e, ntile, 2 * FF_O / 256, F.G, F.bid, 1, 1024, 0}; pg8::EpiSwiGLUS<pg8::ScaleSlot> E{F.w<pg8::bf16_t>(WS_ACT1), FF_O, 2 * FF_O / 256, {F.w<float>(WS_SLOT_RSTD)}};
        pg8::gemm_phase<pg8::EpiSwiGLUS<pg8::ScaleSlot>, pg8::MoeOrder, true, true>(glds, g, S, E, F.w<int>(WS_SLOT_TOK)); } SEAM(17);
    if (IN(18)) { const int* tile_e = F.w<int>(WS_TILE_E); const int ntile = tile_e[TILE_CAP];
        { pg8::Gemm g{F.w<pg8::bf16_t>(WS_ACT1), F.w<pg8::bf16_t>(WS_WDN_O), FF_O, FF_O, FF_O}; pg8::MoeOrder S{tile_e, ntile < MOE_FULL_TILES ? ntile : MOE_FULL_TILES, 4, F.G, F.bid, 1, FF_O, 0};
          pg8::EpiMoeY E{F.w<pg8::bf16_t>(WS_Y), 0, 4, FF_O, 0};
          pg8::gemm_phase<pg8::EpiMoeY, pg8::MoeOrder, true, false>(glds, g, S, E, nullptr); }
        if (ntile > MOE_FULL_TILES) { pg8::Gemm g{F.w<pg8::bf16_t>(WS_ACT1), F.w<pg8::bf16_t>(WS_WDN_O), FF_O, FF_O, FF_O / MOE_TAIL_SPLIT}; pg8::MoeOrder S{tile_e, ntile - MOE_FULL_TILES, 4, F.G, F.bid, MOE_TAIL_SPLIT, FF_O / MOE_TAIL_SPLIT, MOE_FULL_TILES};
          pg8::EpiMoeY E{F.w<pg8::bf16_t>(WS_YP), (size_t)MOE_TAIL_ROWS * 1024, 4, FF_O / MOE_TAIL_SPLIT, MOE_FULL_TILES * 256};
          pg8::gemm_phase<pg8::EpiMoeY, pg8::MoeOrder, true, false>(glds, g, S, E, nullptr); } } SEAM(18);
    if (IN(19)) { ph_moe_combine(F); }
#undef IN
#undef SEAM
}

#ifndef FAST_MASK
#define FAST_MASK 0xFFFFFu
#endif
#ifndef ONE_LAUNCH
#define ONE_LAUNCH 0
#endif
struct Ptrs {
    const float* in[N_INPUTS]; float* out; unsigned char* ws;
    template <class T> T* w(size_t off) const { return (T*)(ws + off); }
};
static int g_grid = 0;
static void launch_mega(const Ptrs& P, int lo, int hi, hipStream_t st, int sub = 3) {
    Args a{}; a.sub = sub; for (int i = 0; i < N_INPUTS; ++i) a.in[i] = P.in[i]; a.out = P.out; a.ws = P.ws; a.ph_lo = lo; a.ph_hi = hi;
    hipLaunchKernelGGL(mega, dim3(g_grid), dim3(NTHR), LDS_BYTES, st, a);
    const hipError_t le = hipPeekAtLastError();
    if (le != hipSuccess) fprintf(stderr, "kernel_launch: mega[%d,%d) failed: %s\n", lo, hi, hipGetErrorName(le));
}
#if !ONE_LAUNCH
static void naive_weights(const Ptrs& P, hipStream_t st) {
    auto wt = [&](int idx, int K, int N, int Npad, size_t off, int mode, int nexp, size_t wes, size_t wtes) {
        nv::k_wt<<<dim3((Npad + 31) / 32, K / 32, nexp), 256, 0, st>>>(P.in[idx], K, N, Npad, P.w<bf16>(off), mode, wes, wtes); };
    wt(I_W_IN_E, 1024, N_IN_E, QKV_LD, WS_W_IN_E, 0, 1, 0, 0);
    wt(I_W_OUT_E, 1024, 1024, 1024, WS_W_OUT_E, 0, 1, 0, 0);
    wt(I_W_GATE_E, 1024, FF_E, FF_E, WS_W_GU_E, 1, 1, 0, 0);
    wt(I_W_UP_E, 1024, FF_E, FF_E, WS_W_GU_E, 2, 1, 0, 0);
    wt(I_W_DOWN_E, FF_E, 1024, 1024, WS_W_DN_E, 0, 1, 0, 0);
    wt(I_W_IN_O, 1024, N_IN_O, C1_LD, WS_W_IN_O, 0, 1, 0, 0);
    wt(I_W_UQ, 384, 1536, 1536, WS_W_UQ, 0, 1, 0, 0);
    wt(I_W_UKV, 256, 2048, 2048, WS_W_UKV, 0, 1, 0, 0);
    wt(I_W_OUT_O, 1024, 1024, 1024, WS_W_OUT_O, 0, 1, 0, 0);
    wt(I_W_GATE_O, 1024, FF_O, FF_O, WS_WGU_O, 1, NEXP, (size_t)1024 * FF_O, (size_t)2 * FF_O * 1024);
    wt(I_W_UP_O, 1024, FF_O, FF_O, WS_WGU_O, 2, NEXP, (size_t)1024 * FF_O, (size_t)2 * FF_O * 1024);
    wt(I_W_DOWN_O, FF_O, 1024, 1024, WS_WDN_O, 0, NEXP, (size_t)1024 * FF_O, (size_t)1024 * FF_O);
}
template <int EPI> static void naive_gemm(nv::GemmArgs a, hipStream_t st) { nv::k_gemm<EPI><<<dim3(a.N / 64, a.M / 64), 256, 0, st>>>(a); }
__global__ void k_rope_tab(float2* tab) { const int idx = blockIdx.x * 256 + threadIdx.x; const int pos = idx >> 4, i = idx & 15; const float fr = powf(10000.f, -(float)i / 16.f), ang = (float)pos * fr; tab[idx] = make_float2(cosf(ang), sinf(ang)); }

static void naive_phase(const Ptrs& P, int k, hipStream_t st) {
    bf16* H = P.w<bf16>(WS_H); bf16* QKV = P.w<bf16>(WS_QKV0); bf16* O = P.w<bf16>(WS_O); float* X = P.out;
    bf16* C1 = P.w<bf16>(WS_C1); bf16* QR = P.w<bf16>(WS_QR); bf16* KVR = P.w<bf16>(WS_KVR); bf16* KM = P.w<bf16>(WS_KM); bf16* O1 = P.w<bf16>(WS_O1);
    switch (k) {
    case 0: naive_weights(P, st); k_rope_tab<<<SEQ * 16 / 256, 256, 0, st>>>(P.w<float2>(WS_ROPE)); nv::k_rmsnorm<<<M_TOK / 4, 256, 0, st>>>(P.in[I_X], P.in[I_MIXN_E], H); break;
    case 1: { nv::GemmArgs a{}; a.A = H; a.lda = 1024; a.Bt = P.w<bf16>(WS_W_IN_E); a.K = 1024; a.M = M_TOK; a.N = QKV_LD; a.Cb = QKV; a.ldc = QKV_LD; naive_gemm<0>(a, st); } break;
    case 2: nv::k_kmean<<<NB * 8 * 16, 64, 0, st>>>(QKV, P.in[I_MKN], P.w<float>(WS_KMEAN));
            nv::k_qknorm<<<M_TOK * 32 / 256, 256, 0, st>>>(QKV, P.in[I_MQN], P.in[I_MKN], P.in[I_DQN], P.in[I_DKN]);
            break;
    case 100: nv::k_dsa_index<<<M_TOK, 256, 0, st>>>(QKV, P.w<unsigned long long>(WS_MASKT)); break;
    case 3: { nv::AttnArgs a{}; a.Q = QKV + C_MQ; a.ldq = QKV_LD; a.qhs = 64; a.K = QKV + C_MK; a.ldk = QKV_LD; a.khs = 64; a.V = QKV + C_MV; a.ldv = QKV_LD; a.vhs = 64; a.O = O; a.ocol0 = 0; a.H = 8;
              a.relb = P.in[I_RELB]; a.bcol0 = 0; a.kmean = P.w<float>(WS_KMEAN); a.maskt = nullptr; nv::k_attn<0, 64><<<NB * 8 * SEQ / 4, 256, 0, st>>>(a); }
            { nv::AttnArgs a{}; a.Q = QKV + C_DQ; a.ldq = QKV_LD; a.qhs = 64; a.K = QKV + C_DK; a.ldk = QKV_LD; a.khs = 64; a.V = QKV + C_DV; a.ldv = QKV_LD; a.vhs = 64; a.O = O; a.ocol0 = 512; a.H = 8;
              a.relb = P.in[I_RELB]; a.bcol0 = 8; a.kmean = nullptr; a.maskt = P.w<unsigned long long>(WS_MASKT); nv::k_attn<1, 64><<<NB * 8 * SEQ / 4, 256, 0, st>>>(a); } break;
    case 4: { nv::GemmArgs a{}; a.A = O; a.lda = 1024; a.Bt = P.w<bf16>(WS_W_OUT_E); a.K = 1024; a.M = M_TOK; a.N = 1024; a.Cf = X; a.R = P.in[I_X]; a.ldc = 1024; naive_gemm<1>(a, st); } break;
    case 5: nv::k_rmsnorm<<<M_TOK / 4, 256, 0, st>>>(X, P.in[I_FFNN_E], H); break;
    case 6: { nv::GemmArgs a{}; a.A = H; a.lda = 1024; a.Bt = P.w<bf16>(WS_W_GU_E); a.K = 1024; a.M = M_TOK; a.N = FF_E; a.Cb = P.w<bf16>(WS_ACT0); a.ldc = FF_E; naive_gemm<2>(a, st); } break;
    case 7: { nv::GemmArgs a{}; a.A = P.w<bf16>(WS_ACT0); a.lda = FF_E; a.Bt = P.w<bf16>(WS_W_DN_E); a.K = FF_E; a.M = M_TOK; a.N = 1024; a.Cf = X; a.R = X; a.ldc = 1024; naive_gemm<1>(a, st); } break;
    case 8: nv::k_rmsnorm<<<M_TOK / 4, 256, 0, st>>>(X, P.in[I_MIXN_O], H); break;
    case 9: { nv::GemmArgs a{}; a.A = H; a.lda = 1024; a.Bt = P.w<bf16>(WS_W_IN_O); a.K = 1024; a.M = M_TOK; a.N = C1_LD; a.Cb = C1; a.ldc = C1_LD; naive_gemm<0>(a, st); } break;
    case 10: nv::k_rmsnorm_bf<<<M_TOK / 4, 256, 0, st>>>(C1, C1_LD, C1_CQ, 384, P.in[I_QAN], P.w<bf16>(WS_CQN), 384);
             nv::k_rmsnorm_bf<<<M_TOK / 4, 256, 0, st>>>(C1, C1_LD, C1_CKV, 256, P.in[I_KVAN], P.w<bf16>(WS_CKVN), 256); break;
    case 11: { nv::GemmArgs a{}; a.A = P.w<bf16>(WS_CQN); a.lda = 384; a.Bt = P.w<bf16>(WS_W_UQ); a.K = 384; a.M = M_TOK; a.N = QR_LD; a.Cb = QR; a.ldc = QR_LD; naive_gemm<0>(a, st); }
             { nv::GemmArgs a{}; a.A = P.w<bf16>(WS_CKVN); a.lda = 256; a.Bt = P.w<bf16>(WS_W_UKV); a.K = 256; a.M = M_TOK; a.N = KVR_LD; a.Cb = KVR; a.ldc = KVR_LD; naive_gemm<0>(a, st); } break;
    case 12: nv::k_mla_prep<<<M_TOK * 16 / 256, 256, 0, st>>>(QR, KVR, C1, KM, P.in[I_MLAQN], P.in[I_MLAKN]); break;
    case 13: { nv::AttnArgs a{}; a.Q = QR; a.ldq = QR_LD; a.qhs = 96; a.K = KM; a.ldk = QR_LD; a.khs = 96; a.V = KVR + 64; a.ldv = KVR_LD; a.vhs = 128; a.O = O1; a.ocol0 = 0; a.H = 16;
               nv::k_attn<2, 96><<<NB * 16 * SEQ / 4, 256, 0, st>>>(a); } break;
    case 14: { nv::GemmArgs a{}; a.A = O1; a.lda = 1024; a.Bt = P.w<bf16>(WS_W_OUT_O); a.K = 1024; a.M = M_TOK; a.N = 1024; a.Cf = X; a.R = X; a.ldc = 1024; naive_gemm<1>(a, st); } break;
    case 15: nv::k_rmsnorm_route<<<M_TOK / 4, 256, 0, st>>>(X, P.in[I_FFNN_O], H, P.in[I_W_ROUTER], P.in[I_B_ROUTER], P.w<int2>(WS_ROUTE_E), P.w<float2>(WS_ROUTE_G));
             nv::k_route_count<<<256, 64, 0, st>>>(P.w<int2>(WS_ROUTE_E), P.w<int>(WS_CNT_WG)); break;
    case 16: nv::k_slots<<<256, 64, 0, st>>>(P.w<int2>(WS_ROUTE_E), P.w<float2>(WS_ROUTE_G), P.w<int>(WS_CNT_WG), P.w<int>(WS_SLOT_TOK), P.w<float>(WS_SLOT_GATE), P.w<int>(WS_TILE_E)); break;
    case 17: { nv::GemmArgs a{}; a.A = H; a.lda = 1024; a.Bt = P.w<bf16>(WS_WGU_O); a.K = 1024; a.M = SLOT_CAP; a.N = FF_O; a.Cb = P.w<bf16>(WS_ACT1); a.ldc = FF_O;
               a.tile_e = P.w<int>(WS_TILE_E); a.stok = P.w<int>(WS_SLOT_TOK); a.sgate = P.w<float>(WS_SLOT_GATE); a.b_estride = (size_t)2 * FF_O * 1024; naive_gemm<3>(a, st); } break;
    case 18: { nv::GemmArgs a{}; a.A = P.w<bf16>(WS_ACT1); a.lda = FF_O; a.Bt = P.w<bf16>(WS_WDN_O); a.K = FF_O; a.M = SLOT_CAP; a.N = 1024; a.Cf = X; a.ldc = 1024;
               a.tile_e = P.w<int>(WS_TILE_E); a.stok = P.w<int>(WS_SLOT_TOK); a.sgate = P.w<float>(WS_SLOT_GATE); a.b_estride = (size_t)1024 * FF_O; naive_gemm<4>(a, st); } break;
    }
}
#endif

extern "C" void kernel_launch(void* const* d_in, const int* in_sizes, int n_in, void* d_out, int out_size, void* d_ws, size_t ws_size, hipStream_t stream) {
    if (n_in != N_INPUTS || out_size != M_TOK * DM || ws_size < WS_END) { fprintf(stderr, "kernel_launch: unexpected shapes (n_in %d out %d ws %zu)\n", n_in, out_size, ws_size); return; }
    if (g_grid == 0) {
        int dev = 0, cus = 0, per_cu = 0;
        if (hipGetDevice(&dev) != hipSuccess || hipDeviceGetAttribute(&cus, hipDeviceAttributeMultiprocessorCount, dev) != hipSuccess) { g_grid = -1; return; }
        if (hipFuncSetAttribute((const void*)mega, hipFuncAttributeMaxDynamicSharedMemorySize, LDS_BYTES) != hipSuccess) { fprintf(stderr, "kernel_launch: cannot get %d B of dynamic LDS\n", LDS_BYTES); g_grid = -1; return; }
        if (hipOccupancyMaxActiveBlocksPerMultiprocessor(&per_cu, (const void*)mega, NTHR, LDS_BYTES) != hipSuccess || per_cu < 1) { fprintf(stderr, "kernel_launch: occupancy query says %d\n", per_cu); }
        (void)hipGetLastError();
        g_grid = cus;
    }
    if (g_grid < 0) return;
    Ptrs P{}; for (int i = 0; i < N_INPUTS; ++i) P.in[i] = (const float*)d_in[i]; P.out = (float*)d_out; P.ws = (unsigned char*)d_ws;
    (void)hipMemsetAsync((char*)d_ws + WS_CTL, 0, 65536, stream);
#if ONE_LAUNCH
    launch_mega(P, 0, NPHASE, stream);
#else
    for (int k = 0; k < NPHASE; ++k) { if ((FAST_MASK >> k) & 1u) { launch_mega(P, k, k + 1, stream);
#ifdef DUP_MASK
            for (int rep = 0; rep < DUP_REPS; ++rep) if ((DUP_MASK >> k) & 1u) launch_mega(P, k, k + 1, stream, 2);
#endif
        } else naive_phase(P, k, stream);
        if (k == 2 && !(HAVE_INDEX && ((FAST_MASK >> 2) & 1u))) naive_phase(P, 100, stream); }
#endif
}
```

```cpp
#define ONE_LAUNCH 1
#define HAVE_ATTN 1
#define HAVE_INDEX 1
#include <hip/hip_runtime.h>
#include <stdint.h>
#include <stdio.h>

typedef unsigned short bf16;
__device__ __forceinline__ float bf2f(bf16 v) { return __uint_as_float(((unsigned)v) << 16); }
__device__ __forceinline__ bf16 f2bf(float f) { unsigned u = __float_as_uint(f); return (bf16)((u + 0x7fffu + ((u >> 16) & 1u)) >> 16); }
typedef float f32x2_t __attribute__((ext_vector_type(2))); typedef __bf16 bf16x2_t __attribute__((ext_vector_type(2)));
__device__ __forceinline__ unsigned pk2(float lo, float hi) { f32x2_t v = {lo, hi}; bf16x2_t b = __builtin_convertvector(v, bf16x2_t); return __builtin_bit_cast(unsigned, b); }

constexpr int NB = 4, SEQ = 4096, M_TOK = NB * SEQ, DM = 1024;
constexpr int QKV_LD = 3584;
constexpr int C_MQ = 0, C_MK = 512, C_MV = 1024, C_DQ = 1536, C_DK = 2048, C_DV = 2560, C_IQ = 3072, C_IK = 3328, C_IW = 3392, N_IN_E = 3396;
constexpr int FF_E = 2816, FF_O = 3584, NEXP = 8;
constexpr int C1_LD = 768, N_IN_O = 672, C1_CQ = 0, C1_CKV = 384, C1_KPE = 640;
constexpr int QR_LD = 1536, KVR_LD = 2048;
constexpr int SLOT_CAP = 34816, TILE_CAP = 136;
constexpr float EPS = 1e-6f;
constexpr float LOG2E = 1.4426950408889634f;
constexpr float QSCALE64 = 0.125f * LOG2E;
constexpr float QSCALE96 = 0.10206207261596575f * LOG2E;

constexpr size_t MiB = 1u << 20;
constexpr size_t WS_CTL = 0;
constexpr size_t WS_KMEAN = 1 * MiB;
constexpr size_t WS_ROUTE_E = 1 * MiB + 128 * 1024;
constexpr size_t WS_ROUTE_G = 1 * MiB + 256 * 1024;
constexpr size_t WS_CNT_WG = 1 * MiB + 384 * 1024;
constexpr size_t WS_SLOT_TOK = 1 * MiB + 400 * 1024;
constexpr size_t WS_SLOT_GATE = 1 * MiB + 544 * 1024;
constexpr size_t WS_TILE_E = 1 * MiB + 688 * 1024;
constexpr size_t WS_TOK_SLOT = 1 * MiB + 704 * 1024;
constexpr size_t WS_REFS = 1 * MiB + 832 * 1024;
constexpr size_t WS_WDN_O = 2 * MiB;
constexpr size_t WS_WGU_O = 58 * MiB;
constexpr size_t WS_Y = 58 * MiB;
constexpr size_t WS_YP = 128 * MiB;
constexpr int MOE_FULL_TILES = 128, MOE_TAIL_SPLIT = 7, MOE_TAIL_ROWS = SLOT_CAP - MOE_FULL_TILES * 256;
constexpr size_t WS_H = 170 * MiB;
constexpr size_t WS_SCR = 202 * MiB;
constexpr size_t WS_QKV0 = WS_SCR;
constexpr size_t WS_O = 314 * MiB;
constexpr size_t WS_ACT0 = WS_SCR;
constexpr size_t WS_C1 = WS_SCR;
constexpr size_t WS_LSP = 226 * MiB;
constexpr size_t WS_CQN = 228 * MiB;
constexpr size_t WS_CKVN = 238 * MiB;
constexpr size_t WS_QR = 246 * MiB;
constexpr size_t WS_KVR = 294 * MiB;
constexpr size_t WS_KM = 358 * MiB;
constexpr size_t WS_O1 = WS_SCR;
constexpr size_t WS_MASKT = 412 * MiB;
constexpr size_t WS_W_IN_E = 420 * MiB;
constexpr size_t WS_W_OUT_E = 427 * MiB;
constexpr size_t WS_W_GU_E = 429 * MiB;
constexpr size_t WS_W_DN_E = 440 * MiB;
constexpr size_t WS_W_IN_O = 446 * MiB;
constexpr size_t WS_W_LAT = 448 * MiB;
constexpr int W_LAT_LD = 640;
constexpr size_t WS_W_UQ = WS_W_LAT, WS_W_UKV = WS_W_LAT;
constexpr size_t WS_W_OUT_O = 452 * MiB + 512 * 1024;
constexpr size_t WS_ACT1 = WS_SCR;
constexpr size_t WS_ROPE = 455 * MiB;
constexpr size_t WS_SSP = 456 * MiB;
constexpr size_t WS_SLOT_RSTD = 457 * MiB;
constexpr size_t WS_RSTD = 457 * MiB + 256 * 1024;
constexpr size_t WS_END = 458 * MiB;
static_assert(WS_W_LAT + (size_t)3584 * 640 * 2 <= WS_W_OUT_O && WS_W_OUT_O + (size_t)1024 * 1024 * 2 <= WS_ROPE, "tail of the ws map");
static_assert(WS_ACT1 + (size_t)SLOT_CAP * FF_O * 2 <= WS_W_IN_O, "ACT1 must not reach the odd-layer weights");
static_assert(WS_Y + (size_t)SLOT_CAP * 1024 * 2 <= WS_YP && WS_YP + (size_t)MOE_TAIL_SPLIT * MOE_TAIL_ROWS * 1024 * 2 <= WS_SCR && WS_TOK_SLOT + (size_t)M_TOK * 8 <= 2 * MiB, "Y / TOK_SLOT map");
static_assert(WS_W_DN_E + (size_t)1024 * 2816 * 2 <= WS_W_IN_O && WS_KM + (size_t)M_TOK * 1536 * 2 <= WS_MASKT, "ws map");

enum { I_X = 0, I_RELB, I_MIXN_E, I_W_IN_E, I_MQN, I_MKN, I_DQN, I_DKN, I_W_OUT_E, I_FFNN_E, I_W_GATE_E, I_W_UP_E, I_W_DOWN_E,
       I_MIXN_O, I_W_IN_O, I_QAN, I_KVAN, I_W_UQ, I_W_UKV, I_MLAQN, I_MLAKN, I_W_OUT_O, I_FFNN_O, I_W_ROUTER, I_B_ROUTER,
       I_W_GATE_O, I_W_UP_O, I_W_DOWN_O, N_INPUTS };

__device__ __forceinline__ float wave_sum(float v) {
#pragma unroll
    for (int o = 1; o < 64; o <<= 1) v += __shfl_xor(v, o);
    return v;
}
__device__ __forceinline__ float wave_max(float v) {
#pragma unroll
    for (int o = 1; o < 64; o <<= 1) v = fmaxf(v, __shfl_xor(v, o));
    return v;
}
__device__ __forceinline__ int rel_bucket(int n) {
    if (n < 16) return n;
    int b = 16;
    b += (n >= 21); b += (n >= 27); b += (n >= 35); b += (n >= 46); b += (n >= 59); b += (n >= 77); b += (n >= 99); b += (n >= 128);
    b += (n >= 166); b += (n >= 216); b += (n >= 280); b += (n >= 363); b += (n >= 470); b += (n >= 609); b += (n >= 790);
    return b;
}
__device__ __forceinline__ unsigned fkey(float f) { unsigned u = __float_as_uint(f); return (u & 0x80000000u) ? ~u : (u | 0x80000000u); }
__device__ __forceinline__ float bflo(unsigned u) { return __uint_as_float(u << 16); }
__device__ __forceinline__ float bfhi(unsigned u) { return __uint_as_float(u & 0xffff0000u); }
__device__ __forceinline__ float silu_f(float x) { return x / (1.f + __expf(-x)); }

namespace pg8 {
#define PG8_LAS __attribute__((address_space(3)))
typedef unsigned short bf16_t;
typedef short bf16x8 __attribute__((ext_vector_type(8)));
typedef float f32x4 __attribute__((ext_vector_type(4)));
typedef unsigned u32x4 __attribute__((ext_vector_type(4)));
constexpr int BM = 256, BK = 64, HALF = 128, HTB = HALF * BK * 2, STAGE_BYTES = 8 * HTB, NXCD = 8, WGM = 8;

__host__ __device__ __forceinline__ int lds_byte(int r, int c) { const int st = (r >> 4) * 2 + (c >> 5), rr = r & 15, cc = c & 31, ob = rr * 64 + cc * 2; return st * 1024 + (ob ^ (((ob >> 9) & 1) << 5)); }
__host__ __device__ __forceinline__ void stage_rc(int b, int& R, int& C) { const int st = b / 1024, sb = b % 1024, swz = sb ^ (((sb >> 9) & 1) << 5); R = (st >> 1) * 16 + swz / 64; C = (st & 1) * 32 + (swz % 64) / 2; }
__host__ __device__ __forceinline__ int perm32(int rho) { const int n = rho >> 4, i = rho & 15; return 8 * (i >> 2) + 4 * n + (i & 3); }

struct Unit { int pm, pn, koff, nt; };
struct Gemm { const bf16_t* A; const bf16_t* Bt; int lda, ldb, K; };

__device__ __forceinline__ bool static_unit(int nM, int nN, int G, int c, int i, int& pm, int& pn) {
    const int nwg = nM * nN; const long L = (long)i * G + c; if (L >= nwg) return false;
    int wgid = (int)L; { const int q = nwg / NXCD, r = nwg % NXCD, xcd = wgid % NXCD, off = wgid / NXCD; wgid = (xcd < r ? xcd * (q + 1) : r * (q + 1) + (xcd - r) * q) + off; }
    const int nig = WGM * nN, gid = wgid / nig, fm = gid * WGM, gsz = (nM - fm) < WGM ? (nM - fm) : WGM;
    pm = fm + ((wgid % nig) % gsz); pn = (wgid % nig) / gsz; return true;
}
struct StaticOrder {
    static constexpr bool USE_LIST = false;
    int nM, nN, G, c;
    __device__ __forceinline__ bool next(int i, Unit& u) const { u.koff = 0; u.nt = 0; return static_unit(nM, nN, G, c, i, u.pm, u.pn); }
};
struct MoeOrder {
    static constexpr bool USE_LIST = true;
    const int* tile_e; int nM, nN, G, c, ksplit, Kpart, pm0;
    __device__ __forceinline__ bool next(int i, Unit& u) const {
        const int nwg = nM * nN; const long L = (long)i * G + c; if (L >= (long)nwg * ksplit) return false;
        const int ks = (int)(L / nwg), w = (int)(L % nwg); int pm, j;
        static_unit(nM, nN, nwg, w, 0, pm, j);
        u.pm = pm0 + pm; u.pn = tile_e[pm0 + pm] * nN + j; u.koff = ks * Kpart; u.nt = 0; return true;
    }
};

struct LatJointOrder {
    static constexpr bool USE_LIST = true;
    int G, c;
    __device__ __forceinline__ void uq(int idx, Unit& u) const { int pm, pn; static_unit(64, 6, 384, idx, 0, pm, pn); u.pm = pm; u.pn = pn; u.koff = 0; u.nt = 6; }
    __device__ __forceinline__ void ukv(int idx, Unit& u) const { int pm, pn; static_unit(64, 8, 512, idx, 0, pm, pn); u.pm = pm; u.pn = 6 + pn; u.koff = 384; u.nt = 4; }
    __device__ __forceinline__ bool next(int i, Unit& u) const {
        if (G == 256) {
            if (c < 128) { if (i == 0) { uq(c, u); return true; } if (i == 1) { uq(128 + c, u); return true; } if (i == 2) { ukv(c, u); return true; } return false; }
            const int d = c - 128; if (i == 0) { uq(256 + d, u); return true; } if (i >= 1 && i <= 3) { ukv(128 + 3 * d + (i - 1), u); return true; } return false; }
        const int L = i * G + c; if (L >= 896) return false; if (L < 384) uq(L, u); else ukv(L - 384, u); return true;
    }
};

__device__ __forceinline__ unsigned cvt_pk_bf16(float lo, float hi) { unsigned r; asm volatile("v_cvt_pk_bf16_f32 %0, %1, %2" : "=v"(r) : "v"(lo), "v"(hi)); return r; }
__device__ __forceinline__ float fast_silu(float x) { return x * __builtin_amdgcn_rcpf(1.f + __builtin_amdgcn_exp2f(-1.4426950408889634f * x)); }

struct EpiBf16 {
    static constexpr bool PERM = true;
    bf16_t* O; int ldc;
    static constexpr bool HAS_SCALE = false;
    __device__ __forceinline__ void preload(PG8_LAS unsigned char*, int, int) const {}
    __device__ __forceinline__ void operator()(const f32x4 (&acc)[2][2][4][2], const Unit& u, int wr, int wc, int fr, int fq, const PG8_LAS unsigned char* sp, int ui) const {
        const int row0 = u.pm * BM + wr * 64 + fr, col0 = u.pn * BM + wc * 32 + 8 * fq;
#pragma unroll
        for (int ai = 0; ai < 2; ++ai)
#pragma unroll
            for (int m = 0; m < 4; ++m) { bf16_t* rowp = O + (size_t)(row0 + ai * HALF + m * 16) * ldc + col0;
#pragma unroll
                for (int bj = 0; bj < 2; ++bj) { const f32x4 v0 = acc[ai][bj][m][0], v1 = acc[ai][bj][m][1];
                    u32x4 w; w.x = cvt_pk_bf16(v0[0], v0[1]); w.y = cvt_pk_bf16(v0[2], v0[3]); w.z = cvt_pk_bf16(v1[0], v1[1]); w.w = cvt_pk_bf16(v1[2], v1[3]);
                    *(u32x4*)(rowp + bj * HALF) = w; } }
    }
};
struct EpiResF32 {
    static constexpr bool PERM = false;
    const float* R; float* O; int ldc;
    static constexpr bool HAS_SCALE = false;
    __device__ __forceinline__ void preload(PG8_LAS unsigned char*, int, int) const {}
    __device__ __forceinline__ void operator()(const f32x4 (&acc)[2][2][4][2], const Unit& u, int wr, int wc, int fr, int fq, const PG8_LAS unsigned char* sp, int ui) const {
        const int row0 = u.pm * BM + wr * 64 + fr, col0 = u.pn * BM + wc * 32 + 4 * fq;
#pragma unroll
        for (int ai = 0; ai < 2; ++ai)
#pragma unroll
            for (int m = 0; m < 4; ++m) { const size_t off = (size_t)(row0 + ai * HALF + m * 16) * ldc + col0;
#pragma unroll
                for (int bj = 0; bj < 2; ++bj)
#pragma unroll
                    for (int n = 0; n < 2; ++n) { const f32x4 r = *(const f32x4*)(R + off + bj * HALF + n * 16); *(f32x4*)(O + off + bj * HALF + n * 16) = r + acc[ai][bj][m][n]; } }
    }
};
struct EpiSwiGLU {
    static constexpr bool PERM = true;
    bf16_t* O; int ldc; int nmod;
    static constexpr bool HAS_SCALE = false;
    __device__ __forceinline__ void preload(PG8_LAS unsigned char*, int, int) const {}
    __device__ __forceinline__ void operator()(const f32x4 (&acc)[2][2][4][2], const Unit& u, int wr, int wc, int fr, int fq, const PG8_LAS unsigned char* sp, int ui) const {
        const int row0 = u.pm * BM + wr * 64 + fr, col0 = (u.pn % nmod) * HALF + wc * 32 + 8 * fq;
#pragma unroll
        for (int ai = 0; ai < 2; ++ai)
#pragma unroll
            for (int m = 0; m < 4; ++m) { const f32x4 g0 = acc[ai][0][m][0], g1 = acc[ai][0][m][1], u0 = acc[ai][1][m][0], u1 = acc[ai][1][m][1];
                u32x4 w; w.x = cvt_pk_bf16(fast_silu(g0[0]) * u0[0], fast_silu(g0[1]) * u0[1]); w.y = cvt_pk_bf16(fast_silu(g0[2]) * u0[2], fast_silu(g0[3]) * u0[3]);
                w.z = cvt_pk_bf16(fast_silu(g1[0]) * u1[0], fast_silu(g1[1]) * u1[1]); w.w = cvt_pk_bf16(fast_silu(g1[2]) * u1[2], fast_silu(g1[3]) * u1[3]);
                *(u32x4*)(O + (size_t)(row0 + ai * HALF + m * 16) * ldc + col0) = w; }
    }
};
struct EpiMoeY {
    static constexpr bool PERM = true;
    bf16_t* Y; size_t kstride; int nmod, kpart, row_off;
    static constexpr bool HAS_SCALE = false;
    __device__ __forceinline__ void preload(PG8_LAS unsigned char*, int, int) const {}
    __device__ __forceinline__ void operator()(const f32x4 (&acc)[2][2][4][2], const Unit& u, int wr, int wc, int fr, int fq, const PG8_LAS unsigned char* sp, int ui) const {
        const int row0 = u.pm * BM - row_off + wr * 64 + fr, col0 = (u.pn % nmod) * BM + wc * 32 + 8 * fq; bf16_t* base = Y + (size_t)(u.koff / kpart) * kstride;
#pragma unroll
        for (int ai = 0; ai < 2; ++ai)
#pragma unroll
            for (int m = 0; m < 4; ++m) { bf16_t* rowp = base + (size_t)(row0 + ai * HALF + m * 16) * 1024 + col0;
#pragma unroll
                for (int bj = 0; bj < 2; ++bj) { const f32x4 v0 = acc[ai][bj][m][0], v1 = acc[ai][bj][m][1];
                    u32x4 w; w.x = cvt_pk_bf16(v0[0], v0[1]); w.y = cvt_pk_bf16(v0[2], v0[3]); w.z = cvt_pk_bf16(v1[0], v1[1]); w.w = cvt_pk_bf16(v1[2], v1[3]);
                    *(u32x4*)(rowp + bj * HALF) = w; } }
    }
};


template <bool RBF> struct EpiResN {
    static constexpr bool PERM = true;
    const float* Rf; bf16_t* XB; float* SSP; int ldc;
    static constexpr bool HAS_SCALE = false;
    __device__ __forceinline__ void preload(PG8_LAS unsigned char*, int, int) const {}
    __device__ __forceinline__ void operator()(const f32x4 (&acc)[2][2][4][2], const Unit& u, int wr, int wc, int fr, int fq, const PG8_LAS unsigned char*, int) const {
        const int row0 = u.pm * BM + wr * 64 + fr, col0 = u.pn * BM + wc * 32 + 8 * fq;
#pragma unroll
        for (int ai = 0; ai < 2; ++ai)
#pragma unroll
            for (int m = 0; m < 4; ++m) { const int row = row0 + ai * HALF + m * 16; const size_t off = (size_t)row * ldc + col0; float ss = 0.f;
#pragma unroll
                for (int bj = 0; bj < 2; ++bj) { f32x4 r0, r1;
                    if (RBF) { const u32x4 rb = *(const u32x4*)(XB + off + bj * HALF);
                        r0 = (f32x4){__uint_as_float(rb.x << 16), __uint_as_float(rb.x & 0xffff0000u), __uint_as_float(rb.y << 16), __uint_as_float(rb.y & 0xffff0000u)};
                        r1 = (f32x4){__uint_as_float(rb.z << 16), __uint_as_float(rb.z & 0xffff0000u), __uint_as_float(rb.w << 16), __uint_as_float(rb.w & 0xffff0000u)}; }
                    else { r0 = *(const f32x4*)(Rf + off + bj * HALF); r1 = *(const f32x4*)(Rf + off + bj * HALF + 4); }
                    const f32x4 v0 = r0 + acc[ai][bj][m][0], v1 = r1 + acc[ai][bj][m][1];
                    ss += ((v0[0] * v0[0] + v0[1] * v0[1]) + (v0[2] * v0[2] + v0[3] * v0[3])) + ((v1[0] * v1[0] + v1[1] * v1[1]) + (v1[2] * v1[2] + v1[3] * v1[3]));
                    u32x4 w; w.x = cvt_pk_bf16(v0[0], v0[1]); w.y = cvt_pk_bf16(v0[2], v0[3]); w.z = cvt_pk_bf16(v1[0], v1[1]); w.w = cvt_pk_bf16(v1[2], v1[3]);
                    *(u32x4*)(XB + off + bj * HALF) = w; }
                ss += __shfl_xor(ss, 16); ss += __shfl_xor(ss, 32);
                if (fq == 0) SSP[(size_t)row * 16 + (u.pn & 3) * 4 + wc] = ss; }
    }
};
constexpr int MAX_UNITS_WG = 15;
constexpr int SP_SCALE = 0, SP_GIDX = MAX_UNITS_WG * 1024, SP_ULIST = 30720 + 256;
struct ScaleSSP {
    const float* SSP; float eps;
    __device__ __forceinline__ float row(const Unit& u, int r) const { const f32x4* p = (const f32x4*)(SSP + (size_t)(u.pm * BM + r) * 16); const f32x4 a = p[0], b = p[1], c = p[2], d = p[3];
        const float s = ((a[0] + a[1]) + (a[2] + a[3])) + ((b[0] + b[1]) + (b[2] + b[3])) + ((c[0] + c[1]) + (c[2] + c[3])) + ((d[0] + d[1]) + (d[2] + d[3]));
        return __builtin_amdgcn_rsqf(s * (1.f / 1024.f) + eps); }
};
struct ScaleSlot {
    const float* srstd;
    __device__ __forceinline__ float row(const Unit& u, int r) const { return srstd[u.pm * BM + r]; }
};
template <class Sched> __device__ __forceinline__ int build_unit_list(PG8_LAS unsigned char* sp, const Sched& sched, int tid) {
    PG8_LAS int* ul = (PG8_LAS int*)(sp + SP_ULIST);
    if (tid < MAX_UNITS_WG + 1) { Unit u; u.pm = -1; u.pn = 0; u.koff = 0; u.nt = 0; const bool ok = (tid < MAX_UNITS_WG) && sched.next(tid, u); ul[4 * tid] = ok ? u.pm : -1; ul[4 * tid + 1] = u.pn; ul[4 * tid + 2] = u.koff; ul[4 * tid + 3] = u.nt; }
    __syncthreads();
    int n = 0; while (n < MAX_UNITS_WG && ul[4 * n] >= 0) ++n;
    return n;
}
template <class Scale> __device__ __forceinline__ void preload_scales(const Scale& S, PG8_LAS unsigned char* sp, int n, int tid) {
    PG8_LAS float* tab = (PG8_LAS float*)(sp + SP_SCALE); const PG8_LAS int* ul = (const PG8_LAS int*)(sp + SP_ULIST);
    const int rows = n * 256;
    for (int j0 = tid; j0 < rows; j0 += 4 * 512) {
        float v[4];
#pragma unroll
        for (int k = 0; k < 4; ++k) { const int j = j0 + k * 512; if (j < rows) { Unit u; u.pm = ul[4 * (j >> 8)]; u.pn = ul[4 * (j >> 8) + 1]; u.koff = 0; u.nt = 0; v[k] = S.row(u, j & 255); } else v[k] = 0.f; }
#pragma unroll
        for (int k = 0; k < 4; ++k) { const int j = j0 + k * 512; if (j < rows) tab[j] = v[k]; }
    }
}
template <class Scale> struct EpiBf16S {
    static constexpr bool PERM = true;
    bf16_t* O; int ldc; Scale S;
    static constexpr bool HAS_SCALE = true;
    __device__ __forceinline__ void preload(PG8_LAS unsigned char* sp, int n, int tid) const { preload_scales(S, sp, n, tid); }
    __device__ __forceinline__ void operator()(const f32x4 (&acc)[2][2][4][2], const Unit& u, int wr, int wc, int fr, int fq, const PG8_LAS unsigned char* sp, int ui) const {
        const int rl = wr * 64 + fr, row0 = u.pm * BM + rl, col0 = u.pn * BM + wc * 32 + 8 * fq;
        float scv[8]; { const unsigned ta = (unsigned)(size_t)sp + (unsigned)SP_SCALE + (unsigned)(ui * 256 + rl) * 4u;
            asm volatile("ds_read_b32 %0, %8\n\tds_read_b32 %1, %8 offset:64\n\tds_read_b32 %2, %8 offset:128\n\tds_read_b32 %3, %8 offset:192\n\tds_read_b32 %4, %8 offset:512\n\tds_read_b32 %5, %8 offset:576\n\tds_read_b32 %6, %8 offset:640\n\tds_read_b32 %7, %8 offset:704\n\ts_waitcnt lgkmcnt(0)"
                : "=&v"(scv[0]), "=&v"(scv[1]), "=&v"(scv[2]), "=&v"(scv[3]), "=&v"(scv[4]), "=&v"(scv[5]), "=&v"(scv[6]), "=&v"(scv[7]) : "v"(ta) : "memory"); }
#pragma unroll
        for (int ai = 0; ai < 2; ++ai)
#pragma unroll
            for (int m = 0; m < 4; ++m) { bf16_t* rowp = O + (size_t)(row0 + ai * HALF + m * 16) * ldc + col0; const float sc = scv[ai * 4 + m];
#pragma unroll
                for (int bj = 0; bj < 2; ++bj) { const f32x4 v0 = acc[ai][bj][m][0] * sc, v1 = acc[ai][bj][m][1] * sc;
                    u32x4 w; w.x = cvt_pk_bf16(v0[0], v0[1]); w.y = cvt_pk_bf16(v0[2], v0[3]); w.z = cvt_pk_bf16(v1[0], v1[1]); w.w = cvt_pk_bf16(v1[2], v1[3]);
                    *(u32x4*)(rowp + bj * HALF) = w; } }
    }
};
template <class Scale> struct EpiBf16SL {
    static constexpr bool PERM = true;
    bf16_t* O; int ldc; float* LSP; Scale S;
    static constexpr bool HAS_SCALE = true;
    __device__ __forceinline__ void preload(PG8_LAS unsigned char* sp, int n, int tid) const { preload_scales(S, sp, n, tid); }
    __device__ __forceinline__ void operator()(const f32x4 (&acc)[2][2][4][2], const Unit& u, int wr, int wc, int fr, int fq, const PG8_LAS unsigned char* sp, int ui) const {
        const int rl = wr * 64 + fr, row0 = u.pm * BM + rl, col0 = u.pn * BM + wc * 32 + 8 * fq;
        float scv[8]; { const unsigned ta = (unsigned)(size_t)sp + (unsigned)SP_SCALE + (unsigned)(ui * 256 + rl) * 4u;
            asm volatile("ds_read_b32 %0, %8\n\tds_read_b32 %1, %8 offset:64\n\tds_read_b32 %2, %8 offset:128\n\tds_read_b32 %3, %8 offset:192\n\tds_read_b32 %4, %8 offset:512\n\tds_read_b32 %5, %8 offset:576\n\tds_read_b32 %6, %8 offset:640\n\tds_read_b32 %7, %8 offset:704\n\ts_waitcnt lgkmcnt(0)"
                : "=&v"(scv[0]), "=&v"(scv[1]), "=&v"(scv[2]), "=&v"(scv[3]), "=&v"(scv[4]), "=&v"(scv[5]), "=&v"(scv[6]), "=&v"(scv[7]) : "v"(ta) : "memory"); }
#pragma unroll
        for (int ai = 0; ai < 2; ++ai)
#pragma unroll
            for (int m = 0; m < 4; ++m) { const int row = row0 + ai * HALF + m * 16; bf16_t* rowp = O + (size_t)row * ldc + col0; const float sc = scv[ai * 4 + m];
#pragma unroll
                for (int bj = 0; bj < 2; ++bj) { const f32x4 v0 = acc[ai][bj][m][0] * sc, v1 = acc[ai][bj][m][1] * sc;
                    u32x4 w; w.x = cvt_pk_bf16(v0[0], v0[1]); w.y = cvt_pk_bf16(v0[2], v0[3]); w.z = cvt_pk_bf16(v1[0], v1[1]); w.w = cvt_pk_bf16(v1[2], v1[3]);
                    *(u32x4*)(rowp + bj * HALF) = w;
                    float ss = ((v0[0] * v0[0] + v0[1] * v0[1]) + (v0[2] * v0[2] + v0[3] * v0[3])) + ((v1[0] * v1[0] + v1[1] * v1[1]) + (v1[2] * v1[2] + v1[3] * v1[3]));
                    ss += __shfl_xor(ss, 16); ss += __shfl_xor(ss, 32);
                    if (fq == 0) LSP[(size_t)row * 24 + u.pn * 8 + bj * 4 + wc] = ss; } }
    }
};
struct ScaleLat {
    const float* LSP; float eps;
    __device__ __forceinline__ float row(const Unit& u, int r) const { const bool isq = u.pn < 6; const float* p = LSP + (size_t)(u.pm * BM + r) * 24 + (isq ? 0 : 12);
        float s = ((p[0] + p[1]) + (p[2] + p[3])) + ((p[4] + p[5]) + (p[6] + p[7])); if (isq) s += (p[8] + p[9]) + (p[10] + p[11]);
        return __builtin_amdgcn_rsqf(s * (isq ? 1.f / 384 : 1.f / 256) + eps); }
};
struct EpiLatJoint {
    static constexpr bool PERM = true;
    bf16_t* QR; bf16_t* KVR; ScaleLat S;
    static constexpr bool HAS_SCALE = true;
    __device__ __forceinline__ void preload(PG8_LAS unsigned char* sp, int n, int tid) const { preload_scales(S, sp, n, tid); }
    __device__ __forceinline__ void operator()(const f32x4 (&acc)[2][2][4][2], const Unit& u, int wr, int wc, int fr, int fq, const PG8_LAS unsigned char* sp, int ui) const {
        const bool isq = u.pn < 6; bf16_t* O = isq ? QR : KVR; const int ldc = isq ? 1536 : 2048;
        const int rl = wr * 64 + fr, row0 = u.pm * BM + rl, col0 = (isq ? u.pn : u.pn - 6) * BM + wc * 32 + 8 * fq;
        float scv[8]; { const unsigned ta = (unsigned)(size_t)sp + (unsigned)SP_SCALE + (unsigned)(ui * 256 + rl) * 4u;
            asm volatile("ds_read_b32 %0, %8\n\tds_read_b32 %1, %8 offset:64\n\tds_read_b32 %2, %8 offset:128\n\tds_read_b32 %3, %8 offset:192\n\tds_read_b32 %4, %8 offset:512\n\tds_read_b32 %5, %8 offset:576\n\tds_read_b32 %6, %8 offset:640\n\tds_read_b32 %7, %8 offset:704\n\ts_waitcnt lgkmcnt(0)"
                : "=&v"(scv[0]), "=&v"(scv[1]), "=&v"(scv[2]), "=&v"(scv[3]), "=&v"(scv[4]), "=&v"(scv[5]), "=&v"(scv[6]), "=&v"(scv[7]) : "v"(ta) : "memory"); }
#pragma unroll
        for (int ai = 0; ai < 2; ++ai)
#pragma unroll
            for (int m = 0; m < 4; ++m) { bf16_t* rowp = O + (size_t)(row0 + ai * HALF + m * 16) * ldc + col0; const float sc = scv[ai * 4 + m];
#pragma unroll
                for (int bj = 0; bj < 2; ++bj) { const f32x4 v0 = acc[ai][bj][m][0] * sc, v1 = acc[ai][bj][m][1] * sc;
                    u32x4 w; w.x = cvt_pk_bf16(v0[0], v0[1]); w.y = cvt_pk_bf16(v0[2], v0[3]); w.z = cvt_pk_bf16(v1[0], v1[1]); w.w = cvt_pk_bf16(v1[2], v1[3]);
                    *(u32x4*)(rowp + bj * HALF) = w; } }
    }
};
template <class Scale> struct EpiSwiGLUS {
    static constexpr bool PERM = true;
    bf16_t* O; int ldc; int nmod; Scale S;
    static constexpr bool HAS_SCALE = true;
    __device__ __forceinline__ void preload(PG8_LAS unsigned char* sp, int n, int tid) const { preload_scales(S, sp, n, tid); }
    __device__ __forceinline__ void operator()(const f32x4 (&acc)[2][2][4][2], const Unit& u, int wr, int wc, int fr, int fq, const PG8_LAS unsigned char* sp, int ui) const {
        const int rl = wr * 64 + fr, row0 = u.pm * BM + rl, col0 = (u.pn % nmod) * HALF + wc * 32 + 8 * fq;
        float scv[8]; { const unsigned ta = (unsigned)(size_t)sp + (unsigned)SP_SCALE + (unsigned)(ui * 256 + rl) * 4u;
            asm volatile("ds_read_b32 %0, %8\n\tds_read_b32 %1, %8 offset:64\n\tds_read_b32 %2, %8 offset:128\n\tds_read_b32 %3, %8 offset:192\n\tds_read_b32 %4, %8 offset:512\n\tds_read_b32 %5, %8 offset:576\n\tds_read_b32 %6, %8 offset:640\n\tds_read_b32 %7, %8 offset:704\n\ts_waitcnt lgkmcnt(0)"
                : "=&v"(scv[0]), "=&v"(scv[1]), "=&v"(scv[2]), "=&v"(scv[3]), "=&v"(scv[4]), "=&v"(scv[5]), "=&v"(scv[6]), "=&v"(scv[7]) : "v"(ta) : "memory"); }
#pragma unroll
        for (int ai = 0; ai < 2; ++ai)
#pragma unroll
            for (int m = 0; m < 4; ++m) { const float sc = scv[ai * 4 + m];
                const f32x4 g0 = acc[ai][0][m][0] * sc, g1 = acc[ai][0][m][1] * sc, u0 = acc[ai][1][m][0] * sc, u1 = acc[ai][1][m][1] * sc;
                u32x4 w; w.x = cvt_pk_bf16(fast_silu(g0[0]) * u0[0], fast_silu(g0[1]) * u0[1]); w.y = cvt_pk_bf16(fast_silu(g0[2]) * u0[2], fast_silu(g0[3]) * u0[3]);
                w.z = cvt_pk_bf16(fast_silu(g1[0]) * u1[0], fast_silu(g1[1]) * u1[1]); w.w = cvt_pk_bf16(fast_silu(g1[2]) * u1[2], fast_silu(g1[3]) * u1[3]);
                *(u32x4*)(O + (size_t)(row0 + ai * HALF + m * 16) * ldc + col0) = w; }
    }
};

template <class Epi, class Sched, bool ALIGN_EPI, bool GATHER>
__device__ __forceinline__ void gemm_phase(PG8_LAS unsigned char* lds, const Gemm g, const Sched& S, const Epi& E, const int* gidx) {
    const int tid = threadIdx.x, wid = __builtin_amdgcn_readfirstlane(tid >> 6), lane = tid & 63, wr = wid >> 2, wc = wid & 3, fr = lane & 15, fq = lane >> 4;
    const int K = g.K, nt = K / BK, lda = g.lda, ldb = g.ldb;
    unsigned vAc[2][2], vAn[2][2], voffB[2]; int Rl[2], Cl[2];
#pragma unroll
    for (int i = 0; i < 2; ++i) { int R, C; stage_rc(tid * 16 + i * 8192, R, C); const int Rb = Epi::PERM ? ((R & ~31) + perm32(R & 31)) : R; Rl[i] = R; Cl[i] = C;
        voffB[i] = (unsigned)(Rb * ldb + C) * 2u;
#pragma unroll
        for (int h = 0; h < 2; ++h) { vAc[h][i] = (unsigned)((R + h * HALF) * lda + C) * 2u; vAn[h][i] = vAc[h][i]; } }
    const size_t kstep = (size_t)(BK * 2);
    const size_t hstepB = (size_t)HALF * ldb * 2, tstepB = 2 * hstepB, tstepA = GATHER ? 0 : (size_t)BM * lda * 2;
    const unsigned ldsw = (unsigned)wid * 1024u;
    const int aoff = lds_byte(wr * 64 + fr, fq * 8), boff = lds_byte(wc * 32 + fr, fq * 8);
#define PG8_SA(b, h) (((b) * 2 + (h)) * HTB)
#define PG8_SB(b, h) ((4 + (b) * 2 + (h)) * HTB)
#define PG8_STAGE(bufoff, gbase, voff) do { _Pragma("unroll") for (int _i = 0; _i < 2; ++_i) \
        __builtin_amdgcn_global_load_lds((const unsigned*)((const char*)(gbase) + (voff)[_i]), (PG8_LAS unsigned*)(lds + (bufoff) + ldsw + _i * 8192), 16, 0, 0); } while (0)
#define PG8_LDA(dst, b, h) do { _Pragma("unroll") for (int m = 0; m < 4; ++m) _Pragma("unroll") for (int k = 0; k < 2; ++k) dst[m][k] = *(const PG8_LAS bf16x8*)(lds + PG8_SA(b, h) + aoff + m * 2048 + k * 1024); } while (0)
#define PG8_LDB(dst, b, h) do { _Pragma("unroll") for (int n = 0; n < 2; ++n) _Pragma("unroll") for (int k = 0; k < 2; ++k) dst[n][k] = *(const PG8_LAS bf16x8*)(lds + PG8_SB(b, h) + boff + n * 2048 + k * 1024); } while (0)
#define PG8_MMA(ai, bj, At, Bt) do { __builtin_amdgcn_s_setprio(1); _Pragma("unroll") for (int m = 0; m < 4; ++m) _Pragma("unroll") for (int n = 0; n < 2; ++n) _Pragma("unroll") for (int k = 0; k < 2; ++k) \
        acc[ai][bj][m][n] = __builtin_amdgcn_mfma_f32_16x16x32_bf16(Bt[n][k], At[m][k], acc[ai][bj][m][n], 0, 0, 0); __builtin_amdgcn_s_setprio(0); } while (0)
#define PG8_WAIT_V(n) asm volatile("s_waitcnt vmcnt(" #n ")" ::: "memory")
#define PG8_WAIT_L(n) asm volatile("s_waitcnt lgkmcnt(" #n ")" ::: "memory")
#define PG8_BAR __builtin_amdgcn_s_barrier()
#define PG8_SCHED __builtin_amdgcn_sched_barrier(0)
    PG8_LAS unsigned char* spare = lds + STAGE_BYTES;
    constexpr bool LIST = Sched::USE_LIST || Epi::HAS_SCALE || GATHER;
    int nunits = 0;
    if constexpr (LIST) { nunits = build_unit_list(spare, S, tid); if (nunits == 0) return;
        E.preload(spare, nunits, tid);
        if (GATHER) { PG8_LAS int* gt = (PG8_LAS int*)(spare + SP_GIDX); const PG8_LAS int* ul = (const PG8_LAS int*)(spare + SP_ULIST);
            for (int j = tid; j < nunits * 256; j += 512) { int t_ = gidx[ul[4 * (j >> 8)] * BM + (j & 255)]; gt[j] = t_ < 0 ? 0 : t_; } }
        __syncthreads(); }
#define PG8_UNIT(i, u, ok) do { if constexpr (LIST) { int a_, b_, c_, d_; const unsigned ad_ = (unsigned)(size_t)(spare + SP_ULIST) + 16u * (unsigned)(i); \
        asm volatile("ds_read_b32 %0, %4\n\tds_read_b32 %1, %4 offset:4\n\tds_read_b32 %2, %4 offset:8\n\tds_read_b32 %3, %4 offset:12\n\ts_waitcnt lgkmcnt(0)" : "=&v"(a_), "=&v"(b_), "=&v"(c_), "=&v"(d_) : "v"(ad_) : "memory"); \
        (u).pm = __builtin_amdgcn_readfirstlane(a_); (u).pn = __builtin_amdgcn_readfirstlane(b_); (u).koff = __builtin_amdgcn_readfirstlane(c_); (u).nt = __builtin_amdgcn_readfirstlane(d_); ok = (u).pm >= 0; } else { ok = S.next(i, u); } } while (0)
#define PG8_GIDX(dst, ord) do { if (GATHER) { int t0_, t1_, t2_, t3_; const unsigned ad_ = (unsigned)(size_t)(spare + SP_GIDX) + 4u * (unsigned)((ord) * 256); \
        asm volatile("ds_read_b32 %0, %4\n\tds_read_b32 %1, %5\n\tds_read_b32 %2, %4 offset:512\n\tds_read_b32 %3, %5 offset:512\n\ts_waitcnt lgkmcnt(0)" : "=&v"(t0_), "=&v"(t1_), "=&v"(t2_), "=&v"(t3_) : "v"(ad_ + 4u * (unsigned)Rl[0]), "v"(ad_ + 4u * (unsigned)Rl[1]) : "memory"); \
        dst[0][0] = (unsigned)(t0_ * lda + Cl[0]) * 2u; dst[0][1] = (unsigned)(t1_ * lda + Cl[1]) * 2u; dst[1][0] = (unsigned)(t2_ * lda + Cl[0]) * 2u; dst[1][1] = (unsigned)(t3_ * lda + Cl[1]) * 2u; } } while (0)
    Unit cur, nxt; int ui = 0;
    { bool ok0; PG8_UNIT(0, cur, ok0); if (!ok0) return; }
    f32x4 acc[2][2][4][2];
#pragma unroll
    for (int a = 0; a < 2; ++a)
#pragma unroll
        for (int b = 0; b < 2; ++b)
#pragma unroll
            for (int m = 0; m < 4; ++m)
#pragma unroll
                for (int n = 0; n < 2; ++n) acc[a][b][m][n] = (f32x4){0.f, 0.f, 0.f, 0.f};
    bf16x8 At[4][2], B0[2][2], B1[2][2];
    PG8_GIDX(vAc, 0);
    const char* cA = (const char*)g.A + (size_t)cur.pm * tstepA + (size_t)cur.koff * 2; const char* cB = (const char*)g.Bt + (size_t)cur.pn * tstepB + (size_t)cur.koff * 2;
    PG8_STAGE(PG8_SB(0, 0), cB, voffB); PG8_STAGE(PG8_SB(0, 1), cB + hstepB, voffB); PG8_STAGE(PG8_SA(0, 0), cA, vAc[0]); PG8_STAGE(PG8_SA(0, 1), cA, vAc[1]);
    if (wr == 1) PG8_BAR;
    PG8_WAIT_V(2); PG8_BAR;
    PG8_STAGE(PG8_SB(1, 0), cB + kstep, voffB); PG8_STAGE(PG8_SA(1, 0), cA + kstep, vAc[0]); PG8_STAGE(PG8_SB(1, 1), cB + hstepB + kstep, voffB);
    PG8_WAIT_V(6); PG8_BAR;
    for (;;) {
        bool has_next; PG8_UNIT(ui + 1, nxt, has_next);
        if (has_next) PG8_GIDX(vAn, ui + 1);
        const char* nA = has_next ? (const char*)g.A + (size_t)nxt.pm * tstepA + (size_t)nxt.koff * 2 : cA; const char* nB = has_next ? (const char*)g.Bt + (size_t)nxt.pn * tstepB + (size_t)nxt.koff * 2 : cB;
        const int ntc = cur.nt > 0 ? cur.nt : nt;
        for (int t = 0; t < ntc; t += 2) {
            const bool last = (t == ntc - 2);
            const char* a1 = cA + (size_t)(t + 1) * kstep;
            const char* a2 = last ? nA : cA + (size_t)(t + 2) * kstep; const char* b2 = last ? nB : cB + (size_t)(t + 2) * kstep;
            const char* a3 = a2 + kstep; const char* b3 = b2 + kstep;
            unsigned vs0[2], vs1[2];
            if (GATHER) { const bool sw = last && has_next; vs0[0] = sw ? vAn[0][0] : vAc[0][0]; vs0[1] = sw ? vAn[0][1] : vAc[0][1]; vs1[0] = sw ? vAn[1][0] : vAc[1][0]; vs1[1] = sw ? vAn[1][1] : vAc[1][1]; }
            else { vs0[0] = vAc[0][0]; vs0[1] = vAc[0][1]; vs1[0] = vAc[1][0]; vs1[1] = vAc[1][1]; }
            PG8_LDB(B0, 0, 0); PG8_LDB(B1, 0, 1); PG8_SCHED; PG8_LDA(At, 0, 0); PG8_STAGE(PG8_SA(1, 1), a1, vAc[1]);
            PG8_WAIT_V(8); PG8_WAIT_L(0); PG8_BAR; PG8_MMA(0, 0, At, B0); PG8_MMA(0, 1, At, B1); PG8_BAR; PG8_SCHED;
            PG8_LDA(At, 0, 1); PG8_STAGE(PG8_SB(0, 0), b2, voffB); PG8_STAGE(PG8_SB(0, 1), b2 + hstepB, voffB); PG8_STAGE(PG8_SA(0, 0), a2, vs0);
            PG8_WAIT_V(8); PG8_WAIT_L(0); PG8_BAR; PG8_MMA(1, 0, At, B0); PG8_MMA(1, 1, At, B1); PG8_BAR; PG8_SCHED;
            PG8_LDB(B0, 1, 0); PG8_LDB(B1, 1, 1); PG8_SCHED; PG8_LDA(At, 1, 0); PG8_STAGE(PG8_SA(0, 1), a2, vs1);
            PG8_WAIT_V(8); PG8_WAIT_L(0); PG8_BAR; PG8_MMA(0, 0, At, B0); PG8_MMA(0, 1, At, B1); PG8_BAR; PG8_SCHED;
            PG8_LDA(At, 1, 1); PG8_STAGE(PG8_SB(1, 0), b3, voffB); PG8_STAGE(PG8_SB(1, 1), b3 + hstepB, voffB); PG8_STAGE(PG8_SA(1, 0), a3, vs0);
            PG8_WAIT_V(8); PG8_WAIT_L(0); PG8_BAR; PG8_MMA(1, 0, At, B0); PG8_MMA(1, 1, At, B1); PG8_BAR; PG8_SCHED;
        }
        if constexpr (ALIGN_EPI) { if (wr == 0) PG8_BAR; }
        E(acc, cur, wr, wc, fr, fq, spare, ui);
        if (!has_next) break;
#pragma unroll
        for (int a = 0; a < 2; ++a)
#pragma unroll
            for (int b = 0; b < 2; ++b)
#pragma unroll
                for (int m = 0; m < 4; ++m)
#pragma unroll
                    for (int n = 0; n < 2; ++n) acc[a][b][m][n] = (f32x4){0.f, 0.f, 0.f, 0.f};
        cur = nxt; cA = nA; cB = nB; ++ui;
        if (GATHER) {
#pragma unroll
            for (int h = 0; h < 2; ++h) { vAc[h][0] = vAn[h][0]; vAc[h][1] = vAn[h][1]; } }
        if constexpr (ALIGN_EPI) { if (wr == 1) PG8_BAR; }
    }
    PG8_WAIT_V(0);
    if constexpr (!ALIGN_EPI) { if (wr == 0) PG8_BAR; }
    PG8_BAR;
#undef PG8_SA
#undef PG8_SB
#undef PG8_STAGE
#undef PG8_LDA
#undef PG8_LDB
#undef PG8_MMA
#undef PG8_WAIT_V
#undef PG8_WAIT_L
#undef PG8_BAR
#undef PG8_SCHED
#undef PG8_GIDX
#undef PG8_UNIT
}
}

#define GAS __attribute__((address_space(1)))
#define LAS __attribute__((address_space(3)))
typedef unsigned v4u __attribute__((ext_vector_type(4)));
typedef unsigned v2u __attribute__((ext_vector_type(2)));
typedef float f32x4 __attribute__((ext_vector_type(4)));
typedef short bf16x8 __attribute__((ext_vector_type(8)));
typedef float f32x16 __attribute__((ext_vector_type(16)));
#define LDS_WAIT() asm volatile("s_waitcnt lgkmcnt(0)" ::: "memory")
#define VM_WAIT() asm volatile("s_waitcnt vmcnt(0)" ::: "memory")
constexpr int NWAVES = 8, NTHR = 512;
constexpr int LDS_BYTES = 163840 - 1024;
constexpr int LDSCTL_OFF = LDS_BYTES - 1024;

struct Args { const float* in[N_INPUTS]; float* out; unsigned char* ws; int ph_lo, ph_hi, sub, pad; };
struct Frame { LAS unsigned char* lds; int tid, lane, wave, G, bid; const float* const* in; float* out; unsigned char* ws;
    template <class T> __device__ __forceinline__ T* w(size_t off) const { return (T*)(ws + off); } };

__device__ __forceinline__ void transpose_item(const float* W, int K, int N, int Npad, bf16* WT, int mode, LAS unsigned char* scr, int item, int nblk, int lane, const float* gk = nullptr, int ldo = 0) {
    const int kb = item / nblk, nb = item % nblk, k0 = 64 * kb, n0 = 64 * nb;
    const int g = lane >> 4, c = lane & 15, nn = n0 + 4 * c; const bool ok = nn < N;
    const float* src = W + (size_t)(k0 + 2 * g) * N + nn;
    f32x4 a[8], b[8];
#pragma unroll
    for (int i = 0; i < 8; ++i) { a[i] = ok ? *(const f32x4*)(src + (size_t)(8 * i) * N) : (f32x4){0.f, 0.f, 0.f, 0.f}; b[i] = ok ? *(const f32x4*)(src + (size_t)(8 * i + 1) * N) : (f32x4){0.f, 0.f, 0.f, 0.f}; }
    if (gk) {
#pragma unroll
        for (int i = 0; i < 8; ++i) { const float2 gg = *(const float2*)(gk + k0 + 8 * i + 2 * g); a[i] = a[i] * gg.x; b[i] = b[i] * gg.y; } }
#pragma unroll
    for (int i = 0; i < 8; ++i)
#pragma unroll
        for (int j = 0; j < 4; ++j) *(LAS unsigned*)(scr + (4 * c + j) * 128 + ((i ^ (c & 7)) * 16) + 4 * g) = pk2(a[i][j], b[i][j]);
    LDS_WAIT(); asm volatile("" ::: "memory");
#pragma unroll
    for (int r = 0; r < 8; ++r) { const int idx = lane + 64 * r, nl = idx >> 3, ch = idx & 7, n = n0 + nl;
        const v4u v = *(const LAS v4u*)(scr + nl * 128 + ((ch ^ ((nl >> 2) & 7)) * 16));
        if (n < Npad) { const int row = (mode == 0) ? n : (256 * (n / 128) + (n % 128) + (mode == 2 ? 128 : 0)); *(v4u*)(WT + (size_t)row * (ldo ? ldo : K) + k0 + 8 * ch) = v; } }
    LDS_WAIT(); asm volatile("" ::: "memory");
}
__device__ __forceinline__ void rms_row(const float* xrow, const float* g, bf16* orow, int lane, f32x4 (&v)[4]) {
    const f32x4* xr = (const f32x4*)xrow + lane; float s = 0.f;
#pragma unroll
    for (int j = 0; j < 4; ++j) { v[j] = xr[64 * j]; s += (v[j].x * v[j].x + v[j].y * v[j].y) + (v[j].z * v[j].z + v[j].w * v[j].w); }
    const float r = rsqrtf(wave_sum(s) * (1.f / DM) + EPS);
    v2u* o8 = (v2u*)orow + lane;
#pragma unroll
    for (int j = 0; j < 4; ++j) { const f32x4 gg = ((const f32x4*)g)[lane + 64 * j]; v[j] = v[j] * r * gg; v2u o; o.x = pk2(v[j].x, v[j].y); o.y = pk2(v[j].z, v[j].w); o8[64 * j] = o; }
}
__device__ __forceinline__ void ph_rmsnorm(Frame& F, const float* X, const float* g, bf16* H) {
    const int gw = F.bid * NWAVES + F.wave, NGW = F.G * NWAVES, lane = F.lane;
    for (int m = gw; m < M_TOK; m += 4 * NGW) {
        f32x4 v[4][4]; float s[4];
#pragma unroll
        for (int r = 0; r < 4; ++r) { const int mm = (m + r * NGW < M_TOK) ? m + r * NGW : m; const f32x4* xr = (const f32x4*)(X + (size_t)mm * DM) + lane;
#pragma unroll
            for (int j = 0; j < 4; ++j) v[r][j] = xr[64 * j]; }
#pragma unroll
        for (int r = 0; r < 4; ++r) { float t = 0.f;
#pragma unroll
            for (int j = 0; j < 4; ++j) t += (v[r][j].x * v[r][j].x + v[r][j].y * v[r][j].y) + (v[r][j].z * v[r][j].z + v[r][j].w * v[r][j].w);
            s[r] = t; }
#pragma unroll
        for (int o = 1; o < 64; o <<= 1) {
#pragma unroll
            for (int r = 0; r < 4; ++r) s[r] += __shfl_xor(s[r], o); }
#pragma unroll
        for (int r = 0; r < 4; ++r) { if (m + r * NGW < M_TOK) { const float rs = rsqrtf(s[r] * (1.f / DM) + EPS); v2u* o8 = (v2u*)(H + (size_t)(m + r * NGW) * DM) + lane;
#pragma unroll
            for (int j = 0; j < 4; ++j) { const f32x4 gg = ((const f32x4*)g)[lane + 64 * j]; const f32x4 y = v[r][j] * rs * gg; v2u o; o.x = pk2(y.x, y.y); o.y = pk2(y.z, y.w); o8[64 * j] = o; } } }
    }
}
__device__ __forceinline__ void ph_rope_table(Frame& F, float2* tab) {
    for (int idx = F.bid * NTHR + F.tid; idx < SEQ * 16; idx += F.G * NTHR) { const int pos = idx >> 4, i = idx & 15;
        const float fr = powf(10000.f, -(float)i / 16.f), ang = (float)pos * fr; tab[idx] = make_float2(cosf(ang), sinf(ang)); }
}
__device__ __forceinline__ void ph_refs(Frame& F) {
    if (F.bid != 0 || F.wave != 0) return;
    const int l = F.lane; float* refs = F.w<float>(WS_REFS);
#pragma unroll
    for (int mode = 0; mode < 3; ++mode) { const int dq = mode == 2 ? 96 : 64;
        const float* gq = F.in[mode == 0 ? I_MQN : mode == 1 ? I_DQN : I_MLAQN]; const float* gk = F.in[mode == 0 ? I_MKN : mode == 1 ? I_DKN : I_MLAKN];
        float aq = fabsf(gq[l]), ak = fabsf(gk[l]); if (mode == 2 && l < 32) { aq = fmaxf(aq, fabsf(gq[64 + l])); ak = fmaxf(ak, fabsf(gk[64 + l])); }
        const float mq = wave_max(aq), mk = wave_max(ak); const float base = (float)dq * mq * mk * (mode == 2 ? QSCALE96 : QSCALE64);
        if (mode == 2) { if (l < 16) refs[32 + l] = base; }
        else {
#pragma unroll
            for (int h = 0; h < 8; ++h) { const float mb = wave_max(l < 32 ? fmaxf(F.in[I_RELB][l * 16 + mode * 8 + h], 0.f) : 0.f); if (l == 0) refs[mode * 16 + h] = base + mb * LOG2E; } }
    }
}
__device__ __forceinline__ void wt_job(Frame& F, LAS unsigned char* scr, int& base, int idx, int K, int N, int Npad, int mode, int nexp, size_t off, const float* gk = nullptr, int ldo = 0) {
    const int gw = F.bid * NWAVES + F.wave, NGW = F.G * NWAVES;
    const int nblk = Npad / 64, per = (K / 64) * nblk, tot = per * nexp;
    const size_t wes = (size_t)K * N, wtes = (size_t)(mode == 0 ? Npad : 2 * Npad) * K;
    int it = base + ((gw - base % NGW) + NGW) % NGW;
    for (; it < base + tot; it += NGW) { const int r = it - base, e = r / per, q = r % per;
        transpose_item(F.in[idx] + (size_t)e * wes, K, N, Npad, F.w<bf16>(off) + (size_t)e * wtes, mode, scr, q, nblk, F.lane, gk, ldo); }
    base += tot;
}
__device__ __forceinline__ void ph_prologue(Frame& F) {
    LAS unsigned char* scr = F.lds + F.wave * 8192;
    int base = 0;
    wt_job(F, scr, base, I_W_IN_E, 1024, N_IN_E, QKV_LD, 0, 1, WS_W_IN_E);
    wt_job(F, scr, base, I_W_OUT_E, 1024, 1024, 1024, 0, 1, WS_W_OUT_E);
    wt_job(F, scr, base, I_W_GATE_E, 1024, FF_E, FF_E, 1, 1, WS_W_GU_E, F.in[I_FFNN_E]);
    wt_job(F, scr, base, I_W_UP_E, 1024, FF_E, FF_E, 2, 1, WS_W_GU_E, F.in[I_FFNN_E]);
    wt_job(F, scr, base, I_W_DOWN_E, FF_E, 1024, 1024, 0, 1, WS_W_DN_E);
    wt_job(F, scr, base, I_W_IN_O, 1024, N_IN_O, C1_LD, 0, 1, WS_W_IN_O, F.in[I_MIXN_O]);
    wt_job(F, scr, base, I_W_UQ, 384, 1536, 1536, 0, 1, WS_W_LAT, F.in[I_QAN], W_LAT_LD);
    wt_job(F, scr, base, I_W_UKV, 256, 2048, 2048, 0, 1, WS_W_LAT + ((size_t)1536 * W_LAT_LD + 384) * 2, F.in[I_KVAN], W_LAT_LD);
    wt_job(F, scr, base, I_W_OUT_O, 1024, 1024, 1024, 0, 1, WS_W_OUT_O);
    ph_rope_table(F, F.w<float2>(WS_ROPE));
    ph_refs(F);
    ph_rmsnorm(F, F.in[I_X], F.in[I_MIXN_E], F.w<bf16>(WS_H));
}
constexpr int MOE_T_GU = (1024 / 64) * (FF_O / 64) * NEXP, MOE_T_DN = (FF_O / 64) * (1024 / 64) * NEXP, MOE_ITEMS = 2 * MOE_T_GU + MOE_T_DN;
constexpr int MOE_TAIL_A = 4096, MOE_TAIL_B = 4096, MOE_TAIL_C = 3072, MOE_TAIL_ALL = MOE_TAIL_A + MOE_TAIL_B + MOE_TAIL_C, NSLOT_MOE = 4;
__device__ __forceinline__ void moe_convert_item(Frame& F, LAS unsigned char* scr, int it) {
    constexpr int PER_GU = (1024 / 64) * (FF_O / 64), PER_DN = (FF_O / 64) * (1024 / 64);
    if (it < 2 * MOE_T_GU) { const int up = it >= MOE_T_GU, r = it - up * MOE_T_GU, e = r / PER_GU, q = r % PER_GU;
        transpose_item(F.in[up ? I_W_UP_O : I_W_GATE_O] + (size_t)e * 1024 * FF_O, 1024, FF_O, FF_O, F.w<bf16>(WS_WGU_O) + (size_t)e * 2 * FF_O * 1024, up ? 2 : 1, scr, q, FF_O / 64, F.lane, F.in[I_FFNN_O]); }
    else { const int r = it - 2 * MOE_T_GU, e = r / PER_DN, q = r % PER_DN;
        transpose_item(F.in[I_W_DOWN_O] + (size_t)e * FF_O * 1024, FF_O, 1024, 1024, F.w<bf16>(WS_WDN_O) + (size_t)e * 1024 * FF_O, 0, scr, q, 1024 / 64, F.lane); }
}
__device__ __forceinline__ void moe_convert_tail(Frame& F, int first, int n, int wg0) {
    if (F.G != 256 || F.bid < wg0) return;
    LAS unsigned char* scr = F.lds + F.wave * 8192; const int nw = (F.G - wg0) * NWAVES, w = (F.bid - wg0) * NWAVES + F.wave;
    for (int it = first + w; it < first + n; it += nw) moe_convert_item(F, scr, it);
}
__device__ __forceinline__ void moe_convert_slice(Frame& F, int slice) {
    LAS unsigned char* scr = F.lds + F.wave * 8192;
    const int gw = F.bid * NWAVES + F.wave, NGW = F.G * NWAVES, first = (F.G == 256) ? MOE_TAIL_ALL : 0;
    for (int it = first + slice * NGW + gw; it < MOE_ITEMS; it += NSLOT_MOE * NGW) moe_convert_item(F, scr, it);
    __syncthreads();
}
__device__ __forceinline__ void ph_rmsnorm_route(Frame& F, const bf16* X, const float* g, float* rstd_out) {
    const float* wr = F.in[I_W_ROUTER]; const float* br = F.in[I_B_ROUTER]; int2* re = F.w<int2>(WS_ROUTE_E); float2* rg = F.w<float2>(WS_ROUTE_G); int* cnt_wg = F.w<int>(WS_CNT_WG);
    LAS int* cnt = (LAS int*)F.lds;
    f32x4 wg[16][2];
#pragma unroll
    for (int j = 0; j < 4; ++j)
#pragma unroll
        for (int q = 0; q < 4; ++q) { const int d = 4 * F.lane + 256 * j + q; const float gd = g[d]; wg[4 * j + q][0] = *(const f32x4*)(wr + d * 8) * gd; wg[4 * j + q][1] = *(const f32x4*)(wr + d * 8 + 4) * gd; }
    float bre[8];
#pragma unroll
    for (int e = 0; e < 8; ++e) bre[e] = br[e];
    for (int ch = F.bid; ch < 256; ch += F.G) {
        if (F.tid < 8) cnt[F.tid] = 0;
        __syncthreads();
        for (int i = F.wave; i < 64; i += 2 * NWAVES) {
            v2u raw[2][4];
#pragma unroll
            for (int r = 0; r < 2; ++r) { const v2u* xr = (const v2u*)(X + (size_t)(ch * 64 + i + r * NWAVES) * DM) + F.lane;
#pragma unroll
                for (int j = 0; j < 4; ++j) raw[r][j] = xr[64 * j]; }
#pragma unroll
            for (int r = 0; r < 2; ++r) { const int m = ch * 64 + i + r * NWAVES; float s = 0.f; float lg[8];
#pragma unroll
                for (int e = 0; e < 8; ++e) lg[e] = 0.f;
#pragma unroll
                for (int j = 0; j < 4; ++j) { const float x4[4] = {bflo(raw[r][j].x), bfhi(raw[r][j].x), bflo(raw[r][j].y), bfhi(raw[r][j].y)};
#pragma unroll
                    for (int q = 0; q < 4; ++q) { const float y = x4[q]; s += y * y; const f32x4 w0 = wg[4 * j + q][0], w1 = wg[4 * j + q][1];
                        lg[0] += y * w0.x; lg[1] += y * w0.y; lg[2] += y * w0.z; lg[3] += y * w0.w; lg[4] += y * w1.x; lg[5] += y * w1.y; lg[6] += y * w1.z; lg[7] += y * w1.w; } }
                const float rs = rsqrtf(wave_sum(s) * (1.f / DM) + EPS);
                if (F.lane == 0) rstd_out[m] = rs;
#pragma unroll
                for (int e = 0; e < 8; ++e) lg[e] = wave_sum(lg[e]) * rs + bre[e];
                int e0 = 0; float v0 = lg[0];
#pragma unroll
                for (int e = 1; e < 8; ++e) if (lg[e] > v0) { v0 = lg[e]; e0 = e; }
                int e1 = -1; float v1 = -INFINITY;
#pragma unroll
                for (int e = 0; e < 8; ++e) if (e != e0 && lg[e] > v1) { v1 = lg[e]; e1 = e; }
                if (F.lane == 0) { const float p1 = 1.f / (1.f + __expf(v0 - v1)); re[m] = make_int2(e0, e1); rg[m] = make_float2(1.f - p1, p1); atomicAdd((int*)&cnt[e0], 1); atomicAdd((int*)&cnt[e1], 1); } } }
        __syncthreads();
        if (F.tid < 8) cnt_wg[ch * 8 + F.tid] = cnt[F.tid];
        __syncthreads();
    }
}
__device__ __forceinline__ void ph_slots(Frame& F) {
    const int2* re = F.w<int2>(WS_ROUTE_E); const float2* rg = F.w<float2>(WS_ROUTE_G); const int* cnt_wg = F.w<int>(WS_CNT_WG);
    int* stok = F.w<int>(WS_SLOT_TOK); float* sgate = F.w<float>(WS_SLOT_GATE); int* tile_e = F.w<int>(WS_TILE_E); int2* tslot = F.w<int2>(WS_TOK_SLOT); const float* rstd = F.w<float>(WS_RSTD); float* srstd = F.w<float>(WS_SLOT_RSTD);
    LAS int* sh = (LAS int*)F.lds;
    { const int e = F.wave, l = F.lane;
      const int c0 = cnt_wg[(4 * l + 0) * 8 + e], c1 = cnt_wg[(4 * l + 1) * 8 + e], c2 = cnt_wg[(4 * l + 2) * 8 + e], c3 = cnt_wg[(4 * l + 3) * 8 + e];
      const int tot = c0 + c1 + c2 + c3; int incl = tot;
#pragma unroll
      for (int off = 1; off < 64; off <<= 1) { const int v = __shfl_up(incl, off); if (l >= off) incl += v; }
      const int excl = incl - tot;
      sh[64 + 8 * (4 * l + 0) + e] = excl; sh[64 + 8 * (4 * l + 1) + e] = excl + c0; sh[64 + 8 * (4 * l + 2) + e] = excl + c0 + c1; sh[64 + 8 * (4 * l + 3) + e] = excl + c0 + c1 + c2;
      if (l == 63) sh[e] = incl; }
    __syncthreads();
    if (F.tid == 0) { int o = 0; for (int e = 0; e < 8; ++e) { sh[8 + e] = o; o += (sh[e] + 255) / 256 * 256; } sh[16] = o; }
    __syncthreads();
    for (int ch = F.bid; ch < 256; ch += F.G) {
        if (F.wave == 0) { const int row = ch * 64 + F.lane; const int2 e = re[row]; const float2 gg = rg[row]; int s0 = 0, s1 = 0;
            const unsigned long long below = (1ull << F.lane) - 1ull;
#pragma unroll
            for (int q = 0; q < 8; ++q) { const unsigned long long m = __ballot(e.x == q) | __ballot(e.y == q); const int pos = sh[8 + q] + sh[64 + 8 * ch + q] + __popcll(m & below);
                if (e.x == q) s0 = pos; if (e.y == q) s1 = pos; }
            const float rr = rstd[row]; stok[s0] = row; sgate[s0] = gg.x; srstd[s0] = rr; stok[s1] = row; sgate[s1] = gg.y; srstd[s1] = rr; tslot[row] = make_int2(s0, s1); }
    }
    if (F.bid == 0) { for (int e = 0; e < 8; ++e) for (int s = sh[8 + e] + sh[e] + F.tid; s < sh[8 + e + 1]; s += NTHR) { stok[s] = -1; sgate[s] = 0.f; srstd[s] = 0.f; }
        for (int tl = F.tid; tl <= TILE_CAP; tl += NTHR) { int e = -1; for (int q = 0; q < 8; ++q) if (tl * 256 >= sh[8 + q] && tl * 256 < sh[8 + q + 1]) e = q; if (tl == TILE_CAP) e = sh[16] / 256; tile_e[tl] = e; } }
    __syncthreads();
}
__device__ __forceinline__ void ph_rmsnorm_lat(Frame& F) {
    const bf16* C1 = F.w<bf16>(WS_C1); bf16* CQN = F.w<bf16>(WS_CQN); bf16* CKVN = F.w<bf16>(WS_CKVN); const float* gq = F.in[I_QAN]; const float* gkv = F.in[I_KVAN];
    const int gw = F.bid * NWAVES + F.wave, NGW = F.G * NWAVES, lane = F.lane;
    const bool isq = lane < 48; const float* g1 = isq ? gq + lane * 8 : gkv + (lane - 48) * 8; const float* g2 = gkv + (16 + lane) * 8;
    float ga[8], gb[8];
#pragma unroll
    for (int j = 0; j < 8; ++j) { ga[j] = g1[j]; gb[j] = (lane < 16) ? g2[j] : 0.f; }
    for (int m = gw; m < M_TOK; m += 4 * NGW) {
        v4u ra[4], rb[4];
#pragma unroll
        for (int r = 0; r < 4; ++r) { const int mm = (m + r * NGW < M_TOK) ? m + r * NGW : m; const v4u* row = (const v4u*)(C1 + (size_t)mm * C1_LD); ra[r] = row[lane]; rb[r] = (lane < 16) ? row[64 + lane] : (v4u){0u, 0u, 0u, 0u}; }
#pragma unroll
        for (int r = 0; r < 4; ++r) { if (m + r * NGW < M_TOK) { const int mm = m + r * NGW;
            float xa[8], xb[8]; float sa = 0.f, sb = 0.f;
#pragma unroll
            for (int e = 0; e < 4; ++e) { xa[2 * e] = bflo(ra[r][e]); xa[2 * e + 1] = bfhi(ra[r][e]); xb[2 * e] = bflo(rb[r][e]); xb[2 * e + 1] = bfhi(rb[r][e]); }
#pragma unroll
            for (int j = 0; j < 8; ++j) { sa += xa[j] * xa[j]; sb += xb[j] * xb[j]; }
            const float sq = wave_sum(isq ? sa : 0.f), skv = wave_sum((isq ? 0.f : sa) + sb);
            const float rq = rsqrtf(sq * (1.f / 384) + EPS), rkv = rsqrtf(skv * (1.f / 256) + EPS), r1 = isq ? rq : rkv;
            v4u o;
#pragma unroll
            for (int e = 0; e < 4; ++e) o[e] = pk2(xa[2 * e] * r1 * ga[2 * e], xa[2 * e + 1] * r1 * ga[2 * e + 1]);
            if (isq) *(v4u*)(CQN + (size_t)mm * 384 + lane * 8) = o; else *(v4u*)(CKVN + (size_t)mm * 256 + (lane - 48) * 8) = o;
            if (lane < 16) { v4u o2;
#pragma unroll
                for (int e = 0; e < 4; ++e) o2[e] = pk2(xb[2 * e] * rkv * gb[2 * e], xb[2 * e + 1] * rkv * gb[2 * e + 1]);
                *(v4u*)(CKVN + (size_t)mm * 256 + (16 + lane) * 8) = o2; } } }
    }
}
__device__ __forceinline__ void ph_qknorm(Frame& F) {
    bf16* QKV = F.w<bf16>(WS_QKV0); float* kmean2 = F.w<float>(WS_KMEAN); LAS float* part = (LAS float*)F.lds;
    const int lane = F.lane;
    for (int u = F.bid; u < 256; u += F.G) { const int grp = u & 1, half = (u >> 1) & 1, blk = (u >> 2) & 15, b = u >> 6;
        const int col = (grp == 0 ? C_MK : C_DK) + lane * 8;
        const float* g = F.in[grp == 0 ? I_MKN : I_DKN] + (lane & 7) * 8;
        float gg[8];
#pragma unroll
        for (int j = 0; j < 8; ++j) gg[j] = g[j];
        float ks[8];
#pragma unroll
        for (int j = 0; j < 8; ++j) ks[j] = 0.f;
        const size_t row0 = (size_t)b * SEQ + blk * 256 + half * 128;
        for (int i0 = F.wave; i0 < 128; i0 += 4 * NWAVES) {
            v4u raw[4];
#pragma unroll
            for (int u4 = 0; u4 < 4; ++u4) raw[u4] = *(const v4u*)(QKV + (row0 + i0 + u4 * NWAVES) * QKV_LD + col);
#pragma unroll
            for (int u4 = 0; u4 < 4; ++u4) { float x[8];
                x[0] = bflo(raw[u4].x); x[1] = bfhi(raw[u4].x); x[2] = bflo(raw[u4].y); x[3] = bfhi(raw[u4].y); x[4] = bflo(raw[u4].z); x[5] = bfhi(raw[u4].z); x[6] = bflo(raw[u4].w); x[7] = bfhi(raw[u4].w);
                float ss = 0.f;
#pragma unroll
                for (int j = 0; j < 8; ++j) ss += x[j] * x[j];
                ss += __shfl_xor(ss, 1); ss += __shfl_xor(ss, 2); ss += __shfl_xor(ss, 4);
                const float r = rsqrtf(ss * (1.f / 64) + EPS);
#pragma unroll
                for (int j = 0; j < 8; ++j) { x[j] = x[j] * r * gg[j]; ks[j] += x[j]; }
                v4u o; o.x = pk2(x[0], x[1]); o.y = pk2(x[2], x[3]); o.z = pk2(x[4], x[5]); o.w = pk2(x[6], x[7]);
                *(v4u*)(QKV + (row0 + i0 + u4 * NWAVES) * QKV_LD + col) = o; } }
        if (grp == 0) {
#pragma unroll
            for (int j = 0; j < 8; ++j) part[F.wave * 512 + lane * 8 + j] = ks[j];
            __syncthreads();
            { const int c = F.tid; float s = 0.f;
#pragma unroll
              for (int w = 0; w < 8; ++w) s += part[w * 512 + c];
              kmean2[((((b * 8 + (c >> 6)) * 16 + blk) * 2) + half) * 64 + (c & 63)] = s; }
            __syncthreads(); }
    }
}
__device__ __forceinline__ void ph_mla_prep(Frame& F, const float2* tab) {
    const bf16* KVR = F.w<bf16>(WS_KVR); const bf16* C1 = F.w<bf16>(WS_C1); bf16* KM = F.w<bf16>(WS_KM); const float* g = F.in[I_MLAKN];
#pragma unroll 1
    for (int idx = F.bid * NTHR + F.tid; idx < M_TOK * 16; idx += F.G * NTHR) { const int row = idx >> 4, h = idx & 15, pos = row & (SEQ - 1);
        asm volatile("" ::: "memory");
        const v4u* src = (const v4u*)(KVR + (size_t)row * KVR_LD + h * 128);
        const v4u* src2 = (const v4u*)(C1 + (size_t)row * C1_LD + C1_KPE);
        v4u raw[12]; float ss = 0.f;
#pragma unroll
        for (int c = 0; c < 12; ++c) raw[c] = (c >= 8) ? src2[c - 8] : src[c];
#pragma unroll
        for (int c = 0; c < 12; ++c) {
#pragma unroll
            for (int e = 0; e < 4; ++e) { const float lo = bflo(raw[c][e]), hh = bfhi(raw[c][e]); ss += lo * lo + hh * hh; } }
        const float r = rsqrtf(ss * (1.f / 96) + EPS);
        v4u* dst = (v4u*)(KM + (size_t)row * QR_LD + h * 96);
#pragma unroll
        for (int c = 0; c < 8; ++c) { v4u o;
#pragma unroll
            for (int e = 0; e < 4; ++e) o[e] = pk2(bflo(raw[c][e]) * r * g[8 * c + 2 * e], bfhi(raw[c][e]) * r * g[8 * c + 2 * e + 1]);
            dst[c] = o; }
#pragma unroll
        for (int cc = 0; cc < 2; ++cc) { v4u o1, o2;
#pragma unroll
            for (int e = 0; e < 4; ++e) { const int i0 = 8 * cc + 2 * e;
                const float a0 = bflo(raw[8 + cc][e]) * r * g[64 + i0], a1 = bfhi(raw[8 + cc][e]) * r * g[64 + i0 + 1], b0 = bflo(raw[10 + cc][e]) * r * g[80 + i0], b1 = bfhi(raw[10 + cc][e]) * r * g[80 + i0 + 1];
                const float2 c0 = tab[pos * 16 + i0], c1 = tab[pos * 16 + i0 + 1];
                o1[e] = pk2(a0 * c0.x - b0 * c0.y, a1 * c1.x - b1 * c1.y); o2[e] = pk2(a0 * c0.y + b0 * c0.x, a1 * c1.y + b1 * c1.x); }
            dst[8 + cc] = o1; dst[10 + cc] = o2; }
    }
}
__device__ __forceinline__ void moe_y_row(const bf16* Y, const bf16* YP, int slot, int lane, float gate, f32x4 (&x)[4]) {
    if (slot < MOE_FULL_TILES * 256) { const v2u* a = (const v2u*)(Y + (size_t)slot * 1024) + lane;
#pragma unroll
        for (int j = 0; j < 4; ++j) { const v2u p = a[64 * j]; x[j].x += gate * bflo(p.x); x[j].y += gate * bfhi(p.x); x[j].z += gate * bflo(p.y); x[j].w += gate * bfhi(p.y); } }
    else { const v2u* a = (const v2u*)(YP + (size_t)(slot - MOE_FULL_TILES * 256) * 1024) + lane;
#pragma unroll
        for (int j = 0; j < 4; ++j) { float s0 = 0.f, s1 = 0.f, s2 = 0.f, s3 = 0.f;
#pragma unroll
            for (int k = 0; k < MOE_TAIL_SPLIT; ++k) { const v2u p = a[(size_t)k * MOE_TAIL_ROWS * 256 + 64 * j]; s0 += bflo(p.x); s1 += bfhi(p.x); s2 += bflo(p.y); s3 += bfhi(p.y); }
            x[j].x += gate * s0; x[j].y += gate * s1; x[j].z += gate * s2; x[j].w += gate * s3; } }
}
__device__ __forceinline__ void ph_moe_combine(Frame& F) {
    const bf16* Y = F.w<bf16>(WS_Y); const bf16* YP = F.w<bf16>(WS_YP); const int2* tslot = F.w<int2>(WS_TOK_SLOT); const float2* rg = F.w<float2>(WS_ROUTE_G); float* X = F.out; const bf16* XB = F.w<bf16>(WS_H);
    const int gw = F.bid * NWAVES + F.wave, NGW = F.G * NWAVES;
#pragma unroll 2
    for (int m = gw; m < M_TOK; m += NGW) { const int2 sl = tslot[m]; const float2 g = rg[m];
        f32x4* xr = (f32x4*)(X + (size_t)m * DM) + F.lane; const v2u* xb = (const v2u*)(XB + (size_t)m * DM) + F.lane; f32x4 x[4];
#pragma unroll
        for (int j = 0; j < 4; ++j) { const v2u p = xb[64 * j]; x[j] = (f32x4){bflo(p.x), bfhi(p.x), bflo(p.y), bfhi(p.y)}; }
        moe_y_row(Y, YP, sl.x, F.lane, g.x, x); moe_y_row(Y, YP, sl.y, F.lane, g.y, x);
#pragma unroll
        for (int j = 0; j < 4; ++j) xr[64 * j] = x[j]; }
}

namespace at {
typedef short s16x4 __attribute__((ext_vector_type(4)));
typedef short v4i16_t __attribute__((ext_vector_type(4)));
typedef __attribute__((address_space(3))) const char* lds_cptr;
__device__ __forceinline__ unsigned cvtpk(float lo, float hi) { return pk2(lo, hi); }
__device__ __forceinline__ int crow(int r, int hi) { return (r & 3) + 8 * (r >> 2) + 4 * hi; }
__device__ __forceinline__ s16x4 vtr(lds_cptr p) { return __builtin_bit_cast(s16x4, __builtin_amdgcn_ds_read_tr16_b64_v4i16((__attribute__((address_space(3))) v4i16_t*)p)); }

__device__ __forceinline__ void glds16(const void* gbase, unsigned voff, unsigned lds_dst) { unsigned keep;
    asm volatile("s_mov_b32 %0, m0\n\ts_mov_b32 m0, %3\n\ts_nop 0\n\tglobal_load_lds_dwordx4 %1, %2\n\ts_mov_b32 m0, %0" : "=&s"(keep) : "v"(voff), "s"(gbase), "s"(lds_dst) : "memory"); }
__device__ __forceinline__ void glds16b(const void* gbase, unsigned voff, unsigned lds_dst) { unsigned keep;
    asm volatile("s_mov_b32 %0, m0\n\ts_mov_b32 m0, %3\n\ts_nop 0\n\tglobal_load_lds_dwordx4 %1, %2 offset:128\n\ts_mov_b32 m0, %0" : "=&s"(keep) : "v"(voff), "s"(gbase), "s"(lds_dst) : "memory"); }
__device__ __forceinline__ void glds4(const void* gbase, unsigned voff, unsigned lds_dst) { unsigned keep;
    asm volatile("s_mov_b32 %0, m0\n\ts_mov_b32 m0, %3\n\ts_nop 0\n\tglobal_load_lds_dword %1, %2\n\ts_mov_b32 m0, %0" : "=&s"(keep) : "v"(voff), "s"(gbase), "s"(lds_dst) : "memory"); }
constexpr int KBUF = 12288, VBUF = 8192, MBUF = 2048;
constexpr int NSTG = 4;
constexpr int L_K = 0, L_V = NSTG * KBUF, L_M = L_V + NSTG * VBUF, L_TAB = L_M + NSTG * MBUF, TAB_GUARD = 64, TAB_N = SEQ + TAB_GUARD, L_WS = L_TAB + TAB_N * 4, L_OST = L_WS + NWAVES * 64 * 4, L_MISC = L_OST + NWAVES * 4096, L_END = L_MISC + 64;
static_assert(L_END <= LDSCTL_OFF, "attention LDS map");

struct AttnP { const bf16* Q; int ldq, qhs; const bf16* K; int ldk, khs; const bf16* V; int ldv, vhs; bf16* O; int ocol0; const float* relb; int bcol0; const float* kmean; const unsigned long long* maskt;
               const float* refs; const float* gq; const float2* rope; };

template <int MODE, int DQK>
__device__ __forceinline__ void attn_unit(Frame& F, const AttnP& P, int b, int h, int qb, bool build_tab) {
    constexpr int ND0 = DQK / 16;
    LAS unsigned char* lds = F.lds; const lds_cptr shm3 = (lds_cptr)F.lds;
    const int tid = F.tid, lane = F.lane, r32 = lane & 31, hi = lane >> 5, wid = F.wave;
    const size_t rowbase = (size_t)b * SEQ; const int q0 = qb * 256, qw = q0 + wid * 32, q = qw + r32;
    LAS float* tab = (LAS float*)(lds + L_TAB) + TAB_GUARD;
    LAS float* wsf = (LAS float*)(lds + L_WS) + wid * 64;
    const float ref = P.refs[MODE * 16 + h];
    if (MODE != 2 && build_tab) {
        for (int n = tid - TAB_GUARD; n < SEQ; n += NTHR) tab[n] = (n < 0) ? 0.f : P.relb[rel_bucket(n) * 16 + P.bcol0 + h] * LOG2E - ref;
    }
    const bf16* Kh = P.K + rowbase * P.ldk + h * P.khs; const bf16* Vh = P.V + rowbase * P.ldv + h * P.vhs;
    const unsigned kvoff = (unsigned)(lane * P.ldk + wid * 8) * 2u;
    const unsigned vvoff = (unsigned)((16 * (wid & 3) + (lane >> 2)) * P.ldv + (wid >> 2) * 32 + (lane & 3) * 8) * 2u;
    const unsigned lds0 = (unsigned)(size_t)lds;
    const unsigned char* mbase = (MODE == 1) ? (const unsigned char*)(P.maskt + ((size_t)b * 64 * SEQ) + qw) : nullptr;
#define AT_DMA(t, bufi) do { const bf16* kt_ = Kh + (size_t)(t) * 64 * P.ldk; \
        at::glds16(kt_, kvoff, (unsigned)__builtin_amdgcn_readfirstlane(lds0 + L_K + (bufi) * KBUF + wid * 1024)); \
        if (DQK == 96 && wid < 4) at::glds16b(kt_, kvoff, (unsigned)__builtin_amdgcn_readfirstlane(lds0 + L_K + (bufi) * KBUF + (8 + wid) * 1024 - 128));   \
        at::glds16(Vh + (size_t)(t) * 64 * P.ldv, vvoff, (unsigned)__builtin_amdgcn_readfirstlane(lds0 + L_V + (bufi) * VBUF + wid * 1024)); \
        if (MODE == 1) at::glds4(mbase + (size_t)(t) * SEQ * 8, (unsigned)lane * 4u, (unsigned)__builtin_amdgcn_readfirstlane(lds0 + L_M + (bufi) * MBUF + wid * 256)); } while (0)
    const int NT = (q0 + 256) / 64;
    const int tdiag = qw >> 6;
    AT_DMA(0, 0); AT_DMA(1, 1); AT_DMA(2, 2);
    bf16x8 qr[ND0];
    { const bf16* Qw = P.Q + (rowbase + q) * P.ldq + h * P.qhs + hi * 8;
#pragma unroll
      for (int d0 = 0; d0 < ND0; ++d0) qr[d0] = *(const bf16x8*)(Qw + d0 * 16); }
    if (MODE != 2) {
        float x[4][8]; float ss = 0.f;
#pragma unroll
        for (int d0 = 0; d0 < 4; ++d0)
#pragma unroll
            for (int j = 0; j < 8; ++j) { x[d0][j] = bf2f((bf16)qr[d0][j]); ss += x[d0][j] * x[d0][j]; }
        ss += __shfl_xor(ss, 32);
        const float rr = rsqrtf(ss * (1.f / 64) + EPS) * QSCALE64; const float* g = P.gq + hi * 8;
#pragma unroll
        for (int d0 = 0; d0 < 4; ++d0) { v4u w;
#pragma unroll
            for (int e = 0; e < 4; ++e) w[e] = pk2(x[d0][2 * e] * rr * g[d0 * 16 + 2 * e], x[d0][2 * e + 1] * rr * g[d0 * 16 + 2 * e + 1]);
            qr[d0] = __builtin_bit_cast(bf16x8, w); }
    }
    if (MODE == 2) {
        float x[6][8]; float ss = 0.f;
#pragma unroll
        for (int d0 = 0; d0 < 6; ++d0)
#pragma unroll
            for (int j = 0; j < 8; ++j) { x[d0][j] = bf2f((bf16)qr[d0][j]); ss += x[d0][j] * x[d0][j]; }
        ss += __shfl_xor(ss, 32);
        const float rr = rsqrtf(ss * (1.f / 96) + EPS) * QSCALE96; const float* g = P.gq + hi * 8;
#pragma unroll
        for (int d0 = 0; d0 < 6; ++d0)
#pragma unroll
            for (int j = 0; j < 8; ++j) x[d0][j] *= rr * g[d0 * 16 + j];
#pragma unroll
        for (int j = 0; j < 8; ++j) { const float2 cs = P.rope[q * 16 + hi * 8 + j]; const float x1 = x[4][j], x2 = x[5][j]; x[4][j] = x1 * cs.x - x2 * cs.y; x[5][j] = x1 * cs.y + x2 * cs.x; }
#pragma unroll
        for (int d0 = 0; d0 < 6; ++d0) { v4u w; w.x = pk2(x[d0][0], x[d0][1]); w.y = pk2(x[d0][2], x[d0][3]); w.z = pk2(x[d0][4], x[d0][5]); w.w = pk2(x[d0][6], x[d0][7]); qr[d0] = __builtin_bit_cast(bf16x8, w); }
    }
    unsigned keep = 0u; const int blk = qb;
    if (MODE == 0) {
        float v1 = -INFINITY, v2 = -INFINITY, v3 = -INFINITY; int i1 = -1, i2 = -1, i3 = -1;
        LAS float* kml = (LAS float*)(lds + L_OST);
        for (int i = tid; i < blk * 64; i += NTHR) { const float* k2 = P.kmean + (size_t)((b * 8 + h) * 16) * 128 + (i >> 6) * 128 + (i & 63); kml[i] = (k2[0] + k2[64]) * (1.f / 256); }
        asm volatile("s_waitcnt lgkmcnt(0)" ::: "memory"); __builtin_amdgcn_s_barrier();
        const LAS float* km0 = kml + hi * 8;
#pragma unroll 1
        for (int j = 0; j < blk; ++j) { const LAS float* km = km0 + j * 64; float g = 0.f;
#pragma unroll
            for (int d0 = 0; d0 < 4; ++d0) { const f32x4 ka = *(const LAS f32x4*)(km + d0 * 16), kb = *(const LAS f32x4*)(km + d0 * 16 + 4); const bf16x8 qq = qr[d0];
                g += bf2f((bf16)qq[0]) * ka.x + bf2f((bf16)qq[1]) * ka.y + bf2f((bf16)qq[2]) * ka.z + bf2f((bf16)qq[3]) * ka.w + bf2f((bf16)qq[4]) * kb.x + bf2f((bf16)qq[5]) * kb.y + bf2f((bf16)qq[6]) * kb.z + bf2f((bf16)qq[7]) * kb.w; }
            g += __shfl_xor(g, 32);
            if (g > v1) { v3 = v2; i3 = i2; v2 = v1; i2 = i1; v1 = g; i1 = j; } else if (g > v2) { v3 = v2; i3 = i2; v2 = g; i2 = j; } else if (g > v3) { v3 = g; i3 = j; } }
        if (i1 >= 0) keep |= 1u << i1; if (i2 >= 0) keep |= 1u << i2; if (i3 >= 0) keep |= 1u << i3;
    }
    float l_reg = 0.f; f32x16 o[2];
#pragma unroll
    for (int r = 0; r < 16; ++r) { o[0][r] = 0.f; o[1][r] = 0.f; }
    f32x16 cfar;
    { const float cf = -ref;
#pragma unroll
      for (int r = 0; r < 16; ++r) cfar[r] = (MODE == 2) ? cf : 0.f; }
#define AT_WAIT() do { if (DQK == 96 && wid < 4) asm volatile("s_waitcnt vmcnt(6) lgkmcnt(0)" ::: "memory"); \
        else if (MODE == 1) asm volatile("s_waitcnt vmcnt(6) lgkmcnt(0)" ::: "memory"); else asm volatile("s_waitcnt vmcnt(4) lgkmcnt(0)" ::: "memory"); } while (0)
#pragma unroll
    for (int d0 = 0; d0 < ND0; ++d0) asm volatile("" : "+v"(qr[d0]));
    asm volatile("" : "+v"(cfar)); asm volatile("" : "+v"(keep));
    asm volatile("s_waitcnt vmcnt(0) lgkmcnt(0)" ::: "memory");
    __builtin_amdgcn_s_barrier();
    for (int t = 0; t < NT; ++t) {
        const int bufi = t & (NSTG - 1);
        if (t + 3 < NT) AT_DMA(t + 3, (t + 3) & (NSTG - 1));
        bool active = t <= tdiag;
        bool lane_keep = true;
        if (MODE == 0) { const int jb = t >> 2; lane_keep = (jb == blk) || ((keep >> jb) & 1u); active = active && (__ballot(lane_keep) != 0ull); }
        if (active) {
            f32x16 p0, p1;
            const lds_cptr kp = shm3 + L_K + bufi * KBUF + hi * 1024 + r32 * 16;
            bf16x8 kf[2 * ND0];
#pragma unroll
            for (int d0 = 0; d0 < ND0; ++d0) { kf[2 * d0] = *(const __attribute__((address_space(3))) bf16x8*)(kp + d0 * 2048); kf[2 * d0 + 1] = *(const __attribute__((address_space(3))) bf16x8*)(kp + d0 * 2048 + 512); }
            v2u mwv = {0u, 0u}; if (MODE == 1) mwv = *(const LAS v2u*)(lds + L_M + bufi * MBUF + wid * 256 + r32 * 8);
            __builtin_amdgcn_sched_barrier(0);
            if (MODE != 2) { const LAS float* tb = tab + (q - 64 * t - 4 * hi);
#pragma unroll
                for (int r = 0; r < 16; ++r) { const int c = (r & 3) + 8 * (r >> 2); p0[r] = tb[-c]; p1[r] = tb[-c - 32]; }
#pragma unroll
                for (int d0 = 0; d0 < ND0; ++d0) { p0 = __builtin_amdgcn_mfma_f32_32x32x16_bf16(kf[2 * d0], qr[d0], p0, 0, 0, 0); p1 = __builtin_amdgcn_mfma_f32_32x32x16_bf16(kf[2 * d0 + 1], qr[d0], p1, 0, 0, 0); } }
            else {
                p0 = __builtin_amdgcn_mfma_f32_32x32x16_bf16(kf[0], qr[0], cfar, 0, 0, 0); p1 = __builtin_amdgcn_mfma_f32_32x32x16_bf16(kf[1], qr[0], cfar, 0, 0, 0);
#pragma unroll
                for (int d0 = 1; d0 < ND0; ++d0) { p0 = __builtin_amdgcn_mfma_f32_32x32x16_bf16(kf[2 * d0], qr[d0], p0, 0, 0, 0); p1 = __builtin_amdgcn_mfma_f32_32x32x16_bf16(kf[2 * d0 + 1], qr[d0], p1, 0, 0, 0); } }
            const lds_cptr vp = shm3 + L_V + bufi * VBUF + ((lane >> 4) & 1) * 32 + (lane & 3) * 8 + (4 * hi + ((lane & 15) >> 2)) * 64;
            bf16x8 vf[4];
#pragma unroll
            for (int i = 0; i < 4; ++i) { const s16x4 lo = vtr(vp + i * 1024), hh = vtr(vp + i * 1024 + 512); vf[i] = (bf16x8){lo[0], lo[1], lo[2], lo[3], hh[0], hh[1], hh[2], hh[3]}; }
            __builtin_amdgcn_sched_barrier(0);
#pragma unroll
            for (int r = 0; r < 16; ++r) { p0[r] = __builtin_amdgcn_exp2f(p0[r]); p1[r] = __builtin_amdgcn_exp2f(p1[r]); }
            if (MODE != 1 && t == tdiag) { const int kb = 64 * t + 4 * hi;
#pragma unroll
                for (int r = 0; r < 16; ++r) { const int kv = kb + (r & 3) + 8 * (r >> 2); if (kv > q) p0[r] = 0.f; if (kv + 32 > q) p1[r] = 0.f; } }
            if (MODE == 1) { const unsigned wl = mwv.x >> (4 * hi), wh = mwv.y >> (4 * hi);
#pragma unroll
                for (int r = 0; r < 16; ++r) { int m0, m1;
                    asm("v_bfe_i32 %0, %1, %2, 1" : "=v"(m0) : "v"(wl), "n"((r & 3) + 8 * (r >> 2))); asm("v_bfe_i32 %0, %1, %2, 1" : "=v"(m1) : "v"(wh), "n"((r & 3) + 8 * (r >> 2)));
                    p0[r] = __uint_as_float(__float_as_uint(p0[r]) & (unsigned)m0); p1[r] = __uint_as_float(__float_as_uint(p1[r]) & (unsigned)m1); } }
            float sacc = 0.f;
#pragma unroll
            for (int r = 0; r < 16; ++r) sacc += p0[r] + p1[r];
            const unsigned kmask = (MODE == 0 && !lane_keep) ? 0u : 0xffffffffu;
            l_reg += (MODE == 0 && !lane_keep) ? 0.f : sacc;
            v4u pw[4];
#pragma unroll
            for (int k = 0; k < 2; ++k) { pw[k].x = cvtpk(p0[8 * k], p0[8 * k + 1]); pw[k].y = cvtpk(p0[8 * k + 2], p0[8 * k + 3]); pw[k].z = cvtpk(p0[8 * k + 4], p0[8 * k + 5]); pw[k].w = cvtpk(p0[8 * k + 6], p0[8 * k + 7]);
                pw[2 + k].x = cvtpk(p1[8 * k], p1[8 * k + 1]); pw[2 + k].y = cvtpk(p1[8 * k + 2], p1[8 * k + 3]); pw[2 + k].z = cvtpk(p1[8 * k + 4], p1[8 * k + 5]); pw[2 + k].w = cvtpk(p1[8 * k + 6], p1[8 * k + 7]); }
            if (MODE == 0) {
#pragma unroll
                for (int k = 0; k < 4; ++k) { pw[k].x &= kmask; pw[k].y &= kmask; pw[k].z &= kmask; pw[k].w &= kmask; } }
            bf16x8 vg[4];
#pragma unroll
            for (int i = 0; i < 4; ++i) { const s16x4 lo = vtr(vp + 4096 + i * 1024), hh = vtr(vp + 4096 + i * 1024 + 512); vg[i] = (bf16x8){lo[0], lo[1], lo[2], lo[3], hh[0], hh[1], hh[2], hh[3]}; }
#pragma unroll
            for (int i = 0; i < 4; ++i) o[0] = __builtin_amdgcn_mfma_f32_32x32x16_bf16(__builtin_bit_cast(bf16x8, pw[i]), vf[i], o[0], 0, 0, 0);
#pragma unroll
            for (int i = 0; i < 4; ++i) o[1] = __builtin_amdgcn_mfma_f32_32x32x16_bf16(__builtin_bit_cast(bf16x8, pw[i]), vg[i], o[1], 0, 0, 0);
        }
        if (t + 3 < NT) AT_WAIT(); else asm volatile("s_waitcnt vmcnt(0) lgkmcnt(0)" ::: "memory");
        __builtin_amdgcn_s_barrier();
    }
#undef AT_WAIT
    l_reg += __shfl_xor(l_reg, 32);
    if (hi == 0) wsf[r32] = l_reg;
    LDS_WAIT();
    float rli[16];
#pragma unroll
    for (int r = 0; r < 16; ++r) rli[r] = __builtin_amdgcn_rcpf(wsf[crow(r, hi)]);
    bf16* Ow = P.O + (rowbase + qw) * 1024 + P.ocol0 + h * 64;
    { LAS bf16* stg = (LAS bf16*)(lds + L_OST) + wid * 2048;
#pragma unroll
      for (int r = 0; r < 16; ++r) { const int orow = crow(r, hi);
#pragma unroll
          for (int d0 = 0; d0 < 2; ++d0) stg[orow * 64 + d0 * 32 + r32] = f2bf(o[d0][r] * rli[r]); }
      LDS_WAIT();
#pragma unroll
      for (int i = 0; i < 4; ++i) { const int row = i * 8 + (lane >> 3), ch = lane & 7; const v4u v = *(const LAS v4u*)(stg + row * 64 + ch * 8); *(v4u*)(Ow + (size_t)row * 1024 + ch * 8) = v; } }
    asm volatile("s_waitcnt lgkmcnt(0)" ::: "memory"); __builtin_amdgcn_s_barrier();
#undef AT_DMA
}
}

__device__ __forceinline__ void ph_attn_l0(Frame& F) {
    const bf16* QKV = F.w<bf16>(WS_QKV0);
    at::AttnP PM{QKV + C_MQ, QKV_LD, 64, QKV + C_MK, QKV_LD, 64, QKV + C_MV, QKV_LD, 64, F.w<bf16>(WS_O), 0, F.in[I_RELB], 0, F.w<float>(WS_KMEAN), nullptr, F.w<float>(WS_REFS), F.in[I_MQN], nullptr};
    at::AttnP PD{QKV + C_DQ, QKV_LD, 64, QKV + C_DK, QKV_LD, 64, QKV + C_DV, QKV_LD, 64, F.w<bf16>(WS_O), 512, F.in[I_RELB], 8, nullptr, F.w<unsigned long long>(WS_MASKT), F.w<float>(WS_REFS), F.in[I_DQN], nullptr};
    const int vcu = (F.G % 8 == 0) ? (F.bid % 8) * (F.G / 8) + F.bid / 8 : F.bid;
    for (int v = vcu; v < 256; v += F.G) { const int bh = v >> 3, s = v & 7, b = bh >> 3, h = bh & 7;
        at::attn_unit<0, 64>(F, PM, b, h, 15 - s, true); moe_convert_slice(F, 0); at::attn_unit<0, 64>(F, PM, b, h, s, false);
        at::attn_unit<1, 64>(F, PD, b, h, 15 - s, true); moe_convert_slice(F, 1); at::attn_unit<1, 64>(F, PD, b, h, s, false); }
}
__device__ __forceinline__ void ph_attn_mla(Frame& F) {
    at::AttnP PA{F.w<bf16>(WS_QR), QR_LD, 96, F.w<bf16>(WS_KM), QR_LD, 96, F.w<bf16>(WS_KVR) + 64, KVR_LD, 128, F.w<bf16>(WS_O1), 0, nullptr, 0, nullptr, nullptr, F.w<float>(WS_REFS), F.in[I_MLAQN], F.w<float2>(WS_ROPE)};
    const int vcu = (F.G % 8 == 0) ? (F.bid % 8) * (F.G / 8) + F.bid / 8 : F.bid;
    for (int v = vcu; v < 256; v += F.G) { const int bh = v >> 2, s = v & 3, b = bh >> 4, h = bh & 15;
        const bool rev = (bh & 1) != 0; const int q0 = rev ? s : 15 - s, q1 = rev ? 11 - s : 4 + s, q2 = rev ? 4 + s : 11 - s, q3 = rev ? 15 - s : s;
        at::attn_unit<2, 96>(F, PA, b, h, q0, false); moe_convert_slice(F, 2); at::attn_unit<2, 96>(F, PA, b, h, q1, false);
        at::attn_unit<2, 96>(F, PA, b, h, q2, false); moe_convert_slice(F, 3); at::attn_unit<2, 96>(F, PA, b, h, q3, false); }
}

namespace ix {
constexpr int HP = 1028;
constexpr int L_HIST = 0, L_ROW = 32 * HP * 4;
constexpr int MP = 129;
constexpr int L_GE = 0, L_EQ = 32 * MP * 4;
static_assert(L_ROW + 3 * 32 * 4 <= LDSCTL_OFF && L_EQ + 32 * MP * 4 <= L_ROW, "index LDS map");

__device__ __forceinline__ float irelu(float x) { const int i = __float_as_int(x); return __int_as_float(i > 0 ? i : 0); }
__device__ __forceinline__ void hadd0(unsigned base, unsigned u, unsigned k65535) { unsigned a, v;
    asm volatile("v_lshrrev_b32_e32 %0, 22, %2\n\tv_bfe_u32 %1, %2, 21, 1\n\tv_lshl_add_u32 %0, %0, 2, %3\n\tv_mad_u32_u24 %1, %1, %4, 1\n\tds_add_u32 %0, %1"
                 : "=&v"(a), "=&v"(v) : "v"(u), "v"(base), "s"(k65535) : "memory"); }
__device__ __forceinline__ void hadd1(unsigned base, unsigned u, unsigned pre, unsigned k65535, unsigned k1024) { unsigned a, v, t;
    asm volatile("v_lshrrev_b32_e32 %2, 21, %3\n\tv_bfe_u32 %0, %3, 11, 10\n\tv_cmp_eq_u32_e32 vcc, %2, %5\n\tv_bfe_u32 %1, %3, 10, 1\n\tv_mad_u32_u24 %1, %1, %6, 1\n\tv_cndmask_b32_e32 %0, %7, %0, vcc\n\tv_lshl_add_u32 %0, %0, 2, %4\n\tds_add_u32 %0, %1"
                 : "=&v"(a), "=&v"(v), "=&v"(t) : "v"(u), "v"(base), "v"(pre), "s"(k65535), "v"(k1024) : "memory", "vcc"); }
__device__ __forceinline__ void push2(unsigned& ge, unsigned& gt, unsigned xa, unsigned xb, unsigned cge, unsigned cgt) { unsigned long long s0, s1, s2;
    asm("v_cmp_ge_u32_e64 %2, %5, %7\n\tv_cmp_ge_u32_e64 %3, %5, %8\n\tv_cmp_ge_u32_e64 %4, %6, %7\n\tv_cmp_ge_u32_e32 vcc, %6, %8\n\t"
        "v_addc_co_u32_e64 %0, %2, %0, %0, %2\n\tv_addc_co_u32_e64 %1, %3, %1, %1, %3\n\tv_addc_co_u32_e64 %0, %4, %0, %0, %4\n\tv_addc_co_u32_e32 %1, vcc, %1, %1, vcc"
        : "+v"(ge), "+v"(gt), "=&s"(s0), "=&s"(s1), "=&s"(s2) : "v"(xa), "v"(xb), "v"(cge), "v"(cgt) : "vcc"); }

template <int PASS>
__device__ __forceinline__ void pass_loop(const bf16x8 (&qf)[4][4], const f32x2_t (&w2)[4], const bf16* kbase, int KT, int wid, int r32, int hi, LAS unsigned* hist, unsigned mypre) {
    const f32x16 zero16 = {0.f, 0.f, 0.f, 0.f, 0.f, 0.f, 0.f, 0.f, 0.f, 0.f, 0.f, 0.f, 0.f, 0.f, 0.f, 0.f};
    const unsigned hbase = (unsigned)(size_t)(hist + r32 * HP);
    unsigned Fx = 0u, Cge = 0u, Cgt = 0u;
    if (PASS == 2) { const unsigned Tlo = mypre << 10; const bool neg = (mypre >> 21) & 1u;
        Fx = neg ? 0xffffffffu : 0x80000000u; Cge = neg ? ~(Tlo | 1023u) : (Tlo ^ 0x80000000u); Cgt = neg ? (~Tlo + 1u) : ((Tlo + 1024u) ^ 0x80000000u); }
    bf16x8 kn[4];
    { const bf16* kr = kbase + (size_t)((wid < KT ? wid : 0) * 32 + r32) * QKV_LD;
#pragma unroll
      for (int d0 = 0; d0 < 4; ++d0) kn[d0] = *(const bf16x8*)(kr + d0 * 16); }
#pragma unroll 1
    for (int kt = wid; kt < KT; kt += NWAVES) {
        bf16x8 kf[4];
#pragma unroll
        for (int d0 = 0; d0 < 4; ++d0) kf[d0] = kn[d0];
        { const int ktn = (kt + NWAVES < KT) ? kt + NWAVES : kt; const bf16* kr = kbase + (size_t)(ktn * 32 + r32) * QKV_LD;
#pragma unroll
          for (int d0 = 0; d0 < 4; ++d0) kn[d0] = *(const bf16x8*)(kr + d0 * 16); }
        f32x2_t s2[8];
        { f32x16 a0, a1;
          a0 = __builtin_amdgcn_mfma_f32_32x32x16_bf16(kf[0], qf[0][0], zero16, 0, 0, 0); a1 = __builtin_amdgcn_mfma_f32_32x32x16_bf16(kf[0], qf[1][0], zero16, 0, 0, 0);
#pragma unroll
          for (int d0 = 1; d0 < 4; ++d0) { a0 = __builtin_amdgcn_mfma_f32_32x32x16_bf16(kf[d0], qf[0][d0], a0, 0, 0, 0); a1 = __builtin_amdgcn_mfma_f32_32x32x16_bf16(kf[d0], qf[1][d0], a1, 0, 0, 0); }
#pragma unroll
          for (int p = 0; p < 8; ++p) { const f32x2_t r0 = {irelu(a0[2 * p]), irelu(a0[2 * p + 1])}, r1 = {irelu(a1[2 * p]), irelu(a1[2 * p + 1])}; s2[p] = __builtin_elementwise_fma(r1, w2[1], r0 * w2[0]); } }
        { f32x16 a2, a3;
          a2 = __builtin_amdgcn_mfma_f32_32x32x16_bf16(kf[0], qf[2][0], zero16, 0, 0, 0); a3 = __builtin_amdgcn_mfma_f32_32x32x16_bf16(kf[0], qf[3][0], zero16, 0, 0, 0);
#pragma unroll
          for (int d0 = 1; d0 < 4; ++d0) { a2 = __builtin_amdgcn_mfma_f32_32x32x16_bf16(kf[d0], qf[2][d0], a2, 0, 0, 0); a3 = __builtin_amdgcn_mfma_f32_32x32x16_bf16(kf[d0], qf[3][d0], a3, 0, 0, 0); }
#pragma unroll
          for (int p = 0; p < 8; ++p) { const f32x2_t r2 = {irelu(a2[2 * p]), irelu(a2[2 * p + 1])}, r3 = {irelu(a3[2 * p]), irelu(a3[2 * p + 1])}; s2[p] = __builtin_elementwise_fma(r3, w2[3], __builtin_elementwise_fma(r2, w2[2], s2[p])); } }
        unsigned u[16];
#pragma unroll
        for (int p = 0; p < 8; ++p) { u[2 * p] = __float_as_uint(s2[p].x); u[2 * p + 1] = __float_as_uint(s2[p].y); }
        if (kt == KT - 1) {
#pragma unroll
            for (int r = 0; r < 16; ++r) { const int c = (r & 3) + 8 * (r >> 2) + 4 * hi; u[r] = (c <= r32) ? u[r] : 0xffffffffu; } }
        if (PASS == 0) {
#pragma unroll
            for (int r = 0; r < 16; ++r) hadd0(hbase, u[r], 65535u);
        } else if (PASS == 1) {
#pragma unroll
            for (int r = 0; r < 16; ++r) hadd1(hbase, u[r], mypre, 65535u, 1024u);
        } else {
            unsigned ge = 0u, gt = 0u;
#pragma unroll
            for (int r = 15; r >= 1; r -= 2) { push2(ge, gt, u[r] ^ Fx, u[r - 1] ^ Fx, Cge, Cgt); if ((r & 3) == 1 && r > 1) { ge <<= 4; gt <<= 4; } }
            ge <<= 4 * hi; gt <<= 4 * hi; const unsigned eq = ge & ~gt;
            if (ge) atomicOr((unsigned*)(hist + r32 * MP + kt), ge);
            if (eq) atomicOr((unsigned*)(hist + 32 * MP + r32 * MP + kt), eq);
        }
    }
    asm volatile("s_waitcnt lgkmcnt(0)" ::: "memory");
}

__device__ __forceinline__ void dsa_index_unit(Frame& F, int b, int qt) {
    const int tid = F.tid, lane = F.lane, r32 = lane & 31, hi = lane >> 5, wid = F.wave;
    const int q0 = qt * 32, q = q0 + r32, KT = qt + 1;
    const bf16* QKV = F.w<bf16>(WS_QKV0); unsigned long long* maskt = F.w<unsigned long long>(WS_MASKT);
    LAS unsigned* hist = (LAS unsigned*)(F.lds + ix::L_HIST); LAS unsigned* rowi = (LAS unsigned*)(F.lds + ix::L_ROW);
    LAS unsigned* pre = rowi; LAS unsigned* krem = rowi + 32; LAS unsigned* cnteq = rowi + 64;
    const bf16* qrow = QKV + (size_t)(b * SEQ + q) * QKV_LD;
    bf16x8 qf[4][4];
#pragma unroll
    for (int h = 0; h < 4; ++h)
#pragma unroll
        for (int d0 = 0; d0 < 4; ++d0) qf[h][d0] = *(const bf16x8*)(qrow + C_IQ + h * 64 + d0 * 16 + hi * 8);
    f32x2_t w2[4];
    { const v2u wr = *(const v2u*)(qrow + C_IW); const float w0 = __uint_as_float(wr.x << 16), w1 = __uint_as_float(wr.x & 0xffff0000u), w2f = __uint_as_float(wr.y << 16), w3 = __uint_as_float(wr.y & 0xffff0000u);
      w2[0] = (f32x2_t){w0, w0}; w2[1] = (f32x2_t){w1, w1}; w2[2] = (f32x2_t){w2f, w2f}; w2[3] = (f32x2_t){w3, w3}; }
    for (int i = tid; i < 32 * ix::HP; i += NTHR) hist[i] = 0u;
    if (tid < 32) { pre[tid] = 0u; const int n = q0 + tid + 1; krem[tid] = (unsigned)(n < 256 ? n : 256); cnteq[tid] = 0u; }
    __syncthreads();
    const bf16* kbase = QKV + (size_t)(b * SEQ) * QKV_LD + C_IK + hi * 8;
#pragma unroll 1
    for (int pass = 0; pass < 3; ++pass) {
        const unsigned mypre = pre[r32];
        if (pass == 2) { __syncthreads(); for (int i = tid; i < 2 * 32 * ix::MP; i += NTHR) hist[i] = 0u; __syncthreads(); }
        if (pass == 0) pass_loop<0>(qf, w2, kbase, KT, wid, r32, hi, hist, mypre);
        else if (pass == 1) pass_loop<1>(qf, w2, kbase, KT, wid, r32, hi, hist, mypre);
        else pass_loop<2>(qf, w2, kbase, KT, wid, r32, hi, hist, mypre);
        __syncthreads();
        if (pass < 2) {
#pragma unroll 1
            for (int rr = 0; rr < 4; ++rr) { const int row = wid * 4 + rr; const unsigned rowpre = pre[row];
                const bool neg = (pass == 0) ? (lane < 32) : (rowpre >= 1024u); const int rl = (pass == 0) ? (neg ? 63 - lane : lane - 32) : (neg ? 63 - lane : lane);
                const LAS unsigned* hr = hist + row * ix::HP + rl * 16;
                unsigned wr[16], wv[16]; unsigned total = 0u;
#pragma unroll
                for (int i = 0; i < 16; ++i) wr[i] = hr[i];
#pragma unroll
                for (int i = 0; i < 16; ++i) { wv[i] = neg ? __builtin_amdgcn_alignbit(wr[15 - i], wr[15 - i], 16) : wr[i]; total += (wv[i] & 0xffffu) + (wv[i] >> 16); }
                unsigned S = total;
#pragma unroll
                for (int off = 1; off < 64; off <<= 1) { const unsigned v = __shfl_down(S, off); if (lane + off < 64) S += v; }
                const unsigned k = krem[row], above = S - total;
                if (S >= k && above < k) { unsigned run = above, bstar = 0u, newk = 0u, cnt = 0u; bool done = false;
#pragma unroll
                    for (int i = 15; i >= 0; --i) { const unsigned ch = wv[i] >> 16, cl = wv[i] & 0xffffu;
                        if (!done) { if (run + ch >= k) { bstar = 32u * lane + 2u * i + 1u; newk = k - run; cnt = ch; done = true; } else run += ch; }
                        if (!done) { if (run + cl >= k) { bstar = 32u * lane + 2u * i; newk = k - run; cnt = cl; done = true; } else run += cl; } }
                    const unsigned braw = (pass == 0) ? (bstar >= 1024u ? bstar - 1024u : 2047u - bstar) : (neg ? 2047u - bstar : bstar);
                    pre[row] = (rowpre << 11) | braw; krem[row] = newk; cnteq[row] = cnt; } }
            __syncthreads();
            if (pass < 1) { for (int i = tid; i < 32 * ix::HP; i += NTHR) hist[i] = 0u; __syncthreads(); }
        }
    }
#pragma unroll 1
    for (int rr = 0; rr < 4; ++rr) { const int row = wid * 4 + rr; const unsigned need = krem[row], ce = cnteq[row];
        if (need < ce) { LAS unsigned* g = hist + row * ix::MP; LAS unsigned* e = hist + 32 * ix::MP + row * ix::MP;
            const unsigned e0 = e[2 * lane], e1 = e[2 * lane + 1]; const int c0 = __popc(e0), c1 = __popc(e1), c = c0 + c1; int incl = c;
#pragma unroll
            for (int off = 1; off < 64; off <<= 1) { const int v = __shfl_up(incl, off); if (lane >= off) incl += v; }
            int rem = (int)need - (incl - c); rem = rem < 0 ? 0 : (rem > c ? c : rem);
            const int k0 = rem < c0 ? rem : c0, k1 = rem - k0;
            unsigned y0 = e0; for (int i = 0; i < k0; ++i) y0 &= y0 - 1u;
            unsigned y1 = e1; for (int i = 0; i < k1; ++i) y1 &= y1 - 1u;
            g[2 * lane] &= ~y0; g[2 * lane + 1] &= ~y1; } }
    __syncthreads();
    for (int idx = tid; idx < 32 * 64; idx += NTHR) { const int qq = idx & 31, t = idx >> 5;
        const unsigned lo = hist[qq * ix::MP + 2 * t], hh = hist[qq * ix::MP + 2 * t + 1];
        maskt[((size_t)(b * 64 + t) * SEQ) + q0 + qq] = (unsigned long long)lo | ((unsigned long long)hh << 32); }
    __syncthreads();
}
}
__device__ __forceinline__ void ph_dsa_index(Frame& F) {
    for (int v = F.bid; v < 256; v += F.G) { const int b = v >> 6, i = v & 63; ix::dsa_index_unit(F, b, 127 - i); ix::dsa_index_unit(F, b, i); }
}

#define XB_TMO      128
#define XB_XCNT(j)  (256  + 64 * (j))
#define XB_XSUB(j)  (1280 + 64 * (j))
#define XB_XGEN(j)  (2304 + 64 * (j))
#define XB_TOP      3328
#define XB_TOPGEN   3392
#define XCD_BAR_WORDS 3456
#define XB_SPIN_CAP (1u << 18)

__device__ __forceinline__ unsigned xb_ld(unsigned* p)              { return __hip_atomic_load(p, __ATOMIC_RELAXED, __HIP_MEMORY_SCOPE_AGENT); }
__device__ __forceinline__ unsigned xb_add(unsigned* p, unsigned v) { return __hip_atomic_fetch_add(p, v, __ATOMIC_RELAXED, __HIP_MEMORY_SCOPE_AGENT); }
__device__ __forceinline__ unsigned xb_xcc_id() { return (unsigned)__builtin_amdgcn_s_getreg((3 << 11) | 20) & 0xFu; }
#define XB_SPIN(cond, bar) do { unsigned _sp = 0; while (cond) { __builtin_amdgcn_s_sleep(1); \
    if ((++_sp & 255u) == 0u) { if (xb_ld(&(bar)[XB_TMO])) break; if (_sp > XB_SPIN_CAP) { atomicAdd(&(bar)[XB_TMO], 1u); break; } } } } while (0)

struct XcdBarrier {
    unsigned* bar; unsigned x;
    volatile LAS unsigned* st;
};

__device__ __forceinline__ XcdBarrier xcd_barrier_post(unsigned* bar, volatile LAS unsigned* st) {
    XcdBarrier b; b.bar = bar; b.x = xb_xcc_id(); b.st = st;
    if (threadIdx.x == 0) (void)xb_add(&bar[XB_XCNT(b.x)], 1u);
    return b;
}
__device__ __forceinline__ void xcd_barrier_complete(unsigned* bar, unsigned x, unsigned& nloc, unsigned& nx) {
    const unsigned G = gridDim.x * gridDim.y * gridDim.z;
    unsigned sum, cnt, mine, sp = 0u;
    for (;;) {
        sum = 0u; cnt = 0u; mine = 0u;
#pragma unroll
        for (unsigned j = 0; j < 16; ++j) { const unsigned c = xb_ld(&bar[XB_XCNT(j)]); sum += c; cnt += (c > 0u) ? 1u : 0u; mine = (j == x) ? c : mine; }
        if (sum == G) break;
        __builtin_amdgcn_s_sleep(1);
        if ((++sp & 255u) == 0u) { if (xb_ld(&bar[XB_TMO])) break; if (sp > XB_SPIN_CAP) { atomicAdd(&bar[XB_TMO], 1u); break; } }
    }
    nloc = mine > 0u ? mine : 1u; nx = cnt > 0u ? cnt : 1u;
}

__device__ __forceinline__ void xcd_barrier(const XcdBarrier& b) {
    asm volatile("s_waitcnt vmcnt(0)" ::: "memory");
    __syncthreads();
    if (threadIdx.x == 0) {
        unsigned* bar = b.bar;
        __builtin_amdgcn_s_waitcnt(0);
        unsigned nloc = b.st[0], nx = b.st[1];
        if (nloc == 0u) { xcd_barrier_complete(bar, b.x, nloc, nx); b.st[0] = nloc; b.st[1] = nx; }
        const unsigned old = xb_add(&bar[XB_XSUB(b.x)], 1u);
        const unsigned gen = old / nloc;
        if (old + 1u == (gen + 1u) * nloc) {
            __builtin_amdgcn_fence(__ATOMIC_RELEASE, "agent");
            asm volatile("s_waitcnt vmcnt(0)" ::: "memory");
            const unsigned og = xb_add(&bar[XB_TOP], 1u);
            const unsigned tg = og / nx;
            if (og + 1u == (tg + 1u) * nx) xb_add(&bar[XB_TOPGEN], 1u);
            else XB_SPIN(xb_ld(&bar[XB_TOPGEN]) == tg, bar);
            __builtin_amdgcn_fence(__ATOMIC_ACQUIRE, "agent");
            xb_add(&bar[XB_XGEN(b.x)], 1u);
            asm volatile("s_waitcnt vmcnt(0)" ::: "memory");
        } else {
            XB_SPIN(xb_ld(&bar[XB_XGEN(b.x)]) == gen, bar);
            __builtin_amdgcn_fence(__ATOMIC_ACQUIRE, "agent");
            asm volatile("s_waitcnt vmcnt(0)" ::: "memory");
        }
    }
    __syncthreads();
}

constexpr int NPHASE = 20;
constexpr int CW_BAR = 4096;
#ifndef HAVE_ATTN
#define HAVE_ATTN 0
#endif
#ifndef HAVE_INDEX
#define HAVE_INDEX 0
#endif

__global__ void __launch_bounds__(NTHR, 2) mega(Args args) {
    extern __shared__ __attribute__((aligned(16))) unsigned char lds_raw[];
    Frame F; F.lds = (LAS unsigned char*)lds_raw; F.tid = threadIdx.x; F.lane = F.tid & 63; F.wave = __builtin_amdgcn_readfirstlane(F.tid >> 6);
    F.G = gridDim.x; F.bid = blockIdx.x; F.in = args.in; F.out = args.out; F.ws = args.ws;
    volatile LAS unsigned* MISC = (volatile LAS unsigned*)(F.lds + LDSCTL_OFF);
    for (int u = F.tid; u < 256; u += NTHR) MISC[u] = 0u;
    __syncthreads();
    const int lo = args.ph_lo, hi = args.ph_hi;
    XcdBarrier bar; bar.bar = (unsigned*)(args.ws + WS_CTL) + CW_BAR; bar.x = 0; bar.st = nullptr;
    if (hi - lo > 1) bar = xcd_barrier_post((unsigned*)(args.ws + WS_CTL) + CW_BAR, MISC + 8);
#define IN(k) (lo <= (k) && (k) < hi)
#define SEAM(k) do { if (IN(k) && IN((k) + 1)) xcd_barrier(bar); } while (0)
    PG8_LAS unsigned char* glds = (PG8_LAS unsigned char*)lds_raw;
    const pg8::bf16_t* H = F.w<pg8::bf16_t>(WS_H);

    if (IN(0)) { ph_prologue(F); } SEAM(0);
    if (IN(1)) { pg8::Gemm g{H, F.w<pg8::bf16_t>(WS_W_IN_E), 1024, 1024, 1024}; pg8::StaticOrder S{M_TOK / 256, QKV_LD / 256, F.G, F.bid}; pg8::EpiBf16 E{F.w<pg8::bf16_t>(WS_QKV0), QKV_LD};
        pg8::gemm_phase<pg8::EpiBf16, pg8::StaticOrder, true, false>(glds, g, S, E, nullptr);
        moe_convert_tail(F, 0, MOE_TAIL_A, (M_TOK / 256) * (QKV_LD / 256) % 256); } SEAM(1);
    if (IN(2)) { if (args.sub & 1) ph_qknorm(F);
#if HAVE_INDEX
        if (args.sub & 2) ph_dsa_index(F);
#endif
    } SEAM(2);
    if (IN(3)) {
#if HAVE_ATTN
        ph_attn_l0(F);
#endif
    } SEAM(3);
    if (IN(4)) { pg8::Gemm g{F.w<pg8::bf16_t>(WS_O), F.w<pg8::bf16_t>(WS_W_OUT_E), 1024, 1024, 1024}; pg8::StaticOrder S{M_TOK / 256, 4, F.G, F.bid}; pg8::EpiResN<false> E{F.in[I_X], F.w<pg8::bf16_t>(WS_H), F.w<float>(WS_SSP), 1024};
        pg8::gemm_phase<pg8::EpiResN<false>, pg8::StaticOrder, false, false>(glds, g, S, E, nullptr); } SEAM(4);
    if (IN(6)) { pg8::Gemm g{H, F.w<pg8::bf16_t>(WS_W_GU_E), 1024, 1024, 1024}; pg8::StaticOrder S{M_TOK / 256, 2 * FF_E / 256, F.G, F.bid}; pg8::EpiSwiGLUS<pg8::ScaleSSP> E{F.w<pg8::bf16_t>(WS_ACT0), FF_E, 1 << 20, {F.w<float>(WS_SSP), EPS}};
        pg8::gemm_phase<pg8::EpiSwiGLUS<pg8::ScaleSSP>, pg8::StaticOrder, true, false>(glds, g, S, E, nullptr);
        moe_convert_tail(F, MOE_TAIL_A, MOE_TAIL_B, (M_TOK / 256) * (2 * FF_E / 256) % 256); } SEAM(6);
    if (IN(7)) { pg8::Gemm g{F.w<pg8::bf16_t>(WS_ACT0), F.w<pg8::bf16_t>(WS_W_DN_E), FF_E, FF_E, FF_E}; pg8::StaticOrder S{M_TOK / 256, 4, F.G, F.bid}; pg8::EpiResN<true> E{nullptr, F.w<pg8::bf16_t>(WS_H), F.w<float>(WS_SSP), 1024};
        pg8::gemm_phase<pg8::EpiResN<true>, pg8::StaticOrder, false, false>(glds, g, S, E, nullptr); } SEAM(7);
    if (IN(9)) { pg8::Gemm g{H, F.w<pg8::bf16_t>(WS_W_IN_O), 1024, 1024, 1024}; pg8::StaticOrder S{M_TOK / 256, C1_LD / 256, F.G, F.bid}; pg8::EpiBf16SL<pg8::ScaleSSP> E{F.w<pg8::bf16_t>(WS_C1), C1_LD, F.w<float>(WS_LSP), {F.w<float>(WS_SSP), EPS}};
        pg8::gemm_phase<pg8::EpiBf16SL<pg8::ScaleSSP>, pg8::StaticOrder, true, false>(glds, g, S, E, nullptr);
        moe_convert_tail(F, MOE_TAIL_A + MOE_TAIL_B, MOE_TAIL_C, (M_TOK / 256) * (C1_LD / 256)); } SEAM(9);
    if (IN(11)) { pg8::Gemm g{F.w<pg8::bf16_t>(WS_C1), F.w<pg8::bf16_t>(WS_W_LAT), C1_LD, W_LAT_LD, 384}; pg8::LatJointOrder S{F.G, F.bid};
        pg8::EpiLatJoint E{F.w<pg8::bf16_t>(WS_QR), F.w<pg8::bf16_t>(WS_KVR), {F.w<float>(WS_LSP), EPS}};
        pg8::gemm_phase<pg8::EpiLatJoint, pg8::LatJointOrder, true, false>(glds, g, S, E, nullptr); } SEAM(11);
    if (IN(12)) { ph_mla_prep(F, F.w<float2>(WS_ROPE)); } SEAM(12);
    if (IN(13)) {
#if HAVE_ATTN
        ph_attn_mla(F);
#endif
    } SEAM(13);
    if (IN(14)) { pg8::Gemm g{F.w<pg8::bf16_t>(WS_O1), F.w<pg8::bf16_t>(WS_W_OUT_O), 1024, 1024, 1024}; pg8::StaticOrder S{M_TOK / 256, 4, F.G, F.bid}; pg8::EpiResN<true> E{nullptr, F.w<pg8::bf16_t>(WS_H), F.w<float>(WS_SSP), 1024};
        pg8::gemm_phase<pg8::EpiResN<true>, pg8::StaticOrder, false, false>(glds, g, S, E, nullptr); } SEAM(14);
    if (IN(15)) { ph_rmsnorm_route(F, F.w<bf16>(WS_H), F.in[I_FFNN_O], F.w<float>(WS_RSTD)); } SEAM(15);
    if (IN(16)) { ph_slots(F); } SEAM(16);
    if (IN(17)) { const int* tile_e = F.w<int>(WS_TILE_E); const int ntile = tile_e[TILE_CAP];
        pg8::Gemm g{H, F.w<pg8::bf16_t>(WS_WGU_O), 1024, 1024, 1024}; pg8::MoeOrder S{tile_e, ntile, 2 * FF_O / 256, F.G, F.bid, 1, 1024, 0}; pg8::EpiSwiGLUS<pg8::ScaleSlot> E{F.w<pg8::bf16_t>(WS_ACT1), FF_O, 2 * FF_O / 256, {F.w<float>(WS_SLOT_RSTD)}};
        pg8::gemm_phase<pg8::EpiSwiGLUS<pg8::ScaleSlot>, pg8::MoeOrder, true, true>(glds, g, S, E, F.w<int>(WS_SLOT_TOK)); } SEAM(17);
    if (IN(18)) { const int* tile_e = F.w<int>(WS_TILE_E); const int ntile = tile_e[TILE_CAP];
        { pg8::Gemm g{F.w<pg8::bf16_t>(WS_ACT1), F.w<pg8::bf16_t>(WS_WDN_O), FF_O, FF_O, FF_O}; pg8::MoeOrder S{tile_e, ntile < MOE_FULL_TILES ? ntile : MOE_FULL_TILES, 4, F.G, F.bid, 1, FF_O, 0};
          pg8::EpiMoeY E{F.w<pg8::bf16_t>(WS_Y), 0, 4, FF_O, 0};
          pg8::gemm_phase<pg8::EpiMoeY, pg8::MoeOrder, true, false>(glds, g, S, E, nullptr); }
        if (ntile > MOE_FULL_TILES) { pg8::Gemm g{F.w<pg8::bf16_t>(WS_ACT1), F.w<pg8::bf16_t>(WS_WDN_O), FF_O, FF_O, FF_O / MOE_TAIL_SPLIT}; pg8::MoeOrder S{tile_e, ntile - MOE_FULL_TILES, 4, F.G, F.bid, MOE_TAIL_SPLIT, FF_O / MOE_TAIL_SPLIT, MOE_FULL_TILES};
          pg8::EpiMoeY E{F.w<pg8::bf16_t>(WS_YP), (size_t)MOE_TAIL_ROWS * 1024, 4, FF_O / MOE_TAIL_SPLIT, MOE_FULL_TILES * 256};
          pg8::gemm_phase<pg8::EpiMoeY, pg8::MoeOrder, true, false>(glds, g, S, E, nullptr); } } SEAM(18);
    if (IN(19)) { ph_moe_combine(F); }
#undef IN
#undef SEAM
}

#ifndef FAST_MASK
#define FAST_MASK 0xFFFFFu
#endif
#ifndef ONE_LAUNCH
#define ONE_LAUNCH 0
#endif
struct Ptrs {
    const float* in[N_INPUTS]; float* out; unsigned char* ws;
    template <class T> T* w(size_t off) const { return (T*)(ws + off); }
};
static int g_grid = 0;
static void launch_mega(const Ptrs& P, int lo, int hi, hipStream_t st, int sub = 3) {
    Args a{}; a.sub = sub; for (int i = 0; i < N_INPUTS; ++i) a.in[i] = P.in[i]; a.out = P.out; a.ws = P.ws; a.ph_lo = lo; a.ph_hi = hi;
    hipLaunchKernelGGL(mega, dim3(g_grid), dim3(NTHR), LDS_BYTES, st, a);
    const hipError_t le = hipPeekAtLastError();
    if (le != hipSuccess) fprintf(stderr, "kernel_launch: mega[%d,%d) failed: %s\n", lo, hi, hipGetErrorName(le));
}
#if !ONE_LAUNCH
static void naive_weights(const Ptrs& P, hipStream_t st) {
    auto wt = [&](int idx, int K, int N, int Npad, size_t off, int mode, int nexp, size_t wes, size_t wtes) {
        nv::k_wt<<<dim3((Npad + 31) / 32, K / 32, nexp), 256, 0, st>>>(P.in[idx], K, N, Npad, P.w<bf16>(off), mode, wes, wtes); };
    wt(I_W_IN_E, 1024, N_IN_E, QKV_LD, WS_W_IN_E, 0, 1, 0, 0);
    wt(I_W_OUT_E, 1024, 1024, 1024, WS_W_OUT_E, 0, 1, 0, 0);
    wt(I_W_GATE_E, 1024, FF_E, FF_E, WS_W_GU_E, 1, 1, 0, 0);
    wt(I_W_UP_E, 1024, FF_E, FF_E, WS_W_GU_E, 2, 1, 0, 0);
    wt(I_W_DOWN_E, FF_E, 1024, 1024, WS_W_DN_E, 0, 1, 0, 0);
    wt(I_W_IN_O, 1024, N_IN_O, C1_LD, WS_W_IN_O, 0, 1, 0, 0);
    wt(I_W_UQ, 384, 1536, 1536, WS_W_UQ, 0, 1, 0, 0);
    wt(I_W_UKV, 256, 2048, 2048, WS_W_UKV, 0, 1, 0, 0);
    wt(I_W_OUT_O, 1024, 1024, 1024, WS_W_OUT_O, 0, 1, 0, 0);
    wt(I_W_GATE_O, 1024, FF_O, FF_O, WS_WGU_O, 1, NEXP, (size_t)1024 * FF_O, (size_t)2 * FF_O * 1024);
    wt(I_W_UP_O, 1024, FF_O, FF_O, WS_WGU_O, 2, NEXP, (size_t)1024 * FF_O, (size_t)2 * FF_O * 1024);
    wt(I_W_DOWN_O, FF_O, 1024, 1024, WS_WDN_O, 0, NEXP, (size_t)1024 * FF_O, (size_t)1024 * FF_O);
}
template <int EPI> static void naive_gemm(nv::GemmArgs a, hipStream_t st) { nv::k_gemm<EPI><<<dim3(a.N / 64, a.M / 64), 256, 0, st>>>(a); }
__global__ void k_rope_tab(float2* tab) { const int idx = blockIdx.x * 256 + threadIdx.x; const int pos = idx >> 4, i = idx & 15; const float fr = powf(10000.f, -(float)i / 16.f), ang = (float)pos * fr; tab[idx] = make_float2(cosf(ang), sinf(ang)); }

static void naive_phase(const Ptrs& P, int k, hipStream_t st) {
    bf16* H = P.w<bf16>(WS_H); bf16* QKV = P.w<bf16>(WS_QKV0); bf16* O = P.w<bf16>(WS_O); float* X = P.out;
    bf16* C1 = P.w<bf16>(WS_C1); bf16* QR = P.w<bf16>(WS_QR); bf16* KVR = P.w<bf16>(WS_KVR); bf16* KM = P.w<bf16>(WS_KM); bf16* O1 = P.w<bf16>(WS_O1);
    switch (k) {
    case 0: naive_weights(P, st); k_rope_tab<<<SEQ * 16 / 256, 256, 0, st>>>(P.w<float2>(WS_ROPE)); nv::k_rmsnorm<<<M_TOK / 4, 256, 0, st>>>(P.in[I_X], P.in[I_MIXN_E], H); break;
    case 1: { nv::GemmArgs a{}; a.A = H; a.lda = 1024; a.Bt = P.w<bf16>(WS_W_IN_E); a.K = 1024; a.M = M_TOK; a.N = QKV_LD; a.Cb = QKV; a.ldc = QKV_LD; naive_gemm<0>(a, st); } break;
    case 2: nv::k_kmean<<<NB * 8 * 16, 64, 0, st>>>(QKV, P.in[I_MKN], P.w<float>(WS_KMEAN));
            nv::k_qknorm<<<M_TOK * 32 / 256, 256, 0, st>>>(QKV, P.in[I_MQN], P.in[I_MKN], P.in[I_DQN], P.in[I_DKN]);
            break;
    case 100: nv::k_dsa_index<<<M_TOK, 256, 0, st>>>(QKV, P.w<unsigned long long>(WS_MASKT)); break;
    case 3: { nv::AttnArgs a{}; a.Q = QKV + C_MQ; a.ldq = QKV_LD; a.qhs = 64; a.K = QKV + C_MK; a.ldk = QKV_LD; a.khs = 64; a.V = QKV + C_MV; a.ldv = QKV_LD; a.vhs = 64; a.O = O; a.ocol0 = 0; a.H = 8;
              a.relb = P.in[I_RELB]; a.bcol0 = 0; a.kmean = P.w<float>(WS_KMEAN); a.maskt = nullptr; nv::k_attn<0, 64><<<NB * 8 * SEQ / 4, 256, 0, st>>>(a); }
            { nv::AttnArgs a{}; a.Q = QKV + C_DQ; a.ldq = QKV_LD; a.qhs = 64; a.K = QKV + C_DK; a.ldk = QKV_LD; a.khs = 64; a.V = QKV + C_DV; a.ldv = QKV_LD; a.vhs = 64; a.O = O; a.ocol0 = 512; a.H = 8;
              a.relb = P.in[I_RELB]; a.bcol0 = 8; a.kmean = nullptr; a.maskt = P.w<unsigned long long>(WS_MASKT); nv::k_attn<1, 64><<<NB * 8 * SEQ / 4, 256, 0, st>>>(a); } break;
    case 4: { nv::GemmArgs a{}; a.A = O; a.lda = 1024; a.Bt = P.w<bf16>(WS_W_OUT_E); a.K = 1024; a.M = M_TOK; a.N = 1024; a.Cf = X; a.R = P.in[I_X]; a.ldc = 1024; naive_gemm<1>(a, st); } break;
    case 5: nv::k_rmsnorm<<<M_TOK / 4, 256, 0, st>>>(X, P.in[I_FFNN_E], H); break;
    case 6: { nv::GemmArgs a{}; a.A = H; a.lda = 1024; a.Bt = P.w<bf16>(WS_W_GU_E); a.K = 1024; a.M = M_TOK; a.N = FF_E; a.Cb = P.w<bf16>(WS_ACT0); a.ldc = FF_E; naive_gemm<2>(a, st); } break;
    case 7: { nv::GemmArgs a{}; a.A = P.w<bf16>(WS_ACT0); a.lda = FF_E; a.Bt = P.w<bf16>(WS_W_DN_E); a.K = FF_E; a.M = M_TOK; a.N = 1024; a.Cf = X; a.R = X; a.ldc = 1024; naive_gemm<1>(a, st); } break;
    case 8: nv::k_rmsnorm<<<M_TOK / 4, 256, 0, st>>>(X, P.in[I_MIXN_O], H); break;
    case 9: { nv::GemmArgs a{}; a.A = H; a.lda = 1024; a.Bt = P.w<bf16>(WS_W_IN_O); a.K = 1024; a.M = M_TOK; a.N = C1_LD; a.Cb = C1; a.ldc = C1_LD; naive_gemm<0>(a, st); } break;
    case 10: nv::k_rmsnorm_bf<<<M_TOK / 4, 256, 0, st>>>(C1, C1_LD, C1_CQ, 384, P.in[I_QAN], P.w<bf16>(WS_CQN), 384);
             nv::k_rmsnorm_bf<<<M_TOK / 4, 256, 0, st>>>(C1, C1_LD, C1_CKV, 256, P.in[I_KVAN], P.w<bf16>(WS_CKVN), 256); break;
    case 11: { nv::GemmArgs a{}; a.A = P.w<bf16>(WS_CQN); a.lda = 384; a.Bt = P.w<bf16>(WS_W_UQ); a.K = 384; a.M = M_TOK; a.N = QR_LD; a.Cb = QR; a.ldc = QR_LD; naive_gemm<0>(a, st); }
             { nv::GemmArgs a{}; a.A = P.w<bf16>(WS_CKVN); a.lda = 256; a.Bt = P.w<bf16>(WS_W_UKV); a.K = 256; a.M = M_TOK; a.N = KVR_LD; a.Cb = KVR; a.ldc = KVR_LD; naive_gemm<0>(a, st); } break;
    case 12: nv::k_mla_prep<<<M_TOK * 16 / 256, 256, 0, st>>>(QR, KVR, C1, KM, P.in[I_MLAQN], P.in[I_MLAKN]); break;
    case 13: { nv::AttnArgs a{}; a.Q = QR; a.ldq = QR_LD; a.qhs = 96; a.K = KM; a.ldk = QR_LD; a.khs = 96; a.V = KVR + 64; a.ldv = KVR_LD; a.vhs = 128; a.O = O1; a.ocol0 = 0; a.H = 16;
               nv::k_attn<2, 96><<<NB * 16 * SEQ / 4, 256, 0, st>>>(a); } break;
    case 14: { nv::GemmArgs a{}; a.A = O1; a.lda = 1024; a.Bt = P.w<bf16>(WS_W_OUT_O); a.K = 1024; a.M = M_TOK; a.N = 1024; a.Cf = X; a.R = X; a.ldc = 1024; naive_gemm<1>(a, st); } break;
    case 15: nv::k_rmsnorm_route<<<M_TOK / 4, 256, 0, st>>>(X, P.in[I_FFNN_O], H, P.in[I_W_ROUTER], P.in[I_B_ROUTER], P.w<int2>(WS_ROUTE_E), P.w<float2>(WS_ROUTE_G));
             nv::k_route_count<<<256, 64, 0, st>>>(P.w<int2>(WS_ROUTE_E), P.w<int>(WS_CNT_WG)); break;
    case 16: nv::k_slots<<<256, 64, 0, st>>>(P.w<int2>(WS_ROUTE_E), P.w<float2>(WS_ROUTE_G), P.w<int>(WS_CNT_WG), P.w<int>(WS_SLOT_TOK), P.w<float>(WS_SLOT_GATE), P.w<int>(WS_TILE_E)); break;
    case 17: { nv::GemmArgs a{}; a.A = H; a.lda = 1024; a.Bt = P.w<bf16>(WS_WGU_O); a.K = 1024; a.M = SLOT_CAP; a.N = FF_O; a.Cb = P.w<bf16>(WS_ACT1); a.ldc = FF_O;
               a.tile_e = P.w<int>(WS_TILE_E); a.stok = P.w<int>(WS_SLOT_TOK); a.sgate = P.w<float>(WS_SLOT_GATE); a.b_estride = (size_t)2 * FF_O * 1024; naive_gemm<3>(a, st); } break;
    case 18: { nv::GemmArgs a{}; a.A = P.w<bf16>(WS_ACT1); a.lda = FF_O; a.Bt = P.w<bf16>(WS_WDN_O); a.K = FF_O; a.M = SLOT_CAP; a.N = 1024; a.Cf = X; a.ldc = 1024;
               a.tile_e = P.w<int>(WS_TILE_E); a.stok = P.w<int>(WS_SLOT_TOK); a.sgate = P.w<float>(WS_SLOT_GATE); a.b_estride = (size_t)1024 * FF_O; naive_gemm<4>(a, st); } break;
    }
}
#endif

extern "C" void kernel_launch(void* const* d_in, const int* in_sizes, int n_in, void* d_out, int out_size, void* d_ws, size_t ws_size, hipStream_t stream) {
    if (n_in != N_INPUTS || out_size != M_TOK * DM || ws_size < WS_END) { fprintf(stderr, "kernel_launch: unexpected shapes (n_in %d out %d ws %zu)\n", n_in, out_size, ws_size); return; }
    if (g_grid == 0) {
        int dev = 0, cus = 0, per_cu = 0;
        if (hipGetDevice(&dev) != hipSuccess || hipDeviceGetAttribute(&cus, hipDeviceAttributeMultiprocessorCount, dev) != hipSuccess) { g_grid = -1; return; }
        if (hipFuncSetAttribute((const void*)mega, hipFuncAttributeMaxDynamicSharedMemorySize, LDS_BYTES) != hipSuccess) { fprintf(stderr, "kernel_launch: cannot get %d B of dynamic LDS\n", LDS_BYTES); g_grid = -1; return; }
        if (hipOccupancyMaxActiveBlocksPerMultiprocessor(&per_cu, (const void*)mega, NTHR, LDS_BYTES) != hipSuccess || per_cu < 1) { fprintf(stderr, "kernel_launch: occupancy query says %d\n", per_cu); }
        (void)hipGetLastError();
        g_grid = cus;
    }
    if (g_grid < 0) return;
    Ptrs P{}; for (int i = 0; i < N_INPUTS; ++i) P.in[i] = (const float*)d_in[i]; P.out = (float*)d_out; P.ws = (unsigned char*)d_ws;
    (void)hipMemsetAsync((char*)d_ws + WS_CTL, 0, 65536, stream);
#if ONE_LAUNCH
    launch_mega(P, 0, NPHASE, stream);
#else
    for (int k = 0; k < NPHASE; ++k) { if ((FAST_MASK >> k) & 1u) { launch_mega(P, k, k + 1, stream);
#ifdef DUP_MASK
            for (int rep = 0; rep < DUP_REPS; ++rep) if ((DUP_MASK >> k) & 1u) launch_mega(P, k, k + 1, stream, 2);
#endif
        } else naive_phase(P, k, stream);
        if (k == 2 && !(HAVE_INDEX && ((FAST_MASK >> 2) & 1u))) naive_phase(P, 100, stream); }
#endif
}
```

```cpp
#define ONE_LAUNCH 1
#define HAVE_ATTN 1
#define HAVE_INDEX 1
#include <hip/hip_runtime.h>
#include <stdint.h>
#include <stdio.h>

typedef unsigned short bf16;
__device__ __forceinline__ float bf2f(bf16 v) { return __uint_as_float(((unsigned)v) << 16); }
__device__ __forceinline__ bf16 f2bf(float f) { unsigned u = __float_as_uint(f); return (bf16)((u + 0x7fffu + ((u >> 16) & 1u)) >> 16); }
typedef float f32x2_t __attribute__((ext_vector_type(2))); typedef __bf16 bf16x2_t __attribute__((ext_vector_type(2)));
__device__ __forceinline__ unsigned pk2(float lo, float hi) { f32x2_t v = {lo, hi}; bf16x2_t b = __builtin_convertvector(v, bf16x2_t); return __builtin_bit_cast(unsigned, b); }

constexpr int NB = 4, SEQ = 4096, M_TOK = NB * SEQ, DM = 1024;
constexpr int QKV_LD = 3584;
constexpr int C_MQ = 0, C_MK = 512, C_MV = 1024, C_DQ = 1536, C_DK = 2048, C_DV = 2560, C_IQ = 3072, C_IK = 3328, C_IW = 3392, N_IN_E = 3396;
constexpr int FF_E = 2816, FF_O = 3584, NEXP = 8;
constexpr int C1_LD = 768, N_IN_O = 672, C1_CQ = 0, C1_CKV = 384, C1_KPE = 640;
constexpr int QR_LD = 1536, KVR_LD = 2048;
constexpr int SLOT_CAP = 34816, TILE_CAP = 136;
constexpr float EPS = 1e-6f;
constexpr float LOG2E = 1.4426950408889634f;
constexpr float QSCALE64 = 0.125f * LOG2E;
constexpr float QSCALE96 = 0.10206207261596575f * LOG2E;

constexpr size_t MiB = 1u << 20;
constexpr size_t WS_CTL = 0;
constexpr size_t WS_KMEAN = 1 * MiB;
constexpr size_t WS_ROUTE_E = 1 * MiB + 128 * 1024;
constexpr size_t WS_ROUTE_G = 1 * MiB + 256 * 1024;
constexpr size_t WS_CNT_WG = 1 * MiB + 384 * 1024;
constexpr size_t WS_SLOT_TOK = 1 * MiB + 400 * 1024;
constexpr size_t WS_SLOT_GATE = 1 * MiB + 544 * 1024;
constexpr size_t WS_TILE_E = 1 * MiB + 688 * 1024;
constexpr size_t WS_TOK_SLOT = 1 * MiB + 704 * 1024;
constexpr size_t WS_REFS = 1 * MiB + 832 * 1024;
constexpr size_t WS_WDN_O = 2 * MiB;
constexpr size_t WS_WGU_O = 58 * MiB;
constexpr size_t WS_Y = 58 * MiB;
constexpr size_t WS_YP = 128 * MiB;
constexpr int MOE_FULL_TILES = 128, MOE_TAIL_SPLIT = 7, MOE_TAIL_ROWS = SLOT_CAP - MOE_FULL_TILES * 256;
constexpr size_t WS_H = 170 * MiB;
constexpr size_t WS_SCR = 202 * MiB;
constexpr size_t WS_QKV0 = WS_SCR;
constexpr size_t WS_O = 314 * MiB;
constexpr size_t WS_ACT0 = WS_SCR;
constexpr size_t WS_C1 = WS_SCR;
constexpr size_t WS_LSP = 226 * MiB;
constexpr size_t WS_CQN = 228 * MiB;
constexpr size_t WS_CKVN = 238 * MiB;
constexpr size_t WS_QR = 246 * MiB;
constexpr size_t WS_KVR = 294 * MiB;
constexpr size_t WS_KM = 358 * MiB;
constexpr size_t WS_IKT = WS_KM;
constexpr size_t WS_O1 = WS_SCR;
constexpr size_t WS_MASKT = 412 * MiB;
constexpr size_t WS_W_IN_E = 420 * MiB;
constexpr size_t WS_W_OUT_E = 427 * MiB;
constexpr size_t WS_W_GU_E = 429 * MiB;
constexpr size_t WS_W_DN_E = 440 * MiB;
constexpr size_t WS_W_IN_O = 446 * MiB;
constexpr size_t WS_W_LAT = 448 * MiB;
constexpr int W_LAT_LD = 640;
constexpr size_t WS_W_UQ = WS_W_LAT, WS_W_UKV = WS_W_LAT;
constexpr size_t WS_W_OUT_O = 452 * MiB + 512 * 1024;
constexpr size_t WS_ACT1 = WS_SCR;
constexpr size_t WS_ROPE = 455 * MiB;
constexpr size_t WS_SSP = 456 * MiB;
constexpr size_t WS_SLOT_RSTD = 457 * MiB;
constexpr size_t WS_RSTD = 457 * MiB + 256 * 1024;
constexpr size_t WS_END = 458 * MiB;
static_assert(WS_W_LAT + (size_t)3584 * 640 * 2 <= WS_W_OUT_O && WS_W_OUT_O + (size_t)1024 * 1024 * 2 <= WS_ROPE, "tail of the ws map");
static_assert(WS_ACT1 + (size_t)SLOT_CAP * FF_O * 2 <= WS_W_IN_O, "ACT1 must not reach the odd-layer weights");
static_assert(WS_Y + (size_t)SLOT_CAP * 1024 * 2 <= WS_YP && WS_YP + (size_t)MOE_TAIL_SPLIT * MOE_TAIL_ROWS * 1024 * 2 <= WS_SCR && WS_TOK_SLOT + (size_t)M_TOK * 8 <= 2 * MiB, "Y / TOK_SLOT map");
static_assert(WS_W_DN_E + (size_t)1024 * 2816 * 2 <= WS_W_IN_O && WS_KM + (size_t)M_TOK * 1536 * 2 <= WS_MASKT, "ws map");

enum { I_X = 0, I_RELB, I_MIXN_E, I_W_IN_E, I_MQN, I_MKN, I_DQN, I_DKN, I_W_OUT_E, I_FFNN_E, I_W_GATE_E, I_W_UP_E, I_W_DOWN_E,
       I_MIXN_O, I_W_IN_O, I_QAN, I_KVAN, I_W_UQ, I_W_UKV, I_MLAQN, I_MLAKN, I_W_OUT_O, I_FFNN_O, I_W_ROUTER, I_B_ROUTER,
       I_W_GATE_O, I_W_UP_O, I_W_DOWN_O, N_INPUTS };

__device__ __forceinline__ float wave_sum(float v) {
#pragma unroll
    for (int o = 1; o < 64; o <<= 1) v += __shfl_xor(v, o);
    return v;
}
__device__ __forceinline__ float wave_max(float v) {
#pragma unroll
    for (int o = 1; o < 64; o <<= 1) v = fmaxf(v, __shfl_xor(v, o));
    return v;
}
__device__ __forceinline__ int rel_bucket(int n) {
    if (n < 16) return n;
    int b = 16;
    b += (n >= 21); b += (n >= 27); b += (n >= 35); b += (n >= 46); b += (n >= 59); b += (n >= 77); b += (n >= 99); b += (n >= 128);
    b += (n >= 166); b += (n >= 216); b += (n >= 280); b += (n >= 363); b += (n >= 470); b += (n >= 609); b += (n >= 790);
    return b;
}
__device__ __forceinline__ unsigned fkey(float f) { unsigned u = __float_as_uint(f); return (u & 0x80000000u) ? ~u : (u | 0x80000000u); }
__device__ __forceinline__ float bflo(unsigned u) { return __uint_as_float(u << 16); }
__device__ __forceinline__ float bfhi(unsigned u) { return __uint_as_float(u & 0xffff0000u); }
__device__ __forceinline__ float silu_f(float x) { return x / (1.f + __expf(-x)); }

namespace pg8 {
#define PG8_LAS __attribute__((address_space(3)))
typedef unsigned short bf16_t;
typedef short bf16x8 __attribute__((ext_vector_type(8)));
typedef float f32x4 __attribute__((ext_vector_type(4)));
typedef unsigned u32x4 __attribute__((ext_vector_type(4)));
constexpr int BM = 256, BK = 64, HALF = 128, HTB = HALF * BK * 2, STAGE_BYTES = 8 * HTB, NXCD = 8, WGM = 8;

__host__ __device__ __forceinline__ int lds_byte(int r, int c) { const int st = (r >> 4) * 2 + (c >> 5), rr = r & 15, cc = c & 31, ob = rr * 64 + cc * 2; return st * 1024 + (ob ^ (((ob >> 9) & 1) << 5)); }
__host__ __device__ __forceinline__ void stage_rc(int b, int& R, int& C) { const int st = b / 1024, sb = b % 1024, swz = sb ^ (((sb >> 9) & 1) << 5); R = (st >> 1) * 16 + swz / 64; C = (st & 1) * 32 + (swz % 64) / 2; }
__host__ __device__ __forceinline__ int perm32(int rho) { const int n = rho >> 4, i = rho & 15; return 8 * (i >> 2) + 4 * n + (i & 3); }

struct Unit { int pm, pn, koff, nt; };
struct Gemm { const bf16_t* A; const bf16_t* Bt; int lda, ldb, K; };

__device__ __forceinline__ bool static_unit(int nM, int nN, int G, int c, int i, int& pm, int& pn) {
    const int nwg = nM * nN; const long L = (long)i * G + c; if (L >= nwg) return false;
    int wgid = (int)L; { const int q = nwg / NXCD, r = nwg % NXCD, xcd = wgid % NXCD, off = wgid / NXCD; wgid = (xcd < r ? xcd * (q + 1) : r * (q + 1) + (xcd - r) * q) + off; }
    const int nig = WGM * nN, gid = wgid / nig, fm = gid * WGM, gsz = (nM - fm) < WGM ? (nM - fm) : WGM;
    pm = fm + ((wgid % nig) % gsz); pn = (wgid % nig) / gsz; return true;
}
struct StaticOrder {
    static constexpr bool USE_LIST = false;
    int nM, nN, G, c;
    __device__ __forceinline__ bool next(int i, Unit& u) const { u.koff = 0; u.nt = 0; return static_unit(nM, nN, G, c, i, u.pm, u.pn); }
};
struct MoeOrder {
    static constexpr bool USE_LIST = true;
    const int* tile_e; int nM, nN, G, c, ksplit, Kpart, pm0;
    __device__ __forceinline__ bool next(int i, Unit& u) const {
        const int nwg = nM * nN; const long L = (long)i * G + c; if (L >= (long)nwg * ksplit) return false;
        const int ks = (int)(L / nwg), w = (int)(L % nwg); int pm, j;
        static_unit(nM, nN, nwg, w, 0, pm, j);
        u.pm = pm0 + pm; u.pn = tile_e[pm0 + pm] * nN + j; u.koff = ks * Kpart; u.nt = 0; return true;
    }
};

struct LatJointOrder {
    static constexpr bool USE_LIST = true;
    int G, c;
    __device__ __forceinline__ void uq(int idx, Unit& u) const { int pm, pn; static_unit(64, 6, 384, idx, 0, pm, pn); u.pm = pm; u.pn = pn; u.koff = 0; u.nt = 6; }
    __device__ __forceinline__ void ukv(int idx, Unit& u) const { int pm, pn; static_unit(64, 8, 512, idx, 0, pm, pn); u.pm = pm; u.pn = 6 + pn; u.koff = 384; u.nt = 4; }
    __device__ __forceinline__ bool next(int i, Unit& u) const {
        if (G == 256) {
            if (c < 128) { if (i == 0) { uq(c, u); return true; } if (i == 1) { uq(128 + c, u); return true; } if (i == 2) { ukv(c, u); return true; } return false; }
            const int d = c - 128; if (i == 0) { uq(256 + d, u); return true; } if (i >= 1 && i <= 3) { ukv(128 + 3 * d + (i - 1), u); return true; } return false; }
        const int L = i * G + c; if (L >= 896) return false; if (L < 384) uq(L, u); else ukv(L - 384, u); return true;
    }
};

__device__ __forceinline__ unsigned cvt_pk_bf16(float lo, float hi) { unsigned r; asm volatile("v_cvt_pk_bf16_f32 %0, %1, %2" : "=v"(r) : "v"(lo), "v"(hi)); return r; }
__device__ __forceinline__ float fast_silu(float x) { return x * __builtin_amdgcn_rcpf(1.f + __builtin_amdgcn_exp2f(-1.4426950408889634f * x)); }

struct EpiBf16 {
    static constexpr bool PERM = true;
    bf16_t* O; int ldc;
    bf16_t* X2; int x2_pn;
    static constexpr bool HAS_SCALE = false;
    __device__ __forceinline__ void preload(PG8_LAS unsigned char*, int, int) const {}
    __device__ __forceinline__ void operator()(const f32x4 (&acc)[2][2][4][2], const Unit& u, int wr, int wc, int fr, int fq, const PG8_LAS unsigned char* sp, int ui) const {
        const int row0 = u.pm * BM + wr * 64 + fr, col0 = u.pn * BM + wc * 32 + 8 * fq;
        const bool x2 = (X2 != nullptr) && (u.pn == x2_pn) && (wc < 2);
#pragma unroll
        for (int ai = 0; ai < 2; ++ai)
#pragma unroll
            for (int m = 0; m < 4; ++m) { bf16_t* rowp = O + (size_t)(row0 + ai * HALF + m * 16) * ldc + col0;
#pragma unroll
                for (int bj = 0; bj < 2; ++bj) { const f32x4 v0 = acc[ai][bj][m][0], v1 = acc[ai][bj][m][1];
                    u32x4 w; w.x = cvt_pk_bf16(v0[0], v0[1]); w.y = cvt_pk_bf16(v0[2], v0[3]); w.z = cvt_pk_bf16(v1[0], v1[1]); w.w = cvt_pk_bf16(v1[2], v1[3]);
                    *(u32x4*)(rowp + bj * HALF) = w;
                    if (bj == 0 && x2) { const int row = row0 + ai * HALF + m * 16; *(u32x4*)(X2 + ((size_t)(row >> 5) * 8 + (wc * 4 + fq)) * 256 + (row & 31) * 8) = w; } } }
    }
};
struct EpiResF32 {
    static constexpr bool PERM = false;
    const float* R; float* O; int ldc;
    static constexpr bool HAS_SCALE = false;
    __device__ __forceinline__ void preload(PG8_LAS unsigned char*, int, int) const {}
    __device__ __forceinline__ void operator()(const f32x4 (&acc)[2][2][4][2], const Unit& u, int wr, int wc, int fr, int fq, const PG8_LAS unsigned char* sp, int ui) const {
        const int row0 = u.pm * BM + wr * 64 + fr, col0 = u.pn * BM + wc * 32 + 4 * fq;
#pragma unroll
        for (int ai = 0; ai < 2; ++ai)
#pragma unroll
            for (int m = 0; m < 4; ++m) { const size_t off = (size_t)(row0 + ai * HALF + m * 16) * ldc + col0;
#pragma unroll
                for (int bj = 0; bj < 2; ++bj)
#pragma unroll
                    for (int n = 0; n < 2; ++n) { const f32x4 r = *(const f32x4*)(R + off + bj * HALF + n * 16); *(f32x4*)(O + off + bj * HALF + n * 16) = r + acc[ai][bj][m][n]; } }
    }
};
struct EpiSwiGLU {
    static constexpr bool PERM = true;
    bf16_t* O; int ldc; int nmod;
    static constexpr bool HAS_SCALE = false;
    __device__ __forceinline__ void preload(PG8_LAS unsigned char*, int, int) const {}
    __device__ __forceinline__ void operator()(const f32x4 (&acc)[2][2][4][2], const Unit& u, int wr, int wc, int fr, int fq, const PG8_LAS unsigned char* sp, int ui) const {
        const int row0 = u.pm * BM + wr * 64 + fr, col0 = (u.pn % nmod) * HALF + wc * 32 + 8 * fq;
#pragma unroll
        for (int ai = 0; ai < 2; ++ai)
#pragma unroll
            for (int m = 0; m < 4; ++m) { const f32x4 g0 = acc[ai][0][m][0], g1 = acc[ai][0][m][1], u0 = acc[ai][1][m][0], u1 = acc[ai][1][m][1];
                u32x4 w; w.x = cvt_pk_bf16(fast_silu(g0[0]) * u0[0], fast_silu(g0[1]) * u0[1]); w.y = cvt_pk_bf16(fast_silu(g0[2]) * u0[2], fast_silu(g0[3]) * u0[3]);
                w.z = cvt_pk_bf16(fast_silu(g1[0]) * u1[0], fast_silu(g1[1]) * u1[1]); w.w = cvt_pk_bf16(fast_silu(g1[2]) * u1[2], fast_silu(g1[3]) * u1[3]);
                *(u32x4*)(O + (size_t)(row0 + ai * HALF + m * 16) * ldc + col0) = w; }
    }
};
struct EpiMoeY {
    static constexpr bool PERM = true;
    bf16_t* Y; size_t kstride; int nmod, kpart, row_off;
    static constexpr bool HAS_SCALE = false;
    __device__ __forceinline__ void preload(PG8_LAS unsigned char*, int, int) const {}
    __device__ __forceinline__ void operator()(const f32x4 (&acc)[2][2][4][2], const Unit& u, int wr, int wc, int fr, int fq, const PG8_LAS unsigned char* sp, int ui) const {
        const int row0 = u.pm * BM - row_off + wr * 64 + fr, col0 = (u.pn % nmod) * BM + wc * 32 + 8 * fq; bf16_t* base = Y + (size_t)(u.koff / kpart) * kstride;
#pragma unroll
        for (int ai = 0; ai < 2; ++ai)
#pragma unroll
            for (int m = 0; m < 4; ++m) { bf16_t* rowp = base + (size_t)(row0 + ai * HALF + m * 16) * 1024 + col0;
#pragma unroll
                for (int bj = 0; bj < 2; ++bj) { const f32x4 v0 = acc[ai][bj][m][0], v1 = acc[ai][bj][m][1];
                    u32x4 w; w.x = cvt_pk_bf16(v0[0], v0[1]); w.y = cvt_pk_bf16(v0[2], v0[3]); w.z = cvt_pk_bf16(v1[0], v1[1]); w.w = cvt_pk_bf16(v1[2], v1[3]);
                    *(u32x4*)(rowp + bj * HALF) = w; } }
    }
};


template <bool RBF> struct EpiResN {
    static constexpr bool PERM = true;
    const float* Rf; bf16_t* XB; float* SSP; int ldc;
    static constexpr bool HAS_SCALE = false;
    __device__ __forceinline__ void preload(PG8_LAS unsigned char*, int, int) const {}
    __device__ __forceinline__ void operator()(const f32x4 (&acc)[2][2][4][2], const Unit& u, int wr, int wc, int fr, int fq, const PG8_LAS unsigned char*, int) const {
        const int row0 = u.pm * BM + wr * 64 + fr, col0 = u.pn * BM + wc * 32 + 8 * fq;
#pragma unroll
        for (int ai = 0; ai < 2; ++ai)
#pragma unroll
            for (int m = 0; m < 4; ++m) { const int row = row0 + ai * HALF + m * 16; const size_t off = (size_t)row * ldc + col0; float ss = 0.f;
#pragma unroll
                for (int bj = 0; bj < 2; ++bj) { f32x4 r0, r1;
                    if (RBF) { const u32x4 rb = *(const u32x4*)(XB + off + bj * HALF);
                        r0 = (f32x4){__uint_as_float(rb.x << 16), __uint_as_float(rb.x & 0xffff0000u), __uint_as_float(rb.y << 16), __uint_as_float(rb.y & 0xffff0000u)};
                        r1 = (f32x4){__uint_as_float(rb.z << 16), __uint_as_float(rb.z & 0xffff0000u), __uint_as_float(rb.w << 16), __uint_as_float(rb.w & 0xffff0000u)}; }
                    else { r0 = *(const f32x4*)(Rf + off + bj * HALF); r1 = *(const f32x4*)(Rf + off + bj * HALF + 4); }
                    const f32x4 v0 = r0 + acc[ai][bj][m][0], v1 = r1 + acc[ai][bj][m][1];
                    ss += ((v0[0] * v0[0] + v0[1] * v0[1]) + (v0[2] * v0[2] + v0[3] * v0[3])) + ((v1[0] * v1[0] + v1[1] * v1[1]) + (v1[2] * v1[2] + v1[3] * v1[3]));
                    u32x4 w; w.x = cvt_pk_bf16(v0[0], v0[1]); w.y = cvt_pk_bf16(v0[2], v0[3]); w.z = cvt_pk_bf16(v1[0], v1[1]); w.w = cvt_pk_bf16(v1[2], v1[3]);
                    *(u32x4*)(XB + off + bj * HALF) = w; }
                ss += __shfl_xor(ss, 16); ss += __shfl_xor(ss, 32);
                if (fq == 0) SSP[(size_t)row * 16 + (u.pn & 3) * 4 + wc] = ss; }
    }
};
constexpr int MAX_UNITS_WG = 15;
constexpr int SP_SCALE = 0, SP_GIDX = MAX_UNITS_WG * 1024, SP_ULIST = 30720 + 256;
struct ScaleSSP {
    const float* SSP; float eps;
    __device__ __forceinline__ float row(const Unit& u, int r) const { const f32x4* p = (const f32x4*)(SSP + (size_t)(u.pm * BM + r) * 16); const f32x4 a = p[0], b = p[1], c = p[2], d = p[3];
        const float s = ((a[0] + a[1]) + (a[2] + a[3])) + ((b[0] + b[1]) + (b[2] + b[3])) + ((c[0] + c[1]) + (c[2] + c[3])) + ((d[0] + d[1]) + (d[2] + d[3]));
        return __builtin_amdgcn_rsqf(s * (1.f / 1024.f) + eps); }
};
struct ScaleSlot {
    const float* srstd;
    __device__ __forceinline__ float row(const Unit& u, int r) const { return srstd[u.pm * BM + r]; }
};
template <class Sched> __device__ __forceinline__ int build_unit_list(PG8_LAS unsigned char* sp, const Sched& sched, int tid) {
    PG8_LAS int* ul = (PG8_LAS int*)(sp + SP_ULIST);
    if (tid < MAX_UNITS_WG + 1) { Unit u; u.pm = -1; u.pn = 0; u.koff = 0; u.nt = 0; const bool ok = (tid < MAX_UNITS_WG) && sched.next(tid, u); ul[4 * tid] = ok ? u.pm : -1; ul[4 * tid + 1] = u.pn; ul[4 * tid + 2] = u.koff; ul[4 * tid + 3] = u.nt; }
    __syncthreads();
    int n = 0; while (n < MAX_UNITS_WG && ul[4 * n] >= 0) ++n;
    return n;
}
template <class Scale> __device__ __forceinline__ void preload_scales(const Scale& S, PG8_LAS unsigned char* sp, int n, int tid) {
    PG8_LAS float* tab = (PG8_LAS float*)(sp + SP_SCALE); const PG8_LAS int* ul = (const PG8_LAS int*)(sp + SP_ULIST);
    const int rows = n * 256;
    for (int j0 = tid; j0 < rows; j0 += 4 * 512) {
        float v[4];
#pragma unroll
        for (int k = 0; k < 4; ++k) { const int j = j0 + k * 512; if (j < rows) { Unit u; u.pm = ul[4 * (j >> 8)]; u.pn = ul[4 * (j >> 8) + 1]; u.koff = 0; u.nt = 0; v[k] = S.row(u, j & 255); } else v[k] = 0.f; }
#pragma unroll
        for (int k = 0; k < 4; ++k) { const int j = j0 + k * 512; if (j < rows) tab[j] = v[k]; }
    }
}
template <class Scale> struct EpiBf16S {
    static constexpr bool PERM = true;
    bf16_t* O; int ldc; Scale S;
    static constexpr bool HAS_SCALE = true;
    __device__ __forceinline__ void preload(PG8_LAS unsigned char* sp, int n, int tid) const { preload_scales(S, sp, n, tid); }
    __device__ __forceinline__ void operator()(const f32x4 (&acc)[2][2][4][2], const Unit& u, int wr, int wc, int fr, int fq, const PG8_LAS unsigned char* sp, int ui) const {
        const int rl = wr * 64 + fr, row0 = u.pm * BM + rl, col0 = u.pn * BM + wc * 32 + 8 * fq;
        float scv[8]; { const unsigned ta = (unsigned)(size_t)sp + (unsigned)SP_SCALE + (unsigned)(ui * 256 + rl) * 4u;
            asm volatile("ds_read_b32 %0, %8\n\tds_read_b32 %1, %8 offset:64\n\tds_read_b32 %2, %8 offset:128\n\tds_read_b32 %3, %8 offset:192\n\tds_read_b32 %4, %8 offset:512\n\tds_read_b32 %5, %8 offset:576\n\tds_read_b32 %6, %8 offset:640\n\tds_read_b32 %7, %8 offset:704\n\ts_waitcnt lgkmcnt(0)"
                : "=&v"(scv[0]), "=&v"(scv[1]), "=&v"(scv[2]), "=&v"(scv[3]), "=&v"(scv[4]), "=&v"(scv[5]), "=&v"(scv[6]), "=&v"(scv[7]) : "v"(ta) : "memory"); }
#pragma unroll
        for (int ai = 0; ai < 2; ++ai)
#pragma unroll
            for (int m = 0; m < 4; ++m) { bf16_t* rowp = O + (size_t)(row0 + ai * HALF + m * 16) * ldc + col0; const float sc = scv[ai * 4 + m];
#pragma unroll
                for (int bj = 0; bj < 2; ++bj) { const f32x4 v0 = acc[ai][bj][m][0] * sc, v1 = acc[ai][bj][m][1] * sc;
                    u32x4 w; w.x = cvt_pk_bf16(v0[0], v0[1]); w.y = cvt_pk_bf16(v0[2], v0[3]); w.z = cvt_pk_bf16(v1[0], v1[1]); w.w = cvt_pk_bf16(v1[2], v1[3]);
                    *(u32x4*)(rowp + bj * HALF) = w; } }
    }
};
template <class Scale> struct EpiBf16SL {
    static constexpr bool PERM = true;
    bf16_t* O; int ldc; float* LSP; Scale S;
    static constexpr bool HAS_SCALE = true;
    __device__ __forceinline__ void preload(PG8_LAS unsigned char* sp, int n, int tid) const { preload_scales(S, sp, n, tid); }
    __device__ __forceinline__ void operator()(const f32x4 (&acc)[2][2][4][2], const Unit& u, int wr, int wc, int fr, int fq, const PG8_LAS unsigned char* sp, int ui) const {
        const int rl = wr * 64 + fr, row0 = u.pm * BM + rl, col0 = u.pn * BM + wc * 32 + 8 * fq;
        float scv[8]; { const unsigned ta = (unsigned)(size_t)sp + (unsigned)SP_SCALE + (unsigned)(ui * 256 + rl) * 4u;
            asm volatile("ds_read_b32 %0, %8\n\tds_read_b32 %1, %8 offset:64\n\tds_read_b32 %2, %8 offset:128\n\tds_read_b32 %3, %8 offset:192\n\tds_read_b32 %4, %8 offset:512\n\tds_read_b32 %5, %8 offset:576\n\tds_read_b32 %6, %8 offset:640\n\tds_read_b32 %7, %8 offset:704\n\ts_waitcnt lgkmcnt(0)"
                : "=&v"(scv[0]), "=&v"(scv[1]), "=&v"(scv[2]), "=&v"(scv[3]), "=&v"(scv[4]), "=&v"(scv[5]), "=&v"(scv[6]), "=&v"(scv[7]) : "v"(ta) : "memory"); }
#pragma unroll
        for (int ai = 0; ai < 2; ++ai)
#pragma unroll
            for (int m = 0; m < 4; ++m) { const int row = row0 + ai * HALF + m * 16; bf16_t* rowp = O + (size_t)row * ldc + col0; const float sc = scv[ai * 4 + m];
#pragma unroll
                for (int bj = 0; bj < 2; ++bj) { const f32x4 v0 = acc[ai][bj][m][0] * sc, v1 = acc[ai][bj][m][1] * sc;
                    u32x4 w; w.x = cvt_pk_bf16(v0[0], v0[1]); w.y = cvt_pk_bf16(v0[2], v0[3]); w.z = cvt_pk_bf16(v1[0], v1[1]); w.w = cvt_pk_bf16(v1[2], v1[3]);
                    *(u32x4*)(rowp + bj * HALF) = w;
                    float ss = ((v0[0] * v0[0] + v0[1] * v0[1]) + (v0[2] * v0[2] + v0[3] * v0[3])) + ((v1[0] * v1[0] + v1[1] * v1[1]) + (v1[2] * v1[2] + v1[3] * v1[3]));
                    ss += __shfl_xor(ss, 16); ss += __shfl_xor(ss, 32);
                    if (fq == 0) LSP[(size_t)row * 24 + u.pn * 8 + bj * 4 + wc] = ss; } }
    }
};
struct ScaleLat {
    const float* LSP; float eps;
    __device__ __forceinline__ float row(const Unit& u, int r) const { const bool isq = u.pn < 6; const float* p = LSP + (size_t)(u.pm * BM + r) * 24 + (isq ? 0 : 12);
        float s = ((p[0] + p[1]) + (p[2] + p[3])) + ((p[4] + p[5]) + (p[6] + p[7])); if (isq) s += (p[8] + p[9]) + (p[10] + p[11]);
        return __builtin_amdgcn_rsqf(s * (isq ? 1.f / 384 : 1.f / 256) + eps); }
};
struct EpiLatJoint {
    static constexpr bool PERM = true;
    bf16_t* QR; bf16_t* KVR; ScaleLat S;
    static constexpr bool HAS_SCALE = true;
    __device__ __forceinline__ void preload(PG8_LAS unsigned char* sp, int n, int tid) const { preload_scales(S, sp, n, tid); }
    __device__ __forceinline__ void operator()(const f32x4 (&acc)[2][2][4][2], const Unit& u, int wr, int wc, int fr, int fq, const PG8_LAS unsigned char* sp, int ui) const {
        const bool isq = u.pn < 6; bf16_t* O = isq ? QR : KVR; const int ldc = isq ? 1536 : 2048;
        const int rl = wr * 64 + fr, row0 = u.pm * BM + rl, col0 = (isq ? u.pn : u.pn - 6) * BM + wc * 32 + 8 * fq;
        float scv[8]; { const unsigned ta = (unsigned)(size_t)sp + (unsigned)SP_SCALE + (unsigned)(ui * 256 + rl) * 4u;
            asm volatile("ds_read_b32 %0, %8\n\tds_read_b32 %1, %8 offset:64\n\tds_read_b32 %2, %8 offset:128\n\tds_read_b32 %3, %8 offset:192\n\tds_read_b32 %4, %8 offset:512\n\tds_read_b32 %5, %8 offset:576\n\tds_read_b32 %6, %8 offset:640\n\tds_read_b32 %7, %8 offset:704\n\ts_waitcnt lgkmcnt(0)"
                : "=&v"(scv[0]), "=&v"(scv[1]), "=&v"(scv[2]), "=&v"(scv[3]), "=&v"(scv[4]), "=&v"(scv[5]), "=&v"(scv[6]), "=&v"(scv[7]) : "v"(ta) : "memory"); }
#pragma unroll
        for (int ai = 0; ai < 2; ++ai)
#pragma unroll
            for (int m = 0; m < 4; ++m) { bf16_t* rowp = O + (size_t)(row0 + ai * HALF + m * 16) * ldc + col0; const float sc = scv[ai * 4 + m];
#pragma unroll
                for (int bj = 0; bj < 2; ++bj) { const f32x4 v0 = acc[ai][bj][m][0] * sc, v1 = acc[ai][bj][m][1] * sc;
                    u32x4 w; w.x = cvt_pk_bf16(v0[0], v0[1]); w.y = cvt_pk_bf16(v0[2], v0[3]); w.z = cvt_pk_bf16(v1[0], v1[1]); w.w = cvt_pk_bf16(v1[2], v1[3]);
                    *(u32x4*)(rowp + bj * HALF) = w; } }
    }
};
template <class Scale> struct EpiSwiGLUS {
    static constexpr bool PERM = true;
    bf16_t* O; int ldc; int nmod; Scale S;
    static constexpr bool HAS_SCALE = true;
    __device__ __forceinline__ void preload(PG8_LAS unsigned char* sp, int n, int tid) const { preload_scales(S, sp, n, tid); }
    __device__ __forceinline__ void operator()(const f32x4 (&acc)[2][2][4][2], const Unit& u, int wr, int wc, int fr, int fq, const PG8_LAS unsigned char* sp, int ui) const {
        const int rl = wr * 64 + fr, row0 = u.pm * BM + rl, col0 = (u.pn % nmod) * HALF + wc * 32 + 8 * fq;
        float scv[8]; { const unsigned ta = (unsigned)(size_t)sp + (unsigned)SP_SCALE + (unsigned)(ui * 256 + rl) * 4u;
            asm volatile("ds_read_b32 %0, %8\n\tds_read_b32 %1, %8 offset:64\n\tds_read_b32 %2, %8 offset:128\n\tds_read_b32 %3, %8 offset:192\n\tds_read_b32 %4, %8 offset:512\n\tds_read_b32 %5, %8 offset:576\n\tds_read_b32 %6, %8 offset:640\n\tds_read_b32 %7, %8 offset:704\n\ts_waitcnt lgkmcnt(0)"
                : "=&v"(scv[0]), "=&v"(scv[1]), "=&v"(scv[2]), "=&v"(scv[3]), "=&v"(scv[4]), "=&v"(scv[5]), "=&v"(scv[6]), "=&v"(scv[7]) : "v"(ta) : "memory"); }
#pragma unroll
        for (int ai = 0; ai < 2; ++ai)
#pragma unroll
            for (int m = 0; m < 4; ++m) { const float sc = scv[ai * 4 + m];
                const f32x4 g0 = acc[ai][0][m][0] * sc, g1 = acc[ai][0][m][1] * sc, u0 = acc[ai][1][m][0] * sc, u1 = acc[ai][1][m][1] * sc;
                u32x4 w; w.x = cvt_pk_bf16(fast_silu(g0[0]) * u0[0], fast_silu(g0[1]) * u0[1]); w.y = cvt_pk_bf16(fast_silu(g0[2]) * u0[2], fast_silu(g0[3]) * u0[3]);
                w.z = cvt_pk_bf16(fast_silu(g1[0]) * u1[0], fast_silu(g1[1]) * u1[1]); w.w = cvt_pk_bf16(fast_silu(g1[2]) * u1[2], fast_silu(g1[3]) * u1[3]);
                *(u32x4*)(O + (size_t)(row0 + ai * HALF + m * 16) * ldc + col0) = w; }
    }
};

template <class Epi, class Sched, bool ALIGN_EPI, bool GATHER>
__device__ __forceinline__ void gemm_phase(PG8_LAS unsigned char* lds, const Gemm g, const Sched& S, const Epi& E, const int* gidx) {
    const int tid = threadIdx.x, wid = __builtin_amdgcn_readfirstlane(tid >> 6), lane = tid & 63, wr = wid >> 2, wc = wid & 3, fr = lane & 15, fq = lane >> 4;
    const int K = g.K, nt = K / BK, lda = g.lda, ldb = g.ldb;
    unsigned vAc[2][2], vAn[2][2], voffB[2]; int Rl[2], Cl[2];
#pragma unroll
    for (int i = 0; i < 2; ++i) { int R, C; stage_rc(tid * 16 + i * 8192, R, C); const int Rb = Epi::PERM ? ((R & ~31) + perm32(R & 31)) : R; Rl[i] = R; Cl[i] = C;
        voffB[i] = (unsigned)(Rb * ldb + C) * 2u;
#pragma unroll
        for (int h = 0; h < 2; ++h) { vAc[h][i] = (unsigned)((R + h * HALF) * lda + C) * 2u; vAn[h][i] = vAc[h][i]; } }
    const size_t kstep = (size_t)(BK * 2);
    const size_t hstepB = (size_t)HALF * ldb * 2, tstepB = 2 * hstepB, tstepA = GATHER ? 0 : (size_t)BM * lda * 2;
    const unsigned ldsw = (unsigned)wid * 1024u;
    const int aoff = lds_byte(wr * 64 + fr, fq * 8), boff = lds_byte(wc * 32 + fr, fq * 8);
#define PG8_SA(b, h) (((b) * 2 + (h)) * HTB)
#define PG8_SB(b, h) ((4 + (b) * 2 + (h)) * HTB)
#define PG8_STAGE(bufoff, gbase, voff) do { _Pragma("unroll") for (int _i = 0; _i < 2; ++_i) \
        __builtin_amdgcn_global_load_lds((const unsigned*)((const char*)(gbase) + (voff)[_i]), (PG8_LAS unsigned*)(lds + (bufoff) + ldsw + _i * 8192), 16, 0, 0); } while (0)
#define PG8_LDA(dst, b, h) do { _Pragma("unroll") for (int m = 0; m < 4; ++m) _Pragma("unroll") for (int k = 0; k < 2; ++k) dst[m][k] = *(const PG8_LAS bf16x8*)(lds + PG8_SA(b, h) + aoff + m * 2048 + k * 1024); } while (0)
#define PG8_LDB(dst, b, h) do { _Pragma("unroll") for (int n = 0; n < 2; ++n) _Pragma("unroll") for (int k = 0; k < 2; ++k) dst[n][k] = *(const PG8_LAS bf16x8*)(lds + PG8_SB(b, h) + boff + n * 2048 + k * 1024); } while (0)
#define PG8_MMA(ai, bj, At, Bt) do { __builtin_amdgcn_s_setprio(1); _Pragma("unroll") for (int m = 0; m < 4; ++m) _Pragma("unroll") for (int n = 0; n < 2; ++n) _Pragma("unroll") for (int k = 0; k < 2; ++k) \
        acc[ai][bj][m][n] = __builtin_amdgcn_mfma_f32_16x16x32_bf16(Bt[n][k], At[m][k], acc[ai][bj][m][n], 0, 0, 0); __builtin_amdgcn_s_setprio(0); } while (0)
#define PG8_WAIT_V(n) asm volatile("s_waitcnt vmcnt(" #n ")" ::: "memory")
#define PG8_WAIT_L(n) asm volatile("s_waitcnt lgkmcnt(" #n ")" ::: "memory")
#define PG8_BAR __builtin_amdgcn_s_barrier()
#define PG8_SCHED __builtin_amdgcn_sched_barrier(0)
    PG8_LAS unsigned char* spare = lds + STAGE_BYTES;
    constexpr bool LIST = Sched::USE_LIST || Epi::HAS_SCALE || GATHER;
    int nunits = 0;
    if constexpr (LIST) { nunits = build_unit_list(spare, S, tid); if (nunits == 0) return;
        E.preload(spare, nunits, tid);
        if (GATHER) { PG8_LAS int* gt = (PG8_LAS int*)(spare + SP_GIDX); const PG8_LAS int* ul = (const PG8_LAS int*)(spare + SP_ULIST);
            for (int j = tid; j < nunits * 256; j += 512) { int t_ = gidx[ul[4 * (j >> 8)] * BM + (j & 255)]; gt[j] = t_ < 0 ? 0 : t_; } }
        __syncthreads(); }
#define PG8_UNIT(i, u, ok) do { if constexpr (LIST) { int a_, b_, c_, d_; const unsigned ad_ = (unsigned)(size_t)(spare + SP_ULIST) + 16u * (unsigned)(i); \
        asm volatile("ds_read_b32 %0, %4\n\tds_read_b32 %1, %4 offset:4\n\tds_read_b32 %2, %4 offset:8\n\tds_read_b32 %3, %4 offset:12\n\ts_waitcnt lgkmcnt(0)" : "=&v"(a_), "=&v"(b_), "=&v"(c_), "=&v"(d_) : "v"(ad_) : "memory"); \
        (u).pm = __builtin_amdgcn_readfirstlane(a_); (u).pn = __builtin_amdgcn_readfirstlane(b_); (u).koff = __builtin_amdgcn_readfirstlane(c_); (u).nt = __builtin_amdgcn_readfirstlane(d_); ok = (u).pm >= 0; } else { ok = S.next(i, u); } } while (0)
#define PG8_GIDX(dst, ord) do { if (GATHER) { int t0_, t1_, t2_, t3_; const unsigned ad_ = (unsigned)(size_t)(spare + SP_GIDX) + 4u * (unsigned)((ord) * 256); \
        asm volatile("ds_read_b32 %0, %4\n\tds_read_b32 %1, %5\n\tds_read_b32 %2, %4 offset:512\n\tds_read_b32 %3, %5 offset:512\n\ts_waitcnt lgkmcnt(0)" : "=&v"(t0_), "=&v"(t1_), "=&v"(t2_), "=&v"(t3_) : "v"(ad_ + 4u * (unsigned)Rl[0]), "v"(ad_ + 4u * (unsigned)Rl[1]) : "memory"); \
        dst[0][0] = (unsigned)(t0_ * lda + Cl[0]) * 2u; dst[0][1] = (unsigned)(t1_ * lda + Cl[1]) * 2u; dst[1][0] = (unsigned)(t2_ * lda + Cl[0]) * 2u; dst[1][1] = (unsigned)(t3_ * lda + Cl[1]) * 2u; } } while (0)
    Unit cur, nxt; int ui = 0;
    { bool ok0; PG8_UNIT(0, cur, ok0); if (!ok0) return; }
    f32x4 acc[2][2][4][2];
#pragma unroll
    for (int a = 0; a < 2; ++a)
#pragma unroll
        for (int b = 0; b < 2; ++b)
#pragma unroll
            for (int m = 0; m < 4; ++m)
#pragma unroll
                for (int n = 0; n < 2; ++n) acc[a][b][m][n] = (f32x4){0.f, 0.f, 0.f, 0.f};
    bf16x8 At[4][2], B0[2][2], B1[2][2];
    PG8_GIDX(vAc, 0);
    const char* cA = (const char*)g.A + (size_t)cur.pm * tstepA + (size_t)cur.koff * 2; const char* cB = (const char*)g.Bt + (size_t)cur.pn * tstepB + (size_t)cur.koff * 2;
    PG8_STAGE(PG8_SB(0, 0), cB, voffB); PG8_STAGE(PG8_SB(0, 1), cB + hstepB, voffB); PG8_STAGE(PG8_SA(0, 0), cA, vAc[0]); PG8_STAGE(PG8_SA(0, 1), cA, vAc[1]);
    if (wr == 1) PG8_BAR;
    PG8_WAIT_V(2); PG8_BAR;
    PG8_STAGE(PG8_SB(1, 0), cB + kstep, voffB); PG8_STAGE(PG8_SA(1, 0), cA + kstep, vAc[0]); PG8_STAGE(PG8_SB(1, 1), cB + hstepB + kstep, voffB);
    PG8_WAIT_V(6); PG8_BAR;
    for (;;) {
        bool has_next; PG8_UNIT(ui + 1, nxt, has_next);
        if (has_next) PG8_GIDX(vAn, ui + 1);
        const char* nA = has_next ? (const char*)g.A + (size_t)nxt.pm * tstepA + (size_t)nxt.koff * 2 : cA; const char* nB = has_next ? (const char*)g.Bt + (size_t)nxt.pn * tstepB + (size_t)nxt.koff * 2 : cB;
        const int ntc = cur.nt > 0 ? cur.nt : nt;
        for (int t = 0; t < ntc; t += 2) {
            const bool last = (t == ntc - 2);
            const char* a1 = cA + (size_t)(t + 1) * kstep;
            const char* a2 = last ? nA : cA + (size_t)(t + 2) * kstep; const char* b2 = last ? nB : cB + (size_t)(t + 2) * kstep;
            const char* a3 = a2 + kstep; const char* b3 = b2 + kstep;
            unsigned vs0[2], vs1[2];
            if (GATHER) { const bool sw = last && has_next; vs0[0] = sw ? vAn[0][0] : vAc[0][0]; vs0[1] = sw ? vAn[0][1] : vAc[0][1]; vs1[0] = sw ? vAn[1][0] : vAc[1][0]; vs1[1] = sw ? vAn[1][1] : vAc[1][1]; }
            else { vs0[0] = vAc[0][0]; vs0[1] = vAc[0][1]; vs1[0] = vAc[1][0]; vs1[1] = vAc[1][1]; }
            PG8_LDB(B0, 0, 0); PG8_LDB(B1, 0, 1); PG8_SCHED; PG8_LDA(At, 0, 0); PG8_STAGE(PG8_SA(1, 1), a1, vAc[1]);
            PG8_WAIT_V(8); PG8_WAIT_L(0); PG8_BAR; PG8_MMA(0, 0, At, B0); PG8_MMA(0, 1, At, B1); PG8_BAR; PG8_SCHED;
            PG8_LDA(At, 0, 1); PG8_STAGE(PG8_SB(0, 0), b2, voffB); PG8_STAGE(PG8_SB(0, 1), b2 + hstepB, voffB); PG8_STAGE(PG8_SA(0, 0), a2, vs0);
            PG8_WAIT_V(8); PG8_WAIT_L(0); PG8_BAR; PG8_MMA(1, 0, At, B0); PG8_MMA(1, 1, At, B1); PG8_BAR; PG8_SCHED;
            PG8_LDB(B0, 1, 0); PG8_LDB(B1, 1, 1); PG8_SCHED; PG8_LDA(At, 1, 0); PG8_STAGE(PG8_SA(0, 1), a2, vs1);
            PG8_WAIT_V(8); PG8_WAIT_L(0); PG8_BAR; PG8_MMA(0, 0, At, B0); PG8_MMA(0, 1, At, B1); PG8_BAR; PG8_SCHED;
            PG8_LDA(At, 1, 1); PG8_STAGE(PG8_SB(1, 0), b3, voffB); PG8_STAGE(PG8_SB(1, 1), b3 + hstepB, voffB); PG8_STAGE(PG8_SA(1, 0), a3, vs0);
            PG8_WAIT_V(8); PG8_WAIT_L(0); PG8_BAR; PG8_MMA(1, 0, At, B0); PG8_MMA(1, 1, At, B1); PG8_BAR; PG8_SCHED;
        }
        if constexpr (ALIGN_EPI) { if (wr == 0) PG8_BAR; }
        E(acc, cur, wr, wc, fr, fq, spare, ui);
        if (!has_next) break;
#pragma unroll
        for (int a = 0; a < 2; ++a)
#pragma unroll
            for (int b = 0; b < 2; ++b)
#pragma unroll
                for (int m = 0; m < 4; ++m)
#pragma unroll
                    for (int n = 0; n < 2; ++n) acc[a][b][m][n] = (f32x4){0.f, 0.f, 0.f, 0.f};
        cur = nxt; cA = nA; cB = nB; ++ui;
        if (GATHER) {
#pragma unroll
            for (int h = 0; h < 2; ++h) { vAc[h][0] = vAn[h][0]; vAc[h][1] = vAn[h][1]; } }
        if constexpr (ALIGN_EPI) { if (wr == 1) PG8_BAR; }
    }
    PG8_WAIT_V(0);
    if constexpr (!ALIGN_EPI) { if (wr == 0) PG8_BAR; }
    PG8_BAR;
#undef PG8_SA
#undef PG8_SB
#undef PG8_STAGE
#undef PG8_LDA
#undef PG8_LDB
#undef PG8_MMA
#undef PG8_WAIT_V
#undef PG8_WAIT_L
#undef PG8_BAR
#undef PG8_SCHED
#undef PG8_GIDX
#undef PG8_UNIT
}
}

#define GAS __attribute__((address_space(1)))
#define LAS __attribute__((address_space(3)))
typedef unsigned v4u __attribute__((ext_vector_type(4)));
typedef unsigned v2u __attribute__((ext_vector_type(2)));
typedef float f32x4 __attribute__((ext_vector_type(4)));
typedef short bf16x8 __attribute__((ext_vector_type(8)));
typedef float f32x16 __attribute__((ext_vector_type(16)));
#define LDS_WAIT() asm volatile("s_waitcnt lgkmcnt(0)" ::: "memory")
#define VM_WAIT() asm volatile("s_waitcnt vmcnt(0)" ::: "memory")
constexpr int NWAVES = 8, NTHR = 512;
constexpr int LDS_BYTES = 163840 - 1024;
constexpr int LDSCTL_OFF = LDS_BYTES - 1024;

struct Args { const float* in[N_INPUTS]; float* out; unsigned char* ws; int ph_lo, ph_hi, sub, pad; };
struct Frame { LAS unsigned char* lds; int tid, lane, wave, G, bid; const float* const* in; float* out; unsigned char* ws;
    template <class T> __device__ __forceinline__ T* w(size_t off) const { return (T*)(ws + off); } };

__device__ __forceinline__ void transpose_item(const float* W, int K, int N, int Npad, bf16* WT, int mode, LAS unsigned char* scr, int item, int nblk, int lane, const float* gk = nullptr, int ldo = 0) {
    const int kb = item / nblk, nb = item % nblk, k0 = 64 * kb, n0 = 64 * nb;
    const int g = lane >> 4, c = lane & 15, nn = n0 + 4 * c; const bool ok = nn < N;
    const float* src = W + (size_t)(k0 + 2 * g) * N + nn;
    f32x4 a[8], b[8];
#pragma unroll
    for (int i = 0; i < 8; ++i) { a[i] = ok ? *(const f32x4*)(src + (size_t)(8 * i) * N) : (f32x4){0.f, 0.f, 0.f, 0.f}; b[i] = ok ? *(const f32x4*)(src + (size_t)(8 * i + 1) * N) : (f32x4){0.f, 0.f, 0.f, 0.f}; }
    if (gk) {
#pragma unroll
        for (int i = 0; i < 8; ++i) { const float2 gg = *(const float2*)(gk + k0 + 8 * i + 2 * g); a[i] = a[i] * gg.x; b[i] = b[i] * gg.y; } }
#pragma unroll
    for (int i = 0; i < 8; ++i)
#pragma unroll
        for (int j = 0; j < 4; ++j) *(LAS unsigned*)(scr + (4 * c + j) * 128 + ((i ^ (c & 7)) * 16) + 4 * g) = pk2(a[i][j], b[i][j]);
    LDS_WAIT(); asm volatile("" ::: "memory");
#pragma unroll
    for (int r = 0; r < 8; ++r) { const int idx = lane + 64 * r, nl = idx >> 3, ch = idx & 7, n = n0 + nl;
        const v4u v = *(const LAS v4u*)(scr + nl * 128 + ((ch ^ ((nl >> 2) & 7)) * 16));
        if (n < Npad) { const int row = (mode == 0) ? n : (256 * (n / 128) + (n % 128) + (mode == 2 ? 128 : 0)); *(v4u*)(WT + (size_t)row * (ldo ? ldo : K) + k0 + 8 * ch) = v; } }
    LDS_WAIT(); asm volatile("" ::: "memory");
}
__device__ __forceinline__ void rms_row(const float* xrow, const float* g, bf16* orow, int lane, f32x4 (&v)[4]) {
    const f32x4* xr = (const f32x4*)xrow + lane; float s = 0.f;
#pragma unroll
    for (int j = 0; j < 4; ++j) { v[j] = xr[64 * j]; s += (v[j].x * v[j].x + v[j].y * v[j].y) + (v[j].z * v[j].z + v[j].w * v[j].w); }
    const float r = rsqrtf(wave_sum(s) * (1.f / DM) + EPS);
    v2u* o8 = (v2u*)orow + lane;
#pragma unroll
    for (int j = 0; j < 4; ++j) { const f32x4 gg = ((const f32x4*)g)[lane + 64 * j]; v[j] = v[j] * r * gg; v2u o; o.x = pk2(v[j].x, v[j].y); o.y = pk2(v[j].z, v[j].w); o8[64 * j] = o; }
}
__device__ __forceinline__ void ph_rmsnorm(Frame& F, const float* X, const float* g, bf16* H) {
    const int gw = F.bid * NWAVES + F.wave, NGW = F.G * NWAVES, lane = F.lane;
    for (int m = gw; m < M_TOK; m += 4 * NGW) {
        f32x4 v[4][4]; float s[4];
#pragma unroll
        for (int r = 0; r < 4; ++r) { const int mm = (m + r * NGW < M_TOK) ? m + r * NGW : m; const f32x4* xr = (const f32x4*)(X + (size_t)mm * DM) + lane;
#pragma unroll
            for (int j = 0; j < 4; ++j) v[r][j] = xr[64 * j]; }
#pragma unroll
        for (int r = 0; r < 4; ++r) { float t = 0.f;
#pragma unroll
            for (int j = 0; j < 4; ++j) t += (v[r][j].x * v[r][j].x + v[r][j].y * v[r][j].y) + (v[r][j].z * v[r][j].z + v[r][j].w * v[r][j].w);
            s[r] = t; }
#pragma unroll
        for (int o = 1; o < 64; o <<= 1) {
#pragma unroll
            for (int r = 0; r < 4; ++r) s[r] += __shfl_xor(s[r], o); }
#pragma unroll
        for (int r = 0; r < 4; ++r) { if (m + r * NGW < M_TOK) { const float rs = rsqrtf(s[r] * (1.f / DM) + EPS); v2u* o8 = (v2u*)(H + (size_t)(m + r * NGW) * DM) + lane;
#pragma unroll
            for (int j = 0; j < 4; ++j) { const f32x4 gg = ((const f32x4*)g)[lane + 64 * j]; const f32x4 y = v[r][j] * rs * gg; v2u o; o.x = pk2(y.x, y.y); o.y = pk2(y.z, y.w); o8[64 * j] = o; } } }
    }
}
__device__ __forceinline__ void ph_rope_table(Frame& F, float2* tab) {
    for (int idx = F.bid * NTHR + F.tid; idx < SEQ * 16; idx += F.G * NTHR) { const int pos = idx >> 4, i = idx & 15;
        const float fr = powf(10000.f, -(float)i / 16.f), ang = (float)pos * fr; tab[idx] = make_float2(cosf(ang), sinf(ang)); }
}
__device__ __forceinline__ void ph_refs(Frame& F) {
    if (F.bid != 0 || F.wave != 0) return;
    const int l = F.lane; float* refs = F.w<float>(WS_REFS);
#pragma unroll
    for (int mode = 0; mode < 3; ++mode) { const int dq = mode == 2 ? 96 : 64;
        const float* gq = F.in[mode == 0 ? I_MQN : mode == 1 ? I_DQN : I_MLAQN]; const float* gk = F.in[mode == 0 ? I_MKN : mode == 1 ? I_DKN : I_MLAKN];
        float aq = fabsf(gq[l]), ak = fabsf(gk[l]); if (mode == 2 && l < 32) { aq = fmaxf(aq, fabsf(gq[64 + l])); ak = fmaxf(ak, fabsf(gk[64 + l])); }
        const float mq = wave_max(aq), mk = wave_max(ak); const float base = (float)dq * mq * mk * (mode == 2 ? QSCALE96 : QSCALE64);
        if (mode == 2) { if (l < 16) refs[32 + l] = base; }
        else {
#pragma unroll
            for (int h = 0; h < 8; ++h) { const float mb = wave_max(l < 32 ? fmaxf(F.in[I_RELB][l * 16 + mode * 8 + h], 0.f) : 0.f); if (l == 0) refs[mode * 16 + h] = base + mb * LOG2E; } }
    }
}
__device__ __forceinline__ void wt_job(Frame& F, LAS unsigned char* scr, int& base, int idx, int K, int N, int Npad, int mode, int nexp, size_t off, const float* gk = nullptr, int ldo = 0) {
    const int gw = F.bid * NWAVES + F.wave, NGW = F.G * NWAVES;
    const int nblk = Npad / 64, per = (K / 64) * nblk, tot = per * nexp;
    const size_t wes = (size_t)K * N, wtes = (size_t)(mode == 0 ? Npad : 2 * Npad) * K;
    int it = base + ((gw - base % NGW) + NGW) % NGW;
    for (; it < base + tot; it += NGW) { const int r = it - base, e = r / per, q = r % per;
        transpose_item(F.in[idx] + (size_t)e * wes, K, N, Npad, F.w<bf16>(off) + (size_t)e * wtes, mode, scr, q, nblk, F.lane, gk, ldo); }
    base += tot;
}
__device__ __forceinline__ void ph_prologue(Frame& F) {
    LAS unsigned char* scr = F.lds + F.wave * 8192;
    int base = 0;
    wt_job(F, scr, base, I_W_IN_E, 1024, N_IN_E, QKV_LD, 0, 1, WS_W_IN_E);
    wt_job(F, scr, base, I_W_OUT_E, 1024, 1024, 1024, 0, 1, WS_W_OUT_E);
    wt_job(F, scr, base, I_W_GATE_E, 1024, FF_E, FF_E, 1, 1, WS_W_GU_E, F.in[I_FFNN_E]);
    wt_job(F, scr, base, I_W_UP_E, 1024, FF_E, FF_E, 2, 1, WS_W_GU_E, F.in[I_FFNN_E]);
    wt_job(F, scr, base, I_W_DOWN_E, FF_E, 1024, 1024, 0, 1, WS_W_DN_E);
    wt_job(F, scr, base, I_W_IN_O, 1024, N_IN_O, C1_LD, 0, 1, WS_W_IN_O, F.in[I_MIXN_O]);
    wt_job(F, scr, base, I_W_UQ, 384, 1536, 1536, 0, 1, WS_W_LAT, F.in[I_QAN], W_LAT_LD);
    wt_job(F, scr, base, I_W_UKV, 256, 2048, 2048, 0, 1, WS_W_LAT + ((size_t)1536 * W_LAT_LD + 384) * 2, F.in[I_KVAN], W_LAT_LD);
    wt_job(F, scr, base, I_W_OUT_O, 1024, 1024, 1024, 0, 1, WS_W_OUT_O);
    ph_rope_table(F, F.w<float2>(WS_ROPE));
    ph_refs(F);
    ph_rmsnorm(F, F.in[I_X], F.in[I_MIXN_E], F.w<bf16>(WS_H));
}
constexpr int MOE_T_GU = (1024 / 64) * (FF_O / 64) * NEXP, MOE_T_DN = (FF_O / 64) * (1024 / 64) * NEXP, MOE_ITEMS = 2 * MOE_T_GU + MOE_T_DN;
constexpr int MOE_TAIL_A = 4096, MOE_TAIL_B = 4096, MOE_TAIL_C = 3072, MOE_TAIL_ALL = MOE_TAIL_A + MOE_TAIL_B + MOE_TAIL_C, NSLOT_MOE = 4;
__device__ __forceinline__ void moe_convert_item(Frame& F, LAS unsigned char* scr, int it) {
    constexpr int PER_GU = (1024 / 64) * (FF_O / 64), PER_DN = (FF_O / 64) * (1024 / 64);
    if (it < 2 * MOE_T_GU) { const int up = it >= MOE_T_GU, r = it - up * MOE_T_GU, e = r / PER_GU, q = r % PER_GU;
        transpose_item(F.in[up ? I_W_UP_O : I_W_GATE_O] + (size_t)e * 1024 * FF_O, 1024, FF_O, FF_O, F.w<bf16>(WS_WGU_O) + (size_t)e * 2 * FF_O * 1024, up ? 2 : 1, scr, q, FF_O / 64, F.lane, F.in[I_FFNN_O]); }
    else { const int r = it - 2 * MOE_T_GU, e = r / PER_DN, q = r % PER_DN;
        transpose_item(F.in[I_W_DOWN_O] + (size_t)e * FF_O * 1024, FF_O, 1024, 1024, F.w<bf16>(WS_WDN_O) + (size_t)e * 1024 * FF_O, 0, scr, q, 1024 / 64, F.lane); }
}
__device__ __forceinline__ void moe_convert_tail(Frame& F, int first, int n, int wg0) {
    if (F.G != 256 || F.bid < wg0) return;
    LAS unsigned char* scr = F.lds + F.wave * 8192; const int nw = (F.G - wg0) * NWAVES, w = (F.bid - wg0) * NWAVES + F.wave;
    for (int it = first + w; it < first + n; it += nw) moe_convert_item(F, scr, it);
}
__device__ __forceinline__ void moe_convert_slice(Frame& F, int slice) {
    LAS unsigned char* scr = F.lds + F.wave * 8192;
    const int gw = F.bid * NWAVES + F.wave, NGW = F.G * NWAVES, first = (F.G == 256) ? MOE_TAIL_ALL : 0;
    for (int it = first + slice * NGW + gw; it < MOE_ITEMS; it += NSLOT_MOE * NGW) moe_convert_item(F, scr, it);
    __syncthreads();
}
__device__ __forceinline__ void ph_rmsnorm_route(Frame& F, const bf16* X, const float* g, float* rstd_out) {
    const float* wr = F.in[I_W_ROUTER]; const float* br = F.in[I_B_ROUTER]; int2* re = F.w<int2>(WS_ROUTE_E); float2* rg = F.w<float2>(WS_ROUTE_G); int* cnt_wg = F.w<int>(WS_CNT_WG);
    LAS int* cnt = (LAS int*)F.lds;
    f32x4 wg[16][2];
#pragma unroll
    for (int j = 0; j < 4; ++j)
#pragma unroll
        for (int q = 0; q < 4; ++q) { const int d = 4 * F.lane + 256 * j + q; const float gd = g[d]; wg[4 * j + q][0] = *(const f32x4*)(wr + d * 8) * gd; wg[4 * j + q][1] = *(const f32x4*)(wr + d * 8 + 4) * gd; }
    float bre[8];
#pragma unroll
    for (int e = 0; e < 8; ++e) bre[e] = br[e];
    for (int ch = F.bid; ch < 256; ch += F.G) {
        if (F.tid < 8) cnt[F.tid] = 0;
        __syncthreads();
        for (int i = F.wave; i < 64; i += 2 * NWAVES) {
            v2u raw[2][4];
#pragma unroll
            for (int r = 0; r < 2; ++r) { const v2u* xr = (const v2u*)(X + (size_t)(ch * 64 + i + r * NWAVES) * DM) + F.lane;
#pragma unroll
                for (int j = 0; j < 4; ++j) raw[r][j] = xr[64 * j]; }
#pragma unroll
            for (int r = 0; r < 2; ++r) { const int m = ch * 64 + i + r * NWAVES; float s = 0.f; float lg[8];
#pragma unroll
                for (int e = 0; e < 8; ++e) lg[e] = 0.f;
#pragma unroll
                for (int j = 0; j < 4; ++j) { const float x4[4] = {bflo(raw[r][j].x), bfhi(raw[r][j].x), bflo(raw[r][j].y), bfhi(raw[r][j].y)};
#pragma unroll
                    for (int q = 0; q < 4; ++q) { const float y = x4[q]; s += y * y; const f32x4 w0 = wg[4 * j + q][0], w1 = wg[4 * j + q][1];
                        lg[0] += y * w0.x; lg[1] += y * w0.y; lg[2] += y * w0.z; lg[3] += y * w0.w; lg[4] += y * w1.x; lg[5] += y * w1.y; lg[6] += y * w1.z; lg[7] += y * w1.w; } }
                const float rs = rsqrtf(wave_sum(s) * (1.f / DM) + EPS);
                if (F.lane == 0) rstd_out[m] = rs;
#pragma unroll
                for (int e = 0; e < 8; ++e) lg[e] = wave_sum(lg[e]) * rs + bre[e];
                int e0 = 0; float v0 = lg[0];
#pragma unroll
                for (int e = 1; e < 8; ++e) if (lg[e] > v0) { v0 = lg[e]; e0 = e; }
                int e1 = -1; float v1 = -INFINITY;
#pragma unroll
                for (int e = 0; e < 8; ++e) if (e != e0 && lg[e] > v1) { v1 = lg[e]; e1 = e; }
                if (F.lane == 0) { const float p1 = 1.f / (1.f + __expf(v0 - v1)); re[m] = make_int2(e0, e1); rg[m] = make_float2(1.f - p1, p1); atomicAdd((int*)&cnt[e0], 1); atomicAdd((int*)&cnt[e1], 1); } } }
        __syncthreads();
        if (F.tid < 8) cnt_wg[ch * 8 + F.tid] = cnt[F.tid];
        __syncthreads();
    }
}
__device__ __forceinline__ void ph_slots(Frame& F) {
    const int2* re = F.w<int2>(WS_ROUTE_E); const float2* rg = F.w<float2>(WS_ROUTE_G); const int* cnt_wg = F.w<int>(WS_CNT_WG);
    int* stok = F.w<int>(WS_SLOT_TOK); float* sgate = F.w<float>(WS_SLOT_GATE); int* tile_e = F.w<int>(WS_TILE_E); int2* tslot = F.w<int2>(WS_TOK_SLOT); const float* rstd = F.w<float>(WS_RSTD); float* srstd = F.w<float>(WS_SLOT_RSTD);
    LAS int* sh = (LAS int*)F.lds;
    { const int e = F.wave, l = F.lane;
      const int c0 = cnt_wg[(4 * l + 0) * 8 + e], c1 = cnt_wg[(4 * l + 1) * 8 + e], c2 = cnt_wg[(4 * l + 2) * 8 + e], c3 = cnt_wg[(4 * l + 3) * 8 + e];
      const int tot = c0 + c1 + c2 + c3; int incl = tot;
#pragma unroll
      for (int off = 1; off < 64; off <<= 1) { const int v = __shfl_up(incl, off); if (l >= off) incl += v; }
      const int excl = incl - tot;
      sh[64 + 8 * (4 * l + 0) + e] = excl; sh[64 + 8 * (4 * l + 1) + e] = excl + c0; sh[64 + 8 * (4 * l + 2) + e] = excl + c0 + c1; sh[64 + 8 * (4 * l + 3) + e] = excl + c0 + c1 + c2;
      if (l == 63) sh[e] = incl; }
    __syncthreads();
    if (F.tid == 0) { int o = 0; for (int e = 0; e < 8; ++e) { sh[8 + e] = o; o += (sh[e] + 255) / 256 * 256; } sh[16] = o; }
    __syncthreads();
    for (int ch = F.bid; ch < 256; ch += F.G) {
        if (F.wave == 0) { const int row = ch * 64 + F.lane; const int2 e = re[row]; const float2 gg = rg[row]; int s0 = 0, s1 = 0;
            const unsigned long long below = (1ull << F.lane) - 1ull;
#pragma unroll
            for (int q = 0; q < 8; ++q) { const unsigned long long m = __ballot(e.x == q) | __ballot(e.y == q); const int pos = sh[8 + q] + sh[64 + 8 * ch + q] + __popcll(m & below);
                if (e.x == q) s0 = pos; if (e.y == q) s1 = pos; }
            const float rr = rstd[row]; stok[s0] = row; sgate[s0] = gg.x; srstd[s0] = rr; stok[s1] = row; sgate[s1] = gg.y; srstd[s1] = rr; tslot[row] = make_int2(s0, s1); }
    }
    if (F.bid == 0) { for (int e = 0; e < 8; ++e) for (int s = sh[8 + e] + sh[e] + F.tid; s < sh[8 + e + 1]; s += NTHR) { stok[s] = -1; sgate[s] = 0.f; srstd[s] = 0.f; }
        for (int tl = F.tid; tl <= TILE_CAP; tl += NTHR) { int e = -1; for (int q = 0; q < 8; ++q) if (tl * 256 >= sh[8 + q] && tl * 256 < sh[8 + q + 1]) e = q; if (tl == TILE_CAP) e = sh[16] / 256; tile_e[tl] = e; } }
    __syncthreads();
}
__device__ __forceinline__ void ph_rmsnorm_lat(Frame& F) {
    const bf16* C1 = F.w<bf16>(WS_C1); bf16* CQN = F.w<bf16>(WS_CQN); bf16* CKVN = F.w<bf16>(WS_CKVN); const float* gq = F.in[I_QAN]; const float* gkv = F.in[I_KVAN];
    const int gw = F.bid * NWAVES + F.wave, NGW = F.G * NWAVES, lane = F.lane;
    const bool isq = lane < 48; const float* g1 = isq ? gq + lane * 8 : gkv + (lane - 48) * 8; const float* g2 = gkv + (16 + lane) * 8;
    float ga[8], gb[8];
#pragma unroll
    for (int j = 0; j < 8; ++j) { ga[j] = g1[j]; gb[j] = (lane < 16) ? g2[j] : 0.f; }
    for (int m = gw; m < M_TOK; m += 4 * NGW) {
        v4u ra[4], rb[4];
#pragma unroll
        for (int r = 0; r < 4; ++r) { const int mm = (m + r * NGW < M_TOK) ? m + r * NGW : m; const v4u* row = (const v4u*)(C1 + (size_t)mm * C1_LD); ra[r] = row[lane]; rb[r] = (lane < 16) ? row[64 + lane] : (v4u){0u, 0u, 0u, 0u}; }
#pragma unroll
        for (int r = 0; r < 4; ++r) { if (m + r * NGW < M_TOK) { const int mm = m + r * NGW;
            float xa[8], xb[8]; float sa = 0.f, sb = 0.f;
#pragma unroll
            for (int e = 0; e < 4; ++e) { xa[2 * e] = bflo(ra[r][e]); xa[2 * e + 1] = bfhi(ra[r][e]); xb[2 * e] = bflo(rb[r][e]); xb[2 * e + 1] = bfhi(rb[r][e]); }
#pragma unroll
            for (int j = 0; j < 8; ++j) { sa += xa[j] * xa[j]; sb += xb[j] * xb[j]; }
            const float sq = wave_sum(isq ? sa : 0.f), skv = wave_sum((isq ? 0.f : sa) + sb);
            const float rq = rsqrtf(sq * (1.f / 384) + EPS), rkv = rsqrtf(skv * (1.f / 256) + EPS), r1 = isq ? rq : rkv;
            v4u o;
#pragma unroll
            for (int e = 0; e < 4; ++e) o[e] = pk2(xa[2 * e] * r1 * ga[2 * e], xa[2 * e + 1] * r1 * ga[2 * e + 1]);
            if (isq) *(v4u*)(CQN + (size_t)mm * 384 + lane * 8) = o; else *(v4u*)(CKVN + (size_t)mm * 256 + (lane - 48) * 8) = o;
            if (lane < 16) { v4u o2;
#pragma unroll
                for (int e = 0; e < 4; ++e) o2[e] = pk2(xb[2 * e] * rkv * gb[2 * e], xb[2 * e + 1] * rkv * gb[2 * e + 1]);
                *(v4u*)(CKVN + (size_t)mm * 256 + (16 + lane) * 8) = o2; } } }
    }
}
__device__ __forceinline__ void ph_qknorm(Frame& F) {
    bf16* QKV = F.w<bf16>(WS_QKV0); float* kmean2 = F.w<float>(WS_KMEAN); LAS float* part = (LAS float*)F.lds;
    const int lane = F.lane;
    for (int u = F.bid; u < 256; u += F.G) { const int grp = u & 1, half = (u >> 1) & 1, blk = (u >> 2) & 15, b = u >> 6;
        const int col = (grp == 0 ? C_MK : C_DK) + lane * 8;
        const float* g = F.in[grp == 0 ? I_MKN : I_DKN] + (lane & 7) * 8;
        float gg[8];
#pragma unroll
        for (int j = 0; j < 8; ++j) gg[j] = g[j];
        float ks[8];
#pragma unroll
        for (int j = 0; j < 8; ++j) ks[j] = 0.f;
        const size_t row0 = (size_t)b * SEQ + blk * 256 + half * 128;
        for (int i0 = F.wave; i0 < 128; i0 += 4 * NWAVES) {
            v4u raw[4];
#pragma unroll
            for (int u4 = 0; u4 < 4; ++u4) raw[u4] = *(const v4u*)(QKV + (row0 + i0 + u4 * NWAVES) * QKV_LD + col);
#pragma unroll
            for (int u4 = 0; u4 < 4; ++u4) { float x[8];
                x[0] = bflo(raw[u4].x); x[1] = bfhi(raw[u4].x); x[2] = bflo(raw[u4].y); x[3] = bfhi(raw[u4].y); x[4] = bflo(raw[u4].z); x[5] = bfhi(raw[u4].z); x[6] = bflo(raw[u4].w); x[7] = bfhi(raw[u4].w);
                float ss = 0.f;
#pragma unroll
                for (int j = 0; j < 8; ++j) ss += x[j] * x[j];
                ss += __shfl_xor(ss, 1); ss += __shfl_xor(ss, 2); ss += __shfl_xor(ss, 4);
                const float r = rsqrtf(ss * (1.f / 64) + EPS);
#pragma unroll
                for (int j = 0; j < 8; ++j) { x[j] = x[j] * r * gg[j]; ks[j] += x[j]; }
                v4u o; o.x = pk2(x[0], x[1]); o.y = pk2(x[2], x[3]); o.z = pk2(x[4], x[5]); o.w = pk2(x[6], x[7]);
                *(v4u*)(QKV + (row0 + i0 + u4 * NWAVES) * QKV_LD + col) = o; } }
        if (grp == 0) {
#pragma unroll
            for (int j = 0; j < 8; ++j) part[F.wave * 512 + lane * 8 + j] = ks[j];
            __syncthreads();
            { const int c = F.tid; float s = 0.f;
#pragma unroll
              for (int w = 0; w < 8; ++w) s += part[w * 512 + c];
              kmean2[((((b * 8 + (c >> 6)) * 16 + blk) * 2) + half) * 64 + (c & 63)] = s; }
            __syncthreads(); }
    }
}
__device__ __forceinline__ void ph_mla_prep(Frame& F, const float2* tab) {
    const bf16* KVR = F.w<bf16>(WS_KVR); const bf16* C1 = F.w<bf16>(WS_C1); bf16* KM = F.w<bf16>(WS_KM); const float* g = F.in[I_MLAKN];
#pragma unroll 1
    for (int idx = F.bid * NTHR + F.tid; idx < M_TOK * 16; idx += F.G * NTHR) { const int row = idx >> 4, h = idx & 15, pos = row & (SEQ - 1);
        asm volatile("" ::: "memory");
        const v4u* src = (const v4u*)(KVR + (size_t)row * KVR_LD + h * 128);
        const v4u* src2 = (const v4u*)(C1 + (size_t)row * C1_LD + C1_KPE);
        v4u raw[12]; float ss = 0.f;
#pragma unroll
        for (int c = 0; c < 12; ++c) raw[c] = (c >= 8) ? src2[c - 8] : src[c];
#pragma unroll
        for (int c = 0; c < 12; ++c) {
#pragma unroll
            for (int e = 0; e < 4; ++e) { const float lo = bflo(raw[c][e]), hh = bfhi(raw[c][e]); ss += lo * lo + hh * hh; } }
        const float r = rsqrtf(ss * (1.f / 96) + EPS);
        v4u* dst = (v4u*)(KM + (size_t)row * QR_LD + h * 96);
#pragma unroll
        for (int c = 0; c < 8; ++c) { v4u o;
#pragma unroll
            for (int e = 0; e < 4; ++e) o[e] = pk2(bflo(raw[c][e]) * r * g[8 * c + 2 * e], bfhi(raw[c][e]) * r * g[8 * c + 2 * e + 1]);
            dst[c] = o; }
#pragma unroll
        for (int cc = 0; cc < 2; ++cc) { v4u o1, o2;
#pragma unroll
            for (int e = 0; e < 4; ++e) { const int i0 = 8 * cc + 2 * e;
                const float a0 = bflo(raw[8 + cc][e]) * r * g[64 + i0], a1 = bfhi(raw[8 + cc][e]) * r * g[64 + i0 + 1], b0 = bflo(raw[10 + cc][e]) * r * g[80 + i0], b1 = bfhi(raw[10 + cc][e]) * r * g[80 + i0 + 1];
                const float2 c0 = tab[pos * 16 + i0], c1 = tab[pos * 16 + i0 + 1];
                o1[e] = pk2(a0 * c0.x - b0 * c0.y, a1 * c1.x - b1 * c1.y); o2[e] = pk2(a0 * c0.y + b0 * c0.x, a1 * c1.y + b1 * c1.x); }
            dst[8 + cc] = o1; dst[10 + cc] = o2; }
    }
}
__device__ __forceinline__ void moe_y_row(const bf16* Y, const bf16* YP, int slot, int lane, float gate, f32x4 (&x)[4]) {
    if (slot < MOE_FULL_TILES * 256) { const v2u* a = (const v2u*)(Y + (size_t)slot * 1024) + lane;
#pragma unroll
        for (int j = 0; j < 4; ++j) { const v2u p = a[64 * j]; x[j].x += gate * bflo(p.x); x[j].y += gate * bfhi(p.x); x[j].z += gate * bflo(p.y); x[j].w += gate * bfhi(p.y); } }
    else { const v2u* a = (const v2u*)(YP + (size_t)(slot - MOE_FULL_TILES * 256) * 1024) + lane;
#pragma unroll
        for (int j = 0; j < 4; ++j) { float s0 = 0.f, s1 = 0.f, s2 = 0.f, s3 = 0.f;
#pragma unroll
            for (int k = 0; k < MOE_TAIL_SPLIT; ++k) { const v2u p = a[(size_t)k * MOE_TAIL_ROWS * 256 + 64 * j]; s0 += bflo(p.x); s1 += bfhi(p.x); s2 += bflo(p.y); s3 += bfhi(p.y); }
            x[j].x += gate * s0; x[j].y += gate * s1; x[j].z += gate * s2; x[j].w += gate * s3; } }
}
__device__ __forceinline__ void ph_moe_combine(Frame& F) {
    const bf16* Y = F.w<bf16>(WS_Y); const bf16* YP = F.w<bf16>(WS_YP); const int2* tslot = F.w<int2>(WS_TOK_SLOT); const float2* rg = F.w<float2>(WS_ROUTE_G); float* X = F.out; const bf16* XB = F.w<bf16>(WS_H);
    const int gw = F.bid * NWAVES + F.wave, NGW = F.G * NWAVES;
#pragma unroll 2
    for (int m = gw; m < M_TOK; m += NGW) { const int2 sl = tslot[m]; const float2 g = rg[m];
        f32x4* xr = (f32x4*)(X + (size_t)m * DM) + F.lane; const v2u* xb = (const v2u*)(XB + (size_t)m * DM) + F.lane; f32x4 x[4];
#pragma unroll
        for (int j = 0; j < 4; ++j) { const v2u p = xb[64 * j]; x[j] = (f32x4){bflo(p.x), bfhi(p.x), bflo(p.y), bfhi(p.y)}; }
        moe_y_row(Y, YP, sl.x, F.lane, g.x, x); moe_y_row(Y, YP, sl.y, F.lane, g.y, x);
#pragma unroll
        for (int j = 0; j < 4; ++j) xr[64 * j] = x[j]; }
}

namespace at {
typedef short s16x4 __attribute__((ext_vector_type(4)));
typedef short v4i16_t __attribute__((ext_vector_type(4)));
typedef __attribute__((address_space(3))) const char* lds_cptr;
__device__ __forceinline__ unsigned cvtpk(float lo, float hi) { return pk2(lo, hi); }
__device__ __forceinline__ int crow(int r, int hi) { return (r & 3) + 8 * (r >> 2) + 4 * hi; }
__device__ __forceinline__ s16x4 vtr(lds_cptr p) { return __builtin_bit_cast(s16x4, __builtin_amdgcn_ds_read_tr16_b64_v4i16((__attribute__((address_space(3))) v4i16_t*)p)); }

__device__ __forceinline__ void glds16(const void* gbase, unsigned voff, unsigned lds_dst) { unsigned keep;
    asm volatile("s_mov_b32 %0, m0\n\ts_mov_b32 m0, %3\n\ts_nop 0\n\tglobal_load_lds_dwordx4 %1, %2\n\ts_mov_b32 m0, %0" : "=&s"(keep) : "v"(voff), "s"(gbase), "s"(lds_dst) : "memory"); }
__device__ __forceinline__ void glds16b(const void* gbase, unsigned voff, unsigned lds_dst) { unsigned keep;
    asm volatile("s_mov_b32 %0, m0\n\ts_mov_b32 m0, %3\n\ts_nop 0\n\tglobal_load_lds_dwordx4 %1, %2 offset:128\n\ts_mov_b32 m0, %0" : "=&s"(keep) : "v"(voff), "s"(gbase), "s"(lds_dst) : "memory"); }
__device__ __forceinline__ void glds4(const void* gbase, unsigned voff, unsigned lds_dst) { unsigned keep;
    asm volatile("s_mov_b32 %0, m0\n\ts_mov_b32 m0, %3\n\ts_nop 0\n\tglobal_load_lds_dword %1, %2\n\ts_mov_b32 m0, %0" : "=&s"(keep) : "v"(voff), "s"(gbase), "s"(lds_dst) : "memory"); }
constexpr int KBUF = 12288, VBUF = 8192, MBUF = 2048;
constexpr int NSTG = 4;
constexpr int L_K = 0, L_V = NSTG * KBUF, L_M = L_V + NSTG * VBUF, L_TAB = L_M + NSTG * MBUF, TAB_GUARD = 64, TAB_N = SEQ + TAB_GUARD, L_WS = L_TAB + TAB_N * 4, L_OST = L_WS + NWAVES * 64 * 4, L_MISC = L_OST + NWAVES * 4096, L_END = L_MISC + 64;
static_assert(L_END <= LDSCTL_OFF, "attention LDS map");

struct AttnP { const bf16* Q; int ldq, qhs; const bf16* K; int ldk, khs; const bf16* V; int ldv, vhs; bf16* O; int ocol0; const float* relb; int bcol0; const float* kmean; const unsigned long long* maskt;
               const float* refs; const float* gq; const float2* rope; };

template <int MODE, int DQK>
__device__ __forceinline__ void attn_unit(Frame& F, const AttnP& P, int b, int h, int qb, bool build_tab) {
    constexpr int ND0 = DQK / 16;
    LAS unsigned char* lds = F.lds; const lds_cptr shm3 = (lds_cptr)F.lds;
    const int tid = F.tid, lane = F.lane, r32 = lane & 31, hi = lane >> 5, wid = F.wave;
    const size_t rowbase = (size_t)b * SEQ; const int q0 = qb * 256, qw = q0 + wid * 32, q = qw + r32;
    LAS float* tab = (LAS float*)(lds + L_TAB) + TAB_GUARD;
    LAS float* wsf = (LAS float*)(lds + L_WS) + wid * 64;
    const float ref = P.refs[MODE * 16 + h];
    if (MODE != 2 && build_tab) {
        for (int n = tid - TAB_GUARD; n < SEQ; n += NTHR) tab[n] = (n < 0) ? 0.f : P.relb[rel_bucket(n) * 16 + P.bcol0 + h] * LOG2E - ref;
    }
    const bf16* Kh = P.K + rowbase * P.ldk + h * P.khs; const bf16* Vh = P.V + rowbase * P.ldv + h * P.vhs;
    const unsigned kvoff = (unsigned)(lane * P.ldk + wid * 8) * 2u;
    const unsigned vvoff = (unsigned)((16 * (wid & 3) + (lane >> 2)) * P.ldv + (wid >> 2) * 32 + (lane & 3) * 8) * 2u;
    const unsigned lds0 = (unsigned)(size_t)lds;
    const unsigned char* mbase = (MODE == 1) ? (const unsigned char*)(P.maskt + ((size_t)b * 64 * SEQ) + qw) : nullptr;
#define AT_DMA(t, bufi) do { const bf16* kt_ = Kh + (size_t)(t) * 64 * P.ldk; \
        at::glds16(kt_, kvoff, (unsigned)__builtin_amdgcn_readfirstlane(lds0 + L_K + (bufi) * KBUF + wid * 1024)); \
        if (DQK == 96 && wid < 4) at::glds16b(kt_, kvoff, (unsigned)__builtin_amdgcn_readfirstlane(lds0 + L_K + (bufi) * KBUF + (8 + wid) * 1024 - 128));   \
        at::glds16(Vh + (size_t)(t) * 64 * P.ldv, vvoff, (unsigned)__builtin_amdgcn_readfirstlane(lds0 + L_V + (bufi) * VBUF + wid * 1024)); \
        if (MODE == 1) at::glds4(mbase + (size_t)(t) * SEQ * 8, (unsigned)lane * 4u, (unsigned)__builtin_amdgcn_readfirstlane(lds0 + L_M + (bufi) * MBUF + wid * 256)); } while (0)
    const int NT = (q0 + 256) / 64;
    const int tdiag = qw >> 6;
    AT_DMA(0, 0); AT_DMA(1, 1); AT_DMA(2, 2);
    bf16x8 qr[ND0];
    { const bf16* Qw = P.Q + (rowbase + q) * P.ldq + h * P.qhs + hi * 8;
#pragma unroll
      for (int d0 = 0; d0 < ND0; ++d0) qr[d0] = *(const bf16x8*)(Qw + d0 * 16); }
    if (MODE != 2) {
        float x[4][8]; float ss = 0.f;
#pragma unroll
        for (int d0 = 0; d0 < 4; ++d0)
#pragma unroll
            for (int j = 0; j < 8; ++j) { x[d0][j] = bf2f((bf16)qr[d0][j]); ss += x[d0][j] * x[d0][j]; }
        ss += __shfl_xor(ss, 32);
        const float rr = rsqrtf(ss * (1.f / 64) + EPS) * QSCALE64; const float* g = P.gq + hi * 8;
#pragma unroll
        for (int d0 = 0; d0 < 4; ++d0) { v4u w;
#pragma unroll
            for (int e = 0; e < 4; ++e) w[e] = pk2(x[d0][2 * e] * rr * g[d0 * 16 + 2 * e], x[d0][2 * e + 1] * rr * g[d0 * 16 + 2 * e + 1]);
            qr[d0] = __builtin_bit_cast(bf16x8, w); }
    }
    if (MODE == 2) {
        float x[6][8]; float ss = 0.f;
#pragma unroll
        for (int d0 = 0; d0 < 6; ++d0)
#pragma unroll
            for (int j = 0; j < 8; ++j) { x[d0][j] = bf2f((bf16)qr[d0][j]); ss += x[d0][j] * x[d0][j]; }
        ss += __shfl_xor(ss, 32);
        const float rr = rsqrtf(ss * (1.f / 96) + EPS) * QSCALE96; const float* g = P.gq + hi * 8;
#pragma unroll
        for (int d0 = 0; d0 < 6; ++d0)
#pragma unroll
            for (int j = 0; j < 8; ++j) x[d0][j] *= rr * g[d0 * 16 + j];
#pragma unroll
        for (int j = 0; j < 8; ++j) { const float2 cs = P.rope[q * 16 + hi * 8 + j]; const float x1 = x[4][j], x2 = x[5][j]; x[4][j] = x1 * cs.x - x2 * cs.y; x[5][j] = x1 * cs.y + x2 * cs.x; }
#pragma unroll
        for (int d0 = 0; d0 < 6; ++d0) { v4u w; w.x = pk2(x[d0][0], x[d0][1]); w.y = pk2(x[d0][2], x[d0][3]); w.z = pk2(x[d0][4], x[d0][5]); w.w = pk2(x[d0][6], x[d0][7]); qr[d0] = __builtin_bit_cast(bf16x8, w); }
    }
    unsigned keep = 0u; const int blk = qb;
    if (MODE == 0) {
        float v1 = -INFINITY, v2 = -INFINITY, v3 = -INFINITY; int i1 = -1, i2 = -1, i3 = -1;
        LAS float* kml = (LAS float*)(lds + L_OST);
        for (int i = tid; i < blk * 64; i += NTHR) { const float* k2 = P.kmean + (size_t)((b * 8 + h) * 16) * 128 + (i >> 6) * 128 + (i & 63); kml[i] = (k2[0] + k2[64]) * (1.f / 256); }
        asm volatile("s_waitcnt lgkmcnt(0)" ::: "memory"); __builtin_amdgcn_s_barrier();
        const LAS float* km0 = kml + hi * 8;
#pragma unroll 1
        for (int j = 0; j < blk; ++j) { const LAS float* km = km0 + j * 64; float g = 0.f;
#pragma unroll
            for (int d0 = 0; d0 < 4; ++d0) { const f32x4 ka = *(const LAS f32x4*)(km + d0 * 16), kb = *(const LAS f32x4*)(km + d0 * 16 + 4); const bf16x8 qq = qr[d0];
                g += bf2f((bf16)qq[0]) * ka.x + bf2f((bf16)qq[1]) * ka.y + bf2f((bf16)qq[2]) * ka.z + bf2f((bf16)qq[3]) * ka.w + bf2f((bf16)qq[4]) * kb.x + bf2f((bf16)qq[5]) * kb.y + bf2f((bf16)qq[6]) * kb.z + bf2f((bf16)qq[7]) * kb.w; }
            g += __shfl_xor(g, 32);
            if (g > v1) { v3 = v2; i3 = i2; v2 = v1; i2 = i1; v1 = g; i1 = j; } else if (g > v2) { v3 = v2; i3 = i2; v2 = g; i2 = j; } else if (g > v3) { v3 = g; i3 = j; } }
        if (i1 >= 0) keep |= 1u << i1; if (i2 >= 0) keep |= 1u << i2; if (i3 >= 0) keep |= 1u << i3;
    }
    float l_reg = 0.f; f32x16 o[2];
#pragma unroll
    for (int r = 0; r < 16; ++r) { o[0][r] = 0.f; o[1][r] = 0.f; }
    f32x16 cfar;
    { const float cf = -ref;
#pragma unroll
      for (int r = 0; r < 16; ++r) cfar[r] = (MODE == 2) ? cf : 0.f; }
#define AT_WAIT() do { if (DQK == 96 && wid < 4) asm volatile("s_waitcnt vmcnt(6) lgkmcnt(0)" ::: "memory"); \
        else if (MODE == 1) asm volatile("s_waitcnt vmcnt(6) lgkmcnt(0)" ::: "memory"); else asm volatile("s_waitcnt vmcnt(4) lgkmcnt(0)" ::: "memory"); } while (0)
#pragma unroll
    for (int d0 = 0; d0 < ND0; ++d0) asm volatile("" : "+v"(qr[d0]));
    asm volatile("" : "+v"(cfar)); asm volatile("" : "+v"(keep));
    asm volatile("s_waitcnt vmcnt(0) lgkmcnt(0)" ::: "memory");
    __builtin_amdgcn_s_barrier();
    for (int t = 0; t < NT; ++t) {
        const int bufi = t & (NSTG - 1);
        if (t + 3 < NT) AT_DMA(t + 3, (t + 3) & (NSTG - 1));
        bool active = t <= tdiag;
        bool lane_keep = true;
        if (MODE == 0) { const int jb = t >> 2; lane_keep = (jb == blk) || ((keep >> jb) & 1u); active = active && (__ballot(lane_keep) != 0ull); }
        if (active) {
            f32x16 p0, p1;
            const lds_cptr kp = shm3 + L_K + bufi * KBUF + hi * 1024 + r32 * 16;
            bf16x8 kf[2 * ND0];
#pragma unroll
            for (int d0 = 0; d0 < ND0; ++d0) { kf[2 * d0] = *(const __attribute__((address_space(3))) bf16x8*)(kp + d0 * 2048); kf[2 * d0 + 1] = *(const __attribute__((address_space(3))) bf16x8*)(kp + d0 * 2048 + 512); }
            v2u mwv = {0u, 0u}; if (MODE == 1) mwv = *(const LAS v2u*)(lds + L_M + bufi * MBUF + wid * 256 + r32 * 8);
            __builtin_amdgcn_sched_barrier(0);
            if (MODE != 2) { const LAS float* tb = tab + (q - 64 * t - 4 * hi);
#pragma unroll
                for (int r = 0; r < 16; ++r) { const int c = (r & 3) + 8 * (r >> 2); p0[r] = tb[-c]; p1[r] = tb[-c - 32]; }
#pragma unroll
                for (int d0 = 0; d0 < ND0; ++d0) { p0 = __builtin_amdgcn_mfma_f32_32x32x16_bf16(kf[2 * d0], qr[d0], p0, 0, 0, 0); p1 = __builtin_amdgcn_mfma_f32_32x32x16_bf16(kf[2 * d0 + 1], qr[d0], p1, 0, 0, 0); } }
            else {
                p0 = __builtin_amdgcn_mfma_f32_32x32x16_bf16(kf[0], qr[0], cfar, 0, 0, 0); p1 = __builtin_amdgcn_mfma_f32_32x32x16_bf16(kf[1], qr[0], cfar, 0, 0, 0);
#pragma unroll
                for (int d0 = 1; d0 < ND0; ++d0) { p0 = __builtin_amdgcn_mfma_f32_32x32x16_bf16(kf[2 * d0], qr[d0], p0, 0, 0, 0); p1 = __builtin_amdgcn_mfma_f32_32x32x16_bf16(kf[2 * d0 + 1], qr[d0], p1, 0, 0, 0); } }
            const lds_cptr vp = shm3 + L_V + bufi * VBUF + ((lane >> 4) & 1) * 32 + (lane & 3) * 8 + (4 * hi + ((lane & 15) >> 2)) * 64;
            bf16x8 vf[4];
#pragma unroll
            for (int i = 0; i < 4; ++i) { const s16x4 lo = vtr(vp + i * 1024), hh = vtr(vp + i * 1024 + 512); vf[i] = (bf16x8){lo[0], lo[1], lo[2], lo[3], hh[0], hh[1], hh[2], hh[3]}; }
            __builtin_amdgcn_sched_barrier(0);
#pragma unroll
            for (int r = 0; r < 16; ++r) { p0[r] = __builtin_amdgcn_exp2f(p0[r]); p1[r] = __builtin_amdgcn_exp2f(p1[r]); }
            if (MODE != 1 && t == tdiag) { const int kb = 64 * t + 4 * hi;
#pragma unroll
                for (int r = 0; r < 16; ++r) { const int kv = kb + (r & 3) + 8 * (r >> 2); if (kv > q) p0[r] = 0.f; if (kv + 32 > q) p1[r] = 0.f; } }
            if (MODE == 1) { const unsigned wl = mwv.x >> (4 * hi), wh = mwv.y >> (4 * hi);
#pragma unroll
                for (int r = 0; r < 16; ++r) { int m0, m1;
                    asm("v_bfe_i32 %0, %1, %2, 1" : "=v"(m0) : "v"(wl), "n"((r & 3) + 8 * (r >> 2))); asm("v_bfe_i32 %0, %1, %2, 1" : "=v"(m1) : "v"(wh), "n"((r & 3) + 8 * (r >> 2)));
                    p0[r] = __uint_as_float(__float_as_uint(p0[r]) & (unsigned)m0); p1[r] = __uint_as_float(__float_as_uint(p1[r]) & (unsigned)m1); } }
            float sacc = 0.f;
#pragma unroll
            for (int r = 0; r < 16; ++r) sacc += p0[r] + p1[r];
            const unsigned kmask = (MODE == 0 && !lane_keep) ? 0u : 0xffffffffu;
            l_reg += (MODE == 0 && !lane_keep) ? 0.f : sacc;
            v4u pw[4];
#pragma unroll
            for (int k = 0; k < 2; ++k) { pw[k].x = cvtpk(p0[8 * k], p0[8 * k + 1]); pw[k].y = cvtpk(p0[8 * k + 2], p0[8 * k + 3]); pw[k].z = cvtpk(p0[8 * k + 4], p0[8 * k + 5]); pw[k].w = cvtpk(p0[8 * k + 6], p0[8 * k + 7]);
                pw[2 + k].x = cvtpk(p1[8 * k], p1[8 * k + 1]); pw[2 + k].y = cvtpk(p1[8 * k + 2], p1[8 * k + 3]); pw[2 + k].z = cvtpk(p1[8 * k + 4], p1[8 * k + 5]); pw[2 + k].w = cvtpk(p1[8 * k + 6], p1[8 * k + 7]); }
            if (MODE == 0) {
#pragma unroll
                for (int k = 0; k < 4; ++k) { pw[k].x &= kmask; pw[k].y &= kmask; pw[k].z &= kmask; pw[k].w &= kmask; } }
            bf16x8 vg[4];
#pragma unroll
            for (int i = 0; i < 4; ++i) { const s16x4 lo = vtr(vp + 4096 + i * 1024), hh = vtr(vp + 4096 + i * 1024 + 512); vg[i] = (bf16x8){lo[0], lo[1], lo[2], lo[3], hh[0], hh[1], hh[2], hh[3]}; }
#pragma unroll
            for (int i = 0; i < 4; ++i) o[0] = __builtin_amdgcn_mfma_f32_32x32x16_bf16(__builtin_bit_cast(bf16x8, pw[i]), vf[i], o[0], 0, 0, 0);
#pragma unroll
            for (int i = 0; i < 4; ++i) o[1] = __builtin_amdgcn_mfma_f32_32x32x16_bf16(__builtin_bit_cast(bf16x8, pw[i]), vg[i], o[1], 0, 0, 0);
        }
        if (t + 3 < NT) AT_WAIT(); else asm volatile("s_waitcnt vmcnt(0) lgkmcnt(0)" ::: "memory");
        __builtin_amdgcn_s_barrier();
    }
#undef AT_WAIT
    l_reg += __shfl_xor(l_reg, 32);
    if (hi == 0) wsf[r32] = l_reg;
    LDS_WAIT();
    float rli[16];
#pragma unroll
    for (int r = 0; r < 16; ++r) rli[r] = __builtin_amdgcn_rcpf(wsf[crow(r, hi)]);
    bf16* Ow = P.O + (rowbase + qw) * 1024 + P.ocol0 + h * 64;
    { LAS bf16* stg = (LAS bf16*)(lds + L_OST) + wid * 2048;
#pragma unroll
      for (int r = 0; r < 16; ++r) { const int orow = crow(r, hi);
#pragma unroll
          for (int d0 = 0; d0 < 2; ++d0) stg[orow * 64 + d0 * 32 + r32] = f2bf(o[d0][r] * rli[r]); }
      LDS_WAIT();
#pragma unroll
      for (int i = 0; i < 4; ++i) { const int row = i * 8 + (lane >> 3), ch = lane & 7; const v4u v = *(const LAS v4u*)(stg + row * 64 + ch * 8); *(v4u*)(Ow + (size_t)row * 1024 + ch * 8) = v; } }
    asm volatile("s_waitcnt lgkmcnt(0)" ::: "memory"); __builtin_amdgcn_s_barrier();
#undef AT_DMA
}
}

__device__ __forceinline__ void ph_attn_l0(Frame& F) {
    const bf16* QKV = F.w<bf16>(WS_QKV0);
    at::AttnP PM{QKV + C_MQ, QKV_LD, 64, QKV + C_MK, QKV_LD, 64, QKV + C_MV, QKV_LD, 64, F.w<bf16>(WS_O), 0, F.in[I_RELB], 0, F.w<float>(WS_KMEAN), nullptr, F.w<float>(WS_REFS), F.in[I_MQN], nullptr};
    at::AttnP PD{QKV + C_DQ, QKV_LD, 64, QKV + C_DK, QKV_LD, 64, QKV + C_DV, QKV_LD, 64, F.w<bf16>(WS_O), 512, F.in[I_RELB], 8, nullptr, F.w<unsigned long long>(WS_MASKT), F.w<float>(WS_REFS), F.in[I_DQN], nullptr};
    const int vcu = (F.G % 8 == 0) ? (F.bid % 8) * (F.G / 8) + F.bid / 8 : F.bid;
    for (int v = vcu; v < 256; v += F.G) { const int bh = v >> 3, s = v & 7, b = bh >> 3, h = bh & 7;
        at::attn_unit<0, 64>(F, PM, b, h, 15 - s, true); moe_convert_slice(F, 0); at::attn_unit<0, 64>(F, PM, b, h, s, false);
        at::attn_unit<1, 64>(F, PD, b, h, 15 - s, true); moe_convert_slice(F, 1); at::attn_unit<1, 64>(F, PD, b, h, s, false); }
}
__device__ __forceinline__ void ph_attn_mla(Frame& F) {
    at::AttnP PA{F.w<bf16>(WS_QR), QR_LD, 96, F.w<bf16>(WS_KM), QR_LD, 96, F.w<bf16>(WS_KVR) + 64, KVR_LD, 128, F.w<bf16>(WS_O1), 0, nullptr, 0, nullptr, nullptr, F.w<float>(WS_REFS), F.in[I_MLAQN], F.w<float2>(WS_ROPE)};
    const int vcu = (F.G % 8 == 0) ? (F.bid % 8) * (F.G / 8) + F.bid / 8 : F.bid;
    for (int v = vcu; v < 256; v += F.G) { const int bh = v >> 2, s = v & 3, b = bh >> 4, h = bh & 15;
        const bool rev = (bh & 1) != 0; const int q0 = rev ? s : 15 - s, q1 = rev ? 11 - s : 4 + s, q2 = rev ? 4 + s : 11 - s, q3 = rev ? 15 - s : s;
        at::attn_unit<2, 96>(F, PA, b, h, q0, false); moe_convert_slice(F, 2); at::attn_unit<2, 96>(F, PA, b, h, q1, false);
        at::attn_unit<2, 96>(F, PA, b, h, q2, false); moe_convert_slice(F, 3); at::attn_unit<2, 96>(F, PA, b, h, q3, false); }
}

namespace ix {
constexpr int HP = 1028;
constexpr int L_HIST = 0, L_ROW = 32 * HP * 4;
constexpr int MP = 129;
constexpr int L_GE = 0, L_EQ = 32 * MP * 4;
static_assert(L_ROW + 3 * 32 * 4 <= LDSCTL_OFF && L_EQ + 32 * MP * 4 <= L_ROW, "index LDS map");

__device__ __forceinline__ float irelu(float x) { const int i = __float_as_int(x); return __int_as_float(i > 0 ? i : 0); }
__device__ __forceinline__ float mul_s(float a, float b) { float d; asm("v_mul_f32_e32 %0, %1, %2" : "=v"(d) : "v"(a), "v"(b)); return d; }
__device__ __forceinline__ float fma_s(float a, float b, float c) { float d; asm("v_fma_f32 %0, %1, %2, %3" : "=v"(d) : "v"(a), "v"(b), "v"(c)); return d; }
__device__ __forceinline__ void hadd0(unsigned base, unsigned u, unsigned k65535) { unsigned a, v;
    asm volatile("v_lshrrev_b32_e32 %0, 22, %2\n\tv_bfe_u32 %1, %2, 21, 1\n\tv_lshl_add_u32 %0, %0, 2, %3\n\tv_mad_u32_u24 %1, %1, %4, 1\n\tds_add_u32 %0, %1"
                 : "=&v"(a), "=&v"(v) : "v"(u), "v"(base), "s"(k65535) : "memory"); }
__device__ __forceinline__ void hadd1(unsigned base, unsigned u, unsigned pre, unsigned k65535, unsigned k1024) { unsigned a, v, t;
    asm volatile("v_lshrrev_b32_e32 %2, 21, %3\n\tv_bfe_u32 %0, %3, 11, 10\n\tv_cmp_eq_u32_e32 vcc, %2, %5\n\tv_bfe_u32 %1, %3, 10, 1\n\tv_mad_u32_u24 %1, %1, %6, 1\n\tv_cndmask_b32_e32 %0, %7, %0, vcc\n\tv_lshl_add_u32 %0, %0, 2, %4\n\tds_add_u32 %0, %1"
                 : "=&v"(a), "=&v"(v), "=&v"(t) : "v"(u), "v"(base), "v"(pre), "s"(k65535), "v"(k1024) : "memory", "vcc"); }
__device__ __forceinline__ void push2(unsigned& ge, unsigned& gt, unsigned xa, unsigned xb, unsigned cge, unsigned cgt) { unsigned long long s0, s1, s2;
    asm("v_cmp_ge_u32_e64 %2, %5, %7\n\tv_cmp_ge_u32_e64 %3, %5, %8\n\tv_cmp_ge_u32_e64 %4, %6, %7\n\tv_cmp_ge_u32_e32 vcc, %6, %8\n\t"
        "v_addc_co_u32_e64 %0, %2, %0, %0, %2\n\tv_addc_co_u32_e64 %1, %3, %1, %1, %3\n\tv_addc_co_u32_e64 %0, %4, %0, %0, %4\n\tv_addc_co_u32_e32 %1, vcc, %1, %1, vcc"
        : "+v"(ge), "+v"(gt), "=&s"(s0), "=&s"(s1), "=&s"(s2) : "v"(xa), "v"(xb), "v"(cge), "v"(cgt) : "vcc"); }

template <int PASS, int VAR>
__device__ __forceinline__ void tile(bf16x8 (&kf)[4], const bf16* knext, const bf16x8 (&qf)[4][4], const f32x2_t (&w2)[4], bool diag, int kt, int r32, int hi, LAS unsigned* hist, unsigned hbase, unsigned mypre, unsigned Fx, unsigned Cge, unsigned Cgt) {
    const f32x16 zero16 = {0.f, 0.f, 0.f, 0.f, 0.f, 0.f, 0.f, 0.f, 0.f, 0.f, 0.f, 0.f, 0.f, 0.f, 0.f, 0.f};
    unsigned u[16];
    if (VAR & 2) {
#pragma unroll
        for (int r = 0; r < 16; ++r) u[r] = __builtin_bit_cast(v4u, kf[r & 3])[r >> 2];
    } else {
        float sc[16];
        { f32x16 a0, a1;
          a0 = __builtin_amdgcn_mfma_f32_32x32x16_bf16(kf[0], qf[0][0], zero16, 0, 0, 0); a1 = __builtin_amdgcn_mfma_f32_32x32x16_bf16(kf[0], qf[1][0], zero16, 0, 0, 0);
#pragma unroll
          for (int d0 = 1; d0 < 4; ++d0) { a0 = __builtin_amdgcn_mfma_f32_32x32x16_bf16(kf[d0], qf[0][d0], a0, 0, 0, 0); a1 = __builtin_amdgcn_mfma_f32_32x32x16_bf16(kf[d0], qf[1][d0], a1, 0, 0, 0); }
#pragma unroll
          for (int r = 0; r < 16; ++r) sc[r] = fma_s(irelu(a1[r]), w2[1].x, mul_s(irelu(a0[r]), w2[0].x)); }
        { f32x16 a2, a3;
          a2 = __builtin_amdgcn_mfma_f32_32x32x16_bf16(kf[0], qf[2][0], zero16, 0, 0, 0); a3 = __builtin_amdgcn_mfma_f32_32x32x16_bf16(kf[0], qf[3][0], zero16, 0, 0, 0);
#pragma unroll
          for (int d0 = 1; d0 < 4; ++d0) { a2 = __builtin_amdgcn_mfma_f32_32x32x16_bf16(kf[d0], qf[2][d0], a2, 0, 0, 0); a3 = __builtin_amdgcn_mfma_f32_32x32x16_bf16(kf[d0], qf[3][d0], a3, 0, 0, 0); }
#pragma unroll
          for (int d0 = 0; d0 < 4; ++d0) { if (!(VAR & 8)) kf[d0] = *(const bf16x8*)(knext + d0 * 512); }
#pragma unroll
          for (int r = 0; r < 16; ++r) sc[r] = fma_s(irelu(a3[r]), w2[3].x, fma_s(irelu(a2[r]), w2[2].x, sc[r])); }
#pragma unroll
        for (int r = 0; r < 16; ++r) u[r] = __float_as_uint(sc[r]);
    }
    if (diag) {
#pragma unroll
        for (int r = 0; r < 16; ++r) { const int c = (r & 3) + 8 * (r >> 2) + 4 * hi; u[r] = (c <= r32) ? u[r] : 0xffffffffu; } }
    if (PASS == 0) {
#pragma unroll
        for (int r = 0; r < 16; ++r) { if (VAR & 1) asm volatile("" :: "v"(u[r])); else hadd0(hbase, u[r], 65535u); }
    } else if (PASS == 1) {
#pragma unroll
        for (int r = 0; r < 16; ++r) { if (VAR & 1) asm volatile("" :: "v"(u[r])); else hadd1(hbase, u[r], mypre, 65535u, 1024u); }
    } else {
        unsigned ge = 0u, gt = 0u;
#pragma unroll
        for (int r = 15; r >= 1; r -= 2) { push2(ge, gt, u[r] ^ Fx, u[r - 1] ^ Fx, Cge, Cgt); if ((r & 3) == 1 && r > 1) { ge <<= 4; gt <<= 4; } }
        ge <<= 4 * hi; gt <<= 4 * hi; const unsigned eq = ge & ~gt;
        if (ge) atomicOr((unsigned*)(hist + r32 * MP + kt), ge);
        if (eq) atomicOr((unsigned*)(hist + 32 * MP + r32 * MP + kt), eq);
    }
}
template <int PASS, int VAR>
__device__ __forceinline__ void pass_loop(const bf16x8 (&qf)[4][4], const f32x2_t (&w2)[4], const bf16* kbase, int KT, int wid, int r32, int hi, LAS unsigned* hist, unsigned mypre) {
    const unsigned hbase = (unsigned)(size_t)(hist + r32 * HP);
    unsigned Fx = 0u, Cge = 0u, Cgt = 0u;
    if (PASS == 2) { const unsigned Tlo = mypre << 10; const bool neg = (mypre >> 21) & 1u;
        Fx = neg ? 0xffffffffu : 0x80000000u; Cge = neg ? ~(Tlo | 1023u) : (Tlo ^ 0x80000000u); Cgt = neg ? (~Tlo + 1u) : ((Tlo + 1024u) ^ 0x80000000u); }
    bf16x8 ka[4], kb[4];
    { const bf16* kr = kbase + (size_t)(wid < KT ? wid : 0) * 2048; const bf16* kr2 = kbase + (size_t)(wid + NWAVES < KT ? wid + NWAVES : 0) * 2048;
#pragma unroll
      for (int d0 = 0; d0 < 4; ++d0) ka[d0] = *(const bf16x8*)(kr + d0 * 512);
#pragma unroll
      for (int d0 = 0; d0 < 4; ++d0) kb[d0] = *(const bf16x8*)(kr2 + d0 * 512); }
    int kt = wid;
#pragma unroll 1
    for (; kt + NWAVES < KT; kt += 2 * NWAVES) {
        tile<PASS, VAR>(ka, kbase + (size_t)(kt + 2 * NWAVES < KT ? kt + 2 * NWAVES : kt) * 2048, qf, w2, false, kt, r32, hi, hist, hbase, mypre, Fx, Cge, Cgt);
        tile<PASS, VAR>(kb, kbase + (size_t)(kt + 3 * NWAVES < KT ? kt + 3 * NWAVES : kt) * 2048, qf, w2, kt + NWAVES == KT - 1, kt + NWAVES, r32, hi, hist, hbase, mypre, Fx, Cge, Cgt);
    }
    if (kt < KT) tile<PASS, VAR>(ka, kbase + (size_t)kt * 2048, qf, w2, kt == KT - 1, kt, r32, hi, hist, hbase, mypre, Fx, Cge, Cgt);
    asm volatile("s_waitcnt lgkmcnt(0)" ::: "memory");
}

template <int VAR>
__device__ __forceinline__ void dsa_index_unit(Frame& F, int b, int qt) {
    const int tid = F.tid, lane = F.lane, r32 = lane & 31, hi = lane >> 5, wid = F.wave;
    const int q0 = qt * 32, q = q0 + r32, KT = qt + 1;
    const bf16* QKV = F.w<bf16>(WS_QKV0); unsigned long long* maskt = F.w<unsigned long long>(VAR ? WS_H : WS_MASKT);
    LAS unsigned* hist = (LAS unsigned*)(F.lds + ix::L_HIST); LAS unsigned* rowi = (LAS unsigned*)(F.lds + ix::L_ROW);
    LAS unsigned* pre = rowi; LAS unsigned* krem = rowi + 32; LAS unsigned* cnteq = rowi + 64;
    const bf16* qrow = QKV + (size_t)(b * SEQ + q) * QKV_LD;
    bf16x8 qf[4][4];
#pragma unroll
    for (int h = 0; h < 4; ++h)
#pragma unroll
        for (int d0 = 0; d0 < 4; ++d0) qf[h][d0] = *(const bf16x8*)(qrow + C_IQ + h * 64 + d0 * 16 + hi * 8);
    f32x2_t w2[4];
    { const v2u wr = *(const v2u*)(qrow + C_IW); const float w0 = __uint_as_float(wr.x << 16), w1 = __uint_as_float(wr.x & 0xffff0000u), w2f = __uint_as_float(wr.y << 16), w3 = __uint_as_float(wr.y & 0xffff0000u);
      w2[0] = (f32x2_t){w0, w0}; w2[1] = (f32x2_t){w1, w1}; w2[2] = (f32x2_t){w2f, w2f}; w2[3] = (f32x2_t){w3, w3}; }
    for (int i = tid; i < 32 * ix::HP; i += NTHR) hist[i] = 0u;
    if (tid < 32) { pre[tid] = 0u; const int n = q0 + tid + 1; krem[tid] = (unsigned)(n < 256 ? n : 256); cnteq[tid] = 0u; }
    __syncthreads();
    const bf16* kbase = F.w<bf16>(WS_IKT) + (size_t)(b * 128) * 2048 + hi * 256 + r32 * 8;
#pragma unroll 1
    for (int pass = 0; pass < 3; ++pass) {
        const unsigned mypre = pre[r32];
        if (pass == 2) { __syncthreads(); for (int i = tid; i < 2 * 32 * ix::MP; i += NTHR) hist[i] = 0u; __syncthreads(); }
        if (pass == 0) pass_loop<0, VAR>(qf, w2, kbase, KT, wid, r32, hi, hist, mypre);
        else if (pass == 1) pass_loop<1, VAR>(qf, w2, kbase, KT, wid, r32, hi, hist, mypre);
        else pass_loop<2, VAR>(qf, w2, kbase, KT, wid, r32, hi, hist, mypre);
        __syncthreads();
        if (pass < 2) {
#pragma unroll 1
            for (int rr = 0; rr < 4; ++rr) { const int row = wid * 4 + rr; const unsigned rowpre = pre[row];
                const bool neg = (pass == 0) ? (lane < 32) : (rowpre >= 1024u); const int rl = (pass == 0) ? (neg ? 63 - lane : lane - 32) : (neg ? 63 - lane : lane);
                const LAS unsigned* hr = hist + row * ix::HP + rl * 16;
                unsigned wr[16], wv[16]; unsigned total = 0u;
#pragma unroll
                for (int i = 0; i < 16; ++i) wr[i] = hr[i];
#pragma unroll
                for (int i = 0; i < 16; ++i) { wv[i] = neg ? __builtin_amdgcn_alignbit(wr[15 - i], wr[15 - i], 16) : wr[i]; total += (wv[i] & 0xffffu) + (wv[i] >> 16); }
                unsigned S = total;
#pragma unroll
                for (int off = 1; off < 64; off <<= 1) { const unsigned v = __shfl_down(S, off); if (lane + off < 64) S += v; }
                const unsigned k = krem[row], above = S - total;
                if (S >= k && above < k) { unsigned run = above, bstar = 0u, newk = 0u, cnt = 0u; bool done = false;
#pragma unroll
                    for (int i = 15; i >= 0; --i) { const unsigned ch = wv[i] >> 16, cl = wv[i] & 0xffffu;
                        if (!done) { if (run + ch >= k) { bstar = 32u * lane + 2u * i + 1u; newk = k - run; cnt = ch; done = true; } else run += ch; }
                        if (!done) { if (run + cl >= k) { bstar = 32u * lane + 2u * i; newk = k - run; cnt = cl; done = true; } else run += cl; } }
                    const unsigned braw = (pass == 0) ? (bstar >= 1024u ? bstar - 1024u : 2047u - bstar) : (neg ? 2047u - bstar : bstar);
                    pre[row] = (rowpre << 11) | braw; krem[row] = newk; cnteq[row] = cnt; } }
            __syncthreads();
            if (pass < 1) { for (int i = tid; i < 32 * ix::HP; i += NTHR) hist[i] = 0u; __syncthreads(); }
        }
    }
#pragma unroll 1
    for (int rr = 0; rr < 4; ++rr) { const int row = wid * 4 + rr; const unsigned need = krem[row], ce = cnteq[row];
        if (need < ce) { LAS unsigned* g = hist + row * ix::MP; LAS unsigned* e = hist + 32 * ix::MP + row * ix::MP;
            const unsigned e0 = e[2 * lane], e1 = e[2 * lane + 1]; const int c0 = __popc(e0), c1 = __popc(e1), c = c0 + c1; int incl = c;
#pragma unroll
            for (int off = 1; off < 64; off <<= 1) { const int v = __shfl_up(incl, off); if (lane >= off) incl += v; }
            int rem = (int)need - (incl - c); rem = rem < 0 ? 0 : (rem > c ? c : rem);
            const int k0 = rem < c0 ? rem : c0, k1 = rem - k0;
            unsigned y0 = e0; for (int i = 0; i < k0; ++i) y0 &= y0 - 1u;
            unsigned y1 = e1; for (int i = 0; i < k1; ++i) y1 &= y1 - 1u;
            g[2 * lane] &= ~y0; g[2 * lane + 1] &= ~y1; } }
    __syncthreads();
    for (int idx = tid; idx < 32 * 64; idx += NTHR) { const int qq = idx & 31, t = idx >> 5;
        const unsigned lo = hist[qq * ix::MP + 2 * t], hh = hist[qq * ix::MP + 2 * t + 1];
        maskt[((size_t)(b * 64 + t) * SEQ) + q0 + qq] = (unsigned long long)lo | ((unsigned long long)hh << 32); }
    __syncthreads();
}
}
template <int VAR>
__device__ __forceinline__ void ph_dsa_index(Frame& F) {
    for (int v = F.bid; v < 256; v += F.G) { const int b = v >> 6, i = v & 63; ix::dsa_index_unit<VAR>(F, b, 127 - i); ix::dsa_index_unit<VAR>(F, b, i); }
}

#define XB_TMO      128
#define XB_XCNT(j)  (256  + 64 * (j))
#define XB_XSUB(j)  (1280 + 64 * (j))
#define XB_XGEN(j)  (2304 + 64 * (j))
#define XB_TOP      3328
#define XB_TOPGEN   3392
#define XCD_BAR_WORDS 3456
#define XB_SPIN_CAP (1u << 18)

__device__ __forceinline__ unsigned xb_ld(unsigned* p)              { return __hip_atomic_load(p, __ATOMIC_RELAXED, __HIP_MEMORY_SCOPE_AGENT); }
__device__ __forceinline__ unsigned xb_add(unsigned* p, unsigned v) { return __hip_atomic_fetch_add(p, v, __ATOMIC_RELAXED, __HIP_MEMORY_SCOPE_AGENT); }
__device__ __forceinline__ unsigned xb_xcc_id() { return (unsigned)__builtin_amdgcn_s_getreg((3 << 11) | 20) & 0xFu; }
#define XB_SPIN(cond, bar) do { unsigned _sp = 0; while (cond) { __builtin_amdgcn_s_sleep(1); \
    if ((++_sp & 255u) == 0u) { if (xb_ld(&(bar)[XB_TMO])) break; if (_sp > XB_SPIN_CAP) { atomicAdd(&(bar)[XB_TMO], 1u); break; } } } } while (0)

struct XcdBarrier {
    unsigned* bar; unsigned x;
    volatile LAS unsigned* st;
};

__device__ __forceinline__ XcdBarrier xcd_barrier_post(unsigned* bar, volatile LAS unsigned* st) {
    XcdBarrier b; b.bar = bar; b.x = xb_xcc_id(); b.st = st;
    if (threadIdx.x == 0) (void)xb_add(&bar[XB_XCNT(b.x)], 1u);
    return b;
}
__device__ __forceinline__ void xcd_barrier_complete(unsigned* bar, unsigned x, unsigned& nloc, unsigned& nx) {
    const unsigned G = gridDim.x * gridDim.y * gridDim.z;
    unsigned sum, cnt, mine, sp = 0u;
    for (;;) {
        sum = 0u; cnt = 0u; mine = 0u;
#pragma unroll
        for (unsigned j = 0; j < 16; ++j) { const unsigned c = xb_ld(&bar[XB_XCNT(j)]); sum += c; cnt += (c > 0u) ? 1u : 0u; mine = (j == x) ? c : mine; }
        if (sum == G) break;
        __builtin_amdgcn_s_sleep(1);
        if ((++sp & 255u) == 0u) { if (xb_ld(&bar[XB_TMO])) break; if (sp > XB_SPIN_CAP) { atomicAdd(&bar[XB_TMO], 1u); break; } }
    }
    nloc = mine > 0u ? mine : 1u; nx = cnt > 0u ? cnt : 1u;
}

__device__ __forceinline__ void xcd_barrier(const XcdBarrier& b) {
    asm volatile("s_waitcnt vmcnt(0)" ::: "memory");
    __syncthreads();
    if (threadIdx.x == 0) {
        unsigned* bar = b.bar;
        __builtin_amdgcn_s_waitcnt(0);
        unsigned nloc = b.st[0], nx = b.st[1];
        if (nloc == 0u) { xcd_barrier_complete(bar, b.x, nloc, nx); b.st[0] = nloc; b.st[1] = nx; }
        const unsigned old = xb_add(&bar[XB_XSUB(b.x)], 1u);
        const unsigned gen = old / nloc;
        if (old + 1u == (gen + 1u) * nloc) {
            __builtin_amdgcn_fence(__ATOMIC_RELEASE, "agent");
            asm volatile("s_waitcnt vmcnt(0)" ::: "memory");
            const unsigned og = xb_add(&bar[XB_TOP], 1u);
            const unsigned tg = og / nx;
            if (og + 1u == (tg + 1u) * nx) xb_add(&bar[XB_TOPGEN], 1u);
            else XB_SPIN(xb_ld(&bar[XB_TOPGEN]) == tg, bar);
            __builtin_amdgcn_fence(__ATOMIC_ACQUIRE, "agent");
            xb_add(&bar[XB_XGEN(b.x)], 1u);
            asm volatile("s_waitcnt vmcnt(0)" ::: "memory");
        } else {
            XB_SPIN(xb_ld(&bar[XB_XGEN(b.x)]) == gen, bar);
            __builtin_amdgcn_fence(__ATOMIC_ACQUIRE, "agent");
            asm volatile("s_waitcnt vmcnt(0)" ::: "memory");
        }
    }
    __syncthreads();
}

constexpr int NPHASE = 20;
constexpr int CW_BAR = 4096;
#ifndef HAVE_ATTN
#define HAVE_ATTN 0
#endif
#ifndef HAVE_INDEX
#define HAVE_INDEX 0
#endif

__global__ void __launch_bounds__(NTHR, 2) mega(Args args) {
    extern __shared__ __attribute__((aligned(16))) unsigned char lds_raw[];
    Frame F; F.lds = (LAS unsigned char*)lds_raw; F.tid = threadIdx.x; F.lane = F.tid & 63; F.wave = __builtin_amdgcn_readfirstlane(F.tid >> 6);
    F.G = gridDim.x; F.bid = blockIdx.x; F.in = args.in; F.out = args.out; F.ws = args.ws;
    volatile LAS unsigned* MISC = (volatile LAS unsigned*)(F.lds + LDSCTL_OFF);
    for (int u = F.tid; u < 256; u += NTHR) MISC[u] = 0u;
    __syncthreads();
    const int lo = args.ph_lo, hi = args.ph_hi;
    XcdBarrier bar; bar.bar = (unsigned*)(args.ws + WS_CTL) + CW_BAR; bar.x = 0; bar.st = nullptr;
    if (hi - lo > 1) bar = xcd_barrier_post((unsigned*)(args.ws + WS_CTL) + CW_BAR, MISC + 8);
#define IN(k) (lo <= (k) && (k) < hi)
#define SEAM(k) do { if (IN(k) && IN((k) + 1)) xcd_barrier(bar); } while (0)
    PG8_LAS unsigned char* glds = (PG8_LAS unsigned char*)lds_raw;
    const pg8::bf16_t* H = F.w<pg8::bf16_t>(WS_H);

    if (IN(0)) { ph_prologue(F); } SEAM(0);
    if (IN(1)) { pg8::Gemm g{H, F.w<pg8::bf16_t>(WS_W_IN_E), 1024, 1024, 1024}; pg8::StaticOrder S{M_TOK / 256, QKV_LD / 256, F.G, F.bid}; pg8::EpiBf16 E{F.w<pg8::bf16_t>(WS_QKV0), QKV_LD, F.w<pg8::bf16_t>(WS_IKT), C_IK / 256};
        pg8::gemm_phase<pg8::EpiBf16, pg8::StaticOrder, true, false>(glds, g, S, E, nullptr);
        moe_convert_tail(F, 0, MOE_TAIL_A, (M_TOK / 256) * (QKV_LD / 256) % 256); } SEAM(1);
    if (IN(2)) { if (args.sub & 1) ph_qknorm(F);
#if HAVE_INDEX
        if (args.sub & 2) ph_dsa_index<0>(F);
#ifdef IDX_VAR
        if (args.sub & 4) ph_dsa_index<IDX_VAR>(F);
#endif
#endif
    } SEAM(2);
    if (IN(3)) {
#if HAVE_ATTN
        ph_attn_l0(F);
#endif
    } SEAM(3);
    if (IN(4)) { pg8::Gemm g{F.w<pg8::bf16_t>(WS_O), F.w<pg8::bf16_t>(WS_W_OUT_E), 1024, 1024, 1024}; pg8::StaticOrder S{M_TOK / 256, 4, F.G, F.bid}; pg8::EpiResN<false> E{F.in[I_X], F.w<pg8::bf16_t>(WS_H), F.w<float>(WS_SSP), 1024};
        pg8::gemm_phase<pg8::EpiResN<false>, pg8::StaticOrder, false, false>(glds, g, S, E, nullptr); } SEAM(4);
    if (IN(6)) { pg8::Gemm g{H, F.w<pg8::bf16_t>(WS_W_GU_E), 1024, 1024, 1024}; pg8::StaticOrder S{M_TOK / 256, 2 * FF_E / 256, F.G, F.bid}; pg8::EpiSwiGLUS<pg8::ScaleSSP> E{F.w<pg8::bf16_t>(WS_ACT0), FF_E, 1 << 20, {F.w<float>(WS_SSP), EPS}};
        pg8::gemm_phase<pg8::EpiSwiGLUS<pg8::ScaleSSP>, pg8::StaticOrder, true, false>(glds, g, S, E, nullptr);
        moe_convert_tail(F, MOE_TAIL_A, MOE_TAIL_B, (M_TOK / 256) * (2 * FF_E / 256) % 256); } SEAM(6);
    if (IN(7)) { pg8::Gemm g{F.w<pg8::bf16_t>(WS_ACT0), F.w<pg8::bf16_t>(WS_W_DN_E), FF_E, FF_E, FF_E}; pg8::StaticOrder S{M_TOK / 256, 4, F.G, F.bid}; pg8::EpiResN<true> E{nullptr, F.w<pg8::bf16_t>(WS_H), F.w<float>(WS_SSP), 1024};
        pg8::gemm_phase<pg8::EpiResN<true>, pg8::StaticOrder, false, false>(glds, g, S, E, nullptr); } SEAM(7);
    if (IN(9)) { pg8::Gemm g{H, F.w<pg8::bf16_t>(WS_W_IN_O), 1024, 1024, 1024}; pg8::StaticOrder S{M_TOK / 256, C1_LD / 256, F.G, F.bid}; pg8::EpiBf16SL<pg8::ScaleSSP> E{F.w<pg8::bf16_t>(WS_C1), C1_LD, F.w<float>(WS_LSP), {F.w<float>(WS_SSP), EPS}};
        pg8::gemm_phase<pg8::EpiBf16SL<pg8::ScaleSSP>, pg8::StaticOrder, true, false>(glds, g, S, E, nullptr);
        moe_convert_tail(F, MOE_TAIL_A + MOE_TAIL_B, MOE_TAIL_C, (M_TOK / 256) * (C1_LD / 256)); } SEAM(9);
    if (IN(11)) { pg8::Gemm g{F.w<pg8::bf16_t>(WS_C1), F.w<pg8::bf16_t>(WS_W_LAT), C1_LD, W_LAT_LD, 384}; pg8::LatJointOrder S{F.G, F.bid};
        pg8::EpiLatJoint E{F.w<pg8::bf16_t>(WS_QR), F.w<pg8::bf16_t>(WS_KVR), {F.w<float>(WS_LSP), EPS}};
        pg8::gemm_phase<pg8::EpiLatJoint, pg8::LatJointOrder, true, false>(glds, g, S, E, nullptr); } SEAM(11);
    if (IN(12)) { ph_mla_prep(F, F.w<float2>(WS_ROPE)); } SEAM(12);
    if (IN(13)) {
#if HAVE_ATTN
        ph_attn_mla(F);
#endif
    } SEAM(13);
    if (IN(14)) { pg8::Gemm g{F.w<pg8::bf16_t>(WS_O1), F.w<pg8::bf16_t>(WS_W_OUT_O), 1024, 1024, 1024}; pg8::StaticOrder S{M_TOK / 256, 4, F.G, F.bid}; pg8::EpiResN<true> E{nullptr, F.w<pg8::bf16_t>(WS_H), F.w<float>(WS_SSP), 1024};
        pg8::gemm_phase<pg8::EpiResN<true>, pg8::StaticOrder, false, false>(glds, g, S, E, nullptr); } SEAM(14);
    if (IN(15)) { ph_rmsnorm_route(F, F.w<bf16>(WS_H), F.in[I_FFNN_O], F.w<float>(WS_RSTD)); } SEAM(15);
    if (IN(16)) { ph_slots(F); } SEAM(16);
    if (IN(17)) { const int* tile_e = F.w<int>(WS_TILE_E); const int ntile = tile_e[TILE_CAP];
        pg8::Gemm g{H, F.w<pg8::bf16_t>(WS_WGU_O), 1024, 1024, 1024}; pg8::MoeOrder S{tile_e, ntile, 2 * FF_O / 256, F.G, F.bid, 1, 1024, 0}; pg8::EpiSwiGLUS<pg8::ScaleSlot> E{F.w<pg8::bf16_t>(WS_ACT1), FF_O, 2 * FF_O / 256, {F.w<float>(WS_SLOT_RSTD)}};
        pg8::gemm_phase<pg8::EpiSwiGLUS<pg8::ScaleSlot>, pg8::MoeOrder, true, true>(glds, g, S, E, F.w<int>(WS_SLOT_TOK)); } SEAM(17);
    if (IN(18)) { const int* tile_e = F.w<int>(WS_TILE_E); const int ntile = tile_e[TILE_CAP];
        { pg8::Gemm g{F.w<pg8::bf16_t>(WS_ACT1), F.w<pg8::bf16_t>(WS_WDN_O), FF_O, FF_O, FF_O}; pg8::MoeOrder S{tile_e, ntile < MOE_FULL_TILES ? ntile : MOE_FULL_TILES, 4, F.G, F.bid, 1, FF_O, 0};
          pg8::EpiMoeY E{F.w<pg8::bf16_t>(WS_Y), 0, 4, FF_O, 0};
          pg8::gemm_phase<pg8::EpiMoeY, pg8::MoeOrder, true, false>(glds, g, S, E, nullptr); }
        if (ntile > MOE_FULL_TILES) { pg8::Gemm g{F.w<pg8::bf16_t>(WS_ACT1), F.w<pg8::bf16_t>(WS_WDN_O), FF_O, FF_O, FF_O / MOE_TAIL_SPLIT}; pg8::MoeOrder S{tile_e, ntile - MOE_FULL_TILES, 4, F.G, F.bid, MOE_TAIL_SPLIT, FF_O / MOE_TAIL_SPLIT, MOE_FULL_TILES};
          pg8::EpiMoeY E{F.w<pg8::bf16_t>(WS_YP), (size_t)MOE_TAIL_ROWS * 1024, 4, FF_O / MOE_TAIL_SPLIT, MOE_FULL_TILES * 256};
          pg8::gemm_phase<pg8::EpiMoeY, pg8::MoeOrder, true, false>(glds, g, S, E, nullptr); } } SEAM(18);
    if (IN(19)) { ph_moe_combine(F); }
#undef IN
#undef SEAM
}

#ifndef FAST_MASK
#define FAST_MASK 0xFFFFFu
#endif
#ifndef DUP_SUB
#define DUP_SUB 2
#endif
#ifndef ONE_LAUNCH
#define ONE_LAUNCH 0
#endif
struct Ptrs {
    const float* in[N_INPUTS]; float* out; unsigned char* ws;
    template <class T> T* w(size_t off) const { return (T*)(ws + off); }
};
static int g_grid = 0;
static void launch_mega(const Ptrs& P, int lo, int hi, hipStream_t st, int sub = 3) {
    Args a{}; a.sub = sub; for (int i = 0; i < N_INPUTS; ++i) a.in[i] = P.in[i]; a.out = P.out; a.ws = P.ws; a.ph_lo = lo; a.ph_hi = hi;
    hipLaunchKernelGGL(mega, dim3(g_grid), dim3(NTHR), LDS_BYTES, st, a);
    const hipError_t le = hipPeekAtLastError();
    if (le != hipSuccess) fprintf(stderr, "kernel_launch: mega[%d,%d) failed: %s\n", lo, hi, hipGetErrorName(le));
}
#if !ONE_LAUNCH
static void naive_weights(const Ptrs& P, hipStream_t st) {
    auto wt = [&](int idx, int K, int N, int Npad, size_t off, int mode, int nexp, size_t wes, size_t wtes) {
        nv::k_wt<<<dim3((Npad + 31) / 32, K / 32, nexp), 256, 0, st>>>(P.in[idx], K, N, Npad, P.w<bf16>(off), mode, wes, wtes); };
    wt(I_W_IN_E, 1024, N_IN_E, QKV_LD, WS_W_IN_E, 0, 1, 0, 0);
    wt(I_W_OUT_E, 1024, 1024, 1024, WS_W_OUT_E, 0, 1, 0, 0);
    wt(I_W_GATE_E, 1024, FF_E, FF_E, WS_W_GU_E, 1, 1, 0, 0);
    wt(I_W_UP_E, 1024, FF_E, FF_E, WS_W_GU_E, 2, 1, 0, 0);
    wt(I_W_DOWN_E, FF_E, 1024, 1024, WS_W_DN_E, 0, 1, 0, 0);
    wt(I_W_IN_O, 1024, N_IN_O, C1_LD, WS_W_IN_O, 0, 1, 0, 0);
    wt(I_W_UQ, 384, 1536, 1536, WS_W_UQ, 0, 1, 0, 0);
    wt(I_W_UKV, 256, 2048, 2048, WS_W_UKV, 0, 1, 0, 0);
    wt(I_W_OUT_O, 1024, 1024, 1024, WS_W_OUT_O, 0, 1, 0, 0);
    wt(I_W_GATE_O, 1024, FF_O, FF_O, WS_WGU_O, 1, NEXP, (size_t)1024 * FF_O, (size_t)2 * FF_O * 1024);
    wt(I_W_UP_O, 1024, FF_O, FF_O, WS_WGU_O, 2, NEXP, (size_t)1024 * FF_O, (size_t)2 * FF_O * 1024);
    wt(I_W_DOWN_O, FF_O, 1024, 1024, WS_WDN_O, 0, NEXP, (size_t)1024 * FF_O, (size_t)1024 * FF_O);
}
template <int EPI> static void naive_gemm(nv::GemmArgs a, hipStream_t st) { nv::k_gemm<EPI><<<dim3(a.N / 64, a.M / 64), 256, 0, st>>>(a); }
__global__ void k_rope_tab(float2* tab) { const int idx = blockIdx.x * 256 + threadIdx.x; const int pos = idx >> 4, i = idx & 15; const float fr = powf(10000.f, -(float)i / 16.f), ang = (float)pos * fr; tab[idx] = make_float2(cosf(ang), sinf(ang)); }

static void naive_phase(const Ptrs& P, int k, hipStream_t st) {
    bf16* H = P.w<bf16>(WS_H); bf16* QKV = P.w<bf16>(WS_QKV0); bf16* O = P.w<bf16>(WS_O); float* X = P.out;
    bf16* C1 = P.w<bf16>(WS_C1); bf16* QR = P.w<bf16>(WS_QR); bf16* KVR = P.w<bf16>(WS_KVR); bf16* KM = P.w<bf16>(WS_KM); bf16* O1 = P.w<bf16>(WS_O1);
    switch (k) {
    case 0: naive_weights(P, st); k_rope_tab<<<SEQ * 16 / 256, 256, 0, st>>>(P.w<float2>(WS_ROPE)); nv::k_rmsnorm<<<M_TOK / 4, 256, 0, st>>>(P.in[I_X], P.in[I_MIXN_E], H); break;
    case 1: { nv::GemmArgs a{}; a.A = H; a.lda = 1024; a.Bt = P.w<bf16>(WS_W_IN_E); a.K = 1024; a.M = M_TOK; a.N = QKV_LD; a.Cb = QKV; a.ldc = QKV_LD; naive_gemm<0>(a, st); } break;
    case 2: nv::k_kmean<<<NB * 8 * 16, 64, 0, st>>>(QKV, P.in[I_MKN], P.w<float>(WS_KMEAN));
            nv::k_qknorm<<<M_TOK * 32 / 256, 256, 0, st>>>(QKV, P.in[I_MQN], P.in[I_MKN], P.in[I_DQN], P.in[I_DKN]);
            break;
    case 100: nv::k_dsa_index<<<M_TOK, 256, 0, st>>>(QKV, P.w<unsigned long long>(WS_MASKT)); break;
    case 3: { nv::AttnArgs a{}; a.Q = QKV + C_MQ; a.ldq = QKV_LD; a.qhs = 64; a.K = QKV + C_MK; a.ldk = QKV_LD; a.khs = 64; a.V = QKV + C_MV; a.ldv = QKV_LD; a.vhs = 64; a.O = O; a.ocol0 = 0; a.H = 8;
              a.relb = P.in[I_RELB]; a.bcol0 = 0; a.kmean = P.w<float>(WS_KMEAN); a.maskt = nullptr; nv::k_attn<0, 64><<<NB * 8 * SEQ / 4, 256, 0, st>>>(a); }
            { nv::AttnArgs a{}; a.Q = QKV + C_DQ; a.ldq = QKV_LD; a.qhs = 64; a.K = QKV + C_DK; a.ldk = QKV_LD; a.khs = 64; a.V = QKV + C_DV; a.ldv = QKV_LD; a.vhs = 64; a.O = O; a.ocol0 = 512; a.H = 8;
              a.relb = P.in[I_RELB]; a.bcol0 = 8; a.kmean = nullptr; a.maskt = P.w<unsigned long long>(WS_MASKT); nv::k_attn<1, 64><<<NB * 8 * SEQ / 4, 256, 0, st>>>(a); } break;
    case 4: { nv::GemmArgs a{}; a.A = O; a.lda = 1024; a.Bt = P.w<bf16>(WS_W_OUT_E); a.K = 1024; a.M = M_TOK; a.N = 1024; a.Cf = X; a.R = P.in[I_X]; a.ldc = 1024; naive_gemm<1>(a, st); } break;
    case 5: nv::k_rmsnorm<<<M_TOK / 4, 256, 0, st>>>(X, P.in[I_FFNN_E], H); break;
    case 6: { nv::GemmArgs a{}; a.A = H; a.lda = 1024; a.Bt = P.w<bf16>(WS_W_GU_E); a.K = 1024; a.M = M_TOK; a.N = FF_E; a.Cb = P.w<bf16>(WS_ACT0); a.ldc = FF_E; naive_gemm<2>(a, st); } break;
    case 7: { nv::GemmArgs a{}; a.A = P.w<bf16>(WS_ACT0); a.lda = FF_E; a.Bt = P.w<bf16>(WS_W_DN_E); a.K = FF_E; a.M = M_TOK; a.N = 1024; a.Cf = X; a.R = X; a.ldc = 1024; naive_gemm<1>(a, st); } break;
    case 8: nv::k_rmsnorm<<<M_TOK / 4, 256, 0, st>>>(X, P.in[I_MIXN_O], H); break;
    case 9: { nv::GemmArgs a{}; a.A = H; a.lda = 1024; a.Bt = P.w<bf16>(WS_W_IN_O); a.K = 1024; a.M = M_TOK; a.N = C1_LD; a.Cb = C1; a.ldc = C1_LD; naive_gemm<0>(a, st); } break;
    case 10: nv::k_rmsnorm_bf<<<M_TOK / 4, 256, 0, st>>>(C1, C1_LD, C1_CQ, 384, P.in[I_QAN], P.w<bf16>(WS_CQN), 384);
             nv::k_rmsnorm_bf<<<M_TOK / 4, 256, 0, st>>>(C1, C1_LD, C1_CKV, 256, P.in[I_KVAN], P.w<bf16>(WS_CKVN), 256); break;
    case 11: { nv::GemmArgs a{}; a.A = P.w<bf16>(WS_CQN); a.lda = 384; a.Bt = P.w<bf16>(WS_W_UQ); a.K = 384; a.M = M_TOK; a.N = QR_LD; a.Cb = QR; a.ldc = QR_LD; naive_gemm<0>(a, st); }
             { nv::GemmArgs a{}; a.A = P.w<bf16>(WS_CKVN); a.lda = 256; a.Bt = P.w<bf16>(WS_W_UKV); a.K = 256; a.M = M_TOK; a.N = KVR_LD; a.Cb = KVR; a.ldc = KVR_LD; naive_gemm<0>(a, st); } break;
    case 12: nv::k_mla_prep<<<M_TOK * 16 / 256, 256, 0, st>>>(QR, KVR, C1, KM, P.in[I_MLAQN], P.in[I_MLAKN]); break;
    case 13: { nv::AttnArgs a{}; a.Q = QR; a.ldq = QR_LD; a.qhs = 96; a.K = KM; a.ldk = QR_LD; a.khs = 96; a.V = KVR + 64; a.ldv = KVR_LD; a.vhs = 128; a.O = O1; a.ocol0 = 0; a.H = 16;
               nv::k_attn<2, 96><<<NB * 16 * SEQ / 4, 256, 0, st>>>(a); } break;
    case 14: { nv::GemmArgs a{}; a.A = O1; a.lda = 1024; a.Bt = P.w<bf16>(WS_W_OUT_O); a.K = 1024; a.M = M_TOK; a.N = 1024; a.Cf = X; a.R = X; a.ldc = 1024; naive_gemm<1>(a, st); } break;
    case 15: nv::k_rmsnorm_route<<<M_TOK / 4, 256, 0, st>>>(X, P.in[I_FFNN_O], H, P.in[I_W_ROUTER], P.in[I_B_ROUTER], P.w<int2>(WS_ROUTE_E), P.w<float2>(WS_ROUTE_G));
             nv::k_route_count<<<256, 64, 0, st>>>(P.w<int2>(WS_ROUTE_E), P.w<int>(WS_CNT_WG)); break;
    case 16: nv::k_slots<<<256, 64, 0, st>>>(P.w<int2>(WS_ROUTE_E), P.w<float2>(WS_ROUTE_G), P.w<int>(WS_CNT_WG), P.w<int>(WS_SLOT_TOK), P.w<float>(WS_SLOT_GATE), P.w<int>(WS_TILE_E)); break;
    case 17: { nv::GemmArgs a{}; a.A = H; a.lda = 1024; a.Bt = P.w<bf16>(WS_WGU_O); a.K = 1024; a.M = SLOT_CAP; a.N = FF_O; a.Cb = P.w<bf16>(WS_ACT1); a.ldc = FF_O;
               a.tile_e = P.w<int>(WS_TILE_E); a.stok = P.w<int>(WS_SLOT_TOK); a.sgate = P.w<float>(WS_SLOT_GATE); a.b_estride = (size_t)2 * FF_O * 1024; naive_gemm<3>(a, st); } break;
    case 18: { nv::GemmArgs a{}; a.A = P.w<bf16>(WS_ACT1); a.lda = FF_O; a.Bt = P.w<bf16>(WS_WDN_O); a.K = FF_O; a.M = SLOT_CAP; a.N = 1024; a.Cf = X; a.ldc = 1024;
               a.tile_e = P.w<int>(WS_TILE_E); a.stok = P.w<int>(WS_SLOT_TOK); a.sgate = P.w<float>(WS_SLOT_GATE); a.b_estride = (size_t)1024 * FF_O; naive_gemm<4>(a, st); } break;
    }
}
#endif

extern "C" void kernel_launch(void* const* d_in, const int* in_sizes, int n_in, void* d_out, int out_size, void* d_ws, size_t ws_size, hipStream_t stream) {
    if (n_in != N_INPUTS || out_size != M_TOK * DM || ws_size < WS_END) { fprintf(stderr, "kernel_launch: unexpected shapes (n_in %d out %d ws %zu)\n", n_in, out_size, ws_size); return; }
    if (g_grid == 0) {
        int dev = 0, cus = 0, per_cu = 0;
        if (hipGetDevice(&dev) != hipSuccess || hipDeviceGetAttribute(&cus, hipDeviceAttributeMultiprocessorCount, dev) != hipSuccess) { g_grid = -1; return; }
        if (hipFuncSetAttribute((const void*)mega, hipFuncAttributeMaxDynamicSharedMemorySize, LDS_BYTES) != hipSuccess) { fprintf(stderr, "kernel_launch: cannot get %d B of dynamic LDS\n", LDS_BYTES); g_grid = -1; return; }
        if (hipOccupancyMaxActiveBlocksPerMultiprocessor(&per_cu, (const void*)mega, NTHR, LDS_BYTES) != hipSuccess || per_cu < 1) { fprintf(stderr, "kernel_launch: occupancy query says %d\n", per_cu); }
        (void)hipGetLastError();
        g_grid = cus;
    }
    if (g_grid < 0) return;
    Ptrs P{}; for (int i = 0; i < N_INPUTS; ++i) P.in[i] = (const float*)d_in[i]; P.out = (float*)d_out; P.ws = (unsigned char*)d_ws;
    (void)hipMemsetAsync((char*)d_ws + WS_CTL, 0, 65536, stream);
#if ONE_LAUNCH
    launch_mega(P, 0, NPHASE, stream);
#else
    for (int k = 0; k < NPHASE; ++k) { if ((FAST_MASK >> k) & 1u) { launch_mega(P, k, k + 1, stream);
#ifdef DUP_MASK
            for (int rep = 0; rep < DUP_REPS; ++rep) if ((DUP_MASK >> k) & 1u) launch_mega(P, k, k + 1, stream, DUP_SUB);
#endif
        } else naive_phase(P, k, stream);
        if (k == 2 && !(HAVE_INDEX && ((FAST_MASK >> 2) & 1u))) naive_phase(P, 100, stream); }
#endif
}
```

```cpp
#define ONE_LAUNCH 1
#define HAVE_ATTN 1
#define HAVE_INDEX 1
#include <hip/hip_runtime.h>
#include <stdint.h>
#include <stdio.h>

typedef unsigned short bf16;
__device__ __forceinline__ float bf2f(bf16 v) { return __uint_as_float(((unsigned)v) << 16); }
__device__ __forceinline__ bf16 f2bf(float f) { unsigned u = __float_as_uint(f); return (bf16)((u + 0x7fffu + ((u >> 16) & 1u)) >> 16); }
typedef float f32x2_t __attribute__((ext_vector_type(2))); typedef __bf16 bf16x2_t __attribute__((ext_vector_type(2)));
__device__ __forceinline__ unsigned pk2(float lo, float hi) { f32x2_t v = {lo, hi}; bf16x2_t b = __builtin_convertvector(v, bf16x2_t); return __builtin_bit_cast(unsigned, b); }

constexpr int NB = 4, SEQ = 4096, M_TOK = NB * SEQ, DM = 1024;
constexpr int QKV_LD = 3584;
constexpr int C_MQ = 0, C_MK = 512, C_MV = 1024, C_DQ = 1536, C_DK = 2048, C_DV = 2560, C_IQ = 3072, C_IK = 3328, C_IW = 3392, N_IN_E = 3396;
constexpr int FF_E = 2816, FF_O = 3584, NEXP = 8;
constexpr int C1_LD = 768, N_IN_O = 672, C1_CQ = 0, C1_CKV = 384, C1_KPE = 640;
constexpr int QR_LD = 1536, KVR_LD = 2048;
constexpr int SLOT_CAP = 34816, TILE_CAP = 136;
constexpr float EPS = 1e-6f;
constexpr float LOG2E = 1.4426950408889634f;
constexpr float QSCALE64 = 0.125f * LOG2E;
constexpr float QSCALE96 = 0.10206207261596575f * LOG2E;

constexpr size_t MiB = 1u << 20;
constexpr size_t WS_CTL = 0;
constexpr size_t WS_KMEAN = 1 * MiB;
constexpr size_t WS_ROUTE_E = 1 * MiB + 128 * 1024;
constexpr size_t WS_ROUTE_G = 1 * MiB + 256 * 1024;
constexpr size_t WS_CNT_WG = 1 * MiB + 384 * 1024;
constexpr size_t WS_SLOT_TOK = 1 * MiB + 400 * 1024;
constexpr size_t WS_SLOT_GATE = 1 * MiB + 544 * 1024;
constexpr size_t WS_TILE_E = 1 * MiB + 688 * 1024;
constexpr size_t WS_TOK_SLOT = 1 * MiB + 704 * 1024;
constexpr size_t WS_REFS = 1 * MiB + 832 * 1024;
constexpr size_t WS_WDN_O = 2 * MiB;
constexpr size_t WS_WGU_O = 58 * MiB;
constexpr size_t WS_Y = 58 * MiB;
constexpr size_t WS_YP = 128 * MiB;
constexpr int MOE_FULL_TILES = 128, MOE_TAIL_SPLIT = 7, MOE_TAIL_ROWS = SLOT_CAP - MOE_FULL_TILES * 256;
constexpr size_t WS_H = 170 * MiB;
constexpr size_t WS_SCR = 202 * MiB;
constexpr size_t WS_QKV0 = WS_SCR;
constexpr size_t WS_O = 314 * MiB;
constexpr size_t WS_ACT0 = WS_SCR;
constexpr size_t WS_C1 = WS_SCR;
constexpr size_t WS_LSP = 226 * MiB;
constexpr size_t WS_CQN = 228 * MiB;
constexpr size_t WS_CKVN = 238 * MiB;
constexpr size_t WS_KSS = 238 * MiB;
constexpr size_t WS_QR = 246 * MiB;
constexpr size_t WS_KVR = 294 * MiB;
constexpr size_t WS_KM = 358 * MiB;
constexpr size_t WS_IKT = WS_KM;
constexpr size_t WS_O1 = WS_SCR;
constexpr size_t WS_MASKT = 412 * MiB;
constexpr size_t WS_W_IN_E = 420 * MiB;
constexpr size_t WS_W_OUT_E = 427 * MiB;
constexpr size_t WS_W_GU_E = 429 * MiB;
constexpr size_t WS_W_DN_E = 440 * MiB;
constexpr size_t WS_W_IN_O = 446 * MiB;
constexpr size_t WS_W_LAT = 448 * MiB;
constexpr int W_LAT_LD = 640;
constexpr size_t WS_W_UQ = WS_W_LAT, WS_W_UKV = WS_W_LAT;
constexpr size_t WS_W_OUT_O = 452 * MiB + 512 * 1024;
constexpr size_t WS_ACT1 = WS_SCR;
constexpr size_t WS_ROPE = 455 * MiB;
constexpr size_t WS_SSP = 456 * MiB;
constexpr size_t WS_SLOT_RSTD = 457 * MiB;
constexpr size_t WS_RSTD = 457 * MiB + 256 * 1024;
constexpr size_t WS_END = 458 * MiB;
static_assert(WS_W_LAT + (size_t)3584 * 640 * 2 <= WS_W_OUT_O && WS_W_OUT_O + (size_t)1024 * 1024 * 2 <= WS_ROPE, "tail of the ws map");
static_assert(WS_ACT1 + (size_t)SLOT_CAP * FF_O * 2 <= WS_W_IN_O, "ACT1 must not reach the odd-layer weights");
static_assert(WS_Y + (size_t)SLOT_CAP * 1024 * 2 <= WS_YP && WS_YP + (size_t)MOE_TAIL_SPLIT * MOE_TAIL_ROWS * 1024 * 2 <= WS_SCR && WS_TOK_SLOT + (size_t)M_TOK * 8 <= 2 * MiB, "Y / TOK_SLOT map");
static_assert(WS_W_DN_E + (size_t)1024 * 2816 * 2 <= WS_W_IN_O && WS_KM + (size_t)M_TOK * 1536 * 2 <= WS_MASKT, "ws map");

enum { I_X = 0, I_RELB, I_MIXN_E, I_W_IN_E, I_MQN, I_MKN, I_DQN, I_DKN, I_W_OUT_E, I_FFNN_E, I_W_GATE_E, I_W_UP_E, I_W_DOWN_E,
       I_MIXN_O, I_W_IN_O, I_QAN, I_KVAN, I_W_UQ, I_W_UKV, I_MLAQN, I_MLAKN, I_W_OUT_O, I_FFNN_O, I_W_ROUTER, I_B_ROUTER,
       I_W_GATE_O, I_W_UP_O, I_W_DOWN_O, N_INPUTS };

__device__ __forceinline__ float wave_sum(float v) {
#pragma unroll
    for (int o = 1; o < 64; o <<= 1) v += __shfl_xor(v, o);
    return v;
}
__device__ __forceinline__ float wave_max(float v) {
#pragma unroll
    for (int o = 1; o < 64; o <<= 1) v = fmaxf(v, __shfl_xor(v, o));
    return v;
}
__device__ __forceinline__ int rel_bucket(int n) {
    if (n < 16) return n;
    int b = 16;
    b += (n >= 21); b += (n >= 27); b += (n >= 35); b += (n >= 46); b += (n >= 59); b += (n >= 77); b += (n >= 99); b += (n >= 128);
    b += (n >= 166); b += (n >= 216); b += (n >= 280); b += (n >= 363); b += (n >= 470); b += (n >= 609); b += (n >= 790);
    return b;
}
__device__ __forceinline__ unsigned fkey(float f) { unsigned u = __float_as_uint(f); return (u & 0x80000000u) ? ~u : (u | 0x80000000u); }
__device__ __forceinline__ float bflo(unsigned u) { return __uint_as_float(u << 16); }
__device__ __forceinline__ float bfhi(unsigned u) { return __uint_as_float(u & 0xffff0000u); }
__device__ __forceinline__ float silu_f(float x) { return x / (1.f + __expf(-x)); }

namespace pg8 {
#define PG8_LAS __attribute__((address_space(3)))
typedef unsigned short bf16_t;
typedef short bf16x8 __attribute__((ext_vector_type(8)));
typedef float f32x4 __attribute__((ext_vector_type(4)));
typedef unsigned u32x4 __attribute__((ext_vector_type(4)));
typedef unsigned u32x2 __attribute__((ext_vector_type(2)));
constexpr int BM = 256, BK = 64, HALF = 128, HTB = HALF * BK * 2, STAGE_BYTES = 8 * HTB, NXCD = 8, WGM = 8;

__host__ __device__ __forceinline__ int lds_byte(int r, int c) { const int st = (r >> 4) * 2 + (c >> 5), rr = r & 15, cc = c & 31, ob = rr * 64 + cc * 2; return st * 1024 + (ob ^ (((ob >> 9) & 1) << 5)); }
__host__ __device__ __forceinline__ void stage_rc(int b, int& R, int& C) { const int st = b / 1024, sb = b % 1024, swz = sb ^ (((sb >> 9) & 1) << 5); R = (st >> 1) * 16 + swz / 64; C = (st & 1) * 32 + (swz % 64) / 2; }
__host__ __device__ __forceinline__ int perm32(int rho) { const int n = rho >> 4, i = rho & 15; return 8 * (i >> 2) + 4 * n + (i & 3); }

struct Unit { int pm, pn, koff, nt; };
struct Gemm { const bf16_t* A; const bf16_t* Bt; int lda, ldb, K; };

__device__ __forceinline__ bool static_unit(int nM, int nN, int G, int c, int i, int& pm, int& pn) {
    const int nwg = nM * nN; const long L = (long)i * G + c; if (L >= nwg) return false;
    int wgid = (int)L; { const int q = nwg / NXCD, r = nwg % NXCD, xcd = wgid % NXCD, off = wgid / NXCD; wgid = (xcd < r ? xcd * (q + 1) : r * (q + 1) + (xcd - r) * q) + off; }
    const int nig = WGM * nN, gid = wgid / nig, fm = gid * WGM, gsz = (nM - fm) < WGM ? (nM - fm) : WGM;
    pm = fm + ((wgid % nig) % gsz); pn = (wgid % nig) / gsz; return true;
}
struct StaticOrder {
    static constexpr bool USE_LIST = false;
    int nM, nN, G, c;
    __device__ __forceinline__ bool next(int i, Unit& u) const { u.koff = 0; u.nt = 0; return static_unit(nM, nN, G, c, i, u.pm, u.pn); }
};
struct MoeOrder {
    static constexpr bool USE_LIST = true;
    const int* tile_e; int nM, nN, G, c, ksplit, Kpart, pm0;
    __device__ __forceinline__ bool next(int i, Unit& u) const {
        const int nwg = nM * nN; const long L = (long)i * G + c; if (L >= (long)nwg * ksplit) return false;
        const int ks = (int)(L / nwg), w = (int)(L % nwg); int pm, j;
        static_unit(nM, nN, nwg, w, 0, pm, j);
        u.pm = pm0 + pm; u.pn = tile_e[pm0 + pm] * nN + j; u.koff = ks * Kpart; u.nt = 0; return true;
    }
};

struct LatJointOrder {
    static constexpr bool USE_LIST = true;
    int G, c;
    __device__ __forceinline__ void uq(int idx, Unit& u) const { int pm, pn; static_unit(64, 6, 384, idx, 0, pm, pn); u.pm = pm; u.pn = pn; u.koff = 0; u.nt = 6; }
    __device__ __forceinline__ void ukv(int idx, Unit& u) const { int pm, pn; static_unit(64, 8, 512, idx, 0, pm, pn); u.pm = pm; u.pn = 6 + pn; u.koff = 384; u.nt = 4; }
    __device__ __forceinline__ bool next(int i, Unit& u) const {
        if (G == 256) {
            if (c < 128) { if (i == 0) { uq(c, u); return true; } if (i == 1) { uq(128 + c, u); return true; } if (i == 2) { ukv(c, u); return true; } return false; }
            const int d = c - 128; if (i == 0) { uq(256 + d, u); return true; } if (i >= 1 && i <= 3) { ukv(128 + 3 * d + (i - 1), u); return true; } return false; }
        const int L = i * G + c; if (L >= 896) return false; if (L < 384) uq(L, u); else ukv(L - 384, u); return true;
    }
};

__device__ __forceinline__ unsigned cvt_pk_bf16(float lo, float hi) { unsigned r; asm volatile("v_cvt_pk_bf16_f32 %0, %1, %2" : "=v"(r) : "v"(lo), "v"(hi)); return r; }
__device__ __forceinline__ float fast_silu(float x) { return x * __builtin_amdgcn_rcpf(1.f + __builtin_amdgcn_exp2f(-1.4426950408889634f * x)); }

struct EpiBf16 {
    static constexpr bool PERM = true;
    bf16_t* O; int ldc;
    bf16_t* X2; int x2_pn;
    static constexpr bool HAS_SCALE = false;
    __device__ __forceinline__ void preload(PG8_LAS unsigned char*, int, int) const {}
    __device__ __forceinline__ void operator()(const f32x4 (&acc)[2][2][4][2], const Unit& u, int wr, int wc, int fr, int fq, const PG8_LAS unsigned char* sp, int ui) const {
        const int row0 = u.pm * BM + wr * 64 + fr, col0 = u.pn * BM + wc * 32 + 8 * fq;
        const bool x2 = (X2 != nullptr) && (u.pn == x2_pn) && (wc < 2);
#pragma unroll
        for (int ai = 0; ai < 2; ++ai)
#pragma unroll
            for (int m = 0; m < 4; ++m) { bf16_t* rowp = O + (size_t)(row0 + ai * HALF + m * 16) * ldc + col0;
#pragma unroll
                for (int bj = 0; bj < 2; ++bj) { const f32x4 v0 = acc[ai][bj][m][0], v1 = acc[ai][bj][m][1];
                    u32x4 w; w.x = cvt_pk_bf16(v0[0], v0[1]); w.y = cvt_pk_bf16(v0[2], v0[3]); w.z = cvt_pk_bf16(v1[0], v1[1]); w.w = cvt_pk_bf16(v1[2], v1[3]);
                    *(u32x4*)(rowp + bj * HALF) = w;
                    if (bj == 0 && x2) { const int row = row0 + ai * HALF + m * 16; *(u32x4*)(X2 + ((size_t)(row >> 5) * 8 + (wc * 4 + fq)) * 256 + (row & 31) * 8) = w; } } }
    }
};
struct EpiResF32 {
    static constexpr bool PERM = false;
    const float* R; float* O; int ldc;
    static constexpr bool HAS_SCALE = false;
    __device__ __forceinline__ void preload(PG8_LAS unsigned char*, int, int) const {}
    __device__ __forceinline__ void operator()(const f32x4 (&acc)[2][2][4][2], const Unit& u, int wr, int wc, int fr, int fq, const PG8_LAS unsigned char* sp, int ui) const {
        const int row0 = u.pm * BM + wr * 64 + fr, col0 = u.pn * BM + wc * 32 + 4 * fq;
#pragma unroll
        for (int ai = 0; ai < 2; ++ai)
#pragma unroll
            for (int m = 0; m < 4; ++m) { const size_t off = (size_t)(row0 + ai * HALF + m * 16) * ldc + col0;
#pragma unroll
                for (int bj = 0; bj < 2; ++bj)
#pragma unroll
                    for (int n = 0; n < 2; ++n) { const f32x4 r = *(const f32x4*)(R + off + bj * HALF + n * 16); *(f32x4*)(O + off + bj * HALF + n * 16) = r + acc[ai][bj][m][n]; } }
    }
};
struct EpiSwiGLU {
    static constexpr bool PERM = true;
    bf16_t* O; int ldc; int nmod;
    static constexpr bool HAS_SCALE = false;
    __device__ __forceinline__ void preload(PG8_LAS unsigned char*, int, int) const {}
    __device__ __forceinline__ void operator()(const f32x4 (&acc)[2][2][4][2], const Unit& u, int wr, int wc, int fr, int fq, const PG8_LAS unsigned char* sp, int ui) const {
        const int row0 = u.pm * BM + wr * 64 + fr, col0 = (u.pn % nmod) * HALF + wc * 32 + 8 * fq;
#pragma unroll
        for (int ai = 0; ai < 2; ++ai)
#pragma unroll
            for (int m = 0; m < 4; ++m) { const f32x4 g0 = acc[ai][0][m][0], g1 = acc[ai][0][m][1], u0 = acc[ai][1][m][0], u1 = acc[ai][1][m][1];
                u32x4 w; w.x = cvt_pk_bf16(fast_silu(g0[0]) * u0[0], fast_silu(g0[1]) * u0[1]); w.y = cvt_pk_bf16(fast_silu(g0[2]) * u0[2], fast_silu(g0[3]) * u0[3]);
                w.z = cvt_pk_bf16(fast_silu(g1[0]) * u1[0], fast_silu(g1[1]) * u1[1]); w.w = cvt_pk_bf16(fast_silu(g1[2]) * u1[2], fast_silu(g1[3]) * u1[3]);
                *(u32x4*)(O + (size_t)(row0 + ai * HALF + m * 16) * ldc + col0) = w; }
    }
};
struct EpiMoeY {
    static constexpr bool PERM = true;
    bf16_t* Y; size_t kstride; int nmod, kpart, row_off;
    static constexpr bool HAS_SCALE = false;
    __device__ __forceinline__ void preload(PG8_LAS unsigned char*, int, int) const {}
    __device__ __forceinline__ void operator()(const f32x4 (&acc)[2][2][4][2], const Unit& u, int wr, int wc, int fr, int fq, const PG8_LAS unsigned char* sp, int ui) const {
        const int row0 = u.pm * BM - row_off + wr * 64 + fr, col0 = (u.pn % nmod) * BM + wc * 32 + 8 * fq; bf16_t* base = Y + (size_t)(u.koff / kpart) * kstride;
#pragma unroll
        for (int ai = 0; ai < 2; ++ai)
#pragma unroll
            for (int m = 0; m < 4; ++m) { bf16_t* rowp = base + (size_t)(row0 + ai * HALF + m * 16) * 1024 + col0;
#pragma unroll
                for (int bj = 0; bj < 2; ++bj) { const f32x4 v0 = acc[ai][bj][m][0], v1 = acc[ai][bj][m][1];
                    u32x4 w; w.x = cvt_pk_bf16(v0[0], v0[1]); w.y = cvt_pk_bf16(v0[2], v0[3]); w.z = cvt_pk_bf16(v1[0], v1[1]); w.w = cvt_pk_bf16(v1[2], v1[3]);
                    *(u32x4*)(rowp + bj * HALF) = w; } }
    }
};


template <bool RBF> struct EpiResN {
    static constexpr bool PERM = true;
    const float* Rf; bf16_t* XB; float* SSP; int ldc;
    static constexpr bool HAS_SCALE = false;
    __device__ __forceinline__ void preload(PG8_LAS unsigned char*, int, int) const {}
    __device__ __forceinline__ void operator()(const f32x4 (&acc)[2][2][4][2], const Unit& u, int wr, int wc, int fr, int fq, const PG8_LAS unsigned char*, int) const {
        const int row0 = u.pm * BM + wr * 64 + fr, col0 = u.pn * BM + wc * 32 + 8 * fq;
#pragma unroll
        for (int ai = 0; ai < 2; ++ai)
#pragma unroll
            for (int m = 0; m < 4; ++m) { const int row = row0 + ai * HALF + m * 16; const size_t off = (size_t)row * ldc + col0; float ss = 0.f;
#pragma unroll
                for (int bj = 0; bj < 2; ++bj) { f32x4 r0, r1;
                    if (RBF) { const u32x4 rb = *(const u32x4*)(XB + off + bj * HALF);
                        r0 = (f32x4){__uint_as_float(rb.x << 16), __uint_as_float(rb.x & 0xffff0000u), __uint_as_float(rb.y << 16), __uint_as_float(rb.y & 0xffff0000u)};
                        r1 = (f32x4){__uint_as_float(rb.z << 16), __uint_as_float(rb.z & 0xffff0000u), __uint_as_float(rb.w << 16), __uint_as_float(rb.w & 0xffff0000u)}; }
                    else { r0 = *(const f32x4*)(Rf + off + bj * HALF); r1 = *(const f32x4*)(Rf + off + bj * HALF + 4); }
                    const f32x4 v0 = r0 + acc[ai][bj][m][0], v1 = r1 + acc[ai][bj][m][1];
                    ss += ((v0[0] * v0[0] + v0[1] * v0[1]) + (v0[2] * v0[2] + v0[3] * v0[3])) + ((v1[0] * v1[0] + v1[1] * v1[1]) + (v1[2] * v1[2] + v1[3] * v1[3]));
                    u32x4 w; w.x = cvt_pk_bf16(v0[0], v0[1]); w.y = cvt_pk_bf16(v0[2], v0[3]); w.z = cvt_pk_bf16(v1[0], v1[1]); w.w = cvt_pk_bf16(v1[2], v1[3]);
                    *(u32x4*)(XB + off + bj * HALF) = w; }
                ss += __shfl_xor(ss, 16); ss += __shfl_xor(ss, 32);
                if (fq == 0) SSP[(size_t)row * 16 + (u.pn & 3) * 4 + wc] = ss; }
    }
};
constexpr int MAX_UNITS_WG = 15;
constexpr int SP_SCALE = 0, SP_GIDX = MAX_UNITS_WG * 1024, SP_ULIST = 30720 + 256;
struct ScaleSSP {
    const float* SSP; float eps;
    __device__ __forceinline__ float row(const Unit& u, int r) const { const f32x4* p = (const f32x4*)(SSP + (size_t)(u.pm * BM + r) * 16); const f32x4 a = p[0], b = p[1], c = p[2], d = p[3];
        const float s = ((a[0] + a[1]) + (a[2] + a[3])) + ((b[0] + b[1]) + (b[2] + b[3])) + ((c[0] + c[1]) + (c[2] + c[3])) + ((d[0] + d[1]) + (d[2] + d[3]));
        return __builtin_amdgcn_rsqf(s * (1.f / 1024.f) + eps); }
};
struct ScaleSlot {
    const float* srstd;
    __device__ __forceinline__ float row(const Unit& u, int r) const { return srstd[u.pm * BM + r]; }
};
template <class Sched> __device__ __forceinline__ int build_unit_list(PG8_LAS unsigned char* sp, const Sched& sched, int tid) {
    PG8_LAS int* ul = (PG8_LAS int*)(sp + SP_ULIST);
    if (tid < MAX_UNITS_WG + 1) { Unit u; u.pm = -1; u.pn = 0; u.koff = 0; u.nt = 0; const bool ok = (tid < MAX_UNITS_WG) && sched.next(tid, u); ul[4 * tid] = ok ? u.pm : -1; ul[4 * tid + 1] = u.pn; ul[4 * tid + 2] = u.koff; ul[4 * tid + 3] = u.nt; }
    __syncthreads();
    int n = 0; while (n < MAX_UNITS_WG && ul[4 * n] >= 0) ++n;
    return n;
}
template <class Scale> __device__ __forceinline__ void preload_scales(const Scale& S, PG8_LAS unsigned char* sp, int n, int tid) {
    PG8_LAS float* tab = (PG8_LAS float*)(sp + SP_SCALE); const PG8_LAS int* ul = (const PG8_LAS int*)(sp + SP_ULIST);
    const int rows = n * 256;
    for (int j0 = tid; j0 < rows; j0 += 4 * 512) {
        float v[4];
#pragma unroll
        for (int k = 0; k < 4; ++k) { const int j = j0 + k * 512; if (j < rows) { Unit u; u.pm = ul[4 * (j >> 8)]; u.pn = ul[4 * (j >> 8) + 1]; u.koff = 0; u.nt = 0; v[k] = S.row(u, j & 255); } else v[k] = 0.f; }
#pragma unroll
        for (int k = 0; k < 4; ++k) { const int j = j0 + k * 512; if (j < rows) tab[j] = v[k]; }
    }
}
template <class Scale> struct EpiBf16S {
    static constexpr bool PERM = true;
    bf16_t* O; int ldc; Scale S;
    static constexpr bool HAS_SCALE = true;
    __device__ __forceinline__ void preload(PG8_LAS unsigned char* sp, int n, int tid) const { preload_scales(S, sp, n, tid); }
    __device__ __forceinline__ void operator()(const f32x4 (&acc)[2][2][4][2], const Unit& u, int wr, int wc, int fr, int fq, const PG8_LAS unsigned char* sp, int ui) const {
        const int rl = wr * 64 + fr, row0 = u.pm * BM + rl, col0 = u.pn * BM + wc * 32 + 8 * fq;
        float scv[8]; { const unsigned ta = (unsigned)(size_t)sp + (unsigned)SP_SCALE + (unsigned)(ui * 256 + rl) * 4u;
            asm volatile("ds_read_b32 %0, %8\n\tds_read_b32 %1, %8 offset:64\n\tds_read_b32 %2, %8 offset:128\n\tds_read_b32 %3, %8 offset:192\n\tds_read_b32 %4, %8 offset:512\n\tds_read_b32 %5, %8 offset:576\n\tds_read_b32 %6, %8 offset:640\n\tds_read_b32 %7, %8 offset:704\n\ts_waitcnt lgkmcnt(0)"
                : "=&v"(scv[0]), "=&v"(scv[1]), "=&v"(scv[2]), "=&v"(scv[3]), "=&v"(scv[4]), "=&v"(scv[5]), "=&v"(scv[6]), "=&v"(scv[7]) : "v"(ta) : "memory"); }
#pragma unroll
        for (int ai = 0; ai < 2; ++ai)
#pragma unroll
            for (int m = 0; m < 4; ++m) { bf16_t* rowp = O + (size_t)(row0 + ai * HALF + m * 16) * ldc + col0; const float sc = scv[ai * 4 + m];
#pragma unroll
                for (int bj = 0; bj < 2; ++bj) { const f32x4 v0 = acc[ai][bj][m][0] * sc, v1 = acc[ai][bj][m][1] * sc;
                    u32x4 w; w.x = cvt_pk_bf16(v0[0], v0[1]); w.y = cvt_pk_bf16(v0[2], v0[3]); w.z = cvt_pk_bf16(v1[0], v1[1]); w.w = cvt_pk_bf16(v1[2], v1[3]);
                    *(u32x4*)(rowp + bj * HALF) = w; } }
    }
};
template <class Scale> struct EpiBf16SL {
    static constexpr bool PERM = true;
    bf16_t* O; int ldc; float* LSP; Scale S;
    static constexpr bool HAS_SCALE = true;
    __device__ __forceinline__ void preload(PG8_LAS unsigned char* sp, int n, int tid) const { preload_scales(S, sp, n, tid); }
    __device__ __forceinline__ void operator()(const f32x4 (&acc)[2][2][4][2], const Unit& u, int wr, int wc, int fr, int fq, const PG8_LAS unsigned char* sp, int ui) const {
        const int rl = wr * 64 + fr, row0 = u.pm * BM + rl, col0 = u.pn * BM + wc * 32 + 8 * fq;
        float scv[8]; { const unsigned ta = (unsigned)(size_t)sp + (unsigned)SP_SCALE + (unsigned)(ui * 256 + rl) * 4u;
            asm volatile("ds_read_b32 %0, %8\n\tds_read_b32 %1, %8 offset:64\n\tds_read_b32 %2, %8 offset:128\n\tds_read_b32 %3, %8 offset:192\n\tds_read_b32 %4, %8 offset:512\n\tds_read_b32 %5, %8 offset:576\n\tds_read_b32 %6, %8 offset:640\n\tds_read_b32 %7, %8 offset:704\n\ts_waitcnt lgkmcnt(0)"
                : "=&v"(scv[0]), "=&v"(scv[1]), "=&v"(scv[2]), "=&v"(scv[3]), "=&v"(scv[4]), "=&v"(scv[5]), "=&v"(scv[6]), "=&v"(scv[7]) : "v"(ta) : "memory"); }
#pragma unroll
        for (int ai = 0; ai < 2; ++ai)
#pragma unroll
            for (int m = 0; m < 4; ++m) { const int row = row0 + ai * HALF + m * 16; bf16_t* rowp = O + (size_t)row * ldc + col0; const float sc = scv[ai * 4 + m];
#pragma unroll
                for (int bj = 0; bj < 2; ++bj) { const f32x4 v0 = acc[ai][bj][m][0] * sc, v1 = acc[ai][bj][m][1] * sc;
                    u32x4 w; w.x = cvt_pk_bf16(v0[0], v0[1]); w.y = cvt_pk_bf16(v0[2], v0[3]); w.z = cvt_pk_bf16(v1[0], v1[1]); w.w = cvt_pk_bf16(v1[2], v1[3]);
                    *(u32x4*)(rowp + bj * HALF) = w;
                    float ss = ((v0[0] * v0[0] + v0[1] * v0[1]) + (v0[2] * v0[2] + v0[3] * v0[3])) + ((v1[0] * v1[0] + v1[1] * v1[1]) + (v1[2] * v1[2] + v1[3] * v1[3]));
                    ss += __shfl_xor(ss, 16); ss += __shfl_xor(ss, 32);
                    if (fq == 0) LSP[(size_t)row * 24 + u.pn * 8 + bj * 4 + wc] = ss; } }
    }
};
struct ScaleLat {
    const float* LSP; float eps;
    __device__ __forceinline__ float row(const Unit& u, int r) const { const bool isq = u.pn < 6; const float* p = LSP + (size_t)(u.pm * BM + r) * 24 + (isq ? 0 : 12);
        float s = ((p[0] + p[1]) + (p[2] + p[3])) + ((p[4] + p[5]) + (p[6] + p[7])); if (isq) s += (p[8] + p[9]) + (p[10] + p[11]);
        return __builtin_amdgcn_rsqf(s * (isq ? 1.f / 384 : 1.f / 256) + eps); }
};
__device__ __forceinline__ float sum_rows4(float x) {
    { const unsigned xi = __float_as_uint(x); const u32x2 r = __builtin_amdgcn_permlane16_swap(xi, xi, false, false); x = __uint_as_float(r.x) + __uint_as_float(r.y); }
    { const unsigned xi = __float_as_uint(x); const u32x2 r = __builtin_amdgcn_permlane32_swap(xi, xi, false, false); x = __uint_as_float(r.x) + __uint_as_float(r.y); }
    return x;
}
struct EpiLatJoint {
    static constexpr bool PERM = true;
    bf16_t* QR; bf16_t* KVR; bf16_t* KM; float* KSS; const float* gk; ScaleLat S;
    static constexpr bool HAS_SCALE = true;
    __device__ __forceinline__ void preload(PG8_LAS unsigned char* sp, int n, int tid) const { preload_scales(S, sp, n, tid);
        PG8_LAS float* tab2 = (PG8_LAS float*)(sp + SP_GIDX); const PG8_LAS int* ul = (const PG8_LAS int*)(sp + SP_ULIST);
        for (int j = tid; j < n * 256; j += 512) tab2[j] = S.LSP[(size_t)(ul[4 * (j >> 8)] * BM + (j & 255)) * 24 + 20];
        if (tid < 64) tab2[14 * 256 + tid] = gk[tid]; }
    __device__ __forceinline__ void operator()(const f32x4 (&acc)[2][2][4][2], const Unit& u, int wr, int wc, int fr, int fq, const PG8_LAS unsigned char* sp, int ui) const {
        const bool isq = u.pn < 6; bf16_t* O = isq ? QR : KVR; const int ldc = isq ? 1536 : 2048;
        const int rl = wr * 64 + fr, row0 = u.pm * BM + rl, col0 = isq ? u.pn * BM + wc * 32 + 8 * fq : (u.pn - 6) * BM + ((((wc & 1) << 1) | (wc >> 1)) * 64) + 8 * fq, cstep = isq ? HALF : 32;
        float scv[8]; { const unsigned ta = (unsigned)(size_t)sp + (unsigned)SP_SCALE + (unsigned)(ui * 256 + rl) * 4u;
            asm volatile("ds_read_b32 %0, %8\n\tds_read_b32 %1, %8 offset:64\n\tds_read_b32 %2, %8 offset:128\n\tds_read_b32 %3, %8 offset:192\n\tds_read_b32 %4, %8 offset:512\n\tds_read_b32 %5, %8 offset:576\n\tds_read_b32 %6, %8 offset:640\n\tds_read_b32 %7, %8 offset:704\n\ts_waitcnt lgkmcnt(0)"
                : "=&v"(scv[0]), "=&v"(scv[1]), "=&v"(scv[2]), "=&v"(scv[3]), "=&v"(scv[4]), "=&v"(scv[5]), "=&v"(scv[6]), "=&v"(scv[7]) : "v"(ta) : "memory"); }
        if (isq || wc >= 2) {
#pragma unroll
            for (int ai = 0; ai < 2; ++ai)
#pragma unroll
                for (int m = 0; m < 4; ++m) { bf16_t* rowp = O + (size_t)(row0 + ai * HALF + m * 16) * ldc + col0; const float sc = scv[ai * 4 + m];
#pragma unroll
                    for (int bj = 0; bj < 2; ++bj) { const f32x4 v0 = acc[ai][bj][m][0] * sc, v1 = acc[ai][bj][m][1] * sc;
                        u32x4 w; w.x = cvt_pk_bf16(v0[0], v0[1]); w.y = cvt_pk_bf16(v0[2], v0[3]); w.z = cvt_pk_bf16(v1[0], v1[1]); w.w = cvt_pk_bf16(v1[2], v1[3]);
                        *(u32x4*)(rowp + bj * cstep) = w; } }
        } else {
            const int hd = 2 * (u.pn - 6) + wc;
            float spe[8]; { const unsigned ta = (unsigned)(size_t)sp + (unsigned)SP_GIDX + (unsigned)(ui * 256 + rl) * 4u;
                asm volatile("ds_read_b32 %0, %8\n\tds_read_b32 %1, %8 offset:64\n\tds_read_b32 %2, %8 offset:128\n\tds_read_b32 %3, %8 offset:192\n\tds_read_b32 %4, %8 offset:512\n\tds_read_b32 %5, %8 offset:576\n\tds_read_b32 %6, %8 offset:640\n\tds_read_b32 %7, %8 offset:704\n\ts_waitcnt lgkmcnt(0)"
                    : "=&v"(spe[0]), "=&v"(spe[1]), "=&v"(spe[2]), "=&v"(spe[3]), "=&v"(spe[4]), "=&v"(spe[5]), "=&v"(spe[6]), "=&v"(spe[7]) : "v"(ta) : "memory"); }
            f32x4 g[4]; { const unsigned ga = (unsigned)(size_t)sp + (unsigned)SP_GIDX + (unsigned)(14 * 256 + 8 * fq) * 4u;
                asm volatile("ds_read_b128 %0, %4\n\tds_read_b128 %1, %4 offset:16\n\tds_read_b128 %2, %4 offset:128\n\tds_read_b128 %3, %4 offset:144\n\ts_waitcnt lgkmcnt(0)" : "=&v"(g[0]), "=&v"(g[1]), "=&v"(g[2]), "=&v"(g[3]) : "v"(ga) : "memory"); }
#pragma unroll
            for (int ai = 0; ai < 2; ++ai)
#pragma unroll
                for (int m = 0; m < 4; ++m) { const int row = row0 + ai * HALF + m * 16; const float sc = scv[ai * 4 + m];
                    const f32x4 a0 = acc[ai][0][m][0] * sc, a1 = acc[ai][0][m][1] * sc, b0 = acc[ai][1][m][0] * sc, b1 = acc[ai][1][m][1] * sc;
                    float ss = (((a0[0] * a0[0] + a0[1] * a0[1]) + (a0[2] * a0[2] + a0[3] * a0[3])) + ((a1[0] * a1[0] + a1[1] * a1[1]) + (a1[2] * a1[2] + a1[3] * a1[3])))
                             + (((b0[0] * b0[0] + b0[1] * b0[1]) + (b0[2] * b0[2] + b0[3] * b0[3])) + ((b1[0] * b1[0] + b1[1] * b1[1]) + (b1[2] * b1[2] + b1[3] * b1[3])));
                    ss = sum_rows4(ss);
                    const float r = __builtin_amdgcn_rsqf((ss + spe[ai * 4 + m]) * (1.f / 96) + S.eps);
                    bf16_t* kp = KM + (size_t)row * 1536 + hd * 96 + 8 * fq;
                    { const f32x4 y0 = a0 * r * g[0], y1 = a1 * r * g[1]; u32x4 w; w.x = cvt_pk_bf16(y0[0], y0[1]); w.y = cvt_pk_bf16(y0[2], y0[3]); w.z = cvt_pk_bf16(y1[0], y1[1]); w.w = cvt_pk_bf16(y1[2], y1[3]); *(u32x4*)kp = w; }
                    { const f32x4 y0 = b0 * r * g[2], y1 = b1 * r * g[3]; u32x4 w; w.x = cvt_pk_bf16(y0[0], y0[1]); w.y = cvt_pk_bf16(y0[2], y0[3]); w.z = cvt_pk_bf16(y1[0], y1[1]); w.w = cvt_pk_bf16(y1[2], y1[3]); *(u32x4*)(kp + 32) = w; }
                    if (fq == 0) KSS[(size_t)row * 16 + hd] = r; }
        }
    }
};
template <class Scale> struct EpiSwiGLUS {
    static constexpr bool PERM = true;
    bf16_t* O; int ldc; int nmod; Scale S;
    static constexpr bool HAS_SCALE = true;
    __device__ __forceinline__ void preload(PG8_LAS unsigned char* sp, int n, int tid) const { preload_scales(S, sp, n, tid); }
    __device__ __forceinline__ void operator()(const f32x4 (&acc)[2][2][4][2], const Unit& u, int wr, int wc, int fr, int fq, const PG8_LAS unsigned char* sp, int ui) const {
        const int rl = wr * 64 + fr, row0 = u.pm * BM + rl, col0 = (u.pn % nmod) * HALF + wc * 32 + 8 * fq;
        float scv[8]; { const unsigned ta = (unsigned)(size_t)sp + (unsigned)SP_SCALE + (unsigned)(ui * 256 + rl) * 4u;
            asm volatile("ds_read_b32 %0, %8\n\tds_read_b32 %1, %8 offset:64\n\tds_read_b32 %2, %8 offset:128\n\tds_read_b32 %3, %8 offset:192\n\tds_read_b32 %4, %8 offset:512\n\tds_read_b32 %5, %8 offset:576\n\tds_read_b32 %6, %8 offset:640\n\tds_read_b32 %7, %8 offset:704\n\ts_waitcnt lgkmcnt(0)"
                : "=&v"(scv[0]), "=&v"(scv[1]), "=&v"(scv[2]), "=&v"(scv[3]), "=&v"(scv[4]), "=&v"(scv[5]), "=&v"(scv[6]), "=&v"(scv[7]) : "v"(ta) : "memory"); }
#pragma unroll
        for (int ai = 0; ai < 2; ++ai)
#pragma unroll
            for (int m = 0; m < 4; ++m) { const float sc = scv[ai * 4 + m];
                const f32x4 g0 = acc[ai][0][m][0] * sc, g1 = acc[ai][0][m][1] * sc, u0 = acc[ai][1][m][0] * sc, u1 = acc[ai][1][m][1] * sc;
                u32x4 w; w.x = cvt_pk_bf16(fast_silu(g0[0]) * u0[0], fast_silu(g0[1]) * u0[1]); w.y = cvt_pk_bf16(fast_silu(g0[2]) * u0[2], fast_silu(g0[3]) * u0[3]);
                w.z = cvt_pk_bf16(fast_silu(g1[0]) * u1[0], fast_silu(g1[1]) * u1[1]); w.w = cvt_pk_bf16(fast_silu(g1[2]) * u1[2], fast_silu(g1[3]) * u1[3]);
                *(u32x4*)(O + (size_t)(row0 + ai * HALF + m * 16) * ldc + col0) = w; }
    }
};

template <class Epi, class Sched, bool ALIGN_EPI, bool GATHER>
__device__ __forceinline__ void gemm_phase(PG8_LAS unsigned char* lds, const Gemm g, const Sched& S, const Epi& E, const int* gidx) {
    const int tid = threadIdx.x, wid = __builtin_amdgcn_readfirstlane(tid >> 6), lane = tid & 63, wr = wid >> 2, wc = wid & 3, fr = lane & 15, fq = lane >> 4;
    const int K = g.K, nt = K / BK, lda = g.lda, ldb = g.ldb;
    unsigned vAc[2][2], vAn[2][2], voffB[2]; int Rl[2], Cl[2];
#pragma unroll
    for (int i = 0; i < 2; ++i) { int R, C; stage_rc(tid * 16 + i * 8192, R, C); const int Rb = Epi::PERM ? ((R & ~31) + perm32(R & 31)) : R; Rl[i] = R; Cl[i] = C;
        voffB[i] = (unsigned)(Rb * ldb + C) * 2u;
#pragma unroll
        for (int h = 0; h < 2; ++h) { vAc[h][i] = (unsigned)((R + h * HALF) * lda + C) * 2u; vAn[h][i] = vAc[h][i]; } }
    const size_t kstep = (size_t)(BK * 2);
    const size_t hstepB = (size_t)HALF * ldb * 2, tstepB = 2 * hstepB, tstepA = GATHER ? 0 : (size_t)BM * lda * 2;
    const unsigned ldsw = (unsigned)wid * 1024u;
    const int aoff = lds_byte(wr * 64 + fr, fq * 8), boff = lds_byte(wc * 32 + fr, fq * 8);
#define PG8_SA(b, h) (((b) * 2 + (h)) * HTB)
#define PG8_SB(b, h) ((4 + (b) * 2 + (h)) * HTB)
#define PG8_STAGE(bufoff, gbase, voff) do { _Pragma("unroll") for (int _i = 0; _i < 2; ++_i) \
        __builtin_amdgcn_global_load_lds((const unsigned*)((const char*)(gbase) + (voff)[_i]), (PG8_LAS unsigned*)(lds + (bufoff) + ldsw + _i * 8192), 16, 0, 0); } while (0)
#define PG8_LDA(dst, b, h) do { _Pragma("unroll") for (int m = 0; m < 4; ++m) _Pragma("unroll") for (int k = 0; k < 2; ++k) dst[m][k] = *(const PG8_LAS bf16x8*)(lds + PG8_SA(b, h) + aoff + m * 2048 + k * 1024); } while (0)
#define PG8_LDB(dst, b, h) do { _Pragma("unroll") for (int n = 0; n < 2; ++n) _Pragma("unroll") for (int k = 0; k < 2; ++k) dst[n][k] = *(const PG8_LAS bf16x8*)(lds + PG8_SB(b, h) + boff + n * 2048 + k * 1024); } while (0)
#define PG8_MMA(ai, bj, At, Bt) do { __builtin_amdgcn_s_setprio(1); _Pragma("unroll") for (int m = 0; m < 4; ++m) _Pragma("unroll") for (int n = 0; n < 2; ++n) _Pragma("unroll") for (int k = 0; k < 2; ++k) \
        acc[ai][bj][m][n] = __builtin_amdgcn_mfma_f32_16x16x32_bf16(Bt[n][k], At[m][k], acc[ai][bj][m][n], 0, 0, 0); __builtin_amdgcn_s_setprio(0); } while (0)
#define PG8_WAIT_V(n) asm volatile("s_waitcnt vmcnt(" #n ")" ::: "memory")
#define PG8_WAIT_L(n) asm volatile("s_waitcnt lgkmcnt(" #n ")" ::: "memory")
#define PG8_BAR __builtin_amdgcn_s_barrier()
#define PG8_SCHED __builtin_amdgcn_sched_barrier(0)
    PG8_LAS unsigned char* spare = lds + STAGE_BYTES;
    constexpr bool LIST = Sched::USE_LIST || Epi::HAS_SCALE || GATHER;
    int nunits = 0;
    if constexpr (LIST) { nunits = build_unit_list(spare, S, tid); if (nunits == 0) return;
        E.preload(spare, nunits, tid);
        if (GATHER) { PG8_LAS int* gt = (PG8_LAS int*)(spare + SP_GIDX); const PG8_LAS int* ul = (const PG8_LAS int*)(spare + SP_ULIST);
            for (int j = tid; j < nunits * 256; j += 512) { int t_ = gidx[ul[4 * (j >> 8)] * BM + (j & 255)]; gt[j] = t_ < 0 ? 0 : t_; } }
        __syncthreads(); }
#define PG8_UNIT(i, u, ok) do { if constexpr (LIST) { int a_, b_, c_, d_; const unsigned ad_ = (unsigned)(size_t)(spare + SP_ULIST) + 16u * (unsigned)(i); \
        asm volatile("ds_read_b32 %0, %4\n\tds_read_b32 %1, %4 offset:4\n\tds_read_b32 %2, %4 offset:8\n\tds_read_b32 %3, %4 offset:12\n\ts_waitcnt lgkmcnt(0)" : "=&v"(a_), "=&v"(b_), "=&v"(c_), "=&v"(d_) : "v"(ad_) : "memory"); \
        (u).pm = __builtin_amdgcn_readfirstlane(a_); (u).pn = __builtin_amdgcn_readfirstlane(b_); (u).koff = __builtin_amdgcn_readfirstlane(c_); (u).nt = __builtin_amdgcn_readfirstlane(d_); ok = (u).pm >= 0; } else { ok = S.next(i, u); } } while (0)
#define PG8_GIDX(dst, ord) do { if (GATHER) { int t0_, t1_, t2_, t3_; const unsigned ad_ = (unsigned)(size_t)(spare + SP_GIDX) + 4u * (unsigned)((ord) * 256); \
        asm volatile("ds_read_b32 %0, %4\n\tds_read_b32 %1, %5\n\tds_read_b32 %2, %4 offset:512\n\tds_read_b32 %3, %5 offset:512\n\ts_waitcnt lgkmcnt(0)" : "=&v"(t0_), "=&v"(t1_), "=&v"(t2_), "=&v"(t3_) : "v"(ad_ + 4u * (unsigned)Rl[0]), "v"(ad_ + 4u * (unsigned)Rl[1]) : "memory"); \
        dst[0][0] = (unsigned)(t0_ * lda + Cl[0]) * 2u; dst[0][1] = (unsigned)(t1_ * lda + Cl[1]) * 2u; dst[1][0] = (unsigned)(t2_ * lda + Cl[0]) * 2u; dst[1][1] = (unsigned)(t3_ * lda + Cl[1]) * 2u; } } while (0)
    Unit cur, nxt; int ui = 0;
    { bool ok0; PG8_UNIT(0, cur, ok0); if (!ok0) return; }
    f32x4 acc[2][2][4][2];
#pragma unroll
    for (int a = 0; a < 2; ++a)
#pragma unroll
        for (int b = 0; b < 2; ++b)
#pragma unroll
            for (int m = 0; m < 4; ++m)
#pragma unroll
                for (int n = 0; n < 2; ++n) acc[a][b][m][n] = (f32x4){0.f, 0.f, 0.f, 0.f};
    bf16x8 At[4][2], B0[2][2], B1[2][2];
    PG8_GIDX(vAc, 0);
    const char* cA = (const char*)g.A + (size_t)cur.pm * tstepA + (size_t)cur.koff * 2; const char* cB = (const char*)g.Bt + (size_t)cur.pn * tstepB + (size_t)cur.koff * 2;
    PG8_STAGE(PG8_SB(0, 0), cB, voffB); PG8_STAGE(PG8_SB(0, 1), cB + hstepB, voffB); PG8_STAGE(PG8_SA(0, 0), cA, vAc[0]); PG8_STAGE(PG8_SA(0, 1), cA, vAc[1]);
    if (wr == 1) PG8_BAR;
    PG8_WAIT_V(2); PG8_BAR;
    PG8_STAGE(PG8_SB(1, 0), cB + kstep, voffB); PG8_STAGE(PG8_SA(1, 0), cA + kstep, vAc[0]); PG8_STAGE(PG8_SB(1, 1), cB + hstepB + kstep, voffB);
    PG8_WAIT_V(6); PG8_BAR;
    for (;;) {
        bool has_next; PG8_UNIT(ui + 1, nxt, has_next);
        if (has_next) PG8_GIDX(vAn, ui + 1);
        const char* nA = has_next ? (const char*)g.A + (size_t)nxt.pm * tstepA + (size_t)nxt.koff * 2 : cA; const char* nB = has_next ? (const char*)g.Bt + (size_t)nxt.pn * tstepB + (size_t)nxt.koff * 2 : cB;
        const int ntc = cur.nt > 0 ? cur.nt : nt;
        for (int t = 0; t < ntc; t += 2) {
            const bool last = (t == ntc - 2);
            const char* a1 = cA + (size_t)(t + 1) * kstep;
            const char* a2 = last ? nA : cA + (size_t)(t + 2) * kstep; const char* b2 = last ? nB : cB + (size_t)(t + 2) * kstep;
            const char* a3 = a2 + kstep; const char* b3 = b2 + kstep;
            unsigned vs0[2], vs1[2];
            if (GATHER) { const bool sw = last && has_next; vs0[0] = sw ? vAn[0][0] : vAc[0][0]; vs0[1] = sw ? vAn[0][1] : vAc[0][1]; vs1[0] = sw ? vAn[1][0] : vAc[1][0]; vs1[1] = sw ? vAn[1][1] : vAc[1][1]; }
            else { vs0[0] = vAc[0][0]; vs0[1] = vAc[0][1]; vs1[0] = vAc[1][0]; vs1[1] = vAc[1][1]; }
            PG8_LDB(B0, 0, 0); PG8_LDB(B1, 0, 1); PG8_SCHED; PG8_LDA(At, 0, 0); PG8_STAGE(PG8_SA(1, 1), a1, vAc[1]);
            PG8_WAIT_V(8); PG8_WAIT_L(0); PG8_BAR; PG8_MMA(0, 0, At, B0); PG8_MMA(0, 1, At, B1); PG8_BAR; PG8_SCHED;
            PG8_LDA(At, 0, 1); PG8_STAGE(PG8_SB(0, 0), b2, voffB); PG8_STAGE(PG8_SB(0, 1), b2 + hstepB, voffB); PG8_STAGE(PG8_SA(0, 0), a2, vs0);
            PG8_WAIT_V(8); PG8_WAIT_L(0); PG8_BAR; PG8_MMA(1, 0, At, B0); PG8_MMA(1, 1, At, B1); PG8_BAR; PG8_SCHED;
            PG8_LDB(B0, 1, 0); PG8_LDB(B1, 1, 1); PG8_SCHED; PG8_LDA(At, 1, 0); PG8_STAGE(PG8_SA(0, 1), a2, vs1);
            PG8_WAIT_V(8); PG8_WAIT_L(0); PG8_BAR; PG8_MMA(0, 0, At, B0); PG8_MMA(0, 1, At, B1); PG8_BAR; PG8_SCHED;
            PG8_LDA(At, 1, 1); PG8_STAGE(PG8_SB(1, 0), b3, voffB); PG8_STAGE(PG8_SB(1, 1), b3 + hstepB, voffB); PG8_STAGE(PG8_SA(1, 0), a3, vs0);
            PG8_WAIT_V(8); PG8_WAIT_L(0); PG8_BAR; PG8_MMA(1, 0, At, B0); PG8_MMA(1, 1, At, B1); PG8_BAR; PG8_SCHED;
        }
        if constexpr (ALIGN_EPI) { if (wr == 0) PG8_BAR; }
        E(acc, cur, wr, wc, fr, fq, spare, ui);
        if (!has_next) break;
#pragma unroll
        for (int a = 0; a < 2; ++a)
#pragma unroll
            for (int b = 0; b < 2; ++b)
#pragma unroll
                for (int m = 0; m < 4; ++m)
#pragma unroll
                    for (int n = 0; n < 2; ++n) acc[a][b][m][n] = (f32x4){0.f, 0.f, 0.f, 0.f};
        cur = nxt; cA = nA; cB = nB; ++ui;
        if (GATHER) {
#pragma unroll
            for (int h = 0; h < 2; ++h) { vAc[h][0] = vAn[h][0]; vAc[h][1] = vAn[h][1]; } }
        if constexpr (ALIGN_EPI) { if (wr == 1) PG8_BAR; }
    }
    PG8_WAIT_V(0);
    if constexpr (!ALIGN_EPI) { if (wr == 0) PG8_BAR; }
    PG8_BAR;
#undef PG8_SA
#undef PG8_SB
#undef PG8_STAGE
#undef PG8_LDA
#undef PG8_LDB
#undef PG8_MMA
#undef PG8_WAIT_V
#undef PG8_WAIT_L
#undef PG8_BAR
#undef PG8_SCHED
#undef PG8_GIDX
#undef PG8_UNIT
}
}

#define GAS __attribute__((address_space(1)))
#define LAS __attribute__((address_space(3)))
typedef unsigned v4u __attribute__((ext_vector_type(4)));
typedef unsigned v2u __attribute__((ext_vector_type(2)));
typedef float f32x4 __attribute__((ext_vector_type(4)));
typedef short bf16x8 __attribute__((ext_vector_type(8)));
typedef float f32x16 __attribute__((ext_vector_type(16)));
#define LDS_WAIT() asm volatile("s_waitcnt lgkmcnt(0)" ::: "memory")
#define VM_WAIT() asm volatile("s_waitcnt vmcnt(0)" ::: "memory")
constexpr int NWAVES = 8, NTHR = 512;
constexpr int LDS_BYTES = 163840 - 1024;
constexpr int LDSCTL_OFF = LDS_BYTES - 1024;

struct Args { const float* in[N_INPUTS]; float* out; unsigned char* ws; int ph_lo, ph_hi, sub, pad; };
struct Frame { LAS unsigned char* lds; int tid, lane, wave, G, bid; const float* const* in; float* out; unsigned char* ws;
    template <class T> __device__ __forceinline__ T* w(size_t off) const { return (T*)(ws + off); } };

__device__ __forceinline__ void transpose_item(const float* W, int K, int N, int Npad, bf16* WT, int mode, LAS unsigned char* scr, int item, int nblk, int lane, const float* gk = nullptr, int ldo = 0) {
    const int kb = item / nblk, nb = item % nblk, k0 = 64 * kb, n0 = 64 * nb;
    const int g = lane >> 4, c = lane & 15, nn = n0 + 4 * c; const bool ok = nn < N;
    const float* src = W + (size_t)(k0 + 2 * g) * N + nn;
    f32x4 a[8], b[8];
#pragma unroll
    for (int i = 0; i < 8; ++i) { a[i] = ok ? *(const f32x4*)(src + (size_t)(8 * i) * N) : (f32x4){0.f, 0.f, 0.f, 0.f}; b[i] = ok ? *(const f32x4*)(src + (size_t)(8 * i + 1) * N) : (f32x4){0.f, 0.f, 0.f, 0.f}; }
    if (gk) {
#pragma unroll
        for (int i = 0; i < 8; ++i) { const float2 gg = *(const float2*)(gk + k0 + 8 * i + 2 * g); a[i] = a[i] * gg.x; b[i] = b[i] * gg.y; } }
#pragma unroll
    for (int i = 0; i < 8; ++i)
#pragma unroll
        for (int j = 0; j < 4; ++j) *(LAS unsigned*)(scr + (4 * c + j) * 128 + ((i ^ (c & 7)) * 16) + 4 * g) = pk2(a[i][j], b[i][j]);
    LDS_WAIT(); asm volatile("" ::: "memory");
#pragma unroll
    for (int r = 0; r < 8; ++r) { const int idx = lane + 64 * r, nl = idx >> 3, ch = idx & 7, n = n0 + nl;
        const v4u v = *(const LAS v4u*)(scr + nl * 128 + ((ch ^ ((nl >> 2) & 7)) * 16));
        if (n < Npad) { const int row = (mode == 0) ? n : (mode == 3) ? (256 * (n / 256) + ((n >> 5) & 1) * 128 + ((((n >> 6) & 1) << 1) | ((n >> 7) & 1)) * 32 + (n & 31)) : (256 * (n / 128) + (n % 128) + (mode == 2 ? 128 : 0)); *(v4u*)(WT + (size_t)row * (ldo ? ldo : K) + k0 + 8 * ch) = v; } }
    LDS_WAIT(); asm volatile("" ::: "memory");
}
__device__ __forceinline__ void rms_row(const float* xrow, const float* g, bf16* orow, int lane, f32x4 (&v)[4]) {
    const f32x4* xr = (const f32x4*)xrow + lane; float s = 0.f;
#pragma unroll
    for (int j = 0; j < 4; ++j) { v[j] = xr[64 * j]; s += (v[j].x * v[j].x + v[j].y * v[j].y) + (v[j].z * v[j].z + v[j].w * v[j].w); }
    const float r = rsqrtf(wave_sum(s) * (1.f / DM) + EPS);
    v2u* o8 = (v2u*)orow + lane;
#pragma unroll
    for (int j = 0; j < 4; ++j) { const f32x4 gg = ((const f32x4*)g)[lane + 64 * j]; v[j] = v[j] * r * gg; v2u o; o.x = pk2(v[j].x, v[j].y); o.y = pk2(v[j].z, v[j].w); o8[64 * j] = o; }
}
__device__ __forceinline__ void ph_rmsnorm(Frame& F, const float* X, const float* g, bf16* H) {
    const int gw = F.bid * NWAVES + F.wave, NGW = F.G * NWAVES, lane = F.lane;
    for (int m = gw; m < M_TOK; m += 4 * NGW) {
        f32x4 v[4][4]; float s[4];
#pragma unroll
        for (int r = 0; r < 4; ++r) { const int mm = (m + r * NGW < M_TOK) ? m + r * NGW : m; const f32x4* xr = (const f32x4*)(X + (size_t)mm * DM) + lane;
#pragma unroll
            for (int j = 0; j < 4; ++j) v[r][j] = xr[64 * j]; }
#pragma unroll
        for (int r = 0; r < 4; ++r) { float t = 0.f;
#pragma unroll
            for (int j = 0; j < 4; ++j) t += (v[r][j].x * v[r][j].x + v[r][j].y * v[r][j].y) + (v[r][j].z * v[r][j].z + v[r][j].w * v[r][j].w);
            s[r] = t; }
#pragma unroll
        for (int o = 1; o < 64; o <<= 1) {
#pragma unroll
            for (int r = 0; r < 4; ++r) s[r] += __shfl_xor(s[r], o); }
#pragma unroll
        for (int r = 0; r < 4; ++r) { if (m + r * NGW < M_TOK) { const float rs = rsqrtf(s[r] * (1.f / DM) + EPS); v2u* o8 = (v2u*)(H + (size_t)(m + r * NGW) * DM) + lane;
#pragma unroll
            for (int j = 0; j < 4; ++j) { const f32x4 gg = ((const f32x4*)g)[lane + 64 * j]; const f32x4 y = v[r][j] * rs * gg; v2u o; o.x = pk2(y.x, y.y); o.y = pk2(y.z, y.w); o8[64 * j] = o; } } }
    }
}
__device__ __forceinline__ void ph_rope_table(Frame& F, float2* tab) {
    for (int idx = F.bid * NTHR + F.tid; idx < SEQ * 16; idx += F.G * NTHR) { const int pos = idx >> 4, i = idx & 15;
        const float fr = powf(10000.f, -(float)i / 16.f), ang = (float)pos * fr; tab[idx] = make_float2(cosf(ang), sinf(ang)); }
}
__device__ __forceinline__ void ph_refs(Frame& F) {
    if (F.bid != 0 || F.wave != 0) return;
    const int l = F.lane; float* refs = F.w<float>(WS_REFS);
#pragma unroll
    for (int mode = 0; mode < 3; ++mode) { const int dq = mode == 2 ? 96 : 64;
        const float* gq = F.in[mode == 0 ? I_MQN : mode == 1 ? I_DQN : I_MLAQN]; const float* gk = F.in[mode == 0 ? I_MKN : mode == 1 ? I_DKN : I_MLAKN];
        float aq = fabsf(gq[l]), ak = fabsf(gk[l]); if (mode == 2 && l < 32) { aq = fmaxf(aq, fabsf(gq[64 + l])); ak = fmaxf(ak, fabsf(gk[64 + l])); }
        const float mq = wave_max(aq), mk = wave_max(ak); const float base = (float)dq * mq * mk * (mode == 2 ? QSCALE96 : QSCALE64);
        if (mode == 2) { if (l < 16) refs[32 + l] = base; }
        else {
#pragma unroll
            for (int h = 0; h < 8; ++h) { const float mb = wave_max(l < 32 ? fmaxf(F.in[I_RELB][l * 16 + mode * 8 + h], 0.f) : 0.f); if (l == 0) refs[mode * 16 + h] = base + mb * LOG2E; } }
    }
}
__device__ __forceinline__ void wt_job(Frame& F, LAS unsigned char* scr, int& base, int idx, int K, int N, int Npad, int mode, int nexp, size_t off, const float* gk = nullptr, int ldo = 0) {
    const int gw = F.bid * NWAVES + F.wave, NGW = F.G * NWAVES;
    const int nblk = Npad / 64, per = (K / 64) * nblk, tot = per * nexp;
    const size_t wes = (size_t)K * N, wtes = (size_t)(mode == 0 ? Npad : 2 * Npad) * K;
    int it = base + ((gw - base % NGW) + NGW) % NGW;
    for (; it < base + tot; it += NGW) { const int r = it - base, e = r / per, q = r % per;
        transpose_item(F.in[idx] + (size_t)e * wes, K, N, Npad, F.w<bf16>(off) + (size_t)e * wtes, mode, scr, q, nblk, F.lane, gk, ldo); }
    base += tot;
}
__device__ __forceinline__ void ph_prologue(Frame& F) {
    LAS unsigned char* scr = F.lds + F.wave * 8192;
    int base = 0;
    wt_job(F, scr, base, I_W_IN_E, 1024, N_IN_E, QKV_LD, 0, 1, WS_W_IN_E);
    wt_job(F, scr, base, I_W_OUT_E, 1024, 1024, 1024, 0, 1, WS_W_OUT_E);
    wt_job(F, scr, base, I_W_GATE_E, 1024, FF_E, FF_E, 1, 1, WS_W_GU_E, F.in[I_FFNN_E]);
    wt_job(F, scr, base, I_W_UP_E, 1024, FF_E, FF_E, 2, 1, WS_W_GU_E, F.in[I_FFNN_E]);
    wt_job(F, scr, base, I_W_DOWN_E, FF_E, 1024, 1024, 0, 1, WS_W_DN_E);
    wt_job(F, scr, base, I_W_IN_O, 1024, N_IN_O, C1_LD, 0, 1, WS_W_IN_O, F.in[I_MIXN_O]);
    wt_job(F, scr, base, I_W_UQ, 384, 1536, 1536, 0, 1, WS_W_LAT, F.in[I_QAN], W_LAT_LD);
    wt_job(F, scr, base, I_W_UKV, 256, 2048, 2048, 3, 1, WS_W_LAT + ((size_t)1536 * W_LAT_LD + 384) * 2, F.in[I_KVAN], W_LAT_LD);
    wt_job(F, scr, base, I_W_OUT_O, 1024, 1024, 1024, 0, 1, WS_W_OUT_O);
    ph_rope_table(F, F.w<float2>(WS_ROPE));
    ph_refs(F);
    ph_rmsnorm(F, F.in[I_X], F.in[I_MIXN_E], F.w<bf16>(WS_H));
}
constexpr int MOE_T_GU = (1024 / 64) * (FF_O / 64) * NEXP, MOE_T_DN = (FF_O / 64) * (1024 / 64) * NEXP, MOE_ITEMS = 2 * MOE_T_GU + MOE_T_DN;
constexpr int MOE_TAIL_A = 4096, MOE_TAIL_B = 4096, MOE_TAIL_C = 3072, MOE_TAIL_ALL = MOE_TAIL_A + MOE_TAIL_B + MOE_TAIL_C, NSLOT_MOE = 4;
__device__ __forceinline__ void moe_convert_item(Frame& F, LAS unsigned char* scr, int it) {
    constexpr int PER_GU = (1024 / 64) * (FF_O / 64), PER_DN = (FF_O / 64) * (1024 / 64);
    if (it < 2 * MOE_T_GU) { const int up = it >= MOE_T_GU, r = it - up * MOE_T_GU, e = r / PER_GU, q = r % PER_GU;
        transpose_item(F.in[up ? I_W_UP_O : I_W_GATE_O] + (size_t)e * 1024 * FF_O, 1024, FF_O, FF_O, F.w<bf16>(WS_WGU_O) + (size_t)e * 2 * FF_O * 1024, up ? 2 : 1, scr, q, FF_O / 64, F.lane, F.in[I_FFNN_O]); }
    else { const int r = it - 2 * MOE_T_GU, e = r / PER_DN, q = r % PER_DN;
        transpose_item(F.in[I_W_DOWN_O] + (size_t)e * FF_O * 1024, FF_O, 1024, 1024, F.w<bf16>(WS_WDN_O) + (size_t)e * 1024 * FF_O, 0, scr, q, 1024 / 64, F.lane); }
}
__device__ __forceinline__ void moe_convert_tail(Frame& F, int first, int n, int wg0) {
    if (F.G != 256 || F.bid < wg0) return;
    LAS unsigned char* scr = F.lds + F.wave * 8192; const int nw = (F.G - wg0) * NWAVES, w = (F.bid - wg0) * NWAVES + F.wave;
    for (int it = first + w; it < first + n; it += nw) moe_convert_item(F, scr, it);
}
__device__ __forceinline__ void moe_convert_slice(Frame& F, int slice) {
    LAS unsigned char* scr = F.lds + F.wave * 8192;
    const int gw = F.bid * NWAVES + F.wave, NGW = F.G * NWAVES, first = (F.G == 256) ? MOE_TAIL_ALL : 0;
    for (int it = first + slice * NGW + gw; it < MOE_ITEMS; it += NSLOT_MOE * NGW) moe_convert_item(F, scr, it);
    __syncthreads();
}
__device__ __forceinline__ void ph_rmsnorm_route(Frame& F, const bf16* X, const float* g, float* rstd_out) {
    const float* wr = F.in[I_W_ROUTER]; const float* br = F.in[I_B_ROUTER]; int2* re = F.w<int2>(WS_ROUTE_E); float2* rg = F.w<float2>(WS_ROUTE_G); int* cnt_wg = F.w<int>(WS_CNT_WG);
    LAS int* cnt = (LAS int*)F.lds;
    f32x4 wg[16][2];
#pragma unroll
    for (int j = 0; j < 4; ++j)
#pragma unroll
        for (int q = 0; q < 4; ++q) { const int d = 4 * F.lane + 256 * j + q; const float gd = g[d]; wg[4 * j + q][0] = *(const f32x4*)(wr + d * 8) * gd; wg[4 * j + q][1] = *(const f32x4*)(wr + d * 8 + 4) * gd; }
    float bre[8];
#pragma unroll
    for (int e = 0; e < 8; ++e) bre[e] = br[e];
    for (int ch = F.bid; ch < 256; ch += F.G) {
        if (F.tid < 8) cnt[F.tid] = 0;
        __syncthreads();
        for (int i = F.wave; i < 64; i += 2 * NWAVES) {
            v2u raw[2][4];
#pragma unroll
            for (int r = 0; r < 2; ++r) { const v2u* xr = (const v2u*)(X + (size_t)(ch * 64 + i + r * NWAVES) * DM) + F.lane;
#pragma unroll
                for (int j = 0; j < 4; ++j) raw[r][j] = xr[64 * j]; }
#pragma unroll
            for (int r = 0; r < 2; ++r) { const int m = ch * 64 + i + r * NWAVES; float s = 0.f; float lg[8];
#pragma unroll
                for (int e = 0; e < 8; ++e) lg[e] = 0.f;
#pragma unroll
                for (int j = 0; j < 4; ++j) { const float x4[4] = {bflo(raw[r][j].x), bfhi(raw[r][j].x), bflo(raw[r][j].y), bfhi(raw[r][j].y)};
#pragma unroll
                    for (int q = 0; q < 4; ++q) { const float y = x4[q]; s += y * y; const f32x4 w0 = wg[4 * j + q][0], w1 = wg[4 * j + q][1];
                        lg[0] += y * w0.x; lg[1] += y * w0.y; lg[2] += y * w0.z; lg[3] += y * w0.w; lg[4] += y * w1.x; lg[5] += y * w1.y; lg[6] += y * w1.z; lg[7] += y * w1.w; } }
                const float rs = rsqrtf(wave_sum(s) * (1.f / DM) + EPS);
                if (F.lane == 0) rstd_out[m] = rs;
#pragma unroll
                for (int e = 0; e < 8; ++e) lg[e] = wave_sum(lg[e]) * rs + bre[e];
                int e0 = 0; float v0 = lg[0];
#pragma unroll
                for (int e = 1; e < 8; ++e) if (lg[e] > v0) { v0 = lg[e]; e0 = e; }
                int e1 = -1; float v1 = -INFINITY;
#pragma unroll
                for (int e = 0; e < 8; ++e) if (e != e0 && lg[e] > v1) { v1 = lg[e]; e1 = e; }
                if (F.lane == 0) { const float p1 = 1.f / (1.f + __expf(v0 - v1)); re[m] = make_int2(e0, e1); rg[m] = make_float2(1.f - p1, p1); atomicAdd((int*)&cnt[e0], 1); atomicAdd((int*)&cnt[e1], 1); } } }
        __syncthreads();
        if (F.tid < 8) cnt_wg[ch * 8 + F.tid] = cnt[F.tid];
        __syncthreads();
    }
}
__device__ __forceinline__ void ph_slots(Frame& F) {
    const int2* re = F.w<int2>(WS_ROUTE_E); const float2* rg = F.w<float2>(WS_ROUTE_G); const int* cnt_wg = F.w<int>(WS_CNT_WG);
    int* stok = F.w<int>(WS_SLOT_TOK); float* sgate = F.w<float>(WS_SLOT_GATE); int* tile_e = F.w<int>(WS_TILE_E); int2* tslot = F.w<int2>(WS_TOK_SLOT); const float* rstd = F.w<float>(WS_RSTD); float* srstd = F.w<float>(WS_SLOT_RSTD);
    LAS int* sh = (LAS int*)F.lds;
    { const int e = F.wave, l = F.lane;
      const int c0 = cnt_wg[(4 * l + 0) * 8 + e], c1 = cnt_wg[(4 * l + 1) * 8 + e], c2 = cnt_wg[(4 * l + 2) * 8 + e], c3 = cnt_wg[(4 * l + 3) * 8 + e];
      const int tot = c0 + c1 + c2 + c3; int incl = tot;
#pragma unroll
      for (int off = 1; off < 64; off <<= 1) { const int v = __shfl_up(incl, off); if (l >= off) incl += v; }
      const int excl = incl - tot;
      sh[64 + 8 * (4 * l + 0) + e] = excl; sh[64 + 8 * (4 * l + 1) + e] = excl + c0; sh[64 + 8 * (4 * l + 2) + e] = excl + c0 + c1; sh[64 + 8 * (4 * l + 3) + e] = excl + c0 + c1 + c2;
      if (l == 63) sh[e] = incl; }
    __syncthreads();
    if (F.tid == 0) { int o = 0; for (int e = 0; e < 8; ++e) { sh[8 + e] = o; o += (sh[e] + 255) / 256 * 256; } sh[16] = o; }
    __syncthreads();
    for (int ch = F.bid; ch < 256; ch += F.G) {
        if (F.wave == 0) { const int row = ch * 64 + F.lane; const int2 e = re[row]; const float2 gg = rg[row]; int s0 = 0, s1 = 0;
            const unsigned long long below = (1ull << F.lane) - 1ull;
#pragma unroll
            for (int q = 0; q < 8; ++q) { const unsigned long long m = __ballot(e.x == q) | __ballot(e.y == q); const int pos = sh[8 + q] + sh[64 + 8 * ch + q] + __popcll(m & below);
                if (e.x == q) s0 = pos; if (e.y == q) s1 = pos; }
            const float rr = rstd[row]; stok[s0] = row; sgate[s0] = gg.x; srstd[s0] = rr; stok[s1] = row; sgate[s1] = gg.y; srstd[s1] = rr; tslot[row] = make_int2(s0, s1); }
    }
    if (F.bid == 0) { for (int e = 0; e < 8; ++e) for (int s = sh[8 + e] + sh[e] + F.tid; s < sh[8 + e + 1]; s += NTHR) { stok[s] = -1; sgate[s] = 0.f; srstd[s] = 0.f; }
        for (int tl = F.tid; tl <= TILE_CAP; tl += NTHR) { int e = -1; for (int q = 0; q < 8; ++q) if (tl * 256 >= sh[8 + q] && tl * 256 < sh[8 + q + 1]) e = q; if (tl == TILE_CAP) e = sh[16] / 256; tile_e[tl] = e; } }
    __syncthreads();
}
__device__ __forceinline__ void ph_rmsnorm_lat(Frame& F) {
    const bf16* C1 = F.w<bf16>(WS_C1); bf16* CQN = F.w<bf16>(WS_CQN); bf16* CKVN = F.w<bf16>(WS_CKVN); const float* gq = F.in[I_QAN]; const float* gkv = F.in[I_KVAN];
    const int gw = F.bid * NWAVES + F.wave, NGW = F.G * NWAVES, lane = F.lane;
    const bool isq = lane < 48; const float* g1 = isq ? gq + lane * 8 : gkv + (lane - 48) * 8; const float* g2 = gkv + (16 + lane) * 8;
    float ga[8], gb[8];
#pragma unroll
    for (int j = 0; j < 8; ++j) { ga[j] = g1[j]; gb[j] = (lane < 16) ? g2[j] : 0.f; }
    for (int m = gw; m < M_TOK; m += 4 * NGW) {
        v4u ra[4], rb[4];
#pragma unroll
        for (int r = 0; r < 4; ++r) { const int mm = (m + r * NGW < M_TOK) ? m + r * NGW : m; const v4u* row = (const v4u*)(C1 + (size_t)mm * C1_LD); ra[r] = row[lane]; rb[r] = (lane < 16) ? row[64 + lane] : (v4u){0u, 0u, 0u, 0u}; }
#pragma unroll
        for (int r = 0; r < 4; ++r) { if (m + r * NGW < M_TOK) { const int mm = m + r * NGW;
            float xa[8], xb[8]; float sa = 0.f, sb = 0.f;
#pragma unroll
            for (int e = 0; e < 4; ++e) { xa[2 * e] = bflo(ra[r][e]); xa[2 * e + 1] = bfhi(ra[r][e]); xb[2 * e] = bflo(rb[r][e]); xb[2 * e + 1] = bfhi(rb[r][e]); }
#pragma unroll
            for (int j = 0; j < 8; ++j) { sa += xa[j] * xa[j]; sb += xb[j] * xb[j]; }
            const float sq = wave_sum(isq ? sa : 0.f), skv = wave_sum((isq ? 0.f : sa) + sb);
            const float rq = rsqrtf(sq * (1.f / 384) + EPS), rkv = rsqrtf(skv * (1.f / 256) + EPS), r1 = isq ? rq : rkv;
            v4u o;
#pragma unroll
            for (int e = 0; e < 4; ++e) o[e] = pk2(xa[2 * e] * r1 * ga[2 * e], xa[2 * e + 1] * r1 * ga[2 * e + 1]);
            if (isq) *(v4u*)(CQN + (size_t)mm * 384 + lane * 8) = o; else *(v4u*)(CKVN + (size_t)mm * 256 + (lane - 48) * 8) = o;
            if (lane < 16) { v4u o2;
#pragma unroll
                for (int e = 0; e < 4; ++e) o2[e] = pk2(xb[2 * e] * rkv * gb[2 * e], xb[2 * e + 1] * rkv * gb[2 * e + 1]);
                *(v4u*)(CKVN + (size_t)mm * 256 + (16 + lane) * 8) = o2; } } }
    }
}
template <int DUMMY>
__device__ __forceinline__ void ph_qknorm(Frame& F) {
    bf16* QKV = F.w<bf16>(WS_QKV0); float* kmean2 = F.w<float>(WS_KMEAN); LAS float* part = (LAS float*)F.lds;
    const int lane = F.lane;
    for (int u = F.bid; u < 256; u += F.G) { const int grp = u & 1, half = (u >> 1) & 1, blk = (u >> 2) & 15, b = u >> 6;
        const int col = (grp == 0 ? C_MK : C_DK) + lane * 8;
        const float* g = F.in[grp == 0 ? I_MKN : I_DKN] + (lane & 7) * 8;
        float gg[8];
#pragma unroll
        for (int j = 0; j < 8; ++j) gg[j] = g[j];
        float ks[8];
#pragma unroll
        for (int j = 0; j < 8; ++j) ks[j] = 0.f;
        const size_t row0 = (size_t)b * SEQ + blk * 256 + half * 128;
        for (int i0 = F.wave; i0 < 128; i0 += 4 * NWAVES) {
            v4u raw[4];
#pragma unroll
            for (int u4 = 0; u4 < 4; ++u4) raw[u4] = *(const v4u*)(QKV + (row0 + i0 + u4 * NWAVES) * QKV_LD + col);
#pragma unroll
            for (int u4 = 0; u4 < 4; ++u4) { float x[8];
                x[0] = bflo(raw[u4].x); x[1] = bfhi(raw[u4].x); x[2] = bflo(raw[u4].y); x[3] = bfhi(raw[u4].y); x[4] = bflo(raw[u4].z); x[5] = bfhi(raw[u4].z); x[6] = bflo(raw[u4].w); x[7] = bfhi(raw[u4].w);
                float ss = 0.f;
#pragma unroll
                for (int j = 0; j < 8; ++j) ss += x[j] * x[j];
                ss += __shfl_xor(ss, 1); ss += __shfl_xor(ss, 2); ss += __shfl_xor(ss, 4);
                const float r = rsqrtf(ss * (1.f / 64) + EPS);
#pragma unroll
                for (int j = 0; j < 8; ++j) { x[j] = x[j] * r * gg[j]; ks[j] += x[j]; }
                v4u o; o.x = pk2(x[0], x[1]); o.y = pk2(x[2], x[3]); o.z = pk2(x[4], x[5]); o.w = pk2(x[6], x[7]);
                if (DUMMY) *(v4u*)(F.w<bf16>(WS_O) + (row0 + i0 + u4 * NWAVES) * 1024 + (col & 511)) = o; else *(v4u*)(QKV + (row0 + i0 + u4 * NWAVES) * QKV_LD + col) = o; } }
        if (grp == 0) {
#pragma unroll
            for (int j = 0; j < 8; ++j) part[F.wave * 512 + lane * 8 + j] = ks[j];
            __syncthreads();
            { const int c = F.tid; float s = 0.f;
#pragma unroll
              for (int w = 0; w < 8; ++w) s += part[w * 512 + c];
              (DUMMY ? F.w<float>(WS_O) + 8 * 1024 * 1024 / 4 * 3 : kmean2)[((((b * 8 + (c >> 6)) * 16 + blk) * 2) + half) * 64 + (c & 63)] = s; }
            __syncthreads(); }
    }
}
__device__ __forceinline__ void ph_mla_prep(Frame& F, const float2* tab) {
    const float* KSS = F.w<float>(WS_KSS); const bf16* C1 = F.w<bf16>(WS_C1); bf16* KM = F.w<bf16>(WS_KM); const float* g = F.in[I_MLAKN];
#pragma unroll 1
    for (int idx = F.bid * NTHR + F.tid; idx < M_TOK * 16; idx += F.G * NTHR) { const int row = idx >> 4, h = idx & 15, pos = row & (SEQ - 1);
        const v4u* src2 = (const v4u*)(C1 + (size_t)row * C1_LD + C1_KPE);
        v4u raw[4];
#pragma unroll
        for (int c = 0; c < 4; ++c) raw[c] = src2[c];
        const float r = KSS[idx];
        v4u* dst = (v4u*)(KM + (size_t)row * QR_LD + h * 96);
#pragma unroll
        for (int cc = 0; cc < 2; ++cc) { v4u o1, o2;
#pragma unroll
            for (int e = 0; e < 4; ++e) { const int i0 = 8 * cc + 2 * e;
                const float a0 = bflo(raw[cc][e]) * r * g[64 + i0], a1 = bfhi(raw[cc][e]) * r * g[64 + i0 + 1], b0 = bflo(raw[2 + cc][e]) * r * g[80 + i0], b1 = bfhi(raw[2 + cc][e]) * r * g[80 + i0 + 1];
                const float2 c0 = tab[pos * 16 + i0], c1 = tab[pos * 16 + i0 + 1];
                o1[e] = pk2(a0 * c0.x - b0 * c0.y, a1 * c1.x - b1 * c1.y); o2[e] = pk2(a0 * c0.y + b0 * c0.x, a1 * c1.y + b1 * c1.x); }
            dst[8 + cc] = o1; dst[10 + cc] = o2; }
    }
}
__device__ __forceinline__ void moe_y_row(const bf16* Y, const bf16* YP, int slot, int lane, float gate, f32x4 (&x)[4]) {
    if (slot < MOE_FULL_TILES * 256) { const v2u* a = (const v2u*)(Y + (size_t)slot * 1024) + lane;
#pragma unroll
        for (int j = 0; j < 4; ++j) { const v2u p = a[64 * j]; x[j].x += gate * bflo(p.x); x[j].y += gate * bfhi(p.x); x[j].z += gate * bflo(p.y); x[j].w += gate * bfhi(p.y); } }
    else { const v2u* a = (const v2u*)(YP + (size_t)(slot - MOE_FULL_TILES * 256) * 1024) + lane;
#pragma unroll
        for (int j = 0; j < 4; ++j) { float s0 = 0.f, s1 = 0.f, s2 = 0.f, s3 = 0.f;
#pragma unroll
            for (int k = 0; k < MOE_TAIL_SPLIT; ++k) { const v2u p = a[(size_t)k * MOE_TAIL_ROWS * 256 + 64 * j]; s0 += bflo(p.x); s1 += bfhi(p.x); s2 += bflo(p.y); s3 += bfhi(p.y); }
            x[j].x += gate * s0; x[j].y += gate * s1; x[j].z += gate * s2; x[j].w += gate * s3; } }
}
__device__ __forceinline__ void ph_moe_combine(Frame& F) {
    const bf16* Y = F.w<bf16>(WS_Y); const bf16* YP = F.w<bf16>(WS_YP); const int2* tslot = F.w<int2>(WS_TOK_SLOT); const float2* rg = F.w<float2>(WS_ROUTE_G); float* X = F.out; const bf16* XB = F.w<bf16>(WS_H);
    const int gw = F.bid * NWAVES + F.wave, NGW = F.G * NWAVES;
#pragma unroll 2
    for (int m = gw; m < M_TOK; m += NGW) { const int2 sl = tslot[m]; const float2 g = rg[m];
        f32x4* xr = (f32x4*)(X + (size_t)m * DM) + F.lane; const v2u* xb = (const v2u*)(XB + (size_t)m * DM) + F.lane; f32x4 x[4];
#pragma unroll
        for (int j = 0; j < 4; ++j) { const v2u p = xb[64 * j]; x[j] = (f32x4){bflo(p.x), bfhi(p.x), bflo(p.y), bfhi(p.y)}; }
        moe_y_row(Y, YP, sl.x, F.lane, g.x, x); moe_y_row(Y, YP, sl.y, F.lane, g.y, x);
#pragma unroll
        for (int j = 0; j < 4; ++j) xr[64 * j] = x[j]; }
}

namespace at {
typedef short s16x4 __attribute__((ext_vector_type(4)));
typedef short v4i16_t __attribute__((ext_vector_type(4)));
typedef __attribute__((address_space(3))) const char* lds_cptr;
__device__ __forceinline__ unsigned cvtpk(float lo, float hi) { return pk2(lo, hi); }
__device__ __forceinline__ int crow(int r, int hi) { return (r & 3) + 8 * (r >> 2) + 4 * hi; }
__device__ __forceinline__ s16x4 vtr(lds_cptr p) { return __builtin_bit_cast(s16x4, __builtin_amdgcn_ds_read_tr16_b64_v4i16((__attribute__((address_space(3))) v4i16_t*)p)); }

__device__ __forceinline__ void glds16(const void* gbase, unsigned voff, unsigned lds_dst) { unsigned keep;
    asm volatile("s_mov_b32 %0, m0\n\ts_mov_b32 m0, %3\n\ts_nop 0\n\tglobal_load_lds_dwordx4 %1, %2\n\ts_mov_b32 m0, %0" : "=&s"(keep) : "v"(voff), "s"(gbase), "s"(lds_dst) : "memory"); }
__device__ __forceinline__ void glds16b(const void* gbase, unsigned voff, unsigned lds_dst) { unsigned keep;
    asm volatile("s_mov_b32 %0, m0\n\ts_mov_b32 m0, %3\n\ts_nop 0\n\tglobal_load_lds_dwordx4 %1, %2 offset:128\n\ts_mov_b32 m0, %0" : "=&s"(keep) : "v"(voff), "s"(gbase), "s"(lds_dst) : "memory"); }
__device__ __forceinline__ void glds4(const void* gbase, unsigned voff, unsigned lds_dst) { unsigned keep;
    asm volatile("s_mov_b32 %0, m0\n\ts_mov_b32 m0, %3\n\ts_nop 0\n\tglobal_load_lds_dword %1, %2\n\ts_mov_b32 m0, %0" : "=&s"(keep) : "v"(voff), "s"(gbase), "s"(lds_dst) : "memory"); }
constexpr int KBUF = 12288, VBUF = 8192, MBUF = 2048;
constexpr int NSTG = 4;
constexpr int L_K = 0, L_V = NSTG * KBUF, L_M = L_V + NSTG * VBUF, L_TAB = L_M + NSTG * MBUF, TAB_GUARD = 64, TAB_N = SEQ + TAB_GUARD, L_WS = L_TAB + TAB_N * 4, L_OST = L_WS + NWAVES * 64 * 4, L_MISC = L_OST + NWAVES * 4096, L_END = L_MISC + 64;
static_assert(L_END <= LDSCTL_OFF, "attention LDS map");

struct AttnP { const bf16* Q; int ldq, qhs; const bf16* K; int ldk, khs; const bf16* V; int ldv, vhs; bf16* O; int ocol0; const float* relb; int bcol0; const float* kmean; const unsigned long long* maskt;
               const float* refs; const float* gq; const float2* rope; };

template <int MODE, int DQK>
__device__ __forceinline__ void attn_unit(Frame& F, const AttnP& P, int b, int h, int qb, bool build_tab) {
    constexpr int ND0 = DQK / 16;
    LAS unsigned char* lds = F.lds; const lds_cptr shm3 = (lds_cptr)F.lds;
    const int tid = F.tid, lane = F.lane, r32 = lane & 31, hi = lane >> 5, wid = F.wave;
    const size_t rowbase = (size_t)b * SEQ; const int q0 = qb * 256, qw = q0 + wid * 32, q = qw + r32;
    LAS float* tab = (LAS float*)(lds + L_TAB) + TAB_GUARD;
    LAS float* wsf = (LAS float*)(lds + L_WS) + wid * 64;
    const float ref = P.refs[MODE * 16 + h];
    if (MODE != 2 && build_tab) {
        for (int n = tid - TAB_GUARD; n < SEQ; n += NTHR) tab[n] = (n < 0) ? 0.f : P.relb[rel_bucket(n) * 16 + P.bcol0 + h] * LOG2E - ref;
    }
    const bf16* Kh = P.K + rowbase * P.ldk + h * P.khs; const bf16* Vh = P.V + rowbase * P.ldv + h * P.vhs;
    const unsigned kvoff = (unsigned)(lane * P.ldk + wid * 8) * 2u;
    const unsigned vvoff = (unsigned)((16 * (wid & 3) + (lane >> 2)) * P.ldv + (wid >> 2) * 32 + (lane & 3) * 8) * 2u;
    const unsigned lds0 = (unsigned)(size_t)lds;
    const unsigned char* mbase = (MODE == 1) ? (const unsigned char*)(P.maskt + ((size_t)b * 64 * SEQ) + qw) : nullptr;
#define AT_DMA(t, bufi) do { const bf16* kt_ = Kh + (size_t)(t) * 64 * P.ldk; \
        at::glds16(kt_, kvoff, (unsigned)__builtin_amdgcn_readfirstlane(lds0 + L_K + (bufi) * KBUF + wid * 1024)); \
        if (DQK == 96 && wid < 4) at::glds16b(kt_, kvoff, (unsigned)__builtin_amdgcn_readfirstlane(lds0 + L_K + (bufi) * KBUF + (8 + wid) * 1024 - 128));   \
        at::glds16(Vh + (size_t)(t) * 64 * P.ldv, vvoff, (unsigned)__builtin_amdgcn_readfirstlane(lds0 + L_V + (bufi) * VBUF + wid * 1024)); \
        if (MODE == 1) at::glds4(mbase + (size_t)(t) * SEQ * 8, (unsigned)lane * 4u, (unsigned)__builtin_amdgcn_readfirstlane(lds0 + L_M + (bufi) * MBUF + wid * 256)); } while (0)
    const int NT = (q0 + 256) / 64;
    const int tdiag = qw >> 6;
    AT_DMA(0, 0); AT_DMA(1, 1); AT_DMA(2, 2);
    bf16x8 qr[ND0];
    { const bf16* Qw = P.Q + (rowbase + q) * P.ldq + h * P.qhs + hi * 8;
#pragma unroll
      for (int d0 = 0; d0 < ND0; ++d0) qr[d0] = *(const bf16x8*)(Qw + d0 * 16); }
    if (MODE != 2) {
        float x[4][8]; float ss = 0.f;
#pragma unroll
        for (int d0 = 0; d0 < 4; ++d0)
#pragma unroll
            for (int j = 0; j < 8; ++j) { x[d0][j] = bf2f((bf16)qr[d0][j]); ss += x[d0][j] * x[d0][j]; }
        ss += __shfl_xor(ss, 32);
        const float rr = rsqrtf(ss * (1.f / 64) + EPS) * QSCALE64; const float* g = P.gq + hi * 8;
#pragma unroll
        for (int d0 = 0; d0 < 4; ++d0) { v4u w;
#pragma unroll
            for (int e = 0; e < 4; ++e) w[e] = pk2(x[d0][2 * e] * rr * g[d0 * 16 + 2 * e], x[d0][2 * e + 1] * rr * g[d0 * 16 + 2 * e + 1]);
            qr[d0] = __builtin_bit_cast(bf16x8, w); }
    }
    if (MODE == 2) {
        float x[6][8]; float ss = 0.f;
#pragma unroll
        for (int d0 = 0; d0 < 6; ++d0)
#pragma unroll
            for (int j = 0; j < 8; ++j) { x[d0][j] = bf2f((bf16)qr[d0][j]); ss += x[d0][j] * x[d0][j]; }
        ss += __shfl_xor(ss, 32);
        const float rr = rsqrtf(ss * (1.f / 96) + EPS) * QSCALE96; const float* g = P.gq + hi * 8;
#pragma unroll
        for (int d0 = 0; d0 < 6; ++d0)
#pragma unroll
            for (int j = 0; j < 8; ++j) x[d0][j] *= rr * g[d0 * 16 + j];
#pragma unroll
        for (int j = 0; j < 8; ++j) { const float2 cs = P.rope[q * 16 + hi * 8 + j]; const float x1 = x[4][j], x2 = x[5][j]; x[4][j] = x1 * cs.x - x2 * cs.y; x[5][j] = x1 * cs.y + x2 * cs.x; }
#pragma unroll
        for (int d0 = 0; d0 < 6; ++d0) { v4u w; w.x = pk2(x[d0][0], x[d0][1]); w.y = pk2(x[d0][2], x[d0][3]); w.z = pk2(x[d0][4], x[d0][5]); w.w = pk2(x[d0][6], x[d0][7]); qr[d0] = __builtin_bit_cast(bf16x8, w); }
    }
    unsigned keep = 0u; const int blk = qb;
    if (MODE == 0) {
        float v1 = -INFINITY, v2 = -INFINITY, v3 = -INFINITY; int i1 = -1, i2 = -1, i3 = -1;
        LAS float* kml = (LAS float*)(lds + L_OST);
        for (int i = tid; i < blk * 64; i += NTHR) { const float* k2 = P.kmean + (size_t)((b * 8 + h) * 16) * 128 + (i >> 6) * 128 + (i & 63); kml[i] = (k2[0] + k2[64]) * (1.f / 256); }
        asm volatile("s_waitcnt lgkmcnt(0)" ::: "memory"); __builtin_amdgcn_s_barrier();
        const LAS float* km0 = kml + hi * 8;
#pragma unroll 1
        for (int j = 0; j < blk; ++j) { const LAS float* km = km0 + j * 64; float g = 0.f;
#pragma unroll
            for (int d0 = 0; d0 < 4; ++d0) { const f32x4 ka = *(const LAS f32x4*)(km + d0 * 16), kb = *(const LAS f32x4*)(km + d0 * 16 + 4); const bf16x8 qq = qr[d0];
                g += bf2f((bf16)qq[0]) * ka.x + bf2f((bf16)qq[1]) * ka.y + bf2f((bf16)qq[2]) * ka.z + bf2f((bf16)qq[3]) * ka.w + bf2f((bf16)qq[4]) * kb.x + bf2f((bf16)qq[5]) * kb.y + bf2f((bf16)qq[6]) * kb.z + bf2f((bf16)qq[7]) * kb.w; }
            g += __shfl_xor(g, 32);
            if (g > v1) { v3 = v2; i3 = i2; v2 = v1; i2 = i1; v1 = g; i1 = j; } else if (g > v2) { v3 = v2; i3 = i2; v2 = g; i2 = j; } else if (g > v3) { v3 = g; i3 = j; } }
        if (i1 >= 0) keep |= 1u << i1; if (i2 >= 0) keep |= 1u << i2; if (i3 >= 0) keep |= 1u << i3;
    }
    float l_reg = 0.f; f32x16 o[2];
#pragma unroll
    for (int r = 0; r < 16; ++r) { o[0][r] = 0.f; o[1][r] = 0.f; }
    f32x16 cfar;
    { const float cf = -ref;
#pragma unroll
      for (int r = 0; r < 16; ++r) cfar[r] = (MODE == 2) ? cf : 0.f; }
#define AT_WAIT() do { if (DQK == 96 && wid < 4) asm volatile("s_waitcnt vmcnt(6) lgkmcnt(0)" ::: "memory"); \
        else if (MODE == 1) asm volatile("s_waitcnt vmcnt(6) lgkmcnt(0)" ::: "memory"); else asm volatile("s_waitcnt vmcnt(4) lgkmcnt(0)" ::: "memory"); } while (0)
#pragma unroll
    for (int d0 = 0; d0 < ND0; ++d0) asm volatile("" : "+v"(qr[d0]));
    asm volatile("" : "+v"(cfar)); asm volatile("" : "+v"(keep));
    asm volatile("s_waitcnt vmcnt(0) lgkmcnt(0)" ::: "memory");
    __builtin_amdgcn_s_barrier();
    for (int t = 0; t < NT; ++t) {
        const int bufi = t & (NSTG - 1);
        if (t + 3 < NT) AT_DMA(t + 3, (t + 3) & (NSTG - 1));
        bool active = t <= tdiag;
        bool lane_keep = true;
        if (MODE == 0) { const int jb = t >> 2; lane_keep = (jb == blk) || ((keep >> jb) & 1u); active = active && (__ballot(lane_keep) != 0ull); }
        if (active) {
            f32x16 p0, p1;
            const lds_cptr kp = shm3 + L_K + bufi * KBUF + hi * 1024 + r32 * 16;
            bf16x8 kf[2 * ND0];
#pragma unroll
            for (int d0 = 0; d0 < ND0; ++d0) { kf[2 * d0] = *(const __attribute__((address_space(3))) bf16x8*)(kp + d0 * 2048); kf[2 * d0 + 1] = *(const __attribute__((address_space(3))) bf16x8*)(kp + d0 * 2048 + 512); }
            v2u mwv = {0u, 0u}; if (MODE == 1) mwv = *(const LAS v2u*)(lds + L_M + bufi * MBUF + wid * 256 + r32 * 8);
            __builtin_amdgcn_sched_barrier(0);
            if (MODE != 2) { const LAS float* tb = tab + (q - 64 * t - 4 * hi);
#pragma unroll
                for (int r = 0; r < 16; ++r) { const int c = (r & 3) + 8 * (r >> 2); p0[r] = tb[-c]; p1[r] = tb[-c - 32]; }
#pragma unroll
                for (int d0 = 0; d0 < ND0; ++d0) { p0 = __builtin_amdgcn_mfma_f32_32x32x16_bf16(kf[2 * d0], qr[d0], p0, 0, 0, 0); p1 = __builtin_amdgcn_mfma_f32_32x32x16_bf16(kf[2 * d0 + 1], qr[d0], p1, 0, 0, 0); } }
            else {
                p0 = __builtin_amdgcn_mfma_f32_32x32x16_bf16(kf[0], qr[0], cfar, 0, 0, 0); p1 = __builtin_amdgcn_mfma_f32_32x32x16_bf16(kf[1], qr[0], cfar, 0, 0, 0);
#pragma unroll
                for (int d0 = 1; d0 < ND0; ++d0) { p0 = __builtin_amdgcn_mfma_f32_32x32x16_bf16(kf[2 * d0], qr[d0], p0, 0, 0, 0); p1 = __builtin_amdgcn_mfma_f32_32x32x16_bf16(kf[2 * d0 + 1], qr[d0], p1, 0, 0, 0); } }
            const lds_cptr vp = shm3 + L_V + bufi * VBUF + ((lane >> 4) & 1) * 32 + (lane & 3) * 8 + (4 * hi + ((lane & 15) >> 2)) * 64;
            bf16x8 vf[4];
#pragma unroll
            for (int i = 0; i < 4; ++i) { const s16x4 lo = vtr(vp + i * 1024), hh = vtr(vp + i * 1024 + 512); vf[i] = (bf16x8){lo[0], lo[1], lo[2], lo[3], hh[0], hh[1], hh[2], hh[3]}; }
            __builtin_amdgcn_sched_barrier(0);
#pragma unroll
            for (int r = 0; r < 16; ++r) { p0[r] = __builtin_amdgcn_exp2f(p0[r]); p1[r] = __builtin_amdgcn_exp2f(p1[r]); }
            if (MODE != 1 && t == tdiag) { const int kb = 64 * t + 4 * hi;
#pragma unroll
                for (int r = 0; r < 16; ++r) { const int kv = kb + (r & 3) + 8 * (r >> 2); if (kv > q) p0[r] = 0.f; if (kv + 32 > q) p1[r] = 0.f; } }
            if (MODE == 1) { const unsigned wl = mwv.x >> (4 * hi), wh = mwv.y >> (4 * hi);
#pragma unroll
                for (int r = 0; r < 16; ++r) { int m0, m1;
                    asm("v_bfe_i32 %0, %1, %2, 1" : "=v"(m0) : "v"(wl), "n"((r & 3) + 8 * (r >> 2))); asm("v_bfe_i32 %0, %1, %2, 1" : "=v"(m1) : "v"(wh), "n"((r & 3) + 8 * (r >> 2)));
                    p0[r] = __uint_as_float(__float_as_uint(p0[r]) & (unsigned)m0); p1[r] = __uint_as_float(__float_as_uint(p1[r]) & (unsigned)m1); } }
            float sacc = 0.f;
#pragma unroll
            for (int r = 0; r < 16; ++r) sacc += p0[r] + p1[r];
            const unsigned kmask = (MODE == 0 && !lane_keep) ? 0u : 0xffffffffu;
            l_reg += (MODE == 0 && !lane_keep) ? 0.f : sacc;
            v4u pw[4];
#pragma unroll
            for (int k = 0; k < 2; ++k) { pw[k].x = cvtpk(p0[8 * k], p0[8 * k + 1]); pw[k].y = cvtpk(p0[8 * k + 2], p0[8 * k + 3]); pw[k].z = cvtpk(p0[8 * k + 4], p0[8 * k + 5]); pw[k].w = cvtpk(p0[8 * k + 6], p0[8 * k + 7]);
                pw[2 + k].x = cvtpk(p1[8 * k], p1[8 * k + 1]); pw[2 + k].y = cvtpk(p1[8 * k + 2], p1[8 * k + 3]); pw[2 + k].z = cvtpk(p1[8 * k + 4], p1[8 * k + 5]); pw[2 + k].w = cvtpk(p1[8 * k + 6], p1[8 * k + 7]); }
            if (MODE == 0) {
#pragma unroll
                for (int k = 0; k < 4; ++k) { pw[k].x &= kmask; pw[k].y &= kmask; pw[k].z &= kmask; pw[k].w &= kmask; } }
            bf16x8 vg[4];
#pragma unroll
            for (int i = 0; i < 4; ++i) { const s16x4 lo = vtr(vp + 4096 + i * 1024), hh = vtr(vp + 4096 + i * 1024 + 512); vg[i] = (bf16x8){lo[0], lo[1], lo[2], lo[3], hh[0], hh[1], hh[2], hh[3]}; }
#pragma unroll
            for (int i = 0; i < 4; ++i) o[0] = __builtin_amdgcn_mfma_f32_32x32x16_bf16(__builtin_bit_cast(bf16x8, pw[i]), vf[i], o[0], 0, 0, 0);
#pragma unroll
            for (int i = 0; i < 4; ++i) o[1] = __builtin_amdgcn_mfma_f32_32x32x16_bf16(__builtin_bit_cast(bf16x8, pw[i]), vg[i], o[1], 0, 0, 0);
        }
        if (t + 3 < NT) AT_WAIT(); else asm volatile("s_waitcnt vmcnt(0) lgkmcnt(0)" ::: "memory");
        __builtin_amdgcn_s_barrier();
    }
#undef AT_WAIT
    l_reg += __shfl_xor(l_reg, 32);
    if (hi == 0) wsf[r32] = l_reg;
    LDS_WAIT();
    float rli[16];
#pragma unroll
    for (int r = 0; r < 16; ++r) rli[r] = __builtin_amdgcn_rcpf(wsf[crow(r, hi)]);
    bf16* Ow = P.O + (rowbase + qw) * 1024 + P.ocol0 + h * 64;
    { LAS bf16* stg = (LAS bf16*)(lds + L_OST) + wid * 2048;
#pragma unroll
      for (int r = 0; r < 16; ++r) { const int orow = crow(r, hi);
#pragma unroll
          for (int d0 = 0; d0 < 2; ++d0) stg[orow * 64 + d0 * 32 + r32] = f2bf(o[d0][r] * rli[r]); }
      LDS_WAIT();
#pragma unroll
      for (int i = 0; i < 4; ++i) { const int row = i * 8 + (lane >> 3), ch = lane & 7; const v4u v = *(const LAS v4u*)(stg + row * 64 + ch * 8); *(v4u*)(Ow + (size_t)row * 1024 + ch * 8) = v; } }
    asm volatile("s_waitcnt lgkmcnt(0)" ::: "memory"); __builtin_amdgcn_s_barrier();
#undef AT_DMA
}
}

__device__ __forceinline__ void ph_attn_l0(Frame& F) {
    const bf16* QKV = F.w<bf16>(WS_QKV0);
    at::AttnP PM{QKV + C_MQ, QKV_LD, 64, QKV + C_MK, QKV_LD, 64, QKV + C_MV, QKV_LD, 64, F.w<bf16>(WS_O), 0, F.in[I_RELB], 0, F.w<float>(WS_KMEAN), nullptr, F.w<float>(WS_REFS), F.in[I_MQN], nullptr};
    at::AttnP PD{QKV + C_DQ, QKV_LD, 64, QKV + C_DK, QKV_LD, 64, QKV + C_DV, QKV_LD, 64, F.w<bf16>(WS_O), 512, F.in[I_RELB], 8, nullptr, F.w<unsigned long long>(WS_MASKT), F.w<float>(WS_REFS), F.in[I_DQN], nullptr};
    const int vcu = (F.G % 8 == 0) ? (F.bid % 8) * (F.G / 8) + F.bid / 8 : F.bid;
    for (int v = vcu; v < 256; v += F.G) { const int bh = v >> 3, s = v & 7, b = bh >> 3, h = bh & 7;
        at::attn_unit<0, 64>(F, PM, b, h, 15 - s, true); moe_convert_slice(F, 0); at::attn_unit<0, 64>(F, PM, b, h, s, false);
        at::attn_unit<1, 64>(F, PD, b, h, 15 - s, true); moe_convert_slice(F, 1); at::attn_unit<1, 64>(F, PD, b, h, s, false); }
}
__device__ __forceinline__ void ph_attn_mla(Frame& F) {
    at::AttnP PA{F.w<bf16>(WS_QR), QR_LD, 96, F.w<bf16>(WS_KM), QR_LD, 96, F.w<bf16>(WS_KVR) + 64, KVR_LD, 128, F.w<bf16>(WS_O1), 0, nullptr, 0, nullptr, nullptr, F.w<float>(WS_REFS), F.in[I_MLAQN], F.w<float2>(WS_ROPE)};
    const int vcu = (F.G % 8 == 0) ? (F.bid % 8) * (F.G / 8) + F.bid / 8 : F.bid;
    for (int v = vcu; v < 256; v += F.G) { const int bh = v >> 2, s = v & 3, b = bh >> 4, h = bh & 15;
        const bool rev = (bh & 1) != 0; const int q0 = rev ? s : 15 - s, q1 = rev ? 11 - s : 4 + s, q2 = rev ? 4 + s : 11 - s, q3 = rev ? 15 - s : s;
        at::attn_unit<2, 96>(F, PA, b, h, q0, false); moe_convert_slice(F, 2); at::attn_unit<2, 96>(F, PA, b, h, q1, false);
        at::attn_unit<2, 96>(F, PA, b, h, q2, false); moe_convert_slice(F, 3); at::attn_unit<2, 96>(F, PA, b, h, q3, false); }
}

namespace ix {
constexpr int HP = 1028;
constexpr int L_HIST = 0, L_ROW = 32 * HP * 4;
constexpr int MP = 129;
constexpr int L_GE = 0, L_EQ = 32 * MP * 4;
static_assert(L_ROW + 3 * 32 * 4 <= LDSCTL_OFF && L_EQ + 32 * MP * 4 <= L_ROW, "index LDS map");

__device__ __forceinline__ float irelu(float x) { const int i = __float_as_int(x); return __int_as_float(i > 0 ? i : 0); }
__device__ __forceinline__ float mul_s(float a, float b) { float d; asm("v_mul_f32_e32 %0, %1, %2" : "=v"(d) : "v"(a), "v"(b)); return d; }
__device__ __forceinline__ float fma_s(float a, float b, float c) { float d; asm("v_fma_f32 %0, %1, %2, %3" : "=v"(d) : "v"(a), "v"(b), "v"(c)); return d; }
__device__ __forceinline__ void hadd0(unsigned base, unsigned u, unsigned k65535) { unsigned a, v;
    asm volatile("v_lshrrev_b32_e32 %0, 22, %2\n\tv_bfe_u32 %1, %2, 21, 1\n\tv_lshl_add_u32 %0, %0, 2, %3\n\tv_mad_u32_u24 %1, %1, %4, 1\n\tds_add_u32 %0, %1"
                 : "=&v"(a), "=&v"(v) : "v"(u), "v"(base), "s"(k65535) : "memory"); }
__device__ __forceinline__ void hadd1(unsigned base, unsigned u, unsigned pre, unsigned k65535, unsigned k1024) { unsigned a, v, t;
    asm volatile("v_lshrrev_b32_e32 %2, 21, %3\n\tv_bfe_u32 %0, %3, 11, 10\n\tv_cmp_eq_u32_e32 vcc, %2, %5\n\tv_bfe_u32 %1, %3, 10, 1\n\tv_mad_u32_u24 %1, %1, %6, 1\n\tv_cndmask_b32_e32 %0, %7, %0, vcc\n\tv_lshl_add_u32 %0, %0, 2, %4\n\tds_add_u32 %0, %1"
                 : "=&v"(a), "=&v"(v), "=&v"(t) : "v"(u), "v"(base), "v"(pre), "s"(k65535), "v"(k1024) : "memory", "vcc"); }
__device__ __forceinline__ void push2(unsigned& ge, unsigned& gt, unsigned xa, unsigned xb, unsigned cge, unsigned cgt) { unsigned long long s0, s1, s2;
    asm("v_cmp_ge_u32_e64 %2, %5, %7\n\tv_cmp_ge_u32_e64 %3, %5, %8\n\tv_cmp_ge_u32_e64 %4, %6, %7\n\tv_cmp_ge_u32_e32 vcc, %6, %8\n\t"
        "v_addc_co_u32_e64 %0, %2, %0, %0, %2\n\tv_addc_co_u32_e64 %1, %3, %1, %1, %3\n\tv_addc_co_u32_e64 %0, %4, %0, %0, %4\n\tv_addc_co_u32_e32 %1, vcc, %1, %1, vcc"
        : "+v"(ge), "+v"(gt), "=&s"(s0), "=&s"(s1), "=&s"(s2) : "v"(xa), "v"(xb), "v"(cge), "v"(cgt) : "vcc"); }

template <int PASS, int VAR>
__device__ __forceinline__ void tile(bf16x8 (&kf)[4], const bf16* knext, const bf16x8 (&qf)[4][4], const f32x2_t (&w2)[4], bool diag, int kt, int r32, int hi, LAS unsigned* hist, unsigned hbase, unsigned mypre, unsigned Fx, unsigned Cge, unsigned Cgt) {
    const f32x16 zero16 = {0.f, 0.f, 0.f, 0.f, 0.f, 0.f, 0.f, 0.f, 0.f, 0.f, 0.f, 0.f, 0.f, 0.f, 0.f, 0.f};
    unsigned u[16];
    if (VAR & 2) {
#pragma unroll
        for (int r = 0; r < 16; ++r) u[r] = __builtin_bit_cast(v4u, kf[r & 3])[r >> 2];
    } else {
        float sc[16];
        { f32x16 a0, a1;
          a0 = __builtin_amdgcn_mfma_f32_32x32x16_bf16(kf[0], qf[0][0], zero16, 0, 0, 0); a1 = __builtin_amdgcn_mfma_f32_32x32x16_bf16(kf[0], qf[1][0], zero16, 0, 0, 0);
#pragma unroll
          for (int d0 = 1; d0 < 4; ++d0) { a0 = __builtin_amdgcn_mfma_f32_32x32x16_bf16(kf[d0], qf[0][d0], a0, 0, 0, 0); a1 = __builtin_amdgcn_mfma_f32_32x32x16_bf16(kf[d0], qf[1][d0], a1, 0, 0, 0); }
#pragma unroll
          for (int r = 0; r < 16; ++r) sc[r] = fma_s(irelu(a1[r]), w2[1].x, mul_s(irelu(a0[r]), w2[0].x)); }
        { f32x16 a2, a3;
          a2 = __builtin_amdgcn_mfma_f32_32x32x16_bf16(kf[0], qf[2][0], zero16, 0, 0, 0); a3 = __builtin_amdgcn_mfma_f32_32x32x16_bf16(kf[0], qf[3][0], zero16, 0, 0, 0);
#pragma unroll
          for (int d0 = 1; d0 < 4; ++d0) { a2 = __builtin_amdgcn_mfma_f32_32x32x16_bf16(kf[d0], qf[2][d0], a2, 0, 0, 0); a3 = __builtin_amdgcn_mfma_f32_32x32x16_bf16(kf[d0], qf[3][d0], a3, 0, 0, 0); }
#pragma unroll
          for (int d0 = 0; d0 < 4; ++d0) { if (!(VAR & 8)) kf[d0] = *(const bf16x8*)(knext + d0 * 512); }
#pragma unroll
          for (int r = 0; r < 16; ++r) sc[r] = fma_s(irelu(a3[r]), w2[3].x, fma_s(irelu(a2[r]), w2[2].x, sc[r])); }
#pragma unroll
        for (int r = 0; r < 16; ++r) u[r] = __float_as_uint(sc[r]);
    }
    if (diag) {
#pragma unroll
        for (int r = 0; r < 16; ++r) { const int c = (r & 3) + 8 * (r >> 2) + 4 * hi; u[r] = (c <= r32) ? u[r] : 0xffffffffu; } }
    if (PASS == 0) {
#pragma unroll
        for (int r = 0; r < 16; ++r) { if (VAR & 1) asm volatile("" :: "v"(u[r])); else hadd0(hbase, u[r], 65535u); }
    } else if (PASS == 1) {
#pragma unroll
        for (int r = 0; r < 16; ++r) { if (VAR & 1) asm volatile("" :: "v"(u[r])); else hadd1(hbase, u[r], mypre, 65535u, 1024u); }
    } else {
        unsigned ge = 0u, gt = 0u;
#pragma unroll
        for (int r = 15; r >= 1; r -= 2) { push2(ge, gt, u[r] ^ Fx, u[r - 1] ^ Fx, Cge, Cgt); if ((r & 3) == 1 && r > 1) { ge <<= 4; gt <<= 4; } }
        ge <<= 4 * hi; gt <<= 4 * hi; const unsigned eq = ge & ~gt;
        if (ge) atomicOr((unsigned*)(hist + r32 * MP + kt), ge);
        if (eq) atomicOr((unsigned*)(hist + 32 * MP + r32 * MP + kt), eq);
    }
}
template <int PASS, int VAR>
__device__ __forceinline__ void pass_loop(const bf16x8 (&qf)[4][4], const f32x2_t (&w2)[4], const bf16* kbase, int KT, int wid, int r32, int hi, LAS unsigned* hist, unsigned mypre) {
    const unsigned hbase = (unsigned)(size_t)(hist + r32 * HP);
    unsigned Fx = 0u, Cge = 0u, Cgt = 0u;
    if (PASS == 2) { const unsigned Tlo = mypre << 10; const bool neg = (mypre >> 21) & 1u;
        Fx = neg ? 0xffffffffu : 0x80000000u; Cge = neg ? ~(Tlo | 1023u) : (Tlo ^ 0x80000000u); Cgt = neg ? (~Tlo + 1u) : ((Tlo + 1024u) ^ 0x80000000u); }
    bf16x8 ka[4], kb[4];
    { const bf16* kr = kbase + (size_t)(wid < KT ? wid : 0) * 2048; const bf16* kr2 = kbase + (size_t)(wid + NWAVES < KT ? wid + NWAVES : 0) * 2048;
#pragma unroll
      for (int d0 = 0; d0 < 4; ++d0) ka[d0] = *(const bf16x8*)(kr + d0 * 512);
#pragma unroll
      for (int d0 = 0; d0 < 4; ++d0) kb[d0] = *(const bf16x8*)(kr2 + d0 * 512); }
    int kt = wid;
#pragma unroll 1
    for (; kt + NWAVES < KT; kt += 2 * NWAVES) {
        tile<PASS, VAR>(ka, kbase + (size_t)(kt + 2 * NWAVES < KT ? kt + 2 * NWAVES : kt) * 2048, qf, w2, false, kt, r32, hi, hist, hbase, mypre, Fx, Cge, Cgt);
        tile<PASS, VAR>(kb, kbase + (size_t)(kt + 3 * NWAVES < KT ? kt + 3 * NWAVES : kt) * 2048, qf, w2, kt + NWAVES == KT - 1, kt + NWAVES, r32, hi, hist, hbase, mypre, Fx, Cge, Cgt);
    }
    if (kt < KT) tile<PASS, VAR>(ka, kbase + (size_t)kt * 2048, qf, w2, kt == KT - 1, kt, r32, hi, hist, hbase, mypre, Fx, Cge, Cgt);
    asm volatile("s_waitcnt lgkmcnt(0)" ::: "memory");
}

template <int VAR>
__device__ __forceinline__ void dsa_index_unit(Frame& F, int b, int qt) {
    const int tid = F.tid, lane = F.lane, r32 = lane & 31, hi = lane >> 5, wid = F.wave;
    const int q0 = qt * 32, q = q0 + r32, KT = qt + 1;
    const bf16* QKV = F.w<bf16>(WS_QKV0); unsigned long long* maskt = F.w<unsigned long long>(VAR ? WS_H : WS_MASKT);
    LAS unsigned* hist = (LAS unsigned*)(F.lds + ix::L_HIST); LAS unsigned* rowi = (LAS unsigned*)(F.lds + ix::L_ROW);
    LAS unsigned* pre = rowi; LAS unsigned* krem = rowi + 32; LAS unsigned* cnteq = rowi + 64;
    const bf16* qrow = QKV + (size_t)(b * SEQ + q) * QKV_LD;
    bf16x8 qf[4][4];
#pragma unroll
    for (int h = 0; h < 4; ++h)
#pragma unroll
        for (int d0 = 0; d0 < 4; ++d0) qf[h][d0] = *(const bf16x8*)(qrow + C_IQ + h * 64 + d0 * 16 + hi * 8);
    f32x2_t w2[4];
    { const v2u wr = *(const v2u*)(qrow + C_IW); const float w0 = __uint_as_float(wr.x << 16), w1 = __uint_as_float(wr.x & 0xffff0000u), w2f = __uint_as_float(wr.y << 16), w3 = __uint_as_float(wr.y & 0xffff0000u);
      w2[0] = (f32x2_t){w0, w0}; w2[1] = (f32x2_t){w1, w1}; w2[2] = (f32x2_t){w2f, w2f}; w2[3] = (f32x2_t){w3, w3}; }
    for (int i = tid; i < 32 * ix::HP; i += NTHR) hist[i] = 0u;
    if (tid < 32) { pre[tid] = 0u; const int n = q0 + tid + 1; krem[tid] = (unsigned)(n < 256 ? n : 256); cnteq[tid] = 0u; }
    __syncthreads();
    const bf16* kbase = F.w<bf16>(WS_IKT) + (size_t)(b * 128) * 2048 + hi * 256 + r32 * 8;
#pragma unroll 1
    for (int pass = 0; pass < 3; ++pass) {
        const unsigned mypre = pre[r32];
        if (pass == 2) { __syncthreads(); for (int i = tid; i < 2 * 32 * ix::MP; i += NTHR) hist[i] = 0u; __syncthreads(); }
        if (pass == 0) pass_loop<0, VAR>(qf, w2, kbase, KT, wid, r32, hi, hist, mypre);
        else if (pass == 1) pass_loop<1, VAR>(qf, w2, kbase, KT, wid, r32, hi, hist, mypre);
        else pass_loop<2, VAR>(qf, w2, kbase, KT, wid, r32, hi, hist, mypre);
        __syncthreads();
        if (pass < 2) {
#pragma unroll 1
            for (int rr = 0; rr < 4; ++rr) { const int row = wid * 4 + rr; const unsigned rowpre = pre[row];
                const bool neg = (pass == 0) ? (lane < 32) : (rowpre >= 1024u); const int rl = (pass == 0) ? (neg ? 63 - lane : lane - 32) : (neg ? 63 - lane : lane);
                const LAS unsigned* hr = hist + row * ix::HP + rl * 16;
                unsigned wr[16], wv[16]; unsigned total = 0u;
#pragma unroll
                for (int i = 0; i < 16; ++i) wr[i] = hr[i];
#pragma unroll
                for (int i = 0; i < 16; ++i) { wv[i] = neg ? __builtin_amdgcn_alignbit(wr[15 - i], wr[15 - i], 16) : wr[i]; total += (wv[i] & 0xffffu) + (wv[i] >> 16); }
                unsigned S = total;
#pragma unroll
                for (int off = 1; off < 64; off <<= 1) { const unsigned v = __shfl_down(S, off); if (lane + off < 64) S += v; }
                const unsigned k = krem[row], above = S - total;
                if (S >= k && above < k) { unsigned run = above, bstar = 0u, newk = 0u, cnt = 0u; bool done = false;
#pragma unroll
                    for (int i = 15; i >= 0; --i) { const unsigned ch = wv[i] >> 16, cl = wv[i] & 0xffffu;
                        if (!done) { if (run + ch >= k) { bstar = 32u * lane + 2u * i + 1u; newk = k - run; cnt = ch; done = true; } else run += ch; }
                        if (!done) { if (run + cl >= k) { bstar = 32u * lane + 2u * i; newk = k - run; cnt = cl; done = true; } else run += cl; } }
                    const unsigned braw = (pass == 0) ? (bstar >= 1024u ? bstar - 1024u : 2047u - bstar) : (neg ? 2047u - bstar : bstar);
                    pre[row] = (rowpre << 11) | braw; krem[row] = newk; cnteq[row] = cnt; } }
            __syncthreads();
            if (pass < 1) { for (int i = tid; i < 32 * ix::HP; i += NTHR) hist[i] = 0u; __syncthreads(); }
        }
    }
#pragma unroll 1
    for (int rr = 0; rr < 4; ++rr) { const int row = wid * 4 + rr; const unsigned need = krem[row], ce = cnteq[row];
        if (need < ce) { LAS unsigned* g = hist + row * ix::MP; LAS unsigned* e = hist + 32 * ix::MP + row * ix::MP;
            const unsigned e0 = e[2 * lane], e1 = e[2 * lane + 1]; const int c0 = __popc(e0), c1 = __popc(e1), c = c0 + c1; int incl = c;
#pragma unroll
            for (int off = 1; off < 64; off <<= 1) { const int v = __shfl_up(incl, off); if (lane >= off) incl += v; }
            int rem = (int)need - (incl - c); rem = rem < 0 ? 0 : (rem > c ? c : rem);
            const int k0 = rem < c0 ? rem : c0, k1 = rem - k0;
            unsigned y0 = e0; for (int i = 0; i < k0; ++i) y0 &= y0 - 1u;
            unsigned y1 = e1; for (int i = 0; i < k1; ++i) y1 &= y1 - 1u;
            g[2 * lane] &= ~y0; g[2 * lane + 1] &= ~y1; } }
    __syncthreads();
    for (int idx = tid; idx < 32 * 64; idx += NTHR) { const int qq = idx & 31, t = idx >> 5;
        const unsigned lo = hist[qq * ix::MP + 2 * t], hh = hist[qq * ix::MP + 2 * t + 1];
        maskt[((size_t)(b * 64 + t) * SEQ) + q0 + qq] = (unsigned long long)lo | ((unsigned long long)hh << 32); }
    __syncthreads();
}
}
template <int VAR>
__device__ __forceinline__ void ph_dsa_index(Frame& F) {
    for (int v = F.bid; v < 256; v += F.G) { const int b = v >> 6, i = v & 63; ix::dsa_index_unit<VAR>(F, b, 127 - i); ix::dsa_index_unit<VAR>(F, b, i); }
}

#define XB_TMO      128
#define XB_XCNT(j)  (256  + 64 * (j))
#define XB_XSUB(j)  (1280 + 64 * (j))
#define XB_XGEN(j)  (2304 + 64 * (j))
#define XB_TOP      3328
#define XB_TOPGEN   3392
#define XCD_BAR_WORDS 3456
#define XB_SPIN_CAP (1u << 18)

__device__ __forceinline__ unsigned xb_ld(unsigned* p)              { return __hip_atomic_load(p, __ATOMIC_RELAXED, __HIP_MEMORY_SCOPE_AGENT); }
__device__ __forceinline__ unsigned xb_add(unsigned* p, unsigned v) { return __hip_atomic_fetch_add(p, v, __ATOMIC_RELAXED, __HIP_MEMORY_SCOPE_AGENT); }
__device__ __forceinline__ unsigned xb_xcc_id() { return (unsigned)__builtin_amdgcn_s_getreg((3 << 11) | 20) & 0xFu; }
#define XB_SPIN(cond, bar) do { unsigned _sp = 0; while (cond) { __builtin_amdgcn_s_sleep(1); \
    if ((++_sp & 255u) == 0u) { if (xb_ld(&(bar)[XB_TMO])) break; if (_sp > XB_SPIN_CAP) { atomicAdd(&(bar)[XB_TMO], 1u); break; } } } } while (0)

struct XcdBarrier {
    unsigned* bar; unsigned x;
    volatile LAS unsigned* st;
};

__device__ __forceinline__ XcdBarrier xcd_barrier_post(unsigned* bar, volatile LAS unsigned* st) {
    XcdBarrier b; b.bar = bar; b.x = xb_xcc_id(); b.st = st;
    if (threadIdx.x == 0) (void)xb_add(&bar[XB_XCNT(b.x)], 1u);
    return b;
}
__device__ __forceinline__ void xcd_barrier_complete(unsigned* bar, unsigned x, unsigned& nloc, unsigned& nx) {
    const unsigned G = gridDim.x * gridDim.y * gridDim.z;
    unsigned sum, cnt, mine, sp = 0u;
    for (;;) {
        sum = 0u; cnt = 0u; mine = 0u;
#pragma unroll
        for (unsigned j = 0; j < 16; ++j) { const unsigned c = xb_ld(&bar[XB_XCNT(j)]); sum += c; cnt += (c > 0u) ? 1u : 0u; mine = (j == x) ? c : mine; }
        if (sum == G) break;
        __builtin_amdgcn_s_sleep(1);
        if ((++sp & 255u) == 0u) { if (xb_ld(&bar[XB_TMO])) break; if (sp > XB_SPIN_CAP) { atomicAdd(&bar[XB_TMO], 1u); break; } }
    }
    nloc = mine > 0u ? mine : 1u; nx = cnt > 0u ? cnt : 1u;
}

__device__ __forceinline__ void xcd_barrier(const XcdBarrier& b) {
    asm volatile("s_waitcnt vmcnt(0)" ::: "memory");
    __syncthreads();
    if (threadIdx.x == 0) {
        unsigned* bar = b.bar;
        __builtin_amdgcn_s_waitcnt(0);
        unsigned nloc = b.st[0], nx = b.st[1];
        if (nloc == 0u) { xcd_barrier_complete(bar, b.x, nloc, nx); b.st[0] = nloc; b.st[1] = nx; }
        const unsigned old = xb_add(&bar[XB_XSUB(b.x)], 1u);
        const unsigned gen = old / nloc;
        if (old + 1u == (gen + 1u) * nloc) {
            __builtin_amdgcn_fence(__ATOMIC_RELEASE, "agent");
            asm volatile("s_waitcnt vmcnt(0)" ::: "memory");
            const unsigned og = xb_add(&bar[XB_TOP], 1u);
            const unsigned tg = og / nx;
            if (og + 1u == (tg + 1u) * nx) xb_add(&bar[XB_TOPGEN], 1u);
            else XB_SPIN(xb_ld(&bar[XB_TOPGEN]) == tg, bar);
            __builtin_amdgcn_fence(__ATOMIC_ACQUIRE, "agent");
            xb_add(&bar[XB_XGEN(b.x)], 1u);
            asm volatile("s_waitcnt vmcnt(0)" ::: "memory");
        } else {
            XB_SPIN(xb_ld(&bar[XB_XGEN(b.x)]) == gen, bar);
            __builtin_amdgcn_fence(__ATOMIC_ACQUIRE, "agent");
            asm volatile("s_waitcnt vmcnt(0)" ::: "memory");
        }
    }
    __syncthreads();
}

constexpr int NPHASE = 20;
constexpr int CW_BAR = 4096;
#ifndef HAVE_ATTN
#define HAVE_ATTN 0
#endif
#ifndef HAVE_INDEX
#define HAVE_INDEX 0
#endif

__global__ void __launch_bounds__(NTHR, 2) mega(Args args) {
    extern __shared__ __attribute__((aligned(16))) unsigned char lds_raw[];
    Frame F; F.lds = (LAS unsigned char*)lds_raw; F.tid = threadIdx.x; F.lane = F.tid & 63; F.wave = __builtin_amdgcn_readfirstlane(F.tid >> 6);
    F.G = gridDim.x; F.bid = blockIdx.x; F.in = args.in; F.out = args.out; F.ws = args.ws;
    volatile LAS unsigned* MISC = (volatile LAS unsigned*)(F.lds + LDSCTL_OFF);
    for (int u = F.tid; u < 256; u += NTHR) MISC[u] = 0u;
    __syncthreads();
    const int lo = args.ph_lo, hi = args.ph_hi;
    XcdBarrier bar; bar.bar = (unsigned*)(args.ws + WS_CTL) + CW_BAR; bar.x = 0; bar.st = nullptr;
    if (hi - lo > 1) bar = xcd_barrier_post((unsigned*)(args.ws + WS_CTL) + CW_BAR, MISC + 8);
#define IN(k) (lo <= (k) && (k) < hi)
#define SEAM(k) do { if (IN(k) && IN((k) + 1)) xcd_barrier(bar); } while (0)
    PG8_LAS unsigned char* glds = (PG8_LAS unsigned char*)lds_raw;
    const pg8::bf16_t* H = F.w<pg8::bf16_t>(WS_H);

    if (IN(0)) { ph_prologue(F); } SEAM(0);
    if (IN(1)) { pg8::Gemm g{H, F.w<pg8::bf16_t>(WS_W_IN_E), 1024, 1024, 1024}; pg8::StaticOrder S{M_TOK / 256, QKV_LD / 256, F.G, F.bid}; pg8::EpiBf16 E{F.w<pg8::bf16_t>(WS_QKV0), QKV_LD, F.w<pg8::bf16_t>(WS_IKT), C_IK / 256};
        pg8::gemm_phase<pg8::EpiBf16, pg8::StaticOrder, true, false>(glds, g, S, E, nullptr);
        moe_convert_tail(F, 0, MOE_TAIL_A, (M_TOK / 256) * (QKV_LD / 256) % 256); } SEAM(1);
    if (IN(2)) { if (args.sub & 1) ph_qknorm<0>(F);
#ifdef QKN_PROBE
        if (args.sub & 8) ph_qknorm<1>(F);
#endif
#if HAVE_INDEX
        if (args.sub & 2) ph_dsa_index<0>(F);
#ifdef IDX_VAR
        if (args.sub & 4) ph_dsa_index<IDX_VAR>(F);
#endif
#endif
    } SEAM(2);
    if (IN(3)) {
#if HAVE_ATTN
        ph_attn_l0(F);
#endif
    } SEAM(3);
    if (IN(4)) { pg8::Gemm g{F.w<pg8::bf16_t>(WS_O), F.w<pg8::bf16_t>(WS_W_OUT_E), 1024, 1024, 1024}; pg8::StaticOrder S{M_TOK / 256, 4, F.G, F.bid}; pg8::EpiResN<false> E{F.in[I_X], F.w<pg8::bf16_t>(WS_H), F.w<float>(WS_SSP), 1024};
        pg8::gemm_phase<pg8::EpiResN<false>, pg8::StaticOrder, false, false>(glds, g, S, E, nullptr); } SEAM(4);
    if (IN(6)) { pg8::Gemm g{H, F.w<pg8::bf16_t>(WS_W_GU_E), 1024, 1024, 1024}; pg8::StaticOrder S{M_TOK / 256, 2 * FF_E / 256, F.G, F.bid}; pg8::EpiSwiGLUS<pg8::ScaleSSP> E{F.w<pg8::bf16_t>(WS_ACT0), FF_E, 1 << 20, {F.w<float>(WS_SSP), EPS}};
        pg8::gemm_phase<pg8::EpiSwiGLUS<pg8::ScaleSSP>, pg8::StaticOrder, true, false>(glds, g, S, E, nullptr);
        moe_convert_tail(F, MOE_TAIL_A, MOE_TAIL_B, (M_TOK / 256) * (2 * FF_E / 256) % 256); } SEAM(6);
    if (IN(7)) { pg8::Gemm g{F.w<pg8::bf16_t>(WS_ACT0), F.w<pg8::bf16_t>(WS_W_DN_E), FF_E, FF_E, FF_E}; pg8::StaticOrder S{M_TOK / 256, 4, F.G, F.bid}; pg8::EpiResN<true> E{nullptr, F.w<pg8::bf16_t>(WS_H), F.w<float>(WS_SSP), 1024};
        pg8::gemm_phase<pg8::EpiResN<true>, pg8::StaticOrder, false, false>(glds, g, S, E, nullptr); } SEAM(7);
    if (IN(9)) { pg8::Gemm g{H, F.w<pg8::bf16_t>(WS_W_IN_O), 1024, 1024, 1024}; pg8::StaticOrder S{M_TOK / 256, C1_LD / 256, F.G, F.bid}; pg8::EpiBf16SL<pg8::ScaleSSP> E{F.w<pg8::bf16_t>(WS_C1), C1_LD, F.w<float>(WS_LSP), {F.w<float>(WS_SSP), EPS}};
        pg8::gemm_phase<pg8::EpiBf16SL<pg8::ScaleSSP>, pg8::StaticOrder, true, false>(glds, g, S, E, nullptr);
        moe_convert_tail(F, MOE_TAIL_A + MOE_TAIL_B, MOE_TAIL_C, (M_TOK / 256) * (C1_LD / 256)); } SEAM(9);
    if (IN(11)) { pg8::Gemm g{F.w<pg8::bf16_t>(WS_C1), F.w<pg8::bf16_t>(WS_W_LAT), C1_LD, W_LAT_LD, 384}; pg8::LatJointOrder S{F.G, F.bid};
        pg8::EpiLatJoint E{F.w<pg8::bf16_t>(WS_QR), F.w<pg8::bf16_t>(WS_KVR), F.w<pg8::bf16_t>(WS_KM), F.w<float>(WS_KSS), F.in[I_MLAKN], {F.w<float>(WS_LSP), EPS}};
        pg8::gemm_phase<pg8::EpiLatJoint, pg8::LatJointOrder, true, false>(glds, g, S, E, nullptr); } SEAM(11);
    if (IN(12)) { ph_mla_prep(F, F.w<float2>(WS_ROPE)); } SEAM(12);
    if (IN(13)) {
#if HAVE_ATTN
        ph_attn_mla(F);
#endif
    } SEAM(13);
    if (IN(14)) { pg8::Gemm g{F.w<pg8::bf16_t>(WS_O1), F.w<pg8::bf16_t>(WS_W_OUT_O), 1024, 1024, 1024}; pg8::StaticOrder S{M_TOK / 256, 4, F.G, F.bid}; pg8::EpiResN<true> E{nullptr, F.w<pg8::bf16_t>(WS_H), F.w<float>(WS_SSP), 1024};
        pg8::gemm_phase<pg8::EpiResN<true>, pg8::StaticOrder, false, false>(glds, g, S, E, nullptr); } SEAM(14);
    if (IN(15)) { ph_rmsnorm_route(F, F.w<bf16>(WS_H), F.in[I_FFNN_O], F.w<float>(WS_RSTD)); } SEAM(15);
    if (IN(16)) { ph_slots(F); } SEAM(16);
    if (IN(17)) { const int* tile_e = F.w<int>(WS_TILE_E); const int ntile = tile_e[TILE_CAP];
        pg8::Gemm g{H, F.w<pg8::bf16_t>(WS_WGU_O), 1024, 1024, 1024}; pg8::MoeOrder S{tile_e, ntile, 2 * FF_O / 256, F.G, F.bid, 1, 1024, 0}; pg8::EpiSwiGLUS<pg8::ScaleSlot> E{F.w<pg8::bf16_t>(WS_ACT1), FF_O, 2 * FF_O / 256, {F.w<float>(WS_SLOT_RSTD)}};
        pg8::gemm_phase<pg8::EpiSwiGLUS<pg8::ScaleSlot>, pg8::MoeOrder, true, true>(glds, g, S, E, F.w<int>(WS_SLOT_TOK)); } SEAM(17);
    if (IN(18)) { const int* tile_e = F.w<int>(WS_TILE_E); const int ntile = tile_e[TILE_CAP];
        { pg8::Gemm g{F.w<pg8::bf16_t>(WS_ACT1), F.w<pg8::bf16_t>(WS_WDN_O), FF_O, FF_O, FF_O}; pg8::MoeOrder S{tile_e, ntile < MOE_FULL_TILES ? ntile : MOE_FULL_TILES, 4, F.G, F.bid, 1, FF_O, 0};
          pg8::EpiMoeY E{F.w<pg8::bf16_t>(WS_Y), 0, 4, FF_O, 0};
          pg8::gemm_phase<pg8::EpiMoeY, pg8::MoeOrder, true, false>(glds, g, S, E, nullptr); }
        if (ntile > MOE_FULL_TILES) { pg8::Gemm g{F.w<pg8::bf16_t>(WS_ACT1), F.w<pg8::bf16_t>(WS_WDN_O), FF_O, FF_O, FF_O / MOE_TAIL_SPLIT}; pg8::MoeOrder S{tile_e, ntile - MOE_FULL_TILES, 4, F.G, F.bid, MOE_TAIL_SPLIT, FF_O / MOE_TAIL_SPLIT, MOE_FULL_TILES};
          pg8::EpiMoeY E{F.w<pg8::bf16_t>(WS_YP), (size_t)MOE_TAIL_ROWS * 1024, 4, FF_O / MOE_TAIL_SPLIT, MOE_FULL_TILES * 256};
          pg8::gemm_phase<pg8::EpiMoeY, pg8::MoeOrder, true, false>(glds, g, S, E, nullptr); } } SEAM(18);
    if (IN(19)) { ph_moe_combine(F); }
#undef IN
#undef SEAM
}

#ifndef FAST_MASK
#define FAST_MASK 0xFFFFFu
#endif
#ifndef DUP_SUB
#define DUP_SUB 2
#endif
#ifndef ONE_LAUNCH
#define ONE_LAUNCH 0
#endif
struct Ptrs {
    const float* in[N_INPUTS]; float* out; unsigned char* ws;
    template <class T> T* w(size_t off) const { return (T*)(ws + off); }
};
static int g_grid = 0;
static void launch_mega(const Ptrs& P, int lo, int hi, hipStream_t st, int sub = 3) {
    Args a{}; a.sub = sub; for (int i = 0; i < N_INPUTS; ++i) a.in[i] = P.in[i]; a.out = P.out; a.ws = P.ws; a.ph_lo = lo; a.ph_hi = hi;
    hipLaunchKernelGGL(mega, dim3(g_grid), dim3(NTHR), LDS_BYTES, st, a);
    const hipError_t le = hipPeekAtLastError();
    if (le != hipSuccess) fprintf(stderr, "kernel_launch: mega[%d,%d) failed: %s\n", lo, hi, hipGetErrorName(le));
}
#if !ONE_LAUNCH
static void naive_weights(const Ptrs& P, hipStream_t st) {
    auto wt = [&](int idx, int K, int N, int Npad, size_t off, int mode, int nexp, size_t wes, size_t wtes) {
        nv::k_wt<<<dim3((Npad + 31) / 32, K / 32, nexp), 256, 0, st>>>(P.in[idx], K, N, Npad, P.w<bf16>(off), mode, wes, wtes); };
    wt(I_W_IN_E, 1024, N_IN_E, QKV_LD, WS_W_IN_E, 0, 1, 0, 0);
    wt(I_W_OUT_E, 1024, 1024, 1024, WS_W_OUT_E, 0, 1, 0, 0);
    wt(I_W_GATE_E, 1024, FF_E, FF_E, WS_W_GU_E, 1, 1, 0, 0);
    wt(I_W_UP_E, 1024, FF_E, FF_E, WS_W_GU_E, 2, 1, 0, 0);
    wt(I_W_DOWN_E, FF_E, 1024, 1024, WS_W_DN_E, 0, 1, 0, 0);
    wt(I_W_IN_O, 1024, N_IN_O, C1_LD, WS_W_IN_O, 0, 1, 0, 0);
    wt(I_W_UQ, 384, 1536, 1536, WS_W_UQ, 0, 1, 0, 0);
    wt(I_W_UKV, 256, 2048, 2048, WS_W_UKV, 0, 1, 0, 0);
    wt(I_W_OUT_O, 1024, 1024, 1024, WS_W_OUT_O, 0, 1, 0, 0);
    wt(I_W_GATE_O, 1024, FF_O, FF_O, WS_WGU_O, 1, NEXP, (size_t)1024 * FF_O, (size_t)2 * FF_O * 1024);
    wt(I_W_UP_O, 1024, FF_O, FF_O, WS_WGU_O, 2, NEXP, (size_t)1024 * FF_O, (size_t)2 * FF_O * 1024);
    wt(I_W_DOWN_O, FF_O, 1024, 1024, WS_WDN_O, 0, NEXP, (size_t)1024 * FF_O, (size_t)1024 * FF_O);
}
template <int EPI> static void naive_gemm(nv::GemmArgs a, hipStream_t st) { nv::k_gemm<EPI><<<dim3(a.N / 64, a.M / 64), 256, 0, st>>>(a); }
__global__ void k_rope_tab(float2* tab) { const int idx = blockIdx.x * 256 + threadIdx.x; const int pos = idx >> 4, i = idx & 15; const float fr = powf(10000.f, -(float)i / 16.f), ang = (float)pos * fr; tab[idx] = make_float2(cosf(ang), sinf(ang)); }

static void naive_phase(const Ptrs& P, int k, hipStream_t st) {
    bf16* H = P.w<bf16>(WS_H); bf16* QKV = P.w<bf16>(WS_QKV0); bf16* O = P.w<bf16>(WS_O); float* X = P.out;
    bf16* C1 = P.w<bf16>(WS_C1); bf16* QR = P.w<bf16>(WS_QR); bf16* KVR = P.w<bf16>(WS_KVR); bf16* KM = P.w<bf16>(WS_KM); bf16* O1 = P.w<bf16>(WS_O1);
    switch (k) {
    case 0: naive_weights(P, st); k_rope_tab<<<SEQ * 16 / 256, 256, 0, st>>>(P.w<float2>(WS_ROPE)); nv::k_rmsnorm<<<M_TOK / 4, 256, 0, st>>>(P.in[I_X], P.in[I_MIXN_E], H); break;
    case 1: { nv::GemmArgs a{}; a.A = H; a.lda = 1024; a.Bt = P.w<bf16>(WS_W_IN_E); a.K = 1024; a.M = M_TOK; a.N = QKV_LD; a.Cb = QKV; a.ldc = QKV_LD; naive_gemm<0>(a, st); } break;
    case 2: nv::k_kmean<<<NB * 8 * 16, 64, 0, st>>>(QKV, P.in[I_MKN], P.w<float>(WS_KMEAN));
            nv::k_qknorm<<<M_TOK * 32 / 256, 256, 0, st>>>(QKV, P.in[I_MQN], P.in[I_MKN], P.in[I_DQN], P.in[I_DKN]);
            break;
    case 100: nv::k_dsa_index<<<M_TOK, 256, 0, st>>>(QKV, P.w<unsigned long long>(WS_MASKT)); break;
    case 3: { nv::AttnArgs a{}; a.Q = QKV + C_MQ; a.ldq = QKV_LD; a.qhs = 64; a.K = QKV + C_MK; a.ldk = QKV_LD; a.khs = 64; a.V = QKV + C_MV; a.ldv = QKV_LD; a.vhs = 64; a.O = O; a.ocol0 = 0; a.H = 8;
              a.relb = P.in[I_RELB]; a.bcol0 = 0; a.kmean = P.w<float>(WS_KMEAN); a.maskt = nullptr; nv::k_attn<0, 64><<<NB * 8 * SEQ / 4, 256, 0, st>>>(a); }
            { nv::AttnArgs a{}; a.Q = QKV + C_DQ; a.ldq = QKV_LD; a.qhs = 64; a.K = QKV + C_DK; a.ldk = QKV_LD; a.khs = 64; a.V = QKV + C_DV; a.ldv = QKV_LD; a.vhs = 64; a.O = O; a.ocol0 = 512; a.H = 8;
              a.relb = P.in[I_RELB]; a.bcol0 = 8; a.kmean = nullptr; a.maskt = P.w<unsigned long long>(WS_MASKT); nv::k_attn<1, 64><<<NB * 8 * SEQ / 4, 256, 0, st>>>(a); } break;
    case 4: { nv::GemmArgs a{}; a.A = O; a.lda = 1024; a.Bt = P.w<bf16>(WS_W_OUT_E); a.K = 1024; a.M = M_TOK; a.N = 1024; a.Cf = X; a.R = P.in[I_X]; a.ldc = 1024; naive_gemm<1>(a, st); } break;
    case 5: nv::k_rmsnorm<<<M_TOK / 4, 256, 0, st>>>(X, P.in[I_FFNN_E], H); break;
    case 6: { nv::GemmArgs a{}; a.A = H; a.lda = 1024; a.Bt = P.w<bf16>(WS_W_GU_E); a.K = 1024; a.M = M_TOK; a.N = FF_E; a.Cb = P.w<bf16>(WS_ACT0); a.ldc = FF_E; naive_gemm<2>(a, st); } break;
    case 7: { nv::GemmArgs a{}; a.A = P.w<bf16>(WS_ACT0); a.lda = FF_E; a.Bt = P.w<bf16>(WS_W_DN_E); a.K = FF_E; a.M = M_TOK; a.N = 1024; a.Cf = X; a.R = X; a.ldc = 1024; naive_gemm<1>(a, st); } break;
    case 8: nv::k_rmsnorm<<<M_TOK / 4, 256, 0, st>>>(X, P.in[I_MIXN_O], H); break;
    case 9: { nv::GemmArgs a{}; a.A = H; a.lda = 1024; a.Bt = P.w<bf16>(WS_W_IN_O); a.K = 1024; a.M = M_TOK; a.N = C1_LD; a.Cb = C1; a.ldc = C1_LD; naive_gemm<0>(a, st); } break;
    case 10: nv::k_rmsnorm_bf<<<M_TOK / 4, 256, 0, st>>>(C1, C1_LD, C1_CQ, 384, P.in[I_QAN], P.w<bf16>(WS_CQN), 384);
             nv::k_rmsnorm_bf<<<M_TOK / 4, 256, 0, st>>>(C1, C1_LD, C1_CKV, 256, P.in[I_KVAN], P.w<bf16>(WS_CKVN), 256); break;
    case 11: { nv::GemmArgs a{}; a.A = P.w<bf16>(WS_CQN); a.lda = 384; a.Bt = P.w<bf16>(WS_W_UQ); a.K = 384; a.M = M_TOK; a.N = QR_LD; a.Cb = QR; a.ldc = QR_LD; naive_gemm<0>(a, st); }
             { nv::GemmArgs a{}; a.A = P.w<bf16>(WS_CKVN); a.lda = 256; a.Bt = P.w<bf16>(WS_W_UKV); a.K = 256; a.M = M_TOK; a.N = KVR_LD; a.Cb = KVR; a.ldc = KVR_LD; naive_gemm<0>(a, st); } break;
    case 12: nv::k_mla_prep<<<M_TOK * 16 / 256, 256, 0, st>>>(QR, KVR, C1, KM, P.in[I_MLAQN], P.in[I_MLAKN]); break;
    case 13: { nv::AttnArgs a{}; a.Q = QR; a.ldq = QR_LD; a.qhs = 96; a.K = KM; a.ldk = QR_LD; a.khs = 96; a.V = KVR + 64; a.ldv = KVR_LD; a.vhs = 128; a.O = O1; a.ocol0 = 0; a.H = 16;
               nv::k_attn<2, 96><<<NB * 16 * SEQ / 4, 256, 0, st>>>(a); } break;
    case 14: { nv::GemmArgs a{}; a.A = O1; a.lda = 1024; a.Bt = P.w<bf16>(WS_W_OUT_O); a.K = 1024; a.M = M_TOK; a.N = 1024; a.Cf = X; a.R = X; a.ldc = 1024; naive_gemm<1>(a, st); } break;
    case 15: nv::k_rmsnorm_route<<<M_TOK / 4, 256, 0, st>>>(X, P.in[I_FFNN_O], H, P.in[I_W_ROUTER], P.in[I_B_ROUTER], P.w<int2>(WS_ROUTE_E), P.w<float2>(WS_ROUTE_G));
             nv::k_route_count<<<256, 64, 0, st>>>(P.w<int2>(WS_ROUTE_E), P.w<int>(WS_CNT_WG)); break;
    case 16: nv::k_slots<<<256, 64, 0, st>>>(P.w<int2>(WS_ROUTE_E), P.w<float2>(WS_ROUTE_G), P.w<int>(WS_CNT_WG), P.w<int>(WS_SLOT_TOK), P.w<float>(WS_SLOT_GATE), P.w<int>(WS_TILE_E)); break;
    case 17: { nv::GemmArgs a{}; a.A = H; a.lda = 1024; a.Bt = P.w<bf16>(WS_WGU_O); a.K = 1024; a.M = SLOT_CAP; a.N = FF_O; a.Cb = P.w<bf16>(WS_ACT1); a.ldc = FF_O;
               a.tile_e = P.w<int>(WS_TILE_E); a.stok = P.w<int>(WS_SLOT_TOK); a.sgate = P.w<float>(WS_SLOT_GATE); a.b_estride = (size_t)2 * FF_O * 1024; naive_gemm<3>(a, st); } break;
    case 18: { nv::GemmArgs a{}; a.A = P.w<bf16>(WS_ACT1); a.lda = FF_O; a.Bt = P.w<bf16>(WS_WDN_O); a.K = FF_O; a.M = SLOT_CAP; a.N = 1024; a.Cf = X; a.ldc = 1024;
               a.tile_e = P.w<int>(WS_TILE_E); a.stok = P.w<int>(WS_SLOT_TOK); a.sgate = P.w<float>(WS_SLOT_GATE); a.b_estride = (size_t)1024 * FF_O; naive_gemm<4>(a, st); } break;
    }
}
#endif

extern "C" void kernel_launch(void* const* d_in, const int* in_sizes, int n_in, void* d_out, int out_size, void* d_ws, size_t ws_size, hipStream_t stream) {
    if (n_in != N_INPUTS || out_size != M_TOK * DM || ws_size < WS_END) { fprintf(stderr, "kernel_launch: unexpected shapes (n_in %d out %d ws %zu)\n", n_in, out_size, ws_size); return; }
    if (g_grid == 0) {
        int dev = 0, cus = 0, per_cu = 0;
        if (hipGetDevice(&dev) != hipSuccess || hipDeviceGetAttribute(&cus, hipDeviceAttributeMultiprocessorCount, dev) != hipSuccess) { g_grid = -1; return; }
        if (hipFuncSetAttribute((const void*)mega, hipFuncAttributeMaxDynamicSharedMemorySize, LDS_BYTES) != hipSuccess) { fprintf(stderr, "kernel_launch: cannot get %d B of dynamic LDS\n", LDS_BYTES); g_grid = -1; return; }
        if (hipOccupancyMaxActiveBlocksPerMultiprocessor(&per_cu, (const void*)mega, NTHR, LDS_BYTES) != hipSuccess || per_cu < 1) { fprintf(stderr, "kernel_launch: occupancy query says %d\n", per_cu); }
        (void)hipGetLastError();
        g_grid = cus;
    }
    if (g_grid < 0) return;
    Ptrs P{}; for (int i = 0; i < N_INPUTS; ++i) P.in[i] = (const float*)d_in[i]; P.out = (float*)d_out; P.ws = (unsigned char*)d_ws;
    (void)hipMemsetAsync((char*)d_ws + WS_CTL, 0, 65536, stream);
#if ONE_LAUNCH
    launch_mega(P, 0, NPHASE, stream);
#else
    for (int k = 0; k < NPHASE; ++k) { if ((FAST_MASK >> k) & 1u) { launch_mega(P, k, k + 1, stream);
#ifdef DUP_MASK
            for (int rep = 0; rep < DUP_REPS; ++rep) if ((DUP_MASK >> k) & 1u) launch_mega(P, k, k + 1, stream, DUP_SUB);
#endif
        } else naive_phase(P, k, stream);
        if (k == 2 && !(HAVE_INDEX && ((FAST_MASK >> 2) & 1u))) naive_phase(P, 100, stream); }
#endif
}
```

```cpp
#define ONE_LAUNCH 1
#define HAVE_ATTN 1
#define HAVE_INDEX 1
#include <hip/hip_runtime.h>
#include <stdint.h>
#include <stdio.h>

typedef unsigned short bf16;
__device__ __forceinline__ float bf2f(bf16 v) { return __uint_as_float(((unsigned)v) << 16); }
__device__ __forceinline__ bf16 f2bf(float f) { unsigned u = __float_as_uint(f); return (bf16)((u + 0x7fffu + ((u >> 16) & 1u)) >> 16); }
typedef float f32x2_t __attribute__((ext_vector_type(2))); typedef __bf16 bf16x2_t __attribute__((ext_vector_type(2)));
__device__ __forceinline__ unsigned pk2(float lo, float hi) { f32x2_t v = {lo, hi}; bf16x2_t b = __builtin_convertvector(v, bf16x2_t); return __builtin_bit_cast(unsigned, b); }

constexpr int NB = 4, SEQ = 4096, M_TOK = NB * SEQ, DM = 1024;
constexpr int QKV_LD = 3584;
constexpr int C_MQ = 0, C_MK = 512, C_MV = 1024, C_DQ = 1536, C_DK = 2048, C_DV = 2560, C_IQ = 3072, C_IK = 3328, C_IW = 3392, N_IN_E = 3396;
constexpr int FF_E = 2816, FF_O = 3584, NEXP = 8;
constexpr int C1_LD = 768, N_IN_O = 672, C1_CQ = 0, C1_CKV = 384, C1_KPE = 640;
constexpr int QR_LD = 1536, KVR_LD = 2048;
constexpr int SLOT_CAP = 34816, TILE_CAP = 136;
constexpr float EPS = 1e-6f;
constexpr float LOG2E = 1.4426950408889634f;
constexpr float QSCALE64 = 0.125f * LOG2E;
constexpr float QSCALE96 = 0.10206207261596575f * LOG2E;

constexpr size_t MiB = 1u << 20;
constexpr size_t WS_CTL = 0;
constexpr size_t WS_KMEAN = 1 * MiB;
constexpr size_t WS_ROUTE_E = 1 * MiB + 128 * 1024;
constexpr size_t WS_ROUTE_G = 1 * MiB + 256 * 1024;
constexpr size_t WS_CNT_WG = 1 * MiB + 384 * 1024;
constexpr size_t WS_SLOT_TOK = 1 * MiB + 400 * 1024;
constexpr size_t WS_SLOT_GATE = 1 * MiB + 544 * 1024;
constexpr size_t WS_TILE_E = 1 * MiB + 688 * 1024;
constexpr size_t WS_TOK_SLOT = 1 * MiB + 704 * 1024;
constexpr size_t WS_REFS = 1 * MiB + 832 * 1024;
constexpr size_t WS_WDN_O = 2 * MiB;
constexpr size_t WS_WGU_O = 58 * MiB;
constexpr size_t WS_Y = 58 * MiB;
constexpr size_t WS_YP = 128 * MiB;
constexpr int MOE_FULL_TILES = 128, MOE_TAIL_SPLIT = 7, MOE_TAIL_ROWS = SLOT_CAP - MOE_FULL_TILES * 256;
constexpr size_t WS_H = 170 * MiB;
constexpr size_t WS_SCR = 202 * MiB;
constexpr size_t WS_QKV0 = WS_SCR;
constexpr size_t WS_O = 314 * MiB;
constexpr size_t WS_ACT0 = WS_SCR;
constexpr size_t WS_C1 = WS_SCR;
constexpr size_t WS_LSP = 226 * MiB;
constexpr size_t WS_CQN = 228 * MiB;
constexpr size_t WS_CKVN = 238 * MiB;
constexpr size_t WS_KSS = 238 * MiB;
constexpr size_t WS_QR = 246 * MiB;
constexpr size_t WS_KVR = 294 * MiB;
constexpr size_t WS_KM = 358 * MiB;
constexpr size_t WS_IKT = WS_KM;
constexpr size_t WS_O1 = WS_SCR;
constexpr size_t WS_MASKT = 412 * MiB;
constexpr size_t WS_W_IN_E = 420 * MiB;
constexpr size_t WS_W_OUT_E = 427 * MiB;
constexpr size_t WS_W_GU_E = 429 * MiB;
constexpr size_t WS_W_DN_E = 440 * MiB;
constexpr size_t WS_W_IN_O = 446 * MiB;
constexpr size_t WS_W_LAT = 448 * MiB;
constexpr int W_LAT_LD = 640;
constexpr size_t WS_W_UQ = WS_W_LAT, WS_W_UKV = WS_W_LAT;
constexpr size_t WS_W_OUT_O = 452 * MiB + 512 * 1024;
constexpr size_t WS_ACT1 = WS_SCR;
constexpr size_t WS_ROPE = 455 * MiB;
constexpr size_t WS_SSP = 456 * MiB;
constexpr size_t WS_SLOT_RSTD = 457 * MiB;
constexpr size_t WS_RSTD = 457 * MiB + 256 * 1024;
constexpr size_t WS_END = 458 * MiB;
static_assert(WS_W_LAT + (size_t)3584 * 640 * 2 <= WS_W_OUT_O && WS_W_OUT_O + (size_t)1024 * 1024 * 2 <= WS_ROPE, "tail of the ws map");
static_assert(WS_ACT1 + (size_t)SLOT_CAP * FF_O * 2 <= WS_W_IN_O, "ACT1 must not reach the odd-layer weights");
static_assert(WS_Y + (size_t)SLOT_CAP * 1024 * 2 <= WS_YP && WS_YP + (size_t)MOE_TAIL_SPLIT * MOE_TAIL_ROWS * 1024 * 2 <= WS_SCR && WS_TOK_SLOT + (size_t)M_TOK * 8 <= 2 * MiB, "Y / TOK_SLOT map");
static_assert(WS_W_DN_E + (size_t)1024 * 2816 * 2 <= WS_W_IN_O && WS_KM + (size_t)M_TOK * 1536 * 2 <= WS_MASKT, "ws map");

enum { I_X = 0, I_RELB, I_MIXN_E, I_W_IN_E, I_MQN, I_MKN, I_DQN, I_DKN, I_W_OUT_E, I_FFNN_E, I_W_GATE_E, I_W_UP_E, I_W_DOWN_E,
       I_MIXN_O, I_W_IN_O, I_QAN, I_KVAN, I_W_UQ, I_W_UKV, I_MLAQN, I_MLAKN, I_W_OUT_O, I_FFNN_O, I_W_ROUTER, I_B_ROUTER,
       I_W_GATE_O, I_W_UP_O, I_W_DOWN_O, N_INPUTS };

typedef unsigned ws_u2 __attribute__((ext_vector_type(2)));
__device__ __forceinline__ float wave_sum(float v) {
    v += __builtin_bit_cast(float, __builtin_amdgcn_update_dpp(0, __builtin_bit_cast(int, v), 0xB1, 0xF, 0xF, false));
    v += __builtin_bit_cast(float, __builtin_amdgcn_update_dpp(0, __builtin_bit_cast(int, v), 0x4E, 0xF, 0xF, false));
    v += __builtin_bit_cast(float, __builtin_amdgcn_update_dpp(0, __builtin_bit_cast(int, v), 0x124, 0xF, 0xF, false));
    v += __builtin_bit_cast(float, __builtin_amdgcn_update_dpp(0, __builtin_bit_cast(int, v), 0x128, 0xF, 0xF, false));
    { const unsigned xi = __float_as_uint(v); const ws_u2 r = __builtin_amdgcn_permlane16_swap(xi, xi, false, false); v = __uint_as_float(r.x) + __uint_as_float(r.y); }
    { const unsigned xi = __float_as_uint(v); const ws_u2 r = __builtin_amdgcn_permlane32_swap(xi, xi, false, false); v = __uint_as_float(r.x) + __uint_as_float(r.y); }
    return v;
}
__device__ __forceinline__ float wave_max(float v) {
    v = fmaxf(v, __builtin_bit_cast(float, __builtin_amdgcn_update_dpp(0, __builtin_bit_cast(int, v), 0xB1, 0xF, 0xF, false)));
    v = fmaxf(v, __builtin_bit_cast(float, __builtin_amdgcn_update_dpp(0, __builtin_bit_cast(int, v), 0x4E, 0xF, 0xF, false)));
    v = fmaxf(v, __builtin_bit_cast(float, __builtin_amdgcn_update_dpp(0, __builtin_bit_cast(int, v), 0x124, 0xF, 0xF, false)));
    v = fmaxf(v, __builtin_bit_cast(float, __builtin_amdgcn_update_dpp(0, __builtin_bit_cast(int, v), 0x128, 0xF, 0xF, false)));
    { const unsigned xi = __float_as_uint(v); const ws_u2 r = __builtin_amdgcn_permlane16_swap(xi, xi, false, false); v = fmaxf(__uint_as_float(r.x), __uint_as_float(r.y)); }
    { const unsigned xi = __float_as_uint(v); const ws_u2 r = __builtin_amdgcn_permlane32_swap(xi, xi, false, false); v = fmaxf(__uint_as_float(r.x), __uint_as_float(r.y)); }
    return v;
}
__device__ __forceinline__ int rel_bucket(int n) {
    if (n < 16) return n;
    int b = 16;
    b += (n >= 21); b += (n >= 27); b += (n >= 35); b += (n >= 46); b += (n >= 59); b += (n >= 77); b += (n >= 99); b += (n >= 128);
    b += (n >= 166); b += (n >= 216); b += (n >= 280); b += (n >= 363); b += (n >= 470); b += (n >= 609); b += (n >= 790);
    return b;
}
__device__ __forceinline__ unsigned fkey(float f) { unsigned u = __float_as_uint(f); return (u & 0x80000000u) ? ~u : (u | 0x80000000u); }
__device__ __forceinline__ float bflo(unsigned u) { return __uint_as_float(u << 16); }
__device__ __forceinline__ float bfhi(unsigned u) { return __uint_as_float(u & 0xffff0000u); }
__device__ __forceinline__ float silu_f(float x) { return x / (1.f + __expf(-x)); }

#ifndef PG8_WGM
#define PG8_WGM 8
#endif
namespace pg8 {
#define PG8_LAS __attribute__((address_space(3)))
typedef unsigned short bf16_t;
typedef short bf16x8 __attribute__((ext_vector_type(8)));
typedef float f32x4 __attribute__((ext_vector_type(4)));
typedef unsigned u32x4 __attribute__((ext_vector_type(4)));
typedef unsigned u32x2 __attribute__((ext_vector_type(2)));
constexpr int BM = 256, BK = 64, HALF = 128, HTB = HALF * BK * 2, STAGE_BYTES = 8 * HTB, NXCD = 8, WGM = PG8_WGM;

__host__ __device__ __forceinline__ int lds_byte(int r, int c) { const int st = (r >> 4) * 2 + (c >> 5), rr = r & 15, cc = c & 31, ob = rr * 64 + cc * 2; return st * 1024 + (ob ^ (((ob >> 9) & 1) << 5)); }
__host__ __device__ __forceinline__ void stage_rc(int b, int& R, int& C) { const int st = b / 1024, sb = b % 1024, swz = sb ^ (((sb >> 9) & 1) << 5); R = (st >> 1) * 16 + swz / 64; C = (st & 1) * 32 + (swz % 64) / 2; }
__host__ __device__ __forceinline__ int perm32(int rho) { const int n = rho >> 4, i = rho & 15; return 8 * (i >> 2) + 4 * n + (i & 3); }

struct Unit { int pm, pn, koff, nt; };
struct Gemm { const bf16_t* A; const bf16_t* Bt; int lda, ldb, K; };

__device__ __forceinline__ bool static_unit(int nM, int nN, int G, int c, int i, int& pm, int& pn) {
    const int nwg = nM * nN; const long L = (long)i * G + c; if (L >= nwg) return false;
    int wgid = (int)L; { const int q = nwg / NXCD, r = nwg % NXCD, xcd = wgid % NXCD, off = wgid / NXCD; wgid = (xcd < r ? xcd * (q + 1) : r * (q + 1) + (xcd - r) * q) + off; }
    const int nig = WGM * nN, gid = wgid / nig, fm = gid * WGM, gsz = (nM - fm) < WGM ? (nM - fm) : WGM;
    pm = fm + ((wgid % nig) % gsz); pn = (wgid % nig) / gsz; return true;
}
struct StaticOrder {
    static constexpr bool USE_LIST = false;
    int nM, nN, G, c;
    __device__ __forceinline__ bool next(int i, Unit& u) const { u.koff = 0; u.nt = 0; return static_unit(nM, nN, G, c, i, u.pm, u.pn); }
};
struct MoeOrder {
    static constexpr bool USE_LIST = true;
    const int* tile_e; int nM, nN, G, c, ksplit, Kpart, pm0;
    int seg[8] = {0, 0, 0, 0, 0, 0, 0, 0}; bool local = false;
    __device__ __forceinline__ bool next(int i, Unit& u) const {
        const int nwg = nM * nN; const long L = (long)i * G + c; if (L >= (long)nwg * ksplit) return false;
        const int ks = (int)(L / nwg), w = (int)(L % nwg); int pm, j;
        static_unit(nM, nN, nwg, w, 0, pm, j);
        int e = 0; if (local) { const int s0 = (pm0 + pm) * 256;
#pragma unroll
            for (int q = 1; q < 8; ++q) e += (s0 >= seg[q]) ? 1 : 0; } else e = tile_e[pm0 + pm];
        u.pm = pm0 + pm; u.pn = e * nN + j; u.koff = ks * Kpart; u.nt = 0; return true;
    }
};

struct LatJointOrder {
    static constexpr bool USE_LIST = true;
    int G, c;
    __device__ __forceinline__ void uq(int idx, Unit& u) const { int pm, pn; static_unit(64, 6, 384, idx, 0, pm, pn); u.pm = pm; u.pn = pn; u.koff = 0; u.nt = 6; }
    __device__ __forceinline__ void ukv(int idx, Unit& u) const { int pm, pn; static_unit(64, 8, 512, idx, 0, pm, pn); u.pm = pm; u.pn = 6 + pn; u.koff = 384; u.nt = 4; }
    __device__ __forceinline__ bool next(int i, Unit& u) const {
        if (G == 256) {
            if (c < 128) { if (i == 0) { uq(c, u); return true; } if (i == 1) { uq(128 + c, u); return true; } if (i == 2) { ukv(c, u); return true; } return false; }
            const int d = c - 128; if (i == 0) { uq(256 + d, u); return true; } if (i >= 1 && i <= 3) { ukv(128 + 3 * d + (i - 1), u); return true; } return false; }
        const int L = i * G + c; if (L >= 896) return false; if (L < 384) uq(L, u); else ukv(L - 384, u); return true;
    }
};

__device__ __forceinline__ unsigned cvt_pk_bf16(float lo, float hi) { unsigned r; asm volatile("v_cvt_pk_bf16_f32 %0, %1, %2" : "=v"(r) : "v"(lo), "v"(hi)); return r; }
__device__ __forceinline__ float fast_silu(float x) { return x * __builtin_amdgcn_rcpf(1.f + __builtin_amdgcn_exp2f(-1.4426950408889634f * x)); }

struct EpiBf16 {
    static constexpr bool PERM = true;
    bf16_t* O; int ldc;
    bf16_t* X2; int x2_pn;
    static constexpr bool HAS_SCALE = false;
    __device__ __forceinline__ void preload(PG8_LAS unsigned char*, int, int) const {}
    __device__ __forceinline__ void operator()(const f32x4 (&acc)[2][2][4][2], const Unit& u, int wr, int wc, int fr, int fq, const PG8_LAS unsigned char* sp, int ui) const {
        const int row0 = u.pm * BM + wr * 64 + fr, col0 = u.pn * BM + wc * 32 + 8 * fq;
        const bool x2 = (X2 != nullptr) && (u.pn == x2_pn) && (wc < 2);
#pragma unroll
        for (int ai = 0; ai < 2; ++ai)
#pragma unroll
            for (int m = 0; m < 4; ++m) { bf16_t* rowp = O + (size_t)(row0 + ai * HALF + m * 16) * ldc + col0;
#pragma unroll
                for (int bj = 0; bj < 2; ++bj) { const f32x4 v0 = acc[ai][bj][m][0], v1 = acc[ai][bj][m][1];
                    u32x4 w; w.x = cvt_pk_bf16(v0[0], v0[1]); w.y = cvt_pk_bf16(v0[2], v0[3]); w.z = cvt_pk_bf16(v1[0], v1[1]); w.w = cvt_pk_bf16(v1[2], v1[3]);
                    *(u32x4*)(rowp + bj * HALF) = w;
                    if (bj == 0 && x2) { const int row = row0 + ai * HALF + m * 16; *(u32x4*)(X2 + ((size_t)(row >> 5) * 8 + (wc * 4 + fq)) * 256 + (row & 31) * 8) = w; } } }
    }
};
struct EpiResF32 {
    static constexpr bool PERM = false;
    const float* R; float* O; int ldc;
    static constexpr bool HAS_SCALE = false;
    __device__ __forceinline__ void preload(PG8_LAS unsigned char*, int, int) const {}
    __device__ __forceinline__ void operator()(const f32x4 (&acc)[2][2][4][2], const Unit& u, int wr, int wc, int fr, int fq, const PG8_LAS unsigned char* sp, int ui) const {
        const int row0 = u.pm * BM + wr * 64 + fr, col0 = u.pn * BM + wc * 32 + 4 * fq;
#pragma unroll
        for (int ai = 0; ai < 2; ++ai)
#pragma unroll
            for (int m = 0; m < 4; ++m) { const size_t off = (size_t)(row0 + ai * HALF + m * 16) * ldc + col0;
#pragma unroll
                for (int bj = 0; bj < 2; ++bj)
#pragma unroll
                    for (int n = 0; n < 2; ++n) { const f32x4 r = *(const f32x4*)(R + off + bj * HALF + n * 16); *(f32x4*)(O + off + bj * HALF + n * 16) = r + acc[ai][bj][m][n]; } }
    }
};
struct EpiSwiGLU {
    static constexpr bool PERM = true;
    bf16_t* O; int ldc; int nmod;
    static constexpr bool HAS_SCALE = false;
    __device__ __forceinline__ void preload(PG8_LAS unsigned char*, int, int) const {}
    __device__ __forceinline__ void operator()(const f32x4 (&acc)[2][2][4][2], const Unit& u, int wr, int wc, int fr, int fq, const PG8_LAS unsigned char* sp, int ui) const {
        const int row0 = u.pm * BM + wr * 64 + fr, col0 = (u.pn % nmod) * HALF + wc * 32 + 8 * fq;
#pragma unroll
        for (int ai = 0; ai < 2; ++ai)
#pragma unroll
            for (int m = 0; m < 4; ++m) { const f32x4 g0 = acc[ai][0][m][0], g1 = acc[ai][0][m][1], u0 = acc[ai][1][m][0], u1 = acc[ai][1][m][1];
                u32x4 w; w.x = cvt_pk_bf16(fast_silu(g0[0]) * u0[0], fast_silu(g0[1]) * u0[1]); w.y = cvt_pk_bf16(fast_silu(g0[2]) * u0[2], fast_silu(g0[3]) * u0[3]);
                w.z = cvt_pk_bf16(fast_silu(g1[0]) * u1[0], fast_silu(g1[1]) * u1[1]); w.w = cvt_pk_bf16(fast_silu(g1[2]) * u1[2], fast_silu(g1[3]) * u1[3]);
                *(u32x4*)(O + (size_t)(row0 + ai * HALF + m * 16) * ldc + col0) = w; }
    }
};
struct EpiMoeY {
    static constexpr bool PERM = true;
    bf16_t* Y; size_t kstride; int nmod, kpart, row_off;
    static constexpr bool HAS_SCALE = false;
    __device__ __forceinline__ void preload(PG8_LAS unsigned char*, int, int) const {}
    __device__ __forceinline__ void operator()(const f32x4 (&acc)[2][2][4][2], const Unit& u, int wr, int wc, int fr, int fq, const PG8_LAS unsigned char* sp, int ui) const {
        const int row0 = u.pm * BM - row_off + wr * 64 + fr, col0 = (u.pn % nmod) * BM + wc * 32 + 8 * fq; bf16_t* base = Y + (size_t)(u.koff / kpart) * kstride;
#pragma unroll
        for (int ai = 0; ai < 2; ++ai)
#pragma unroll
            for (int m = 0; m < 4; ++m) { bf16_t* rowp = base + (size_t)(row0 + ai * HALF + m * 16) * 1024 + col0;
#pragma unroll
                for (int bj = 0; bj < 2; ++bj) { const f32x4 v0 = acc[ai][bj][m][0], v1 = acc[ai][bj][m][1];
                    u32x4 w; w.x = cvt_pk_bf16(v0[0], v0[1]); w.y = cvt_pk_bf16(v0[2], v0[3]); w.z = cvt_pk_bf16(v1[0], v1[1]); w.w = cvt_pk_bf16(v1[2], v1[3]);
                    *(u32x4*)(rowp + bj * HALF) = w; } }
    }
};


template <bool RBF> struct EpiResN {
    static constexpr bool PERM = true;
    const float* Rf; bf16_t* XB; float* SSP; int ldc;
    static constexpr bool HAS_SCALE = false;
    __device__ __forceinline__ void preload(PG8_LAS unsigned char*, int, int) const {}
    __device__ __forceinline__ void operator()(const f32x4 (&acc)[2][2][4][2], const Unit& u, int wr, int wc, int fr, int fq, const PG8_LAS unsigned char*, int) const {
        const int row0 = u.pm * BM + wr * 64 + fr, col0 = u.pn * BM + wc * 32 + 8 * fq;
#pragma unroll
        for (int ai = 0; ai < 2; ++ai) {
            f32x4 r0[4][2], r1[4][2];
#pragma unroll
            for (int m = 0; m < 4; ++m)
#pragma unroll
                for (int bj = 0; bj < 2; ++bj) { const size_t off = (size_t)(row0 + ai * HALF + m * 16) * ldc + col0 + bj * HALF;
                    if (RBF) { const u32x4 rb = *(const u32x4*)(XB + off);
                        r0[m][bj] = (f32x4){__uint_as_float(rb.x << 16), __uint_as_float(rb.x & 0xffff0000u), __uint_as_float(rb.y << 16), __uint_as_float(rb.y & 0xffff0000u)};
                        r1[m][bj] = (f32x4){__uint_as_float(rb.z << 16), __uint_as_float(rb.z & 0xffff0000u), __uint_as_float(rb.w << 16), __uint_as_float(rb.w & 0xffff0000u)}; }
                    else { r0[m][bj] = *(const f32x4*)(Rf + off); r1[m][bj] = *(const f32x4*)(Rf + off + 4); } }
            asm volatile("" ::: "memory");
#pragma unroll
            for (int m = 0; m < 4; ++m) { const int row = row0 + ai * HALF + m * 16; const size_t off = (size_t)row * ldc + col0; float ss = 0.f;
#pragma unroll
                for (int bj = 0; bj < 2; ++bj) {
                    const f32x4 v0 = r0[m][bj] + acc[ai][bj][m][0], v1 = r1[m][bj] + acc[ai][bj][m][1];
                    ss += ((v0[0] * v0[0] + v0[1] * v0[1]) + (v0[2] * v0[2] + v0[3] * v0[3])) + ((v1[0] * v1[0] + v1[1] * v1[1]) + (v1[2] * v1[2] + v1[3] * v1[3]));
                    u32x4 w; w.x = cvt_pk_bf16(v0[0], v0[1]); w.y = cvt_pk_bf16(v0[2], v0[3]); w.z = cvt_pk_bf16(v1[0], v1[1]); w.w = cvt_pk_bf16(v1[2], v1[3]);
                    *(u32x4*)(XB + off + bj * HALF) = w; }
                ss += __shfl_xor(ss, 16); ss += __shfl_xor(ss, 32);
                if (fq == 0) SSP[(size_t)row * 16 + (u.pn & 3) * 4 + wc] = ss; } }
    }
};
constexpr int MAX_UNITS_WG = 15;
constexpr int SP_SCALE = 0, SP_GIDX = MAX_UNITS_WG * 1024, SP_ULIST = 30720 + 256;
struct ScaleSSP {
    const float* SSP; float eps;
    __device__ __forceinline__ float row(const Unit& u, int r) const { const f32x4* p = (const f32x4*)(SSP + (size_t)(u.pm * BM + r) * 16); const f32x4 a = p[0], b = p[1], c = p[2], d = p[3];
        const float s = ((a[0] + a[1]) + (a[2] + a[3])) + ((b[0] + b[1]) + (b[2] + b[3])) + ((c[0] + c[1]) + (c[2] + c[3])) + ((d[0] + d[1]) + (d[2] + d[3]));
        return __builtin_amdgcn_rsqf(s * (1.f / 1024.f) + eps); }
};
struct ScaleSlot {
    const float* srstd;
    __device__ __forceinline__ float row(const Unit& u, int r) const { return srstd[u.pm * BM + r]; }
};
template <class Sched> __device__ __forceinline__ int build_unit_list(PG8_LAS unsigned char* sp, const Sched& sched, int tid) {
    PG8_LAS int* ul = (PG8_LAS int*)(sp + SP_ULIST);
    if (tid < MAX_UNITS_WG + 1) { Unit u; u.pm = -1; u.pn = 0; u.koff = 0; u.nt = 0; const bool ok = (tid < MAX_UNITS_WG) && sched.next(tid, u); ul[4 * tid] = ok ? u.pm : -1; ul[4 * tid + 1] = u.pn; ul[4 * tid + 2] = u.koff; ul[4 * tid + 3] = u.nt; }
    __syncthreads();
    int n = 0; while (n < MAX_UNITS_WG && ul[4 * n] >= 0) ++n;
    return n;
}
template <class Scale> __device__ __forceinline__ void preload_scales(const Scale& S, PG8_LAS unsigned char* sp, int n, int tid) {
    PG8_LAS float* tab = (PG8_LAS float*)(sp + SP_SCALE); const PG8_LAS int* ul = (const PG8_LAS int*)(sp + SP_ULIST);
    const int rows = n * 256;
    for (int j0 = tid; j0 < rows; j0 += 8 * 512) {
        float v[8];
#pragma unroll
        for (int k = 0; k < 8; ++k) { const int j = j0 + k * 512; if (j < rows) { Unit u; u.pm = ul[4 * (j >> 8)]; u.pn = ul[4 * (j >> 8) + 1]; u.koff = 0; u.nt = 0; v[k] = S.row(u, j & 255); } else v[k] = 0.f; }
#pragma unroll
        for (int k = 0; k < 8; ++k) { const int j = j0 + k * 512; if (j < rows) tab[j] = v[k]; }
    }
}
template <class Scale> struct EpiBf16S {
    static constexpr bool PERM = true;
    bf16_t* O; int ldc; Scale S;
    static constexpr bool HAS_SCALE = true;
    __device__ __forceinline__ void preload(PG8_LAS unsigned char* sp, int n, int tid) const { preload_scales(S, sp, n, tid); }
    __device__ __forceinline__ void operator()(const f32x4 (&acc)[2][2][4][2], const Unit& u, int wr, int wc, int fr, int fq, const PG8_LAS unsigned char* sp, int ui) const {
        const int rl = wr * 64 + fr, row0 = u.pm * BM + rl, col0 = u.pn * BM + wc * 32 + 8 * fq;
        float scv[8]; { const unsigned ta = (unsigned)(size_t)sp + (unsigned)SP_SCALE + (unsigned)(ui * 256 + rl) * 4u;
            asm volatile("ds_read_b32 %0, %8\n\tds_read_b32 %1, %8 offset:64\n\tds_read_b32 %2, %8 offset:128\n\tds_read_b32 %3, %8 offset:192\n\tds_read_b32 %4, %8 offset:512\n\tds_read_b32 %5, %8 offset:576\n\tds_read_b32 %6, %8 offset:640\n\tds_read_b32 %7, %8 offset:704\n\ts_waitcnt lgkmcnt(0)"
                : "=&v"(scv[0]), "=&v"(scv[1]), "=&v"(scv[2]), "=&v"(scv[3]), "=&v"(scv[4]), "=&v"(scv[5]), "=&v"(scv[6]), "=&v"(scv[7]) : "v"(ta) : "memory"); }
#pragma unroll
        for (int ai = 0; ai < 2; ++ai)
#pragma unroll
            for (int m = 0; m < 4; ++m) { bf16_t* rowp = O + (size_t)(row0 + ai * HALF + m * 16) * ldc + col0; const float sc = scv[ai * 4 + m];
#pragma unroll
                for (int bj = 0; bj < 2; ++bj) { const f32x4 v0 = acc[ai][bj][m][0] * sc, v1 = acc[ai][bj][m][1] * sc;
                    u32x4 w; w.x = cvt_pk_bf16(v0[0], v0[1]); w.y = cvt_pk_bf16(v0[2], v0[3]); w.z = cvt_pk_bf16(v1[0], v1[1]); w.w = cvt_pk_bf16(v1[2], v1[3]);
                    *(u32x4*)(rowp + bj * HALF) = w; } }
    }
};
template <class Scale> struct EpiBf16SL {
    static constexpr bool PERM = true;
    bf16_t* O; int ldc; float* LSP; Scale S;
    static constexpr bool HAS_SCALE = true;
    __device__ __forceinline__ void preload(PG8_LAS unsigned char* sp, int n, int tid) const { preload_scales(S, sp, n, tid); }
    __device__ __forceinline__ void operator()(const f32x4 (&acc)[2][2][4][2], const Unit& u, int wr, int wc, int fr, int fq, const PG8_LAS unsigned char* sp, int ui) const {
        const int rl = wr * 64 + fr, row0 = u.pm * BM + rl, col0 = u.pn * BM + wc * 32 + 8 * fq;
        float scv[8]; { const unsigned ta = (unsigned)(size_t)sp + (unsigned)SP_SCALE + (unsigned)(ui * 256 + rl) * 4u;
            asm volatile("ds_read_b32 %0, %8\n\tds_read_b32 %1, %8 offset:64\n\tds_read_b32 %2, %8 offset:128\n\tds_read_b32 %3, %8 offset:192\n\tds_read_b32 %4, %8 offset:512\n\tds_read_b32 %5, %8 offset:576\n\tds_read_b32 %6, %8 offset:640\n\tds_read_b32 %7, %8 offset:704\n\ts_waitcnt lgkmcnt(0)"
                : "=&v"(scv[0]), "=&v"(scv[1]), "=&v"(scv[2]), "=&v"(scv[3]), "=&v"(scv[4]), "=&v"(scv[5]), "=&v"(scv[6]), "=&v"(scv[7]) : "v"(ta) : "memory"); }
#pragma unroll
        for (int ai = 0; ai < 2; ++ai)
#pragma unroll
            for (int m = 0; m < 4; ++m) { const int row = row0 + ai * HALF + m * 16; bf16_t* rowp = O + (size_t)row * ldc + col0; const float sc = scv[ai * 4 + m];
#pragma unroll
                for (int bj = 0; bj < 2; ++bj) { const f32x4 v0 = acc[ai][bj][m][0] * sc, v1 = acc[ai][bj][m][1] * sc;
                    u32x4 w; w.x = cvt_pk_bf16(v0[0], v0[1]); w.y = cvt_pk_bf16(v0[2], v0[3]); w.z = cvt_pk_bf16(v1[0], v1[1]); w.w = cvt_pk_bf16(v1[2], v1[3]);
                    *(u32x4*)(rowp + bj * HALF) = w;
                    float ss = ((v0[0] * v0[0] + v0[1] * v0[1]) + (v0[2] * v0[2] + v0[3] * v0[3])) + ((v1[0] * v1[0] + v1[1] * v1[1]) + (v1[2] * v1[2] + v1[3] * v1[3]));
                    ss += __shfl_xor(ss, 16); ss += __shfl_xor(ss, 32);
                    if (fq == 0) LSP[(size_t)row * 24 + u.pn * 8 + bj * 4 + wc] = ss; } }
    }
};
struct ScaleLat {
    const float* LSP; float eps;
    __device__ __forceinline__ float row(const Unit& u, int r) const { const bool isq = u.pn < 6; const float* p = LSP + (size_t)(u.pm * BM + r) * 24 + (isq ? 0 : 12);
        float s = ((p[0] + p[1]) + (p[2] + p[3])) + ((p[4] + p[5]) + (p[6] + p[7])); if (isq) s += (p[8] + p[9]) + (p[10] + p[11]);
        return __builtin_amdgcn_rsqf(s * (isq ? 1.f / 384 : 1.f / 256) + eps); }
};
__device__ __forceinline__ float sum_rows4(float x) {
    { const unsigned xi = __float_as_uint(x); const u32x2 r = __builtin_amdgcn_permlane16_swap(xi, xi, false, false); x = __uint_as_float(r.x) + __uint_as_float(r.y); }
    { const unsigned xi = __float_as_uint(x); const u32x2 r = __builtin_amdgcn_permlane32_swap(xi, xi, false, false); x = __uint_as_float(r.x) + __uint_as_float(r.y); }
    return x;
}
struct EpiLatJoint {
    static constexpr bool PERM = true;
    bf16_t* QR; bf16_t* KVR; bf16_t* KM; float* KSS; const float* gk; ScaleLat S;
    static constexpr bool HAS_SCALE = true;
    __device__ __forceinline__ void preload(PG8_LAS unsigned char* sp, int n, int tid) const { preload_scales(S, sp, n, tid);
        PG8_LAS float* tab2 = (PG8_LAS float*)(sp + SP_GIDX); const PG8_LAS int* ul = (const PG8_LAS int*)(sp + SP_ULIST);
        { float t2[4];
#pragma unroll
          for (int k = 0; k < 4; ++k) { const int j = tid + k * 512; t2[k] = (j < n * 256) ? S.LSP[(size_t)(ul[4 * (j >> 8)] * BM + (j & 255)) * 24 + 20] : 0.f; }
#pragma unroll
          for (int k = 0; k < 4; ++k) { const int j = tid + k * 512; if (j < n * 256) tab2[j] = t2[k]; } }
        if (tid < 64) tab2[14 * 256 + tid] = gk[tid]; }
    __device__ __forceinline__ void operator()(const f32x4 (&acc)[2][2][4][2], const Unit& u, int wr, int wc, int fr, int fq, const PG8_LAS unsigned char* sp, int ui) const {
        const bool isq = u.pn < 6; bf16_t* O = isq ? QR : KVR; const int ldc = isq ? 1536 : 2048;
        const int rl = wr * 64 + fr, row0 = u.pm * BM + rl, col0 = isq ? u.pn * BM + wc * 32 + 8 * fq : (u.pn - 6) * BM + ((((wc & 1) << 1) | (wc >> 1)) * 64) + 8 * fq, cstep = isq ? HALF : 32;
        float scv[8]; { const unsigned ta = (unsigned)(size_t)sp + (unsigned)SP_SCALE + (unsigned)(ui * 256 + rl) * 4u;
            asm volatile("ds_read_b32 %0, %8\n\tds_read_b32 %1, %8 offset:64\n\tds_read_b32 %2, %8 offset:128\n\tds_read_b32 %3, %8 offset:192\n\tds_read_b32 %4, %8 offset:512\n\tds_read_b32 %5, %8 offset:576\n\tds_read_b32 %6, %8 offset:640\n\tds_read_b32 %7, %8 offset:704\n\ts_waitcnt lgkmcnt(0)"
                : "=&v"(scv[0]), "=&v"(scv[1]), "=&v"(scv[2]), "=&v"(scv[3]), "=&v"(scv[4]), "=&v"(scv[5]), "=&v"(scv[6]), "=&v"(scv[7]) : "v"(ta) : "memory"); }
        if (isq || wc >= 2) {
#pragma unroll
            for (int ai = 0; ai < 2; ++ai)
#pragma unroll
                for (int m = 0; m < 4; ++m) { bf16_t* rowp = O + (size_t)(row0 + ai * HALF + m * 16) * ldc + col0; const float sc = scv[ai * 4 + m];
#pragma unroll
                    for (int bj = 0; bj < 2; ++bj) { const f32x4 v0 = acc[ai][bj][m][0] * sc, v1 = acc[ai][bj][m][1] * sc;
                        u32x4 w; w.x = cvt_pk_bf16(v0[0], v0[1]); w.y = cvt_pk_bf16(v0[2], v0[3]); w.z = cvt_pk_bf16(v1[0], v1[1]); w.w = cvt_pk_bf16(v1[2], v1[3]);
                        *(u32x4*)(rowp + bj * cstep) = w; } }
        } else {
            const int hd = 2 * (u.pn - 6) + wc;
            float spe[8]; { const unsigned ta = (unsigned)(size_t)sp + (unsigned)SP_GIDX + (unsigned)(ui * 256 + rl) * 4u;
                asm volatile("ds_read_b32 %0, %8\n\tds_read_b32 %1, %8 offset:64\n\tds_read_b32 %2, %8 offset:128\n\tds_read_b32 %3, %8 offset:192\n\tds_read_b32 %4, %8 offset:512\n\tds_read_b32 %5, %8 offset:576\n\tds_read_b32 %6, %8 offset:640\n\tds_read_b32 %7, %8 offset:704\n\ts_waitcnt lgkmcnt(0)"
                    : "=&v"(spe[0]), "=&v"(spe[1]), "=&v"(spe[2]), "=&v"(spe[3]), "=&v"(spe[4]), "=&v"(spe[5]), "=&v"(spe[6]), "=&v"(spe[7]) : "v"(ta) : "memory"); }
            f32x4 g[4]; { const unsigned ga = (unsigned)(size_t)sp + (unsigned)SP_GIDX + (unsigned)(14 * 256 + 8 * fq) * 4u;
                asm volatile("ds_read_b128 %0, %4\n\tds_read_b128 %1, %4 offset:16\n\tds_read_b128 %2, %4 offset:128\n\tds_read_b128 %3, %4 offset:144\n\ts_waitcnt lgkmcnt(0)" : "=&v"(g[0]), "=&v"(g[1]), "=&v"(g[2]), "=&v"(g[3]) : "v"(ga) : "memory"); }
#pragma unroll
            for (int ai = 0; ai < 2; ++ai)
#pragma unroll
                for (int m = 0; m < 4; ++m) { const int row = row0 + ai * HALF + m * 16; const float sc = scv[ai * 4 + m];
                    const f32x4 a0 = acc[ai][0][m][0] * sc, a1 = acc[ai][0][m][1] * sc, b0 = acc[ai][1][m][0] * sc, b1 = acc[ai][1][m][1] * sc;
                    float ss = (((a0[0] * a0[0] + a0[1] * a0[1]) + (a0[2] * a0[2] + a0[3] * a0[3])) + ((a1[0] * a1[0] + a1[1] * a1[1]) + (a1[2] * a1[2] + a1[3] * a1[3])))
                             + (((b0[0] * b0[0] + b0[1] * b0[1]) + (b0[2] * b0[2] + b0[3] * b0[3])) + ((b1[0] * b1[0] + b1[1] * b1[1]) + (b1[2] * b1[2] + b1[3] * b1[3])));
                    ss = sum_rows4(ss);
                    const float r = __builtin_amdgcn_rsqf((ss + spe[ai * 4 + m]) * (1.f / 96) + S.eps);
                    bf16_t* kp = KM + (size_t)row * 1536 + hd * 96 + 8 * fq;
                    { const f32x4 y0 = a0 * r * g[0], y1 = a1 * r * g[1]; u32x4 w; w.x = cvt_pk_bf16(y0[0], y0[1]); w.y = cvt_pk_bf16(y0[2], y0[3]); w.z = cvt_pk_bf16(y1[0], y1[1]); w.w = cvt_pk_bf16(y1[2], y1[3]); *(u32x4*)kp = w; }
                    { const f32x4 y0 = b0 * r * g[2], y1 = b1 * r * g[3]; u32x4 w; w.x = cvt_pk_bf16(y0[0], y0[1]); w.y = cvt_pk_bf16(y0[2], y0[3]); w.z = cvt_pk_bf16(y1[0], y1[1]); w.w = cvt_pk_bf16(y1[2], y1[3]); *(u32x4*)(kp + 32) = w; }
                    if (fq == 0) KSS[(size_t)row * 16 + hd] = r; }
        }
    }
};
template <class Scale> struct EpiSwiGLUS {
    static constexpr bool PERM = true;
    bf16_t* O; int ldc; int nmod; Scale S;
    static constexpr bool HAS_SCALE = true;
    __device__ __forceinline__ void preload(PG8_LAS unsigned char* sp, int n, int tid) const { preload_scales(S, sp, n, tid); }
    __device__ __forceinline__ void operator()(const f32x4 (&acc)[2][2][4][2], const Unit& u, int wr, int wc, int fr, int fq, const PG8_LAS unsigned char* sp, int ui) const {
        const int rl = wr * 64 + fr, row0 = u.pm * BM + rl, col0 = (u.pn % nmod) * HALF + wc * 32 + 8 * fq;
        float scv[8]; { const unsigned ta = (unsigned)(size_t)sp + (unsigned)SP_SCALE + (unsigned)(ui * 256 + rl) * 4u;
            asm volatile("ds_read_b32 %0, %8\n\tds_read_b32 %1, %8 offset:64\n\tds_read_b32 %2, %8 offset:128\n\tds_read_b32 %3, %8 offset:192\n\tds_read_b32 %4, %8 offset:512\n\tds_read_b32 %5, %8 offset:576\n\tds_read_b32 %6, %8 offset:640\n\tds_read_b32 %7, %8 offset:704\n\ts_waitcnt lgkmcnt(0)"
                : "=&v"(scv[0]), "=&v"(scv[1]), "=&v"(scv[2]), "=&v"(scv[3]), "=&v"(scv[4]), "=&v"(scv[5]), "=&v"(scv[6]), "=&v"(scv[7]) : "v"(ta) : "memory"); }
#pragma unroll
        for (int ai = 0; ai < 2; ++ai)
#pragma unroll
            for (int m = 0; m < 4; ++m) { const float sc = scv[ai * 4 + m];
                const f32x4 g0 = acc[ai][0][m][0] * sc, g1 = acc[ai][0][m][1] * sc, u0 = acc[ai][1][m][0] * sc, u1 = acc[ai][1][m][1] * sc;
                u32x4 w; w.x = cvt_pk_bf16(fast_silu(g0[0]) * u0[0], fast_silu(g0[1]) * u0[1]); w.y = cvt_pk_bf16(fast_silu(g0[2]) * u0[2], fast_silu(g0[3]) * u0[3]);
                w.z = cvt_pk_bf16(fast_silu(g1[0]) * u1[0], fast_silu(g1[1]) * u1[1]); w.w = cvt_pk_bf16(fast_silu(g1[2]) * u1[2], fast_silu(g1[3]) * u1[3]);
                *(u32x4*)(O + (size_t)(row0 + ai * HALF + m * 16) * ldc + col0) = w; }
    }
};

template <class Epi, class Sched, bool ALIGN_EPI, bool GATHER>
__device__ __forceinline__ void gemm_phase(PG8_LAS unsigned char* lds, const Gemm g, const Sched& S, const Epi& E, const int* gidx) {
    const int tid = threadIdx.x, wid = __builtin_amdgcn_readfirstlane(tid >> 6), lane = tid & 63, wr = wid >> 2, wc = wid & 3, fr = lane & 15, fq = lane >> 4;
    const int K = g.K, nt = K / BK, lda = g.lda, ldb = g.ldb;
    unsigned vAc[2][2], vAn[2][2], voffB[2]; int Rl[2], Cl[2];
#pragma unroll
    for (int i = 0; i < 2; ++i) { int R, C; stage_rc(tid * 16 + i * 8192, R, C); const int Rb = Epi::PERM ? ((R & ~31) + perm32(R & 31)) : R; Rl[i] = R; Cl[i] = C;
        voffB[i] = (unsigned)(Rb * ldb + C) * 2u;
#pragma unroll
        for (int h = 0; h < 2; ++h) { vAc[h][i] = (unsigned)((R + h * HALF) * lda + C) * 2u; vAn[h][i] = vAc[h][i]; } }
    const size_t kstep = (size_t)(BK * 2);
    const size_t hstepB = (size_t)HALF * ldb * 2, tstepB = 2 * hstepB, tstepA = GATHER ? 0 : (size_t)BM * lda * 2;
    const unsigned ldsw = (unsigned)wid * 1024u;
    const int aoff = lds_byte(wr * 64 + fr, fq * 8), boff = lds_byte(wc * 32 + fr, fq * 8);
#define PG8_SA(b, h) (((b) * 2 + (h)) * HTB)
#define PG8_SB(b, h) ((4 + (b) * 2 + (h)) * HTB)
#define PG8_STAGE(bufoff, gbase, voff) do { _Pragma("unroll") for (int _i = 0; _i < 2; ++_i) \
        __builtin_amdgcn_global_load_lds((const unsigned*)((const char*)(gbase) + (voff)[_i]), (PG8_LAS unsigned*)(lds + (bufoff) + ldsw + _i * 8192), 16, 0, 0); } while (0)
#define PG8_LDA(dst, b, h) do { _Pragma("unroll") for (int m = 0; m < 4; ++m) _Pragma("unroll") for (int k = 0; k < 2; ++k) dst[m][k] = *(const PG8_LAS bf16x8*)(lds + PG8_SA(b, h) + aoff + m * 2048 + k * 1024); } while (0)
#define PG8_LDB(dst, b, h) do { _Pragma("unroll") for (int n = 0; n < 2; ++n) _Pragma("unroll") for (int k = 0; k < 2; ++k) dst[n][k] = *(const PG8_LAS bf16x8*)(lds + PG8_SB(b, h) + boff + n * 2048 + k * 1024); } while (0)
#define PG8_MMA(ai, bj, At, Bt) do { __builtin_amdgcn_s_setprio(1); _Pragma("unroll") for (int m = 0; m < 4; ++m) _Pragma("unroll") for (int n = 0; n < 2; ++n) _Pragma("unroll") for (int k = 0; k < 2; ++k) \
        acc[ai][bj][m][n] = __builtin_amdgcn_mfma_f32_16x16x32_bf16(Bt[n][k], At[m][k], acc[ai][bj][m][n], 0, 0, 0); __builtin_amdgcn_s_setprio(0); } while (0)
#define PG8_WAIT_V(n) asm volatile("s_waitcnt vmcnt(" #n ")" ::: "memory")
#define PG8_WAIT_L(n) asm volatile("s_waitcnt lgkmcnt(" #n ")" ::: "memory")
#define PG8_BAR __builtin_amdgcn_s_barrier()
#define PG8_SCHED __builtin_amdgcn_sched_barrier(0)
    PG8_LAS unsigned char* spare = lds + STAGE_BYTES;
    constexpr bool LIST = Sched::USE_LIST || Epi::HAS_SCALE || GATHER;
    int nunits = 0;
    if constexpr (LIST) { nunits = build_unit_list(spare, S, tid); if (nunits == 0) return; }
#define PG8_UNIT(i, u, ok) do { if constexpr (LIST) { int a_, b_, c_, d_; const unsigned ad_ = (unsigned)(size_t)(spare + SP_ULIST) + 16u * (unsigned)(i); \
        asm volatile("ds_read_b32 %0, %4\n\tds_read_b32 %1, %4 offset:4\n\tds_read_b32 %2, %4 offset:8\n\tds_read_b32 %3, %4 offset:12\n\ts_waitcnt lgkmcnt(0)" : "=&v"(a_), "=&v"(b_), "=&v"(c_), "=&v"(d_) : "v"(ad_) : "memory"); \
        (u).pm = __builtin_amdgcn_readfirstlane(a_); (u).pn = __builtin_amdgcn_readfirstlane(b_); (u).koff = __builtin_amdgcn_readfirstlane(c_); (u).nt = __builtin_amdgcn_readfirstlane(d_); ok = (u).pm >= 0; } else { ok = S.next(i, u); } } while (0)
#define PG8_GIDX(dst, ord) do { if (GATHER) { int t0_, t1_, t2_, t3_; const unsigned ad_ = (unsigned)(size_t)(spare + SP_GIDX) + 4u * (unsigned)((ord) * 256); \
        asm volatile("ds_read_b32 %0, %4\n\tds_read_b32 %1, %5\n\tds_read_b32 %2, %4 offset:512\n\tds_read_b32 %3, %5 offset:512\n\ts_waitcnt lgkmcnt(0)" : "=&v"(t0_), "=&v"(t1_), "=&v"(t2_), "=&v"(t3_) : "v"(ad_ + 4u * (unsigned)Rl[0]), "v"(ad_ + 4u * (unsigned)Rl[1]) : "memory"); \
        dst[0][0] = (unsigned)(t0_ * lda + Cl[0]) * 2u; dst[0][1] = (unsigned)(t1_ * lda + Cl[1]) * 2u; dst[1][0] = (unsigned)(t2_ * lda + Cl[0]) * 2u; dst[1][1] = (unsigned)(t3_ * lda + Cl[1]) * 2u; } } while (0)
    Unit cur, nxt; int ui = 0;
    { bool ok0; PG8_UNIT(0, cur, ok0); if (!ok0) return; }
    const char* cB = (const char*)g.Bt + (size_t)cur.pn * tstepB + (size_t)cur.koff * 2;
    if constexpr (LIST) {
        PG8_STAGE(PG8_SB(0, 0), cB, voffB); PG8_STAGE(PG8_SB(0, 1), cB + hstepB, voffB);
        E.preload(spare, nunits, tid);
        if (GATHER) { PG8_LAS int* gt = (PG8_LAS int*)(spare + SP_GIDX); const PG8_LAS int* ul = (const PG8_LAS int*)(spare + SP_ULIST);
            for (int j0 = tid; j0 < nunits * 256; j0 += 8 * 512) {
                int t_[8];
#pragma unroll
                for (int k = 0; k < 8; ++k) { const int j = j0 + k * 512; t_[k] = (j < nunits * 256) ? gidx[ul[4 * (j >> 8)] * BM + (j & 255)] : 0; }
#pragma unroll
                for (int k = 0; k < 8; ++k) { const int j = j0 + k * 512; if (j < nunits * 256) gt[j] = t_[k] < 0 ? 0 : t_[k]; } } }
        __syncthreads(); }
    f32x4 acc[2][2][4][2];
#pragma unroll
    for (int a = 0; a < 2; ++a)
#pragma unroll
        for (int b = 0; b < 2; ++b)
#pragma unroll
            for (int m = 0; m < 4; ++m)
#pragma unroll
                for (int n = 0; n < 2; ++n) acc[a][b][m][n] = (f32x4){0.f, 0.f, 0.f, 0.f};
    bf16x8 At[4][2], B0[2][2], B1[2][2];
    PG8_GIDX(vAc, 0);
    const char* cA = (const char*)g.A + (size_t)cur.pm * tstepA + (size_t)cur.koff * 2;
    if constexpr (!LIST) { PG8_STAGE(PG8_SB(0, 0), cB, voffB); PG8_STAGE(PG8_SB(0, 1), cB + hstepB, voffB); }
    PG8_STAGE(PG8_SA(0, 0), cA, vAc[0]); PG8_STAGE(PG8_SA(0, 1), cA, vAc[1]);
    if (wr == 1) PG8_BAR;
    PG8_WAIT_V(2); PG8_BAR;
    PG8_STAGE(PG8_SB(1, 0), cB + kstep, voffB); PG8_STAGE(PG8_SA(1, 0), cA + kstep, vAc[0]); PG8_STAGE(PG8_SB(1, 1), cB + hstepB + kstep, voffB);
    PG8_WAIT_V(6); PG8_BAR;
    for (;;) {
        bool has_next; PG8_UNIT(ui + 1, nxt, has_next);
        if (has_next) PG8_GIDX(vAn, ui + 1);
        const char* nA = has_next ? (const char*)g.A + (size_t)nxt.pm * tstepA + (size_t)nxt.koff * 2 : cA; const char* nB = has_next ? (const char*)g.Bt + (size_t)nxt.pn * tstepB + (size_t)nxt.koff * 2 : cB;
        const int ntc = cur.nt > 0 ? cur.nt : nt;
        for (int t = 0; t < ntc; t += 2) {
            const bool last = (t == ntc - 2);
            const char* a1 = cA + (size_t)(t + 1) * kstep;
            const char* a2 = last ? nA : cA + (size_t)(t + 2) * kstep; const char* b2 = last ? nB : cB + (size_t)(t + 2) * kstep;
            const char* a3 = a2 + kstep; const char* b3 = b2 + kstep;
            unsigned vs0[2], vs1[2];
            if (GATHER) { const bool sw = last && has_next; vs0[0] = sw ? vAn[0][0] : vAc[0][0]; vs0[1] = sw ? vAn[0][1] : vAc[0][1]; vs1[0] = sw ? vAn[1][0] : vAc[1][0]; vs1[1] = sw ? vAn[1][1] : vAc[1][1]; }
            else { vs0[0] = vAc[0][0]; vs0[1] = vAc[0][1]; vs1[0] = vAc[1][0]; vs1[1] = vAc[1][1]; }
            PG8_LDB(B0, 0, 0); PG8_LDB(B1, 0, 1); PG8_SCHED; PG8_LDA(At, 0, 0); PG8_STAGE(PG8_SA(1, 1), a1, vAc[1]);
            PG8_WAIT_V(8); PG8_WAIT_L(0); PG8_BAR; PG8_MMA(0, 0, At, B0); PG8_MMA(0, 1, At, B1); PG8_BAR; PG8_SCHED;
            PG8_LDA(At, 0, 1); PG8_STAGE(PG8_SB(0, 0), b2, voffB); PG8_STAGE(PG8_SB(0, 1), b2 + hstepB, voffB); PG8_STAGE(PG8_SA(0, 0), a2, vs0);
            PG8_WAIT_V(8); PG8_WAIT_L(0); PG8_BAR; PG8_MMA(1, 0, At, B0); PG8_MMA(1, 1, At, B1); PG8_BAR; PG8_SCHED;
            PG8_LDB(B0, 1, 0); PG8_LDB(B1, 1, 1); PG8_SCHED; PG8_LDA(At, 1, 0); PG8_STAGE(PG8_SA(0, 1), a2, vs1);
            PG8_WAIT_V(8); PG8_WAIT_L(0); PG8_BAR; PG8_MMA(0, 0, At, B0); PG8_MMA(0, 1, At, B1); PG8_BAR; PG8_SCHED;
            PG8_LDA(At, 1, 1); PG8_STAGE(PG8_SB(1, 0), b3, voffB); PG8_STAGE(PG8_SB(1, 1), b3 + hstepB, voffB); PG8_STAGE(PG8_SA(1, 0), a3, vs0);
            PG8_WAIT_V(8); PG8_WAIT_L(0); PG8_BAR; PG8_MMA(1, 0, At, B0); PG8_MMA(1, 1, At, B1); PG8_BAR; PG8_SCHED;
        }
        if constexpr (ALIGN_EPI) { if (wr == 0) PG8_BAR; }
        E(acc, cur, wr, wc, fr, fq, spare, ui);
        if (!has_next) break;
#pragma unroll
        for (int a = 0; a < 2; ++a)
#pragma unroll
            for (int b = 0; b < 2; ++b)
#pragma unroll
                for (int m = 0; m < 4; ++m)
#pragma unroll
                    for (int n = 0; n < 2; ++n) acc[a][b][m][n] = (f32x4){0.f, 0.f, 0.f, 0.f};
        cur = nxt; cA = nA; cB = nB; ++ui;
        if (GATHER) {
#pragma unroll
            for (int h = 0; h < 2; ++h) { vAc[h][0] = vAn[h][0]; vAc[h][1] = vAn[h][1]; } }
        if constexpr (ALIGN_EPI) { if (wr == 1) PG8_BAR; }
    }
    PG8_WAIT_V(0);
    if constexpr (!ALIGN_EPI) { if (wr == 0) PG8_BAR; }
    PG8_BAR;
#undef PG8_SA
#undef PG8_SB
#undef PG8_STAGE
#undef PG8_LDA
#undef PG8_LDB
#undef PG8_MMA
#undef PG8_WAIT_V
#undef PG8_WAIT_L
#undef PG8_BAR
#undef PG8_SCHED
#undef PG8_GIDX
#undef PG8_UNIT
}
}

#define GAS __attribute__((address_space(1)))
#define LAS __attribute__((address_space(3)))
typedef unsigned v4u __attribute__((ext_vector_type(4)));
typedef unsigned v2u __attribute__((ext_vector_type(2)));
typedef float f32x4 __attribute__((ext_vector_type(4)));
typedef short bf16x8 __attribute__((ext_vector_type(8)));
typedef float f32x16 __attribute__((ext_vector_type(16)));
#define LDS_WAIT() asm volatile("s_waitcnt lgkmcnt(0)" ::: "memory")
#define VM_WAIT() asm volatile("s_waitcnt vmcnt(0)" ::: "memory")
constexpr int NWAVES = 8, NTHR = 512;
constexpr int LDS_BYTES = 163840 - 1024;
constexpr int LDSCTL_OFF = LDS_BYTES - 1024;

struct Args { const float* in[N_INPUTS]; float* out; unsigned char* ws; int ph_lo, ph_hi, sub, pad; };
struct Frame { LAS unsigned char* lds; int tid, lane, wave, G, bid; const float* const* in; float* out; unsigned char* ws;
    template <class T> __device__ __forceinline__ T* w(size_t off) const { return (T*)(ws + off); } };

__device__ __forceinline__ void transpose_item(const float* W, int K, int N, int Npad, bf16* WT, int mode, LAS unsigned char* scr, int item, int nblk, int lane, const float* gk = nullptr, int ldo = 0) {
    const int kb = item / nblk, nb = item % nblk, k0 = 64 * kb, n0 = 64 * nb;
    const int g = lane >> 4, c = lane & 15, nn = n0 + 4 * c; const bool ok = nn < N;
    const float* src = W + (size_t)(k0 + 2 * g) * N + nn;
    f32x4 a[8], b[8];
#pragma unroll
    for (int i = 0; i < 8; ++i) { a[i] = ok ? *(const f32x4*)(src + (size_t)(8 * i) * N) : (f32x4){0.f, 0.f, 0.f, 0.f}; b[i] = ok ? *(const f32x4*)(src + (size_t)(8 * i + 1) * N) : (f32x4){0.f, 0.f, 0.f, 0.f}; }
    if (gk) {
#pragma unroll
        for (int i = 0; i < 8; ++i) { const float2 gg = *(const float2*)(gk + k0 + 8 * i + 2 * g); a[i] = a[i] * gg.x; b[i] = b[i] * gg.y; } }
#pragma unroll
    for (int i = 0; i < 8; ++i)
#pragma unroll
        for (int j = 0; j < 4; ++j) *(LAS unsigned*)(scr + (4 * c + j) * 128 + ((i ^ (c & 7)) * 16) + 4 * g) = pk2(a[i][j], b[i][j]);
    LDS_WAIT(); asm volatile("" ::: "memory");
#pragma unroll
    for (int r = 0; r < 8; ++r) { const int idx = lane + 64 * r, nl = idx >> 3, ch = idx & 7, n = n0 + nl;
        const v4u v = *(const LAS v4u*)(scr + nl * 128 + ((ch ^ ((nl >> 2) & 7)) * 16));
        if (n < Npad) { const int row = (mode == 0) ? n : (mode == 3) ? (256 * (n / 256) + ((n >> 5) & 1) * 128 + ((((n >> 6) & 1) << 1) | ((n >> 7) & 1)) * 32 + (n & 31)) : (256 * (n / 128) + (n % 128) + (mode == 2 ? 128 : 0)); *(v4u*)(WT + (size_t)row * (ldo ? ldo : K) + k0 + 8 * ch) = v; } }
    LDS_WAIT(); asm volatile("" ::: "memory");
}
__device__ __forceinline__ void rms_row(const float* xrow, const float* g, bf16* orow, int lane, f32x4 (&v)[4]) {
    const f32x4* xr = (const f32x4*)xrow + lane; float s = 0.f;
#pragma unroll
    for (int j = 0; j < 4; ++j) { v[j] = xr[64 * j]; s += (v[j].x * v[j].x + v[j].y * v[j].y) + (v[j].z * v[j].z + v[j].w * v[j].w); }
    const float r = rsqrtf(wave_sum(s) * (1.f / DM) + EPS);
    v2u* o8 = (v2u*)orow + lane;
#pragma unroll
    for (int j = 0; j < 4; ++j) { const f32x4 gg = ((const f32x4*)g)[lane + 64 * j]; v[j] = v[j] * r * gg; v2u o; o.x = pk2(v[j].x, v[j].y); o.y = pk2(v[j].z, v[j].w); o8[64 * j] = o; }
}
__device__ __forceinline__ void ph_rmsnorm(Frame& F, const float* X, const float* g, bf16* H) {
    const int gw = F.bid * NWAVES + F.wave, NGW = F.G * NWAVES, lane = F.lane;
    f32x4 gg4[4];
#pragma unroll
    for (int j = 0; j < 4; ++j) gg4[j] = ((const f32x4*)g)[lane + 64 * j];
    for (int m = gw; m < M_TOK; m += 4 * NGW) {
        f32x4 v[4][4]; float s[4];
#pragma unroll
        for (int r = 0; r < 4; ++r) { const int mm = (m + r * NGW < M_TOK) ? m + r * NGW : m; const f32x4* xr = (const f32x4*)(X + (size_t)mm * DM) + lane;
#pragma unroll
            for (int j = 0; j < 4; ++j) v[r][j] = xr[64 * j]; }
#pragma unroll
        for (int r = 0; r < 4; ++r) { float t = 0.f;
#pragma unroll
            for (int j = 0; j < 4; ++j) t += (v[r][j].x * v[r][j].x + v[r][j].y * v[r][j].y) + (v[r][j].z * v[r][j].z + v[r][j].w * v[r][j].w);
            s[r] = t; }
#pragma unroll
        for (int r = 0; r < 4; ++r) s[r] = wave_sum(s[r]);
#pragma unroll
        for (int r = 0; r < 4; ++r) { if (m + r * NGW < M_TOK) { const float rs = rsqrtf(s[r] * (1.f / DM) + EPS); v2u* o8 = (v2u*)(H + (size_t)(m + r * NGW) * DM) + lane;
#pragma unroll
            for (int j = 0; j < 4; ++j) { const f32x4 y = v[r][j] * rs * gg4[j]; v2u o; o.x = pk2(y.x, y.y); o.y = pk2(y.z, y.w); o8[64 * j] = o; } } }
    }
}
__device__ __forceinline__ void ph_rope_table(Frame& F, float2* tab) {
    for (int idx = F.bid * NTHR + F.tid; idx < SEQ * 16; idx += F.G * NTHR) { const int pos = idx >> 4, i = idx & 15;
        const float fr = powf(10000.f, -(float)i / 16.f), ang = (float)pos * fr; tab[idx] = make_float2(cosf(ang), sinf(ang)); }
}
__device__ __forceinline__ void ph_refs(Frame& F) {
    if (F.bid != 0 || F.wave != 0) return;
    const int l = F.lane; float* refs = F.w<float>(WS_REFS);
#pragma unroll
    for (int mode = 0; mode < 3; ++mode) { const int dq = mode == 2 ? 96 : 64;
        const float* gq = F.in[mode == 0 ? I_MQN : mode == 1 ? I_DQN : I_MLAQN]; const float* gk = F.in[mode == 0 ? I_MKN : mode == 1 ? I_DKN : I_MLAKN];
        float aq = fabsf(gq[l]), ak = fabsf(gk[l]); if (mode == 2 && l < 32) { aq = fmaxf(aq, fabsf(gq[64 + l])); ak = fmaxf(ak, fabsf(gk[64 + l])); }
        const float mq = wave_max(aq), mk = wave_max(ak); const float base = (float)dq * mq * mk * (mode == 2 ? QSCALE96 : QSCALE64);
        if (mode == 2) { if (l < 16) refs[32 + l] = base; }
        else {
#pragma unroll
            for (int h = 0; h < 8; ++h) { const float mb = wave_max(l < 32 ? fmaxf(F.in[I_RELB][l * 16 + mode * 8 + h], 0.f) : 0.f); if (l == 0) refs[mode * 16 + h] = base + mb * LOG2E; } }
    }
}
__device__ __forceinline__ void wt_job(Frame& F, LAS unsigned char* scr, int& base, int idx, int K, int N, int Npad, int mode, int nexp, size_t off, const float* gk = nullptr, int ldo = 0) {
    const int gw = F.bid * NWAVES + F.wave, NGW = F.G * NWAVES;
    const int nblk = Npad / 64, per = (K / 64) * nblk, tot = per * nexp;
    const size_t wes = (size_t)K * N, wtes = (size_t)(mode == 0 ? Npad : 2 * Npad) * K;
    int it = base + ((gw - base % NGW) + NGW) % NGW;
    for (; it < base + tot; it += NGW) { const int r = it - base, e = r / per, q = r % per;
        transpose_item(F.in[idx] + (size_t)e * wes, K, N, Npad, F.w<bf16>(off) + (size_t)e * wtes, mode, scr, q, nblk, F.lane, gk, ldo); }
    base += tot;
}
#ifndef LATE_DENSE
#define LATE_DENSE 0
#endif
__device__ __forceinline__ void ph_prologue(Frame& F) {
    LAS unsigned char* scr = F.lds + F.wave * 8192;
    int base = 0;
    wt_job(F, scr, base, I_W_IN_E, 1024, N_IN_E, QKV_LD, 0, 1, WS_W_IN_E);
    if (F.G != 256 || !LATE_DENSE) {
        wt_job(F, scr, base, I_W_OUT_E, 1024, 1024, 1024, 0, 1, WS_W_OUT_E);
        wt_job(F, scr, base, I_W_GATE_E, 1024, FF_E, FF_E, 1, 1, WS_W_GU_E, F.in[I_FFNN_E]);
        wt_job(F, scr, base, I_W_UP_E, 1024, FF_E, FF_E, 2, 1, WS_W_GU_E, F.in[I_FFNN_E]);
        wt_job(F, scr, base, I_W_DOWN_E, FF_E, 1024, 1024, 0, 1, WS_W_DN_E);
        wt_job(F, scr, base, I_W_IN_O, 1024, N_IN_O, C1_LD, 0, 1, WS_W_IN_O, F.in[I_MIXN_O]);
        wt_job(F, scr, base, I_W_UQ, 384, 1536, 1536, 0, 1, WS_W_LAT, F.in[I_QAN], W_LAT_LD);
        wt_job(F, scr, base, I_W_UKV, 256, 2048, 2048, 3, 1, WS_W_LAT + ((size_t)1536 * W_LAT_LD + 384) * 2, F.in[I_KVAN], W_LAT_LD);
        wt_job(F, scr, base, I_W_OUT_O, 1024, 1024, 1024, 0, 1, WS_W_OUT_O); }
    ph_rope_table(F, F.w<float2>(WS_ROPE));
    ph_refs(F);
    ph_rmsnorm(F, F.in[I_X], F.in[I_MIXN_E], F.w<bf16>(WS_H));
}
constexpr int MOE_T_GU = (1024 / 64) * (FF_O / 64) * NEXP, MOE_T_DN = (FF_O / 64) * (1024 / 64) * NEXP, MOE_ONLY = 2 * MOE_T_GU + MOE_T_DN;
constexpr int DN_OUT_E = 256, DN_GU_E = (1024 / 64) * (FF_E / 64), DN_DN_E = (FF_E / 64) * (1024 / 64), DN_IN_O = (1024 / 64) * (C1_LD / 64), DN_UQ = (384 / 64) * (1536 / 64), DN_UKV = (256 / 64) * (2048 / 64), DN_OUT_O = 256;
constexpr int DENSE_ITEMS = DN_OUT_E + 2 * DN_GU_E + DN_DN_E + DN_IN_O + DN_UQ + DN_UKV + DN_OUT_O, MOE_ITEMS = DENSE_ITEMS + MOE_ONLY;
constexpr int MOE_TAIL_A = 4096, MOE_TAIL_B = 4096, MOE_TAIL_C = 3072, MOE_TAIL_ALL = MOE_TAIL_A + MOE_TAIL_B + MOE_TAIL_C, NSLOT_MOE = 4;
static_assert(DENSE_ITEMS <= MOE_TAIL_A, "the dense weights must all be converted in phase 1");
__device__ __forceinline__ void moe_convert_item(Frame& F, LAS unsigned char* scr, int it) {
    constexpr int PER_GU = (1024 / 64) * (FF_O / 64), PER_DN = (FF_O / 64) * (1024 / 64);
    int ii = I_W_OUT_O, K = 1024, N = 1024, Np = 1024, mode = 0, ig = -1, ldo = 0, q = 0; size_t so = 0, dof = WS_W_OUT_O;
    if (F.G != 256 || !LATE_DENSE) it += DENSE_ITEMS;
    if (it >= MOE_ITEMS) return;
    if (it < DENSE_ITEMS) {
        if (it < DN_OUT_E) { ii = I_W_OUT_E; dof = WS_W_OUT_E; q = it; }
        else if ((it -= DN_OUT_E) < 2 * DN_GU_E) { const int up = it >= DN_GU_E; ii = up ? I_W_UP_E : I_W_GATE_E; N = FF_E; Np = FF_E; mode = up ? 2 : 1; ig = I_FFNN_E; dof = WS_W_GU_E; q = it - up * DN_GU_E; }
        else if ((it -= 2 * DN_GU_E) < DN_DN_E) { ii = I_W_DOWN_E; K = FF_E; dof = WS_W_DN_E; q = it; }
        else if ((it -= DN_DN_E) < DN_IN_O) { ii = I_W_IN_O; N = N_IN_O; Np = C1_LD; ig = I_MIXN_O; dof = WS_W_IN_O; q = it; }
        else if ((it -= DN_IN_O) < DN_UQ) { ii = I_W_UQ; K = 384; N = 1536; Np = 1536; ig = I_QAN; ldo = W_LAT_LD; dof = WS_W_LAT; q = it; }
        else if ((it -= DN_UQ) < DN_UKV) { ii = I_W_UKV; K = 256; N = 2048; Np = 2048; mode = 3; ig = I_KVAN; ldo = W_LAT_LD; dof = WS_W_LAT + ((size_t)1536 * W_LAT_LD + 384) * 2; q = it; }
        else { q = it - DN_UKV; }
    } else { it -= DENSE_ITEMS;
        if (it < 2 * MOE_T_GU) { const int up = it >= MOE_T_GU, r = it - up * MOE_T_GU, e = r / PER_GU; q = r % PER_GU;
            ii = up ? I_W_UP_O : I_W_GATE_O; N = FF_O; Np = FF_O; mode = up ? 2 : 1; ig = I_FFNN_O; so = (size_t)e * 1024 * FF_O; dof = WS_WGU_O + (size_t)e * 2 * FF_O * 1024 * 2; }
        else { const int r = it - 2 * MOE_T_GU, e = r / PER_DN; q = r % PER_DN; ii = I_W_DOWN_O; K = FF_O; so = (size_t)e * FF_O * 1024; dof = WS_WDN_O + (size_t)e * 1024 * FF_O * 2; } }
    transpose_item(F.in[ii] + so, K, N, Np, F.w<bf16>(dof), mode, scr, q, Np / 64, F.lane, ig >= 0 ? F.in[ig] : nullptr, ldo);
}
__device__ __forceinline__ void moe_convert_tail(Frame& F, int first, int n, int wg0) {
    if (F.G != 256 || F.bid < wg0) return;
    LAS unsigned char* scr = F.lds + F.wave * 8192; const int nw = (F.G - wg0) * NWAVES, w = (F.bid - wg0) * NWAVES + F.wave;
    for (int it = first + w; it < first + n; it += nw) moe_convert_item(F, scr, it);
}
__device__ __forceinline__ void moe_convert_slice(Frame& F, int slice) {
    LAS unsigned char* scr = F.lds + F.wave * 8192;
    const int gw = F.bid * NWAVES + F.wave, NGW = F.G * NWAVES, first = (F.G == 256) ? MOE_TAIL_ALL : 0;
#ifndef SLICE_PAT
#define SLICE_PAT 0
#endif
    constexpr int PER = SLICE_PAT == 0 ? 4 : SLICE_PAT == 3 ? 2 : SLICE_PAT == 4 ? 8 : 6;
    for (int t = 0, it = first + gw; it < MOE_ITEMS; ++t, it += NGW) { const int m = t % PER; const int sl = m < 4 ? m : (SLICE_PAT == 1 ? m - 2 : (m & 1)); if (sl == slice) moe_convert_item(F, scr, it); }
    __syncthreads();
}
__device__ __forceinline__ void ph_rmsnorm_route(Frame& F, const bf16* X, const float* g, float* rstd_out) {
    const float* wr = F.in[I_W_ROUTER]; const float* br = F.in[I_B_ROUTER]; int2* re = F.w<int2>(WS_ROUTE_E); float2* rg = F.w<float2>(WS_ROUTE_G); int* cnt_wg = F.w<int>(WS_CNT_WG);
    LAS int* cnt = (LAS int*)F.lds;
    f32x4 wg[16][2];
#pragma unroll
    for (int j = 0; j < 4; ++j)
#pragma unroll
        for (int q = 0; q < 4; ++q) { const int d = 4 * F.lane + 256 * j + q; const float gd = g[d]; wg[4 * j + q][0] = *(const f32x4*)(wr + d * 8) * gd; wg[4 * j + q][1] = *(const f32x4*)(wr + d * 8 + 4) * gd; }
    float bre[8];
#pragma unroll
    for (int e = 0; e < 8; ++e) bre[e] = br[e];
    for (int ch = F.bid; ch < 256; ch += F.G) {
        if (F.tid < 8) cnt[F.tid] = 0;
        __syncthreads();
        for (int i = F.wave; i < 64; i += 4 * NWAVES) {
            v2u raw[4][4];
#pragma unroll
            for (int r = 0; r < 4; ++r) { const v2u* xr = (const v2u*)(X + (size_t)(ch * 64 + i + r * NWAVES) * DM) + F.lane;
#pragma unroll
                for (int j = 0; j < 4; ++j) raw[r][j] = xr[64 * j]; }
#pragma unroll
            for (int r = 0; r < 4; ++r) { const int m = ch * 64 + i + r * NWAVES; float s = 0.f; float lg[8];
#pragma unroll
                for (int e = 0; e < 8; ++e) lg[e] = 0.f;
#pragma unroll
                for (int j = 0; j < 4; ++j) { const float x4[4] = {bflo(raw[r][j].x), bfhi(raw[r][j].x), bflo(raw[r][j].y), bfhi(raw[r][j].y)};
#pragma unroll
                    for (int q = 0; q < 4; ++q) { const float y = x4[q]; s += y * y; const f32x4 w0 = wg[4 * j + q][0], w1 = wg[4 * j + q][1];
                        lg[0] += y * w0.x; lg[1] += y * w0.y; lg[2] += y * w0.z; lg[3] += y * w0.w; lg[4] += y * w1.x; lg[5] += y * w1.y; lg[6] += y * w1.z; lg[7] += y * w1.w; } }
                const float rs = rsqrtf(wave_sum(s) * (1.f / DM) + EPS);
                if (F.lane == 0) rstd_out[m] = rs;
#pragma unroll
                for (int e = 0; e < 8; ++e) lg[e] = wave_sum(lg[e]) * rs + bre[e];
                int e0 = 0; float v0 = lg[0];
#pragma unroll
                for (int e = 1; e < 8; ++e) if (lg[e] > v0) { v0 = lg[e]; e0 = e; }
                int e1 = -1; float v1 = -INFINITY;
#pragma unroll
                for (int e = 0; e < 8; ++e) if (e != e0 && lg[e] > v1) { v1 = lg[e]; e1 = e; }
                if (F.lane == 0) { const float p1 = 1.f / (1.f + __expf(v0 - v1)); re[m] = make_int2(e0, e1); rg[m] = make_float2(1.f - p1, p1); atomicAdd((int*)&cnt[e0], 1); atomicAdd((int*)&cnt[e1], 1); } } }
        __syncthreads();
        if (F.tid < 8) cnt_wg[ch * 8 + F.tid] = cnt[F.tid];
        __syncthreads();
    }
}
struct MoeSeg { int base[9]; };
__device__ __forceinline__ MoeSeg ph_slots(Frame& F) {
    const int2* re = F.w<int2>(WS_ROUTE_E); const float2* rg = F.w<float2>(WS_ROUTE_G); const int* cnt_wg = F.w<int>(WS_CNT_WG);
    int* stok = F.w<int>(WS_SLOT_TOK); float* sgate = F.w<float>(WS_SLOT_GATE); int* tile_e = F.w<int>(WS_TILE_E); int2* tslot = F.w<int2>(WS_TOK_SLOT); const float* rstd = F.w<float>(WS_RSTD); float* srstd = F.w<float>(WS_SLOT_RSTD);
    LAS int* sh = (LAS int*)F.lds;
    { const int e = F.wave, l = F.lane;
      const int c0 = cnt_wg[(4 * l + 0) * 8 + e], c1 = cnt_wg[(4 * l + 1) * 8 + e], c2 = cnt_wg[(4 * l + 2) * 8 + e], c3 = cnt_wg[(4 * l + 3) * 8 + e];
      const int tot = c0 + c1 + c2 + c3; int incl = tot;
#pragma unroll
      for (int off = 1; off < 64; off <<= 1) { const int v = __shfl_up(incl, off); if (l >= off) incl += v; }
      const int excl = incl - tot;
      sh[64 + 8 * (4 * l + 0) + e] = excl; sh[64 + 8 * (4 * l + 1) + e] = excl + c0; sh[64 + 8 * (4 * l + 2) + e] = excl + c0 + c1; sh[64 + 8 * (4 * l + 3) + e] = excl + c0 + c1 + c2;
      if (l == 63) sh[e] = incl; }
    __syncthreads();
    if (F.tid == 0) { int o = 0; for (int e = 0; e < 8; ++e) { sh[8 + e] = o; o += (sh[e] + 255) / 256 * 256; } sh[16] = o; }
    __syncthreads();
    for (int ch = F.bid; ch < 256; ch += F.G) {
        if (F.wave == 0) { const int row = ch * 64 + F.lane; const int2 e = re[row]; const float2 gg = rg[row]; int s0 = 0, s1 = 0;
            const unsigned long long below = (1ull << F.lane) - 1ull;
#pragma unroll
            for (int q = 0; q < 8; ++q) { const unsigned long long m = __ballot(e.x == q) | __ballot(e.y == q); const int pos = sh[8 + q] + sh[64 + 8 * ch + q] + __popcll(m & below);
                if (e.x == q) s0 = pos; if (e.y == q) s1 = pos; }
            const float rr = rstd[row]; stok[s0] = row; sgate[s0] = gg.x; srstd[s0] = rr; stok[s1] = row; sgate[s1] = gg.y; srstd[s1] = rr; tslot[row] = make_int2(s0, s1); }
    }
    if (F.bid == 0) { for (int e = 0; e < 8; ++e) for (int s = sh[8 + e] + sh[e] + F.tid; s < sh[8 + e + 1]; s += NTHR) { stok[s] = -1; sgate[s] = 0.f; srstd[s] = 0.f; }
        for (int tl = F.tid; tl <= TILE_CAP; tl += NTHR) { int e = -1; for (int q = 0; q < 8; ++q) if (tl * 256 >= sh[8 + q] && tl * 256 < sh[8 + q + 1]) e = q; if (tl == TILE_CAP) e = sh[16] / 256; tile_e[tl] = e; } }
    MoeSeg sg;
#pragma unroll
    for (int e = 0; e < 9; ++e) sg.base[e] = __builtin_amdgcn_readfirstlane(sh[8 + e]);
    __syncthreads();
    return sg;
}
__device__ __forceinline__ void ph_rmsnorm_lat(Frame& F) {
    const bf16* C1 = F.w<bf16>(WS_C1); bf16* CQN = F.w<bf16>(WS_CQN); bf16* CKVN = F.w<bf16>(WS_CKVN); const float* gq = F.in[I_QAN]; const float* gkv = F.in[I_KVAN];
    const int gw = F.bid * NWAVES + F.wave, NGW = F.G * NWAVES, lane = F.lane;
    const bool isq = lane < 48; const float* g1 = isq ? gq + lane * 8 : gkv + (lane - 48) * 8; const float* g2 = gkv + (16 + lane) * 8;
    float ga[8], gb[8];
#pragma unroll
    for (int j = 0; j < 8; ++j) { ga[j] = g1[j]; gb[j] = (lane < 16) ? g2[j] : 0.f; }
    for (int m = gw; m < M_TOK; m += 4 * NGW) {
        v4u ra[4], rb[4];
#pragma unroll
        for (int r = 0; r < 4; ++r) { const int mm = (m + r * NGW < M_TOK) ? m + r * NGW : m; const v4u* row = (const v4u*)(C1 + (size_t)mm * C1_LD); ra[r] = row[lane]; rb[r] = (lane < 16) ? row[64 + lane] : (v4u){0u, 0u, 0u, 0u}; }
#pragma unroll
        for (int r = 0; r < 4; ++r) { if (m + r * NGW < M_TOK) { const int mm = m + r * NGW;
            float xa[8], xb[8]; float sa = 0.f, sb = 0.f;
#pragma unroll
            for (int e = 0; e < 4; ++e) { xa[2 * e] = bflo(ra[r][e]); xa[2 * e + 1] = bfhi(ra[r][e]); xb[2 * e] = bflo(rb[r][e]); xb[2 * e + 1] = bfhi(rb[r][e]); }
#pragma unroll
            for (int j = 0; j < 8; ++j) { sa += xa[j] * xa[j]; sb += xb[j] * xb[j]; }
            const float sq = wave_sum(isq ? sa : 0.f), skv = wave_sum((isq ? 0.f : sa) + sb);
            const float rq = rsqrtf(sq * (1.f / 384) + EPS), rkv = rsqrtf(skv * (1.f / 256) + EPS), r1 = isq ? rq : rkv;
            v4u o;
#pragma unroll
            for (int e = 0; e < 4; ++e) o[e] = pk2(xa[2 * e] * r1 * ga[2 * e], xa[2 * e + 1] * r1 * ga[2 * e + 1]);
            if (isq) *(v4u*)(CQN + (size_t)mm * 384 + lane * 8) = o; else *(v4u*)(CKVN + (size_t)mm * 256 + (lane - 48) * 8) = o;
            if (lane < 16) { v4u o2;
#pragma unroll
                for (int e = 0; e < 4; ++e) o2[e] = pk2(xb[2 * e] * rkv * gb[2 * e], xb[2 * e + 1] * rkv * gb[2 * e + 1]);
                *(v4u*)(CKVN + (size_t)mm * 256 + (16 + lane) * 8) = o2; } } }
    }
}
template <int DUMMY>
__device__ __forceinline__ void ph_qknorm(Frame& F) {
    bf16* QKV = F.w<bf16>(WS_QKV0); float* kmean2 = F.w<float>(WS_KMEAN); LAS float* part = (LAS float*)F.lds;
    const int lane = F.lane;
    for (int u = F.bid; u < 256; u += F.G) { const int grp = u & 1, half = (u >> 1) & 1, blk = (u >> 2) & 15, b = u >> 6;
        const int col = (grp == 0 ? C_MK : C_DK) + lane * 8;
        const float* g = F.in[grp == 0 ? I_MKN : I_DKN] + (lane & 7) * 8;
        float gg[8];
#pragma unroll
        for (int j = 0; j < 8; ++j) gg[j] = g[j];
        float ks[8];
#pragma unroll
        for (int j = 0; j < 8; ++j) ks[j] = 0.f;
        const size_t row0 = (size_t)b * SEQ + blk * 256 + half * 128;
        for (int i0 = F.wave; i0 < 128; i0 += 8 * NWAVES) {
            v4u raw[8];
#pragma unroll
            for (int u4 = 0; u4 < 8; ++u4) raw[u4] = *(const v4u*)(QKV + (row0 + i0 + u4 * NWAVES) * QKV_LD + col);
#pragma unroll
            for (int u4 = 0; u4 < 8; ++u4) { float x[8];
                x[0] = bflo(raw[u4].x); x[1] = bfhi(raw[u4].x); x[2] = bflo(raw[u4].y); x[3] = bfhi(raw[u4].y); x[4] = bflo(raw[u4].z); x[5] = bfhi(raw[u4].z); x[6] = bflo(raw[u4].w); x[7] = bfhi(raw[u4].w);
                float ss = 0.f;
#pragma unroll
                for (int j = 0; j < 8; ++j) ss += x[j] * x[j];
                ss += __shfl_xor(ss, 1); ss += __shfl_xor(ss, 2); ss += __shfl_xor(ss, 4);
                const float r = rsqrtf(ss * (1.f / 64) + EPS);
#pragma unroll
                for (int j = 0; j < 8; ++j) { x[j] = x[j] * r * gg[j]; ks[j] += x[j]; }
                v4u o; o.x = pk2(x[0], x[1]); o.y = pk2(x[2], x[3]); o.z = pk2(x[4], x[5]); o.w = pk2(x[6], x[7]);
                if (DUMMY) *(v4u*)(F.w<bf16>(WS_O) + (row0 + i0 + u4 * NWAVES) * 1024 + (col & 511)) = o; else *(v4u*)(QKV + (row0 + i0 + u4 * NWAVES) * QKV_LD + col) = o; } }
        if (grp == 0) {
#pragma unroll
            for (int j = 0; j < 8; ++j) part[F.wave * 512 + lane * 8 + j] = ks[j];
            __syncthreads();
            { const int c = F.tid; float s = 0.f;
#pragma unroll
              for (int w = 0; w < 8; ++w) s += part[w * 512 + c];
              (DUMMY ? F.w<float>(WS_O) + 8 * 1024 * 1024 / 4 * 3 : kmean2)[((((b * 8 + (c >> 6)) * 16 + blk) * 2) + half) * 64 + (c & 63)] = s; }
            __syncthreads(); }
    }
}
__device__ __forceinline__ void ph_mla_prep(Frame& F, const float2* tab) {
    const float* KSS = F.w<float>(WS_KSS); const bf16* C1 = F.w<bf16>(WS_C1); bf16* KM = F.w<bf16>(WS_KM); const float* g = F.in[I_MLAKN];
#pragma unroll 1
    for (int idx = F.bid * NTHR + F.tid; idx < M_TOK * 16; idx += F.G * NTHR) { const int row = idx >> 4, h = idx & 15, pos = row & (SEQ - 1);
        const v4u* src2 = (const v4u*)(C1 + (size_t)row * C1_LD + C1_KPE);
        v4u raw[4];
#pragma unroll
        for (int c = 0; c < 4; ++c) raw[c] = src2[c];
        const float r = KSS[idx];
        v4u* dst = (v4u*)(KM + (size_t)row * QR_LD + h * 96);
#pragma unroll
        for (int cc = 0; cc < 2; ++cc) { v4u o1, o2;
#pragma unroll
            for (int e = 0; e < 4; ++e) { const int i0 = 8 * cc + 2 * e;
                const float a0 = bflo(raw[cc][e]) * r * g[64 + i0], a1 = bfhi(raw[cc][e]) * r * g[64 + i0 + 1], b0 = bflo(raw[2 + cc][e]) * r * g[80 + i0], b1 = bfhi(raw[2 + cc][e]) * r * g[80 + i0 + 1];
                const float2 c0 = tab[pos * 16 + i0], c1 = tab[pos * 16 + i0 + 1];
                o1[e] = pk2(a0 * c0.x - b0 * c0.y, a1 * c1.x - b1 * c1.y); o2[e] = pk2(a0 * c0.y + b0 * c0.x, a1 * c1.y + b1 * c1.x); }
            dst[8 + cc] = o1; dst[10 + cc] = o2; }
    }
}
__device__ __forceinline__ void moe_y_row(const bf16* Y, const bf16* YP, int slot, int lane, float gate, f32x4 (&x)[4]) {
    if (slot < MOE_FULL_TILES * 256) { const v2u* a = (const v2u*)(Y + (size_t)slot * 1024) + lane;
#pragma unroll
        for (int j = 0; j < 4; ++j) { const v2u p = a[64 * j]; x[j].x += gate * bflo(p.x); x[j].y += gate * bfhi(p.x); x[j].z += gate * bflo(p.y); x[j].w += gate * bfhi(p.y); } }
    else { const v2u* a = (const v2u*)(YP + (size_t)(slot - MOE_FULL_TILES * 256) * 1024) + lane;
#pragma unroll
        for (int j = 0; j < 4; ++j) { float s0 = 0.f, s1 = 0.f, s2 = 0.f, s3 = 0.f;
#pragma unroll
            for (int k = 0; k < MOE_TAIL_SPLIT; ++k) { const v2u p = a[(size_t)k * MOE_TAIL_ROWS * 256 + 64 * j]; s0 += bflo(p.x); s1 += bfhi(p.x); s2 += bflo(p.y); s3 += bfhi(p.y); }
            x[j].x += gate * s0; x[j].y += gate * s1; x[j].z += gate * s2; x[j].w += gate * s3; } }
}
__device__ __forceinline__ void ph_moe_combine(Frame& F) {
    const bf16* Y = F.w<bf16>(WS_Y); const bf16* YP = F.w<bf16>(WS_YP); const int2* tslot = F.w<int2>(WS_TOK_SLOT); const float2* rg = F.w<float2>(WS_ROUTE_G); float* X = F.out; const bf16* XB = F.w<bf16>(WS_H);
    const int gw = F.bid * NWAVES + F.wave, NGW = F.G * NWAVES;
#pragma unroll 2
    for (int m = gw; m < M_TOK; m += NGW) { const int2 sl = tslot[m]; const float2 g = rg[m];
        f32x4* xr = (f32x4*)(X + (size_t)m * DM) + F.lane; const v2u* xb = (const v2u*)(XB + (size_t)m * DM) + F.lane; f32x4 x[4];
#pragma unroll
        for (int j = 0; j < 4; ++j) { const v2u p = xb[64 * j]; x[j] = (f32x4){bflo(p.x), bfhi(p.x), bflo(p.y), bfhi(p.y)}; }
        moe_y_row(Y, YP, sl.x, F.lane, g.x, x); moe_y_row(Y, YP, sl.y, F.lane, g.y, x);
#pragma unroll
        for (int j = 0; j < 4; ++j) xr[64 * j] = x[j]; }
}

#ifndef REF_LIMIT
#define REF_LIMIT 100.f
#endif
namespace at {
typedef short s16x4 __attribute__((ext_vector_type(4)));
typedef short v4i16_t __attribute__((ext_vector_type(4)));
typedef __attribute__((address_space(3))) const char* lds_cptr;
__device__ __forceinline__ unsigned cvtpk(float lo, float hi) { return pk2(lo, hi); }
__device__ __forceinline__ int crow(int r, int hi) { return (r & 3) + 8 * (r >> 2) + 4 * hi; }
__device__ __forceinline__ s16x4 vtr(lds_cptr p) { return __builtin_bit_cast(s16x4, __builtin_amdgcn_ds_read_tr16_b64_v4i16((__attribute__((address_space(3))) v4i16_t*)p)); }

__device__ __forceinline__ void glds16(const void* gbase, unsigned voff, unsigned lds_dst) { unsigned keep;
    asm volatile("s_mov_b32 %0, m0\n\ts_mov_b32 m0, %3\n\ts_nop 0\n\tglobal_load_lds_dwordx4 %1, %2\n\ts_mov_b32 m0, %0" : "=&s"(keep) : "v"(voff), "s"(gbase), "s"(lds_dst) : "memory"); }
__device__ __forceinline__ void glds16b(const void* gbase, unsigned voff, unsigned lds_dst) { unsigned keep;
    asm volatile("s_mov_b32 %0, m0\n\ts_mov_b32 m0, %3\n\ts_nop 0\n\tglobal_load_lds_dwordx4 %1, %2 offset:128\n\ts_mov_b32 m0, %0" : "=&s"(keep) : "v"(voff), "s"(gbase), "s"(lds_dst) : "memory"); }
__device__ __forceinline__ void glds4(const void* gbase, unsigned voff, unsigned lds_dst) { unsigned keep;
    asm volatile("s_mov_b32 %0, m0\n\ts_mov_b32 m0, %3\n\ts_nop 0\n\tglobal_load_lds_dword %1, %2\n\ts_mov_b32 m0, %0" : "=&s"(keep) : "v"(voff), "s"(gbase), "s"(lds_dst) : "memory"); }
constexpr int KBUF = 12288, VBUF = 8192, MBUF = 2048;
constexpr int NSTG = 4;
constexpr int L_K = 0, L_V = NSTG * KBUF, L_M = L_V + NSTG * VBUF, L_TAB = L_M + NSTG * MBUF, TAB_GUARD = 64, TAB_N = SEQ + TAB_GUARD, L_WS = L_TAB + TAB_N * 4, L_OST = L_WS + NWAVES * 64 * 4, L_MISC = L_OST + NWAVES * 4096, L_END = L_MISC + 64;
static_assert(L_END <= LDSCTL_OFF, "attention LDS map");

struct AttnP { const bf16* Q; int ldq, qhs; const bf16* K; int ldk, khs; const bf16* V; int ldv, vhs; bf16* O; int ocol0; const float* relb; int bcol0; const float* kmean; const unsigned long long* maskt;
               const float* refs; const float* gq; const float2* rope; };

template <int MODE, int DQK>
__device__ __forceinline__ void attn_unit(Frame& F, const AttnP& P, int b, int h, int qb, bool build_tab) {
    constexpr int ND0 = DQK / 16;
    LAS unsigned char* lds = F.lds; const lds_cptr shm3 = (lds_cptr)F.lds;
    const int tid = F.tid, lane = F.lane, r32 = lane & 31, hi = lane >> 5, wid = F.wave;
    const size_t rowbase = (size_t)b * SEQ; const int q0 = qb * 256, qw = q0 + wid * 32, q = qw + r32;
    LAS float* tab = (LAS float*)(lds + L_TAB) + (SEQ - 1);
    LAS float* wsf = (LAS float*)(lds + L_WS) + wid * 64;
    float ref = P.refs[MODE * 16 + h]; int tfar = -1;
    const bool sub_ref = (MODE == 2) && __builtin_amdgcn_readfirstlane((int)(ref >= REF_LIMIT)) != 0;
    if (MODE != 2) { const float b31 = P.relb[31 * 16 + P.bcol0 + h] * LOG2E; const bool fast = (ref - b31) < REF_LIMIT; if (fast) ref = b31; tfar = __builtin_amdgcn_readfirstlane(fast ? ((qw - 853) >> 6) : -1); }
    if (MODE != 2 && build_tab) {
        wsf[lane & 31] = P.relb[(lane & 31) * 16 + P.bcol0 + h] * LOG2E - ref;
        asm volatile("s_waitcnt lgkmcnt(0)" ::: "memory");
#pragma unroll
        for (int k = 0; k < (SEQ + TAB_GUARD + NTHR - 1) / NTHR; ++k) { const int n = tid - TAB_GUARD + k * NTHR; if (n < SEQ) tab[-n] = (n < 0) ? 0.f : wsf[rel_bucket(n)]; }
    }
    const bf16* Kh = P.K + rowbase * P.ldk + h * P.khs; const bf16* Vh = P.V + rowbase * P.ldv + h * P.vhs;
    const unsigned kvoff = (unsigned)(lane * P.ldk + wid * 8) * 2u;
    const unsigned vvoff = (unsigned)((16 * (wid & 3) + (lane >> 2)) * P.ldv + (wid >> 2) * 32 + (lane & 3) * 8) * 2u;
    const unsigned lds0 = (unsigned)(size_t)lds;
    const unsigned char* mbase = (MODE == 1) ? (const unsigned char*)(P.maskt + ((size_t)b * 64 * SEQ) + qw) : nullptr;
#define AT_DMA(t, bufi) do { const bf16* kt_ = Kh + (size_t)(t) * 64 * P.ldk; \
        at::glds16(kt_, kvoff, (unsigned)__builtin_amdgcn_readfirstlane(lds0 + L_K + (bufi) * KBUF + wid * 1024)); \
        if (DQK == 96 && wid < 4) at::glds16b(kt_, kvoff, (unsigned)__builtin_amdgcn_readfirstlane(lds0 + L_K + (bufi) * KBUF + (8 + wid) * 1024 - 128));   \
        at::glds16(Vh + (size_t)(t) * 64 * P.ldv, vvoff, (unsigned)__builtin_amdgcn_readfirstlane(lds0 + L_V + (bufi) * VBUF + wid * 1024)); \
        if (MODE == 1) at::glds4(mbase + (size_t)(t) * SEQ * 8, (unsigned)lane * 4u, (unsigned)__builtin_amdgcn_readfirstlane(lds0 + L_M + (bufi) * MBUF + wid * 256)); } while (0)
    const int NT = (q0 + 256) / 64;
    const int tdiag = qw >> 6;
    AT_DMA(0, 0); AT_DMA(1, 1); AT_DMA(2, 2);
    bf16x8 qr[ND0];
    { const bf16* Qw = P.Q + (rowbase + q) * P.ldq + h * P.qhs + hi * 8;
#pragma unroll
      for (int d0 = 0; d0 < ND0; ++d0) qr[d0] = *(const bf16x8*)(Qw + d0 * 16); }
    if (MODE != 2) {
        float x[4][8]; float ss = 0.f;
#pragma unroll
        for (int d0 = 0; d0 < 4; ++d0)
#pragma unroll
            for (int j = 0; j < 8; ++j) { x[d0][j] = bf2f((bf16)qr[d0][j]); ss += x[d0][j] * x[d0][j]; }
        ss += __shfl_xor(ss, 32);
        const float rr = rsqrtf(ss * (1.f / 64) + EPS) * QSCALE64; const float* g = P.gq + hi * 8;
#pragma unroll
        for (int d0 = 0; d0 < 4; ++d0) { v4u w;
#pragma unroll
            for (int e = 0; e < 4; ++e) w[e] = pk2(x[d0][2 * e] * rr * g[d0 * 16 + 2 * e], x[d0][2 * e + 1] * rr * g[d0 * 16 + 2 * e + 1]);
            qr[d0] = __builtin_bit_cast(bf16x8, w); }
    }
    if (MODE == 2) {
        float x[6][8]; float ss = 0.f;
#pragma unroll
        for (int d0 = 0; d0 < 6; ++d0)
#pragma unroll
            for (int j = 0; j < 8; ++j) { x[d0][j] = bf2f((bf16)qr[d0][j]); ss += x[d0][j] * x[d0][j]; }
        ss += __shfl_xor(ss, 32);
        const float rr = rsqrtf(ss * (1.f / 96) + EPS) * QSCALE96; const float* g = P.gq + hi * 8;
#pragma unroll
        for (int d0 = 0; d0 < 6; ++d0)
#pragma unroll
            for (int j = 0; j < 8; ++j) x[d0][j] *= rr * g[d0 * 16 + j];
#pragma unroll
        for (int j = 0; j < 8; ++j) { const float2 cs = P.rope[q * 16 + hi * 8 + j]; const float x1 = x[4][j], x2 = x[5][j]; x[4][j] = x1 * cs.x - x2 * cs.y; x[5][j] = x1 * cs.y + x2 * cs.x; }
#pragma unroll
        for (int d0 = 0; d0 < 6; ++d0) { v4u w; w.x = pk2(x[d0][0], x[d0][1]); w.y = pk2(x[d0][2], x[d0][3]); w.z = pk2(x[d0][4], x[d0][5]); w.w = pk2(x[d0][6], x[d0][7]); qr[d0] = __builtin_bit_cast(bf16x8, w); }
    }
    unsigned keep = 0u; const int blk = qb;
    if (MODE == 0) {
        float v1 = -INFINITY, v2 = -INFINITY, v3 = -INFINITY; int i1 = -1, i2 = -1, i3 = -1;
        LAS float* kml = (LAS float*)(lds + L_OST);
        { float ka_[2], kb_[2];
#pragma unroll
          for (int k = 0; k < 2; ++k) { const int i = tid + k * NTHR; const float* k2 = P.kmean + (size_t)((b * 8 + h) * 16) * 128 + (i >> 6) * 128 + (i & 63); const bool ok = i < blk * 64; ka_[k] = ok ? k2[0] : 0.f; kb_[k] = ok ? k2[64] : 0.f; }
#pragma unroll
          for (int k = 0; k < 2; ++k) { const int i = tid + k * NTHR; if (i < blk * 64) kml[i] = (ka_[k] + kb_[k]) * (1.f / 256); } }
        asm volatile("s_waitcnt lgkmcnt(0)" ::: "memory"); __builtin_amdgcn_s_barrier();
        const LAS float* km0 = kml + hi * 8;
#pragma unroll 1
        for (int j = 0; j < blk; ++j) { const LAS float* km = km0 + j * 64; float g = 0.f;
#pragma unroll
            for (int d0 = 0; d0 < 4; ++d0) { const f32x4 ka = *(const LAS f32x4*)(km + d0 * 16), kb = *(const LAS f32x4*)(km + d0 * 16 + 4); const bf16x8 qq = qr[d0];
                g += bf2f((bf16)qq[0]) * ka.x + bf2f((bf16)qq[1]) * ka.y + bf2f((bf16)qq[2]) * ka.z + bf2f((bf16)qq[3]) * ka.w + bf2f((bf16)qq[4]) * kb.x + bf2f((bf16)qq[5]) * kb.y + bf2f((bf16)qq[6]) * kb.z + bf2f((bf16)qq[7]) * kb.w; }
            { const unsigned gi = __float_as_uint(g); const v2u sw = __builtin_amdgcn_permlane32_swap(gi, gi, false, false); g = __uint_as_float(sw.x) + __uint_as_float(sw.y); }
            if (g > v1) { v3 = v2; i3 = i2; v2 = v1; i2 = i1; v1 = g; i1 = j; } else if (g > v2) { v3 = v2; i3 = i2; v2 = g; i2 = j; } else if (g > v3) { v3 = g; i3 = j; } }
        if (i1 >= 0) keep |= 1u << i1; if (i2 >= 0) keep |= 1u << i2; if (i3 >= 0) keep |= 1u << i3;
    }
    float l_reg = 0.f; f32x16 o[2];
#pragma unroll
    for (int r = 0; r < 16; ++r) { o[0][r] = 0.f; o[1][r] = 0.f; }
    f32x16 ol;
#pragma unroll
    for (int r = 0; r < 16; ++r) ol[r] = 0.f;
    const v4u ones4 = {0x3f803f80u, 0x3f803f80u, 0x3f803f80u, 0x3f803f80u}; bf16x8 ones = __builtin_bit_cast(bf16x8, ones4);
#define AT_WAIT() do { if (DQK == 96 && wid < 4) asm volatile("s_waitcnt vmcnt(6) lgkmcnt(0)" ::: "memory"); \
        else if (MODE == 1) asm volatile("s_waitcnt vmcnt(6) lgkmcnt(0)" ::: "memory"); else asm volatile("s_waitcnt vmcnt(4) lgkmcnt(0)" ::: "memory"); } while (0)
#pragma unroll
    for (int d0 = 0; d0 < ND0; ++d0) asm volatile("" : "+v"(qr[d0]));
    asm volatile("" : "+v"(ones)); asm volatile("" : "+v"(keep));
    asm volatile("s_waitcnt vmcnt(0) lgkmcnt(0)" ::: "memory");
    __builtin_amdgcn_s_barrier();
    for (int t = 0; t < NT; ++t) {
        const int bufi = t & (NSTG - 1);
        if (t + 3 < NT) AT_DMA(t + 3, (t + 3) & (NSTG - 1));
        bool active = t <= tdiag;
        bool lane_keep = true;
        if (MODE == 0) { const int jb = t >> 2; lane_keep = (jb == blk) || ((keep >> jb) & 1u); active = active && (__ballot(lane_keep) != 0ull); }
        if (active) {
            f32x16 p0, p1;
            const lds_cptr kp = shm3 + L_K + bufi * KBUF + hi * 1024 + r32 * 16;
            bf16x8 kf[2 * ND0];
#pragma unroll
            for (int d0 = 0; d0 < ND0; ++d0) { kf[2 * d0] = *(const __attribute__((address_space(3))) bf16x8*)(kp + d0 * 2048); kf[2 * d0 + 1] = *(const __attribute__((address_space(3))) bf16x8*)(kp + d0 * 2048 + 512); }
            v2u mwv = {0u, 0u}; if (MODE == 1) mwv = *(const LAS v2u*)(lds + L_M + bufi * MBUF + wid * 256 + r32 * 8);
            __builtin_amdgcn_sched_barrier(0);
            if (MODE != 2 && t > tfar) { const LAS float* tb = tab + (64 * t + 4 * hi - q);
#pragma unroll
                for (int r = 0; r < 16; ++r) { const int c = (r & 3) + 8 * (r >> 2); p0[r] = tb[c]; p1[r] = tb[c + 32]; }
#pragma unroll
                for (int d0 = 0; d0 < ND0; ++d0) { p0 = __builtin_amdgcn_mfma_f32_32x32x16_bf16(kf[2 * d0], qr[d0], p0, 0, 0, 0); p1 = __builtin_amdgcn_mfma_f32_32x32x16_bf16(kf[2 * d0 + 1], qr[d0], p1, 0, 0, 0); } }
            else if (MODE != 2) {
                const f32x16 z16 = {0.f, 0.f, 0.f, 0.f, 0.f, 0.f, 0.f, 0.f, 0.f, 0.f, 0.f, 0.f, 0.f, 0.f, 0.f, 0.f};
                p0 = __builtin_amdgcn_mfma_f32_32x32x16_bf16(kf[0], qr[0], z16, 0, 0, 0); p1 = __builtin_amdgcn_mfma_f32_32x32x16_bf16(kf[1], qr[0], z16, 0, 0, 0);
#pragma unroll
                for (int d0 = 1; d0 < ND0; ++d0) { p0 = __builtin_amdgcn_mfma_f32_32x32x16_bf16(kf[2 * d0], qr[d0], p0, 0, 0, 0); p1 = __builtin_amdgcn_mfma_f32_32x32x16_bf16(kf[2 * d0 + 1], qr[d0], p1, 0, 0, 0); } }
            else {
                const f32x16 z16 = {0.f, 0.f, 0.f, 0.f, 0.f, 0.f, 0.f, 0.f, 0.f, 0.f, 0.f, 0.f, 0.f, 0.f, 0.f, 0.f};
                p0 = __builtin_amdgcn_mfma_f32_32x32x16_bf16(kf[0], qr[0], z16, 0, 0, 0); p1 = __builtin_amdgcn_mfma_f32_32x32x16_bf16(kf[1], qr[0], z16, 0, 0, 0);
#pragma unroll
                for (int d0 = 1; d0 < ND0; ++d0) { p0 = __builtin_amdgcn_mfma_f32_32x32x16_bf16(kf[2 * d0], qr[d0], p0, 0, 0, 0); p1 = __builtin_amdgcn_mfma_f32_32x32x16_bf16(kf[2 * d0 + 1], qr[d0], p1, 0, 0, 0); } }
            const lds_cptr vp = shm3 + L_V + bufi * VBUF + ((lane >> 4) & 1) * 32 + (lane & 3) * 8 + (4 * hi + ((lane & 15) >> 2)) * 64;
            bf16x8 vf[4];
#pragma unroll
            for (int i = 0; i < 4; ++i) { const s16x4 lo = vtr(vp + i * 1024), hh = vtr(vp + i * 1024 + 512); vf[i] = (bf16x8){lo[0], lo[1], lo[2], lo[3], hh[0], hh[1], hh[2], hh[3]}; }
            __builtin_amdgcn_sched_barrier(0);
            if (MODE == 2 && sub_ref) {
#pragma unroll
                for (int r = 0; r < 16; ++r) { p0[r] -= ref; p1[r] -= ref; } }
#pragma unroll
            for (int r = 0; r < 16; ++r) { p0[r] = __builtin_amdgcn_exp2f(p0[r]); p1[r] = __builtin_amdgcn_exp2f(p1[r]); }
            if (MODE != 1 && t == tdiag) { const int kb = 64 * t + 4 * hi;
#pragma unroll
                for (int r = 0; r < 16; ++r) { const int kv = kb + (r & 3) + 8 * (r >> 2); if (kv > q) p0[r] = 0.f; if (kv + 32 > q) p1[r] = 0.f; } }
            if (MODE == 1) { const unsigned wl = mwv.x >> (4 * hi), wh = mwv.y >> (4 * hi);
#pragma unroll
                for (int r = 0; r < 16; ++r) { int m0, m1;
                    asm("v_bfe_i32 %0, %1, %2, 1" : "=v"(m0) : "v"(wl), "n"((r & 3) + 8 * (r >> 2))); asm("v_bfe_i32 %0, %1, %2, 1" : "=v"(m1) : "v"(wh), "n"((r & 3) + 8 * (r >> 2)));
                    p0[r] = __uint_as_float(__float_as_uint(p0[r]) & (unsigned)m0); p1[r] = __uint_as_float(__float_as_uint(p1[r]) & (unsigned)m1); } }
            float sacc = 0.f;
            if (MODE != 2) {
#pragma unroll
                for (int r = 0; r < 16; ++r) sacc += p0[r] + p1[r]; }
            const unsigned kmask = (MODE == 0 && !lane_keep) ? 0u : 0xffffffffu;
            l_reg += (MODE == 0 && !lane_keep) ? 0.f : sacc;
            v4u pw[4];
#pragma unroll
            for (int k = 0; k < 2; ++k) { pw[k].x = cvtpk(p0[8 * k], p0[8 * k + 1]); pw[k].y = cvtpk(p0[8 * k + 2], p0[8 * k + 3]); pw[k].z = cvtpk(p0[8 * k + 4], p0[8 * k + 5]); pw[k].w = cvtpk(p0[8 * k + 6], p0[8 * k + 7]);
                pw[2 + k].x = cvtpk(p1[8 * k], p1[8 * k + 1]); pw[2 + k].y = cvtpk(p1[8 * k + 2], p1[8 * k + 3]); pw[2 + k].z = cvtpk(p1[8 * k + 4], p1[8 * k + 5]); pw[2 + k].w = cvtpk(p1[8 * k + 6], p1[8 * k + 7]); }
            if (MODE == 0) {
#pragma unroll
                for (int k = 0; k < 4; ++k) { pw[k].x &= kmask; pw[k].y &= kmask; pw[k].z &= kmask; pw[k].w &= kmask; } }
            bf16x8 vg[4];
#pragma unroll
            for (int i = 0; i < 4; ++i) { const s16x4 lo = vtr(vp + 4096 + i * 1024), hh = vtr(vp + 4096 + i * 1024 + 512); vg[i] = (bf16x8){lo[0], lo[1], lo[2], lo[3], hh[0], hh[1], hh[2], hh[3]}; }
#pragma unroll
            for (int i = 0; i < 4; ++i) o[0] = __builtin_amdgcn_mfma_f32_32x32x16_bf16(__builtin_bit_cast(bf16x8, pw[i]), vf[i], o[0], 0, 0, 0);
#pragma unroll
            for (int i = 0; i < 4; ++i) o[1] = __builtin_amdgcn_mfma_f32_32x32x16_bf16(__builtin_bit_cast(bf16x8, pw[i]), vg[i], o[1], 0, 0, 0);
            if (MODE == 2) {
#pragma unroll
                for (int i = 0; i < 4; ++i) ol = __builtin_amdgcn_mfma_f32_32x32x16_bf16(__builtin_bit_cast(bf16x8, pw[i]), ones, ol, 0, 0, 0); }
        }
        if (t + 3 < NT) AT_WAIT(); else asm volatile("s_waitcnt vmcnt(0) lgkmcnt(0)" ::: "memory");
        __builtin_amdgcn_s_barrier();
    }
#undef AT_WAIT
    l_reg += __shfl_xor(l_reg, 32);
    if (hi == 0) wsf[r32] = l_reg;
    LDS_WAIT();
    float rli[16];
#pragma unroll
    for (int r = 0; r < 16; ++r) rli[r] = __builtin_amdgcn_rcpf(MODE == 2 ? ol[r] : wsf[crow(r, hi)]);
    bf16* Ow = P.O + (rowbase + qw) * 1024 + P.ocol0 + h * 64;
    { LAS bf16* stg = (LAS bf16*)(lds + L_OST) + wid * 2048;
#pragma unroll
      for (int r = 0; r < 16; ++r) { const int orow = crow(r, hi);
#pragma unroll
          for (int d0 = 0; d0 < 2; ++d0) stg[orow * 64 + d0 * 32 + r32] = f2bf(o[d0][r] * rli[r]); }
      LDS_WAIT();
#pragma unroll
      for (int i = 0; i < 4; ++i) { const int row = i * 8 + (lane >> 3), ch = lane & 7; const v4u v = *(const LAS v4u*)(stg + row * 64 + ch * 8); *(v4u*)(Ow + (size_t)row * 1024 + ch * 8) = v; } }
    asm volatile("s_waitcnt lgkmcnt(0)" ::: "memory"); __builtin_amdgcn_s_barrier();
#undef AT_DMA
}
}

__device__ __forceinline__ void ph_attn_l0(Frame& F) {
    const bf16* QKV = F.w<bf16>(WS_QKV0);
    at::AttnP PM{QKV + C_MQ, QKV_LD, 64, QKV + C_MK, QKV_LD, 64, QKV + C_MV, QKV_LD, 64, F.w<bf16>(WS_O), 0, F.in[I_RELB], 0, F.w<float>(WS_KMEAN), nullptr, F.w<float>(WS_REFS), F.in[I_MQN], nullptr};
    at::AttnP PD{QKV + C_DQ, QKV_LD, 64, QKV + C_DK, QKV_LD, 64, QKV + C_DV, QKV_LD, 64, F.w<bf16>(WS_O), 512, F.in[I_RELB], 8, nullptr, F.w<unsigned long long>(WS_MASKT), F.w<float>(WS_REFS), F.in[I_DQN], nullptr};
    const int vcu = (F.G % 8 == 0) ? (F.bid % 8) * (F.G / 8) + F.bid / 8 : F.bid;
    for (int v = vcu; v < 256; v += F.G) { const int bh = v >> 3, s = v & 7, b = bh >> 3, h = bh & 7;
        at::attn_unit<0, 64>(F, PM, b, h, 15 - s, true); moe_convert_slice(F, 0); at::attn_unit<0, 64>(F, PM, b, h, s, false);
        at::attn_unit<1, 64>(F, PD, b, h, 15 - s, true); moe_convert_slice(F, 1); at::attn_unit<1, 64>(F, PD, b, h, s, false); }
}
__device__ __forceinline__ void ph_attn_mla(Frame& F) {
    at::AttnP PA{F.w<bf16>(WS_QR), QR_LD, 96, F.w<bf16>(WS_KM), QR_LD, 96, F.w<bf16>(WS_KVR) + 64, KVR_LD, 128, F.w<bf16>(WS_O1), 0, nullptr, 0, nullptr, nullptr, F.w<float>(WS_REFS), F.in[I_MLAQN], F.w<float2>(WS_ROPE)};
    const int vcu = (F.G % 8 == 0) ? (F.bid % 8) * (F.G / 8) + F.bid / 8 : F.bid;
    for (int v = vcu; v < 256; v += F.G) { const int bh = v >> 2, s = v & 3, b = bh >> 4, h = bh & 15;
        const bool rev = (bh & 1) != 0; const int q0 = rev ? s : 15 - s, q1 = rev ? 11 - s : 4 + s, q2 = rev ? 4 + s : 11 - s, q3 = rev ? 15 - s : s;
        at::attn_unit<2, 96>(F, PA, b, h, q0, false); moe_convert_slice(F, 2); at::attn_unit<2, 96>(F, PA, b, h, q1, false);
        at::attn_unit<2, 96>(F, PA, b, h, q2, false); moe_convert_slice(F, 3); at::attn_unit<2, 96>(F, PA, b, h, q3, false); }
}

namespace ix {
constexpr int HP = 1028;
constexpr int L_HIST = 0, L_ROW = 32 * HP * 4;
constexpr int MP = 129;
constexpr int L_GE = 0, L_EQ = 32 * MP * 4;
static_assert(L_ROW + 3 * 32 * 4 <= LDSCTL_OFF && L_EQ + 32 * MP * 4 <= L_ROW, "index LDS map");

__device__ __forceinline__ float irelu(float x) { const int i = __float_as_int(x); return __int_as_float(i > 0 ? i : 0); }
__device__ __forceinline__ float mul_s(float a, float b) { float d; asm("v_mul_f32_e32 %0, %1, %2" : "=v"(d) : "v"(a), "v"(b)); return d; }
__device__ __forceinline__ float fma_s(float a, float b, float c) { float d; asm("v_fma_f32 %0, %1, %2, %3" : "=v"(d) : "v"(a), "v"(b), "v"(c)); return d; }
__device__ __forceinline__ void hadd0(unsigned base, unsigned u, unsigned k65535) { unsigned a, v;
    asm volatile("v_lshrrev_b32_e32 %0, 22, %2\n\tv_bfe_u32 %1, %2, 21, 1\n\tv_lshl_add_u32 %0, %0, 2, %3\n\tv_mad_u32_u24 %1, %1, %4, 1\n\tds_add_u32 %0, %1"
                 : "=&v"(a), "=&v"(v) : "v"(u), "v"(base), "s"(k65535) : "memory"); }
__device__ __forceinline__ void hadd1(unsigned base, unsigned u, unsigned pre, unsigned k65535, unsigned k1024) { unsigned a, v, t;
    asm volatile("v_lshrrev_b32_e32 %2, 21, %3\n\tv_bfe_u32 %0, %3, 11, 10\n\tv_cmp_eq_u32_e32 vcc, %2, %5\n\tv_bfe_u32 %1, %3, 10, 1\n\tv_mad_u32_u24 %1, %1, %6, 1\n\tv_cndmask_b32_e32 %0, %7, %0, vcc\n\tv_lshl_add_u32 %0, %0, 2, %4\n\tds_add_u32 %0, %1"
                 : "=&v"(a), "=&v"(v), "=&v"(t) : "v"(u), "v"(base), "v"(pre), "s"(k65535), "v"(k1024) : "memory", "vcc"); }
__device__ __forceinline__ void push2(unsigned& ge, unsigned& gt, unsigned xa, unsigned xb, unsigned cge, unsigned cgt) { unsigned long long s0, s1, s2;
    asm("v_cmp_ge_u32_e64 %2, %5, %7\n\tv_cmp_ge_u32_e64 %3, %5, %8\n\tv_cmp_ge_u32_e64 %4, %6, %7\n\tv_cmp_ge_u32_e32 vcc, %6, %8\n\t"
        "v_addc_co_u32_e64 %0, %2, %0, %0, %2\n\tv_addc_co_u32_e64 %1, %3, %1, %1, %3\n\tv_addc_co_u32_e64 %0, %4, %0, %0, %4\n\tv_addc_co_u32_e32 %1, vcc, %1, %1, vcc"
        : "+v"(ge), "+v"(gt), "=&s"(s0), "=&s"(s1), "=&s"(s2) : "v"(xa), "v"(xb), "v"(cge), "v"(cgt) : "vcc"); }

template <int PASS, int VAR>
__device__ __forceinline__ void tile(bf16x8 (&kf)[4], const bf16* knext, const bf16x8 (&qf)[4][4], const f32x2_t (&w2)[4], bool diag, int kt, int r32, int hi, LAS unsigned* hist, unsigned hbase, unsigned mypre, unsigned Fx, unsigned Cge, unsigned Cgt) {
    const f32x16 zero16 = {0.f, 0.f, 0.f, 0.f, 0.f, 0.f, 0.f, 0.f, 0.f, 0.f, 0.f, 0.f, 0.f, 0.f, 0.f, 0.f};
    unsigned u[16];
    if (VAR & 2) {
#pragma unroll
        for (int r = 0; r < 16; ++r) u[r] = __builtin_bit_cast(v4u, kf[r & 3])[r >> 2];
    } else {
        float sc[16];
        { f32x16 a0, a1;
          a0 = __builtin_amdgcn_mfma_f32_32x32x16_bf16(kf[0], qf[0][0], zero16, 0, 0, 0); a1 = __builtin_amdgcn_mfma_f32_32x32x16_bf16(kf[0], qf[1][0], zero16, 0, 0, 0);
#pragma unroll
          for (int d0 = 1; d0 < 4; ++d0) { a0 = __builtin_amdgcn_mfma_f32_32x32x16_bf16(kf[d0], qf[0][d0], a0, 0, 0, 0); a1 = __builtin_amdgcn_mfma_f32_32x32x16_bf16(kf[d0], qf[1][d0], a1, 0, 0, 0); }
#pragma unroll
          for (int r = 0; r < 16; ++r) sc[r] = fma_s(irelu(a1[r]), w2[1].x, mul_s(irelu(a0[r]), w2[0].x)); }
        { f32x16 a2, a3;
          a2 = __builtin_amdgcn_mfma_f32_32x32x16_bf16(kf[0], qf[2][0], zero16, 0, 0, 0); a3 = __builtin_amdgcn_mfma_f32_32x32x16_bf16(kf[0], qf[3][0], zero16, 0, 0, 0);
#pragma unroll
          for (int d0 = 1; d0 < 4; ++d0) { a2 = __builtin_amdgcn_mfma_f32_32x32x16_bf16(kf[d0], qf[2][d0], a2, 0, 0, 0); a3 = __builtin_amdgcn_mfma_f32_32x32x16_bf16(kf[d0], qf[3][d0], a3, 0, 0, 0); }
#pragma unroll
          for (int d0 = 0; d0 < 4; ++d0) { if (!(VAR & 8)) kf[d0] = *(const bf16x8*)(knext + d0 * 512); }
#pragma unroll
          for (int r = 0; r < 16; ++r) sc[r] = fma_s(irelu(a3[r]), w2[3].x, fma_s(irelu(a2[r]), w2[2].x, sc[r])); }
#pragma unroll
        for (int r = 0; r < 16; ++r) u[r] = __float_as_uint(sc[r]);
    }
    if (diag) {
#pragma unroll
        for (int r = 0; r < 16; ++r) { const int c = (r & 3) + 8 * (r >> 2) + 4 * hi; u[r] = (c <= r32) ? u[r] : 0xffffffffu; } }
    if (PASS == 0) {
#pragma unroll
        for (int r = 0; r < 16; ++r) { if (VAR & 1) asm volatile("" :: "v"(u[r])); else hadd0(hbase, u[r], 65535u); }
    } else if (PASS == 1) {
#pragma unroll
        for (int r = 0; r < 16; ++r) { if (VAR & 1) asm volatile("" :: "v"(u[r])); else hadd1(hbase, u[r], mypre, 65535u, 1024u); }
    } else {
        unsigned ge = 0u, gt = 0u;
#pragma unroll
        for (int r = 15; r >= 1; r -= 2) { push2(ge, gt, u[r] ^ Fx, u[r - 1] ^ Fx, Cge, Cgt); if ((r & 3) == 1 && r > 1) { ge <<= 4; gt <<= 4; } }
        ge <<= 4 * hi; gt <<= 4 * hi; const unsigned eq = ge & ~gt;
        if (ge) atomicOr((unsigned*)(hist + r32 * MP + kt), ge);
        if (eq) atomicOr((unsigned*)(hist + 32 * MP + r32 * MP + kt), eq);
    }
}
__device__ __forceinline__ void idx_tile_load(bf16x8 (&k)[4], const bf16* kbase, int KT, int t) {
    const bf16* kr = kbase + (size_t)(t < KT ? t : 0) * 2048;
#pragma unroll
    for (int d0 = 0; d0 < 4; ++d0) k[d0] = *(const bf16x8*)(kr + d0 * 512);
}
template <int PASS, int VAR>
__device__ __forceinline__ void pass_loop(const bf16x8 (&qf)[4][4], const f32x2_t (&w2)[4], const bf16* kbase, int KT, int wid, int r32, int hi, LAS unsigned* hist, unsigned mypre, bf16x8 (&ka)[4]) {
    const unsigned hbase = (unsigned)(size_t)(hist + r32 * HP);
    unsigned Fx = 0u, Cge = 0u, Cgt = 0u;
    if (PASS == 2) { const unsigned Tlo = mypre << 10; const bool neg = (mypre >> 21) & 1u;
        Fx = neg ? 0xffffffffu : 0x80000000u; Cge = neg ? ~(Tlo | 1023u) : (Tlo ^ 0x80000000u); Cgt = neg ? (~Tlo + 1u) : ((Tlo + 1024u) ^ 0x80000000u); }
    bf16x8 kb[4]; idx_tile_load(kb, kbase, KT, wid + NWAVES);
    int kt = wid;
#pragma unroll 1
    for (; kt + NWAVES < KT; kt += 2 * NWAVES) {
        tile<PASS, VAR>(ka, kbase + (size_t)(kt + 2 * NWAVES < KT ? kt + 2 * NWAVES : kt) * 2048, qf, w2, false, kt, r32, hi, hist, hbase, mypre, Fx, Cge, Cgt);
        tile<PASS, VAR>(kb, kbase + (size_t)(kt + 3 * NWAVES < KT ? kt + 3 * NWAVES : kt) * 2048, qf, w2, kt + NWAVES == KT - 1, kt + NWAVES, r32, hi, hist, hbase, mypre, Fx, Cge, Cgt);
    }
    if (kt < KT) tile<PASS, VAR>(ka, kbase + (size_t)kt * 2048, qf, w2, kt == KT - 1, kt, r32, hi, hist, hbase, mypre, Fx, Cge, Cgt);
    if (PASS < 2) idx_tile_load(ka, kbase, KT, wid);
    asm volatile("s_waitcnt lgkmcnt(0)" ::: "memory");
}

template <int VAR>
__device__ __forceinline__ void dsa_index_unit(Frame& F, int b, int qt) {
    const int tid = F.tid, lane = F.lane, r32 = lane & 31, hi = lane >> 5, wid = F.wave;
    const int q0 = qt * 32, q = q0 + r32, KT = qt + 1;
    const bf16* QKV = F.w<bf16>(WS_QKV0); unsigned long long* maskt = F.w<unsigned long long>(VAR ? WS_H : WS_MASKT);
    LAS unsigned* hist = (LAS unsigned*)(F.lds + ix::L_HIST); LAS unsigned* rowi = (LAS unsigned*)(F.lds + ix::L_ROW);
    LAS unsigned* pre = rowi; LAS unsigned* krem = rowi + 32; LAS unsigned* cnteq = rowi + 64;
    const bf16* qrow = QKV + (size_t)(b * SEQ + q) * QKV_LD;
    const bf16* kbase = F.w<bf16>(WS_IKT) + (size_t)(b * 128) * 2048 + hi * 256 + r32 * 8;
    bf16x8 ka[4]; ix::idx_tile_load(ka, kbase, KT, wid);
    bf16x8 qf[4][4];
#pragma unroll
    for (int h = 0; h < 4; ++h)
#pragma unroll
        for (int d0 = 0; d0 < 4; ++d0) qf[h][d0] = *(const bf16x8*)(qrow + C_IQ + h * 64 + d0 * 16 + hi * 8);
    f32x2_t w2[4];
    { const v2u wr = *(const v2u*)(qrow + C_IW); const float w0 = __uint_as_float(wr.x << 16), w1 = __uint_as_float(wr.x & 0xffff0000u), w2f = __uint_as_float(wr.y << 16), w3 = __uint_as_float(wr.y & 0xffff0000u);
      w2[0] = (f32x2_t){w0, w0}; w2[1] = (f32x2_t){w1, w1}; w2[2] = (f32x2_t){w2f, w2f}; w2[3] = (f32x2_t){w3, w3}; }
    for (int i = tid; i < 32 * ix::HP; i += NTHR) hist[i] = 0u;
    if (tid < 32) { pre[tid] = 0u; const int n = q0 + tid + 1; krem[tid] = (unsigned)(n < 256 ? n : 256); cnteq[tid] = 0u; }
    __syncthreads();
#pragma unroll 1
    for (int pass = 0; pass < 3; ++pass) {
        const unsigned mypre = pre[r32];
        if (pass == 2) { __syncthreads(); for (int i = tid; i < 2 * 32 * ix::MP; i += NTHR) hist[i] = 0u; __syncthreads(); }
        if (pass == 0) pass_loop<0, VAR>(qf, w2, kbase, KT, wid, r32, hi, hist, mypre, ka);
        else if (pass == 1) pass_loop<1, VAR>(qf, w2, kbase, KT, wid, r32, hi, hist, mypre, ka);
        else pass_loop<2, VAR>(qf, w2, kbase, KT, wid, r32, hi, hist, mypre, ka);
        __syncthreads();
        if (pass < 2) {
#pragma unroll 1
            for (int rr = 0; rr < 4; ++rr) { const int row = wid * 4 + rr; const unsigned rowpre = pre[row];
                const bool neg = (pass == 0) ? (lane < 32) : (rowpre >= 1024u); const int rl = (pass == 0) ? (neg ? 63 - lane : lane - 32) : (neg ? 63 - lane : lane);
                const LAS unsigned* hr = hist + row * ix::HP + rl * 16;
                unsigned wr[16], wv[16]; unsigned total = 0u;
#pragma unroll
                for (int i = 0; i < 16; ++i) wr[i] = hr[i];
#pragma unroll
                for (int i = 0; i < 16; ++i) { wv[i] = neg ? __builtin_amdgcn_alignbit(wr[15 - i], wr[15 - i], 16) : wr[i]; total += (wv[i] & 0xffffu) + (wv[i] >> 16); }
                unsigned S = total;
                S += (unsigned)__builtin_amdgcn_update_dpp(0, (int)S, 0x101, 0xF, 0xF, false); S += (unsigned)__builtin_amdgcn_update_dpp(0, (int)S, 0x102, 0xF, 0xF, false);
                S += (unsigned)__builtin_amdgcn_update_dpp(0, (int)S, 0x104, 0xF, 0xF, false); S += (unsigned)__builtin_amdgcn_update_dpp(0, (int)S, 0x108, 0xF, 0xF, false);
                { const unsigned t1 = (unsigned)__builtin_amdgcn_readlane((int)S, 16), t2 = (unsigned)__builtin_amdgcn_readlane((int)S, 32), t3 = (unsigned)__builtin_amdgcn_readlane((int)S, 48);
                  const int rw = lane >> 4; S += (rw == 0) ? t1 + t2 + t3 : (rw == 1) ? t2 + t3 : (rw == 2) ? t3 : 0u; }
                const unsigned k = krem[row], above = S - total;
                if (S >= k && above < k) { unsigned run = above, bstar = 0u, newk = 0u, cnt = 0u; bool done = false;
#pragma unroll
                    for (int i = 15; i >= 0; --i) { const unsigned ch = wv[i] >> 16, cl = wv[i] & 0xffffu;
                        if (!done) { if (run + ch >= k) { bstar = 32u * lane + 2u * i + 1u; newk = k - run; cnt = ch; done = true; } else run += ch; }
                        if (!done) { if (run + cl >= k) { bstar = 32u * lane + 2u * i; newk = k - run; cnt = cl; done = true; } else run += cl; } }
                    const unsigned braw = (pass == 0) ? (bstar >= 1024u ? bstar - 1024u : 2047u - bstar) : (neg ? 2047u - bstar : bstar);
                    pre[row] = (rowpre << 11) | braw; krem[row] = newk; cnteq[row] = cnt; } }
            __syncthreads();
            if (pass < 1) { for (int i = tid; i < 32 * ix::HP; i += NTHR) hist[i] = 0u; __syncthreads(); }
        }
    }
#pragma unroll 1
    for (int rr = 0; rr < 4; ++rr) { const int row = wid * 4 + rr; const unsigned need = krem[row], ce = cnteq[row];
        if (need < ce) { LAS unsigned* g = hist + row * ix::MP; LAS unsigned* e = hist + 32 * ix::MP + row * ix::MP;
            const unsigned e0 = e[2 * lane], e1 = e[2 * lane + 1]; const int c0 = __popc(e0), c1 = __popc(e1), c = c0 + c1; int incl = c;
#pragma unroll
            for (int off = 1; off < 64; off <<= 1) { const int v = __shfl_up(incl, off); if (lane >= off) incl += v; }
            int rem = (int)need - (incl - c); rem = rem < 0 ? 0 : (rem > c ? c : rem);
            const int k0 = rem < c0 ? rem : c0, k1 = rem - k0;
            unsigned y0 = e0; for (int i = 0; i < k0; ++i) y0 &= y0 - 1u;
            unsigned y1 = e1; for (int i = 0; i < k1; ++i) y1 &= y1 - 1u;
            g[2 * lane] &= ~y0; g[2 * lane + 1] &= ~y1; } }
    __syncthreads();
    for (int idx = tid; idx < 32 * 64; idx += NTHR) { const int qq = idx & 31, t = idx >> 5;
        const unsigned lo = hist[qq * ix::MP + 2 * t], hh = hist[qq * ix::MP + 2 * t + 1];
        maskt[((size_t)(b * 64 + t) * SEQ) + q0 + qq] = (unsigned long long)lo | ((unsigned long long)hh << 32); }
    __syncthreads();
}
}
template <int VAR>
__device__ __forceinline__ void ph_dsa_index(Frame& F) {
    for (int v = F.bid; v < 256; v += F.G) { const int b = v >> 6, i = v & 63; ix::dsa_index_unit<VAR>(F, b, 127 - i); ix::dsa_index_unit<VAR>(F, b, i); }
}

#define XB_TMO      128
#define XB_XCNT(j)  (256  + 64 * (j))
#define XB_XSUB(j)  (1280 + 64 * (j))
#define XB_XGEN(j)  (2304 + 64 * (j))
#define XB_TOP      3328
#define XB_TOPGEN   3392
#define XCD_BAR_WORDS 3456
#define XB_SPIN_CAP (1u << 18)

__device__ __forceinline__ unsigned xb_ld(unsigned* p)              { return __hip_atomic_load(p, __ATOMIC_RELAXED, __HIP_MEMORY_SCOPE_AGENT); }
__device__ __forceinline__ unsigned xb_add(unsigned* p, unsigned v) { return __hip_atomic_fetch_add(p, v, __ATOMIC_RELAXED, __HIP_MEMORY_SCOPE_AGENT); }
__device__ __forceinline__ unsigned xb_xcc_id() { return (unsigned)__builtin_amdgcn_s_getreg((3 << 11) | 20) & 0xFu; }
#define XB_SPIN(cond, bar) do { unsigned _sp = 0; while (cond) { __builtin_amdgcn_s_sleep(1); \
    if ((++_sp & 255u) == 0u) { if (xb_ld(&(bar)[XB_TMO])) break; if (_sp > XB_SPIN_CAP) { atomicAdd(&(bar)[XB_TMO], 1u); break; } } } } while (0)

struct XcdBarrier {
    unsigned* bar; unsigned x;
    volatile LAS unsigned* st;
};

__device__ __forceinline__ XcdBarrier xcd_barrier_post(unsigned* bar, volatile LAS unsigned* st) {
    XcdBarrier b; b.bar = bar; b.x = xb_xcc_id(); b.st = st;
    if (threadIdx.x == 0) (void)xb_add(&bar[XB_XCNT(b.x)], 1u);
    return b;
}
__device__ __forceinline__ void xcd_barrier_complete(unsigned* bar, unsigned x, unsigned& nloc, unsigned& nx) {
    const unsigned G = gridDim.x * gridDim.y * gridDim.z;
    unsigned sum, cnt, mine, sp = 0u;
    for (;;) {
        sum = 0u; cnt = 0u; mine = 0u;
#pragma unroll
        for (unsigned j = 0; j < 16; ++j) { const unsigned c = xb_ld(&bar[XB_XCNT(j)]); sum += c; cnt += (c > 0u) ? 1u : 0u; mine = (j == x) ? c : mine; }
        if (sum == G) break;
        __builtin_amdgcn_s_sleep(1);
        if ((++sp & 255u) == 0u) { if (xb_ld(&bar[XB_TMO])) break; if (sp > XB_SPIN_CAP) { atomicAdd(&bar[XB_TMO], 1u); break; } }
    }
    nloc = mine > 0u ? mine : 1u; nx = cnt > 0u ? cnt : 1u;
}

__device__ __forceinline__ void xcd_barrier(const XcdBarrier& b) {
    asm volatile("s_waitcnt vmcnt(0)" ::: "memory");
    __syncthreads();
    if (threadIdx.x == 0) {
        unsigned* bar = b.bar;
        __builtin_amdgcn_s_waitcnt(0);
        unsigned nloc = b.st[0], nx = b.st[1];
        if (nloc == 0u) { xcd_barrier_complete(bar, b.x, nloc, nx); b.st[0] = nloc; b.st[1] = nx; }
        const unsigned old = xb_add(&bar[XB_XSUB(b.x)], 1u);
        const unsigned gen = old / nloc;
        if (old + 1u == (gen + 1u) * nloc) {
            __builtin_amdgcn_fence(__ATOMIC_RELEASE, "agent");
            asm volatile("s_waitcnt vmcnt(0)" ::: "memory");
            const unsigned og = xb_add(&bar[XB_TOP], 1u);
            const unsigned tg = og / nx;
            if (og + 1u == (tg + 1u) * nx) xb_add(&bar[XB_TOPGEN], 1u);
            else XB_SPIN(xb_ld(&bar[XB_TOPGEN]) == tg, bar);
            __builtin_amdgcn_fence(__ATOMIC_ACQUIRE, "agent");
            xb_add(&bar[XB_XGEN(b.x)], 1u);
            asm volatile("s_waitcnt vmcnt(0)" ::: "memory");
        } else {
            XB_SPIN(xb_ld(&bar[XB_XGEN(b.x)]) == gen, bar);
            __builtin_amdgcn_fence(__ATOMIC_ACQUIRE, "agent");
            asm volatile("s_waitcnt vmcnt(0)" ::: "memory");
        }
    }
    __syncthreads();
}

constexpr int NPHASE = 20;
constexpr int CW_BAR = 4096;
#ifndef HAVE_ATTN
#define HAVE_ATTN 0
#endif
#ifndef HAVE_INDEX
#define HAVE_INDEX 0
#endif

__global__ void __launch_bounds__(NTHR, 2) mega(Args args) {
    extern __shared__ __attribute__((aligned(16))) unsigned char lds_raw[];
    Frame F; F.lds = (LAS unsigned char*)lds_raw; F.tid = threadIdx.x; F.lane = F.tid & 63; F.wave = __builtin_amdgcn_readfirstlane(F.tid >> 6);
    F.G = gridDim.x; F.bid = blockIdx.x; F.in = args.in; F.out = args.out; F.ws = args.ws;
    volatile LAS unsigned* MISC = (volatile LAS unsigned*)(F.lds + LDSCTL_OFF);
    for (int u = F.tid; u < 256; u += NTHR) MISC[u] = 0u;
    __syncthreads();
    const int lo = args.ph_lo, hi = args.ph_hi;
    XcdBarrier bar; bar.bar = (unsigned*)(args.ws + WS_CTL) + CW_BAR; bar.x = 0; bar.st = nullptr;
    if (hi - lo > 1) bar = xcd_barrier_post((unsigned*)(args.ws + WS_CTL) + CW_BAR, MISC + 8);
#define IN(k) (lo <= (k) && (k) < hi)
#define SEAM(k) do { if (IN(k) && IN((k) + 1)) xcd_barrier(bar); } while (0)
    PG8_LAS unsigned char* glds = (PG8_LAS unsigned char*)lds_raw;
    const pg8::bf16_t* H = F.w<pg8::bf16_t>(WS_H);

    if (IN(0)) { ph_prologue(F); } SEAM(0);
    if (IN(1)) { pg8::Gemm g{H, F.w<pg8::bf16_t>(WS_W_IN_E), 1024, 1024, 1024}; pg8::StaticOrder S{M_TOK / 256, QKV_LD / 256, F.G, F.bid}; pg8::EpiBf16 E{F.w<pg8::bf16_t>(WS_QKV0), QKV_LD, F.w<pg8::bf16_t>(WS_IKT), C_IK / 256};
        pg8::gemm_phase<pg8::EpiBf16, pg8::StaticOrder, true, false>(glds, g, S, E, nullptr);
        moe_convert_tail(F, 0, MOE_TAIL_A, (M_TOK / 256) * (QKV_LD / 256) % 256); } SEAM(1);
    if (IN(2)) { if (args.sub & 1) ph_qknorm<0>(F);
#ifdef QKN_PROBE
        if (args.sub & 8) ph_qknorm<1>(F);
#endif
#if HAVE_INDEX
        if (args.sub & 2) ph_dsa_index<0>(F);
#ifdef IDX_VAR
        if (args.sub & 4) ph_dsa_index<IDX_VAR>(F);
#endif
#endif
    } SEAM(2);
    if (IN(3)) {
#if HAVE_ATTN
        ph_attn_l0(F);
#endif
    } SEAM(3);
    if (IN(4)) { pg8::Gemm g{F.w<pg8::bf16_t>(WS_O), F.w<pg8::bf16_t>(WS_W_OUT_E), 1024, 1024, 1024}; pg8::StaticOrder S{M_TOK / 256, 4, F.G, F.bid}; pg8::EpiResN<false> E{F.in[I_X], F.w<pg8::bf16_t>(WS_H), F.w<float>(WS_SSP), 1024};
        pg8::gemm_phase<pg8::EpiResN<false>, pg8::StaticOrder, false, false>(glds, g, S, E, nullptr); } SEAM(4);
    if (IN(6)) { pg8::Gemm g{H, F.w<pg8::bf16_t>(WS_W_GU_E), 1024, 1024, 1024}; pg8::StaticOrder S{M_TOK / 256, 2 * FF_E / 256, F.G, F.bid}; pg8::EpiSwiGLUS<pg8::ScaleSSP> E{F.w<pg8::bf16_t>(WS_ACT0), FF_E, 1 << 20, {F.w<float>(WS_SSP), EPS}};
        pg8::gemm_phase<pg8::EpiSwiGLUS<pg8::ScaleSSP>, pg8::StaticOrder, true, false>(glds, g, S, E, nullptr);
        moe_convert_tail(F, MOE_TAIL_A, MOE_TAIL_B, (M_TOK / 256) * (2 * FF_E / 256) % 256); } SEAM(6);
    if (IN(7)) { pg8::Gemm g{F.w<pg8::bf16_t>(WS_ACT0), F.w<pg8::bf16_t>(WS_W_DN_E), FF_E, FF_E, FF_E}; pg8::StaticOrder S{M_TOK / 256, 4, F.G, F.bid}; pg8::EpiResN<true> E{nullptr, F.w<pg8::bf16_t>(WS_H), F.w<float>(WS_SSP), 1024};
        pg8::gemm_phase<pg8::EpiResN<true>, pg8::StaticOrder, false, false>(glds, g, S, E, nullptr); } SEAM(7);
    if (IN(9)) { pg8::Gemm g{H, F.w<pg8::bf16_t>(WS_W_IN_O), 1024, 1024, 1024}; pg8::StaticOrder S{M_TOK / 256, C1_LD / 256, F.G, F.bid}; pg8::EpiBf16SL<pg8::ScaleSSP> E{F.w<pg8::bf16_t>(WS_C1), C1_LD, F.w<float>(WS_LSP), {F.w<float>(WS_SSP), EPS}};
        pg8::gemm_phase<pg8::EpiBf16SL<pg8::ScaleSSP>, pg8::StaticOrder, true, false>(glds, g, S, E, nullptr);
        moe_convert_tail(F, MOE_TAIL_A + MOE_TAIL_B, MOE_TAIL_C, (M_TOK / 256) * (C1_LD / 256)); } SEAM(9);
    if (IN(11)) { pg8::Gemm g{F.w<pg8::bf16_t>(WS_C1), F.w<pg8::bf16_t>(WS_W_LAT), C1_LD, W_LAT_LD, 384}; pg8::LatJointOrder S{F.G, F.bid};
        pg8::EpiLatJoint E{F.w<pg8::bf16_t>(WS_QR), F.w<pg8::bf16_t>(WS_KVR), F.w<pg8::bf16_t>(WS_KM), F.w<float>(WS_KSS), F.in[I_MLAKN], {F.w<float>(WS_LSP), EPS}};
        pg8::gemm_phase<pg8::EpiLatJoint, pg8::LatJointOrder, true, false>(glds, g, S, E, nullptr); } SEAM(11);
    if (IN(12)) { ph_mla_prep(F, F.w<float2>(WS_ROPE)); } SEAM(12);
    if (IN(13)) {
#if HAVE_ATTN
        ph_attn_mla(F);
#endif
    } SEAM(13);
    if (IN(14)) { pg8::Gemm g{F.w<pg8::bf16_t>(WS_O1), F.w<pg8::bf16_t>(WS_W_OUT_O), 1024, 1024, 1024}; pg8::StaticOrder S{M_TOK / 256, 4, F.G, F.bid}; pg8::EpiResN<true> E{nullptr, F.w<pg8::bf16_t>(WS_H), F.w<float>(WS_SSP), 1024};
        pg8::gemm_phase<pg8::EpiResN<true>, pg8::StaticOrder, false, false>(glds, g, S, E, nullptr); } SEAM(14);
    if (IN(15)) { ph_rmsnorm_route(F, F.w<bf16>(WS_H), F.in[I_FFNN_O], F.w<float>(WS_RSTD)); } SEAM(15);
#define MOE_LOCAL(S_) do { if (have_sg) { (S_).local = true; _Pragma("unroll") for (int e_ = 0; e_ < 8; ++e_) (S_).seg[e_] = sg.base[e_]; } } while (0)
    MoeSeg sg; bool have_sg = false;
#pragma unroll
    for (int e = 0; e < 9; ++e) sg.base[e] = 0;
    if (IN(16)) { sg = ph_slots(F); have_sg = true; } SEAM(16);
    if (IN(17)) { const int* tile_e = F.w<int>(WS_TILE_E); const int ntile = have_sg ? sg.base[8] / 256 : tile_e[TILE_CAP];
        pg8::Gemm g{H, F.w<pg8::bf16_t>(WS_WGU_O), 1024, 1024, 1024}; pg8::MoeOrder S{tile_e, ntile, 2 * FF_O / 256, F.G, F.bid, 1, 1024, 0}; MOE_LOCAL(S); pg8::EpiSwiGLUS<pg8::ScaleSlot> E{F.w<pg8::bf16_t>(WS_ACT1), FF_O, 2 * FF_O / 256, {F.w<float>(WS_SLOT_RSTD)}};
        pg8::gemm_phase<pg8::EpiSwiGLUS<pg8::ScaleSlot>, pg8::MoeOrder, true, true>(glds, g, S, E, F.w<int>(WS_SLOT_TOK)); } SEAM(17);
    if (IN(18)) { const int* tile_e = F.w<int>(WS_TILE_E); const int ntile = have_sg ? sg.base[8] / 256 : tile_e[TILE_CAP];
        { pg8::Gemm g{F.w<pg8::bf16_t>(WS_ACT1), F.w<pg8::bf16_t>(WS_WDN_O), FF_O, FF_O, FF_O}; pg8::MoeOrder S{tile_e, ntile < MOE_FULL_TILES ? ntile : MOE_FULL_TILES, 4, F.G, F.bid, 1, FF_O, 0}; MOE_LOCAL(S);
          pg8::EpiMoeY E{F.w<pg8::bf16_t>(WS_Y), 0, 4, FF_O, 0};
          pg8::gemm_phase<pg8::EpiMoeY, pg8::MoeOrder, true, false>(glds, g, S, E, nullptr); }
        if (ntile > MOE_FULL_TILES) { pg8::Gemm g{F.w<pg8::bf16_t>(WS_ACT1), F.w<pg8::bf16_t>(WS_WDN_O), FF_O, FF_O, FF_O / MOE_TAIL_SPLIT}; pg8::MoeOrder S{tile_e, ntile - MOE_FULL_TILES, 4, F.G, F.bid, MOE_TAIL_SPLIT, FF_O / MOE_TAIL_SPLIT, MOE_FULL_TILES}; MOE_LOCAL(S);
          pg8::EpiMoeY E{F.w<pg8::bf16_t>(WS_YP), (size_t)MOE_TAIL_ROWS * 1024, 4, FF_O / MOE_TAIL_SPLIT, MOE_FULL_TILES * 256};
          pg8::gemm_phase<pg8::EpiMoeY, pg8::MoeOrder, true, false>(glds, g, S, E, nullptr); } } SEAM(18);
    if (IN(19)) { ph_moe_combine(F); }
#undef IN
#undef MOE_LOCAL
#undef SEAM
}

#ifndef FAST_MASK
#define FAST_MASK 0xFFFFFu
#endif
#ifndef DUP_SUB
#define DUP_SUB 2
#endif
#ifndef ONE_LAUNCH
#define ONE_LAUNCH 0
#endif
struct Ptrs {
    const float* in[N_INPUTS]; float* out; unsigned char* ws;
    template <class T> T* w(size_t off) const { return (T*)(ws + off); }
};
static int g_grid = 0;
static void launch_mega(const Ptrs& P, int lo, int hi, hipStream_t st, int sub = 3) {
    Args a{}; a.sub = sub; for (int i = 0; i < N_INPUTS; ++i) a.in[i] = P.in[i]; a.out = P.out; a.ws = P.ws; a.ph_lo = lo; a.ph_hi = hi;
    hipLaunchKernelGGL(mega, dim3(g_grid), dim3(NTHR), LDS_BYTES, st, a);
    const hipError_t le = hipPeekAtLastError();
    if (le != hipSuccess) fprintf(stderr, "kernel_launch: mega[%d,%d) failed: %s\n", lo, hi, hipGetErrorName(le));
}
#if !ONE_LAUNCH
static void naive_weights(const Ptrs& P, hipStream_t st) {
    auto wt = [&](int idx, int K, int N, int Npad, size_t off, int mode, int nexp, size_t wes, size_t wtes) {
        nv::k_wt<<<dim3((Npad + 31) / 32, K / 32, nexp), 256, 0, st>>>(P.in[idx], K, N, Npad, P.w<bf16>(off), mode, wes, wtes); };
    wt(I_W_IN_E, 1024, N_IN_E, QKV_LD, WS_W_IN_E, 0, 1, 0, 0);
    wt(I_W_OUT_E, 1024, 1024, 1024, WS_W_OUT_E, 0, 1, 0, 0);
    wt(I_W_GATE_E, 1024, FF_E, FF_E, WS_W_GU_E, 1, 1, 0, 0);
    wt(I_W_UP_E, 1024, FF_E, FF_E, WS_W_GU_E, 2, 1, 0, 0);
    wt(I_W_DOWN_E, FF_E, 1024, 1024, WS_W_DN_E, 0, 1, 0, 0);
    wt(I_W_IN_O, 1024, N_IN_O, C1_LD, WS_W_IN_O, 0, 1, 0, 0);
    wt(I_W_UQ, 384, 1536, 1536, WS_W_UQ, 0, 1, 0, 0);
    wt(I_W_UKV, 256, 2048, 2048, WS_W_UKV, 0, 1, 0, 0);
    wt(I_W_OUT_O, 1024, 1024, 1024, WS_W_OUT_O, 0, 1, 0, 0);
    wt(I_W_GATE_O, 1024, FF_O, FF_O, WS_WGU_O, 1, NEXP, (size_t)1024 * FF_O, (size_t)2 * FF_O * 1024);
    wt(I_W_UP_O, 1024, FF_O, FF_O, WS_WGU_O, 2, NEXP, (size_t)1024 * FF_O, (size_t)2 * FF_O * 1024);
    wt(I_W_DOWN_O, FF_O, 1024, 1024, WS_WDN_O, 0, NEXP, (size_t)1024 * FF_O, (size_t)1024 * FF_O);
}
template <int EPI> static void naive_gemm(nv::GemmArgs a, hipStream_t st) { nv::k_gemm<EPI><<<dim3(a.N / 64, a.M / 64), 256, 0, st>>>(a); }
__global__ void k_rope_tab(float2* tab) { const int idx = blockIdx.x * 256 + threadIdx.x; const int pos = idx >> 4, i = idx & 15; const float fr = powf(10000.f, -(float)i / 16.f), ang = (float)pos * fr; tab[idx] = make_float2(cosf(ang), sinf(ang)); }

static void naive_phase(const Ptrs& P, int k, hipStream_t st) {
    bf16* H = P.w<bf16>(WS_H); bf16* QKV = P.w<bf16>(WS_QKV0); bf16* O = P.w<bf16>(WS_O); float* X = P.out;
    bf16* C1 = P.w<bf16>(WS_C1); bf16* QR = P.w<bf16>(WS_QR); bf16* KVR = P.w<bf16>(WS_KVR); bf16* KM = P.w<bf16>(WS_KM); bf16* O1 = P.w<bf16>(WS_O1);
    switch (k) {
    case 0: naive_weights(P, st); k_rope_tab<<<SEQ * 16 / 256, 256, 0, st>>>(P.w<float2>(WS_ROPE)); nv::k_rmsnorm<<<M_TOK / 4, 256, 0, st>>>(P.in[I_X], P.in[I_MIXN_E], H); break;
    case 1: { nv::GemmArgs a{}; a.A = H; a.lda = 1024; a.Bt = P.w<bf16>(WS_W_IN_E); a.K = 1024; a.M = M_TOK; a.N = QKV_LD; a.Cb = QKV; a.ldc = QKV_LD; naive_gemm<0>(a, st); } break;
    case 2: nv::k_kmean<<<NB * 8 * 16, 64, 0, st>>>(QKV, P.in[I_MKN], P.w<float>(WS_KMEAN));
            nv::k_qknorm<<<M_TOK * 32 / 256, 256, 0, st>>>(QKV, P.in[I_MQN], P.in[I_MKN], P.in[I_DQN], P.in[I_DKN]);
            break;
    case 100: nv::k_dsa_index<<<M_TOK, 256, 0, st>>>(QKV, P.w<unsigned long long>(WS_MASKT)); break;
    case 3: { nv::AttnArgs a{}; a.Q = QKV + C_MQ; a.ldq = QKV_LD; a.qhs = 64; a.K = QKV + C_MK; a.ldk = QKV_LD; a.khs = 64; a.V = QKV + C_MV; a.ldv = QKV_LD; a.vhs = 64; a.O = O; a.ocol0 = 0; a.H = 8;
              a.relb = P.in[I_RELB]; a.bcol0 = 0; a.kmean = P.w<float>(WS_KMEAN); a.maskt = nullptr; nv::k_attn<0, 64><<<NB * 8 * SEQ / 4, 256, 0, st>>>(a); }
            { nv::AttnArgs a{}; a.Q = QKV + C_DQ; a.ldq = QKV_LD; a.qhs = 64; a.K = QKV + C_DK; a.ldk = QKV_LD; a.khs = 64; a.V = QKV + C_DV; a.ldv = QKV_LD; a.vhs = 64; a.O = O; a.ocol0 = 512; a.H = 8;
              a.relb = P.in[I_RELB]; a.bcol0 = 8; a.kmean = nullptr; a.maskt = P.w<unsigned long long>(WS_MASKT); nv::k_attn<1, 64><<<NB * 8 * SEQ / 4, 256, 0, st>>>(a); } break;
    case 4: { nv::GemmArgs a{}; a.A = O; a.lda = 1024; a.Bt = P.w<bf16>(WS_W_OUT_E); a.K = 1024; a.M = M_TOK; a.N = 1024; a.Cf = X; a.R = P.in[I_X]; a.ldc = 1024; naive_gemm<1>(a, st); } break;
    case 5: nv::k_rmsnorm<<<M_TOK / 4, 256, 0, st>>>(X, P.in[I_FFNN_E], H); break;
    case 6: { nv::GemmArgs a{}; a.A = H; a.lda = 1024; a.Bt = P.w<bf16>(WS_W_GU_E); a.K = 1024; a.M = M_TOK; a.N = FF_E; a.Cb = P.w<bf16>(WS_ACT0); a.ldc = FF_E; naive_gemm<2>(a, st); } break;
    case 7: { nv::GemmArgs a{}; a.A = P.w<bf16>(WS_ACT0); a.lda = FF_E; a.Bt = P.w<bf16>(WS_W_DN_E); a.K = FF_E; a.M = M_TOK; a.N = 1024; a.Cf = X; a.R = X; a.ldc = 1024; naive_gemm<1>(a, st); } break;
    case 8: nv::k_rmsnorm<<<M_TOK / 4, 256, 0, st>>>(X, P.in[I_MIXN_O], H); break;
    case 9: { nv::GemmArgs a{}; a.A = H; a.lda = 1024; a.Bt = P.w<bf16>(WS_W_IN_O); a.K = 1024; a.M = M_TOK; a.N = C1_LD; a.Cb = C1; a.ldc = C1_LD; naive_gemm<0>(a, st); } break;
    case 10: nv::k_rmsnorm_bf<<<M_TOK / 4, 256, 0, st>>>(C1, C1_LD, C1_CQ, 384, P.in[I_QAN], P.w<bf16>(WS_CQN), 384);
             nv::k_rmsnorm_bf<<<M_TOK / 4, 256, 0, st>>>(C1, C1_LD, C1_CKV, 256, P.in[I_KVAN], P.w<bf16>(WS_CKVN), 256); break;
    case 11: { nv::GemmArgs a{}; a.A = P.w<bf16>(WS_CQN); a.lda = 384; a.Bt = P.w<bf16>(WS_W_UQ); a.K = 384; a.M = M_TOK; a.N = QR_LD; a.Cb = QR; a.ldc = QR_LD; naive_gemm<0>(a, st); }
             { nv::GemmArgs a{}; a.A = P.w<bf16>(WS_CKVN); a.lda = 256; a.Bt = P.w<bf16>(WS_W_UKV); a.K = 256; a.M = M_TOK; a.N = KVR_LD; a.Cb = KVR; a.ldc = KVR_LD; naive_gemm<0>(a, st); } break;
    case 12: nv::k_mla_prep<<<M_TOK * 16 / 256, 256, 0, st>>>(QR, KVR, C1, KM, P.in[I_MLAQN], P.in[I_MLAKN]); break;
    case 13: { nv::AttnArgs a{}; a.Q = QR; a.ldq = QR_LD; a.qhs = 96; a.K = KM; a.ldk = QR_LD; a.khs = 96; a.V = KVR + 64; a.ldv = KVR_LD; a.vhs = 128; a.O = O1; a.ocol0 = 0; a.H = 16;
               nv::k_attn<2, 96><<<NB * 16 * SEQ / 4, 256, 0, st>>>(a); } break;
    case 14: { nv::GemmArgs a{}; a.A = O1; a.lda = 1024; a.Bt = P.w<bf16>(WS_W_OUT_O); a.K = 1024; a.M = M_TOK; a.N = 1024; a.Cf = X; a.R = X; a.ldc = 1024; naive_gemm<1>(a, st); } break;
    case 15: nv::k_rmsnorm_route<<<M_TOK / 4, 256, 0, st>>>(X, P.in[I_FFNN_O], H, P.in[I_W_ROUTER], P.in[I_B_ROUTER], P.w<int2>(WS_ROUTE_E), P.w<float2>(WS_ROUTE_G));
             nv::k_route_count<<<256, 64, 0, st>>>(P.w<int2>(WS_ROUTE_E), P.w<int>(WS_CNT_WG)); break;
    case 16: nv::k_slots<<<256, 64, 0, st>>>(P.w<int2>(WS_ROUTE_E), P.w<float2>(WS_ROUTE_G), P.w<int>(WS_CNT_WG), P.w<int>(WS_SLOT_TOK), P.w<float>(WS_SLOT_GATE), P.w<int>(WS_TILE_E)); break;
    case 17: { nv::GemmArgs a{}; a.A = H; a.lda = 1024; a.Bt = P.w<bf16>(WS_WGU_O); a.K = 1024; a.M = SLOT_CAP; a.N = FF_O; a.Cb = P.w<bf16>(WS_ACT1); a.ldc = FF_O;
               a.tile_e = P.w<int>(WS_TILE_E); a.stok = P.w<int>(WS_SLOT_TOK); a.sgate = P.w<float>(WS_SLOT_GATE); a.b_estride = (size_t)2 * FF_O * 1024; naive_gemm<3>(a, st); } break;
    case 18: { nv::GemmArgs a{}; a.A = P.w<bf16>(WS_ACT1); a.lda = FF_O; a.Bt = P.w<bf16>(WS_WDN_O); a.K = FF_O; a.M = SLOT_CAP; a.N = 1024; a.Cf = X; a.ldc = 1024;
               a.tile_e = P.w<int>(WS_TILE_E); a.stok = P.w<int>(WS_SLOT_TOK); a.sgate = P.w<float>(WS_SLOT_GATE); a.b_estride = (size_t)1024 * FF_O; naive_gemm<4>(a, st); } break;
    }
}
#endif

extern "C" void kernel_launch(void* const* d_in, const int* in_sizes, int n_in, void* d_out, int out_size, void* d_ws, size_t ws_size, hipStream_t stream) {
    if (n_in != N_INPUTS || out_size != M_TOK * DM || ws_size < WS_END) { fprintf(stderr, "kernel_launch: unexpected shapes (n_in %d out %d ws %zu)\n", n_in, out_size, ws_size); return; }
    if (g_grid == 0) {
        int dev = 0, cus = 0, per_cu = 0;
        if (hipGetDevice(&dev) != hipSuccess || hipDeviceGetAttribute(&cus, hipDeviceAttributeMultiprocessorCount, dev) != hipSuccess) { g_grid = -1; return; }
        if (hipFuncSetAttribute((const void*)mega, hipFuncAttributeMaxDynamicSharedMemorySize, LDS_BYTES) != hipSuccess) { fprintf(stderr, "kernel_launch: cannot get %d B of dynamic LDS\n", LDS_BYTES); g_grid = -1; return; }
        if (hipOccupancyMaxActiveBlocksPerMultiprocessor(&per_cu, (const void*)mega, NTHR, LDS_BYTES) != hipSuccess || per_cu < 1) { fprintf(stderr, "kernel_launch: occupancy query says %d\n", per_cu); }
        (void)hipGetLastError();
        g_grid = cus;
    }
    if (g_grid < 0) return;
    Ptrs P{}; for (int i = 0; i < N_INPUTS; ++i) P.in[i] = (const float*)d_in[i]; P.out = (float*)d_out; P.ws = (unsigned char*)d_ws;
    (void)hipMemsetAsync((char*)d_ws + WS_CTL, 0, 65536, stream);
#if ONE_LAUNCH
    launch_mega(P, 0, NPHASE, stream);
#else
    for (int k = 0; k < NPHASE; ++k) { if ((FAST_MASK >> k) & 1u) { launch_mega(P, k, k + 1, stream);
#ifdef DUP_MASK
            for (int rep = 0; rep < DUP_REPS; ++rep) if ((DUP_MASK >> k) & 1u) launch_mega(P, k, k + 1, stream, DUP_SUB);
#endif
        } else naive_phase(P, k, stream);
        if (k == 2 && !(HAVE_INDEX && ((FAST_MASK >> 2) & 1u))) naive_phase(P, 100, stream); }
#endif
}
```
